# Optimizing an MI355X kernel written in HIP

```python
import jax, jax.numpy as jnp
from jax import lax
import numpy as np

D_MODEL = 1024
BATCH = 16
SEQ = 2048
DEPTH = 1

CHUNK = 64
D_MIX = D_MODEL
ATTN_WIDTH = D_MIX // 2
HGRN_WIDTH = D_MIX - ATTN_WIDTH
ATTN_HEAD_DIM = 64
ATTN_HEADS = ATTN_WIDTH // ATTN_HEAD_DIM
HGRN_HEAD_DIM = 128
HGRN_HEADS = HGRN_WIDTH // HGRN_HEAD_DIM
LEFT_CHUNKS = 8
BAND = (LEFT_CHUNKS + 1) * CHUNK
REL_CLIP = 128
N_REL = 2 * REL_CLIP + 1
D_FF = 2816
RMS_EPS = 1e-6
PROJ_SIZES = (ATTN_WIDTH, ATTN_WIDTH, ATTN_WIDTH, HGRN_WIDTH, HGRN_WIDTH, HGRN_WIDTH, HGRN_WIDTH)
PROJ_COLS = sum(PROJ_SIZES)
PROJ_SPLITS = tuple(int(v) for v in np.cumsum(PROJ_SIZES)[:-1])

kernel_name = "hybrid_chunk_attn_hgrn2_macaron"


def rms_norm(x, g):
    xf = x.astype(jnp.float32)
    y = xf * lax.rsqrt(jnp.mean(xf * xf, axis=-1, keepdims=True) + RMS_EPS)
    return (y * g.astype(jnp.float32)).astype(x.dtype)


def swiglu_ffn(h, w_gate, w_up, w_down):
    return (jax.nn.silu(h @ w_gate) * (h @ w_up)) @ w_down


def chunked_band_attention(q, k, v, rel_bias):
    B, S, H, Dh = q.shape
    n_chunks = S // CHUNK
    pad = LEFT_CHUNKS * CHUNK
    k_pad = jnp.pad(k, ((0, 0), (pad, 0), (0, 0), (0, 0)))
    v_pad = jnp.pad(v, ((0, 0), (pad, 0), (0, 0), (0, 0)))
    t_pos = jnp.arange(CHUNK)[:, None] + pad
    s_pos = jnp.arange(BAND)[None, :]
    rel_idx = jnp.clip(t_pos - s_pos, -REL_CLIP, REL_CLIP) + REL_CLIP
    bias = rel_bias.astype(jnp.float32)[:, rel_idx]
    scale = Dh ** -0.5
    q_chunks = q.reshape(B, n_chunks, CHUNK, H, Dh).transpose(1, 0, 2, 3, 4)

    def one_chunk(args):
        c, qc = args
        start = c * CHUNK
        kb = lax.dynamic_slice_in_dim(k_pad, start, BAND, axis=1)
        vb = lax.dynamic_slice_in_dim(v_pad, start, BAND, axis=1)
        scores = jnp.einsum('bqhd,bkhd->bhqk', qc, kb,
                            preferred_element_type=jnp.float32) * scale + bias
        key_pos = start - pad + jnp.arange(BAND)
        scores = jnp.where((key_pos >= 0)[None, None, None, :], scores, -jnp.inf)
        p = jax.nn.softmax(scores, axis=-1)
        return jnp.einsum('bhqk,bkhd->bqhd', p.astype(vb.dtype), vb)

    out = lax.map(one_chunk, (jnp.arange(n_chunks), q_chunks))
    return out.transpose(1, 0, 2, 3, 4).reshape(B, S, H * Dh)


def hgrn2_chunkwise(q, k, v, log_f):
    B, S, H, Dk = q.shape
    Dv = v.shape[-1]
    n_chunks = S // CHUNK

    def to_chunks(a):
        return a.reshape(B, n_chunks, CHUNK, H, a.shape[-1]).transpose(1, 0, 3, 2, 4)

    qc, kc, vc, gc = to_chunks(q), to_chunks(k), to_chunks(v), to_chunks(log_f)
    causal = jnp.tril(jnp.ones((CHUNK, CHUNK), dtype=bool))[None, None, :, :, None]

    def step(state, inp):
        qi, ki, vi, gi = inp
        b = jnp.cumsum(gi, axis=2)
        diff = b[:, :, :, None, :] - b[:, :, None, :, :]
        decay = jnp.exp(jnp.where(causal, diff, -jnp.inf))
        scores = jnp.einsum('bhtk,bhsk,bhtsk->bhts', qi, ki, decay)
        o = (jnp.einsum('bhts,bhsv->bhtv', scores, vi)
             + jnp.einsum('bhtk,bhkv->bhtv', qi * jnp.exp(b), state))
        b_last = b[:, :, -1:, :]
        new_state = (state * jnp.exp(b_last[:, :, 0, :])[..., None]
                     + jnp.einsum('bhsk,bhsv->bhkv', ki * jnp.exp(b_last - b), vi))
        return new_state, o

    s0 = jnp.zeros((B, H, Dk, Dv), jnp.float32)
    _, o = lax.scan(step, s0, (qc, kc, vc, gc))
    return o.transpose(1, 0, 3, 2, 4).reshape(B, S, H, Dv)


def setup_inputs(seed: int = 0) -> dict:
    key = jax.random.key(seed)
    ks = jax.random.split(key, 20)
    f32 = jnp.float32

    def w(k, shape, fan_in):
        return jax.random.normal(k, shape, f32) * (fan_in ** -0.5)

    def gain(k, shape):
        return 1.0 + 0.05 * jax.random.normal(k, shape, f32)

    return {
        "x": jax.random.normal(ks[0], (BATCH, SEQ, D_MODEL), f32),
        "ffn1_norm_g": gain(ks[1], (DEPTH, D_MODEL)),
        "ffn1_w_gate": w(ks[2], (DEPTH, D_MODEL, D_FF), D_MODEL),
        "ffn1_w_up": w(ks[3], (DEPTH, D_MODEL, D_FF), D_MODEL),
        "ffn1_w_down": w(ks[4], (DEPTH, D_FF, D_MODEL), D_FF),
        "mix_norm_g": gain(ks[5], (DEPTH, D_MODEL)),
        "w_in": w(ks[6], (DEPTH, D_MODEL, PROJ_COLS), D_MODEL),
        "attn_q_norm_g": gain(ks[7], (DEPTH, ATTN_HEAD_DIM)),
        "attn_k_norm_g": gain(ks[8], (DEPTH, ATTN_HEAD_DIM)),
        "attn_rel_bias": 0.1 * jax.random.normal(ks[9], (DEPTH, ATTN_HEADS, N_REL), f32),
        "hgrn_lower_bounds": 0.1 * jax.random.normal(ks[10], (DEPTH + 1, HGRN_WIDTH), f32),
        "hgrn_out_norm_g": gain(ks[11], (DEPTH, HGRN_HEAD_DIM)),
        "w_out": w(ks[12], (DEPTH, D_MIX, D_MODEL), D_MIX),
        "ffn2_norm_g": gain(ks[13], (DEPTH, D_MODEL)),
        "ffn2_w_gate": w(ks[14], (DEPTH, D_MODEL, D_FF), D_MODEL),
        "ffn2_w_up": w(ks[15], (DEPTH, D_MODEL, D_FF), D_MODEL),
        "ffn2_w_down": w(ks[16], (DEPTH, D_FF, D_MODEL), D_FF),
    }


def reference(x, ffn1_norm_g, ffn1_w_gate, ffn1_w_up, ffn1_w_down, mix_norm_g, w_in,
              attn_q_norm_g, attn_k_norm_g, attn_rel_bias, hgrn_lower_bounds, hgrn_out_norm_g,
              w_out, ffn2_norm_g, ffn2_w_gate, ffn2_w_up, ffn2_w_down):
    B, S, _ = x.shape
    lb_all = jnp.cumsum(jax.nn.softmax(hgrn_lower_bounds.astype(jnp.float32), axis=0), axis=0)

    for l in range(DEPTH):
        h = rms_norm(x, ffn1_norm_g[l])
        x = x + 0.5 * swiglu_ffn(h, ffn1_w_gate[l], ffn1_w_up[l], ffn1_w_down[l])

        h = rms_norm(x, mix_norm_g[l])
        proj = h @ w_in[l]
        aq, ak, av, hq, hf, hi, hg = jnp.split(proj, PROJ_SPLITS, axis=-1)

        aq = rms_norm(aq.reshape(B, S, ATTN_HEADS, ATTN_HEAD_DIM), attn_q_norm_g[l])
        ak = rms_norm(ak.reshape(B, S, ATTN_HEADS, ATTN_HEAD_DIM), attn_k_norm_g[l])
        av = av.reshape(B, S, ATTN_HEADS, ATTN_HEAD_DIM)
        attn_out = chunked_band_attention(aq, ak, av, attn_rel_bias[l])

        lb = lb_all[l]
        f = lb + (1.0 - lb) * jax.nn.sigmoid(hf.astype(jnp.float32))
        shp = (B, S, HGRN_HEADS, HGRN_HEAD_DIM)
        rq = jax.nn.silu(hq.astype(jnp.float32)).reshape(shp)
        rk = (1.0 - f).reshape(shp)
        rv = hi.astype(jnp.float32).reshape(shp)
        ro = hgrn2_chunkwise(rq, rk, rv, jnp.log(f).reshape(shp))
        ro = rms_norm(ro, hgrn_out_norm_g[l]) * jax.nn.silu(hg.astype(jnp.float32).reshape(shp))
        hgrn_out = ro.reshape(B, S, HGRN_WIDTH).astype(x.dtype)

        x = x + jnp.concatenate([attn_out, hgrn_out], axis=-1) @ w_out[l]

        h = rms_norm(x, ffn2_norm_g[l])
        x = x + 0.5 * swiglu_ffn(h, ffn2_w_gate[l], ffn2_w_up[l], ffn2_w_down[l])
    return x
```

```cpp
#include <hip/hip_runtime.h>
#include <cstdio>
#include <cstdint>
namespace pg8 {
#define PG8_LAS __attribute__((address_space(3)))
typedef unsigned short bf16_t;
typedef short bf16x8 __attribute__((ext_vector_type(8)));
typedef float f32x4 __attribute__((ext_vector_type(4)));
typedef unsigned u32x4 __attribute__((ext_vector_type(4)));
constexpr int BM = 256, BK = 64, HALF = 128, HTB = HALF * BK * 2  , STAGE_BYTES = 8 * HTB, NXCD = 8, WGM = 8;

__host__ __device__ __forceinline__ int lds_byte(int r, int c) { const int st = (r >> 4) * 2 + (c >> 5), rr = r & 15, cc = c & 31, ob = rr * 64 + cc * 2; return st * 1024 + (ob ^ (((ob >> 9) & 1) << 5)); }
__host__ __device__ __forceinline__ void stage_rc(int b, int& R, int& C) { const int st = b / 1024, sb = b % 1024, swz = sb ^ (((sb >> 9) & 1) << 5); R = (st >> 1) * 16 + swz / 64; C = (st & 1) * 32 + (swz % 64) / 2; }
__host__ __device__ __forceinline__ int perm32(int rho) { const int n = rho >> 4, i = rho & 15; return 8 * (i >> 2) + 4 * n + (i & 3); }

struct Unit { int pm, pn; };
struct Gemm { const bf16_t* A; const bf16_t* Bt; int M, N, K; };

struct StaticOrder {
    int nM, nN, nwg, G, c;
    __host__ __device__ void init(int M, int N, int G_, int c_) { nM = M / BM; nN = N / BM; nwg = nM * nN; G = G_; c = c_; }
    __host__ __device__ bool next(int i, Unit& u) const {
        const long L = (long)i * G + c; if (L >= nwg) return false;
        int wgid = (int)L; { const int q = nwg / NXCD, r = nwg % NXCD, xcd = wgid % NXCD, off = wgid / NXCD; wgid = (xcd < r ? xcd * (q + 1) : r * (q + 1) + (xcd - r) * q) + off; }
        const int nig = WGM * nN, gid = wgid / nig, fm = gid * WGM, gsz = (nM - fm) < WGM ? (nM - fm) : WGM;
        u.pm = fm + ((wgid % nig) % gsz); u.pn = (wgid % nig) / gsz; return true;
    }
    __device__ __forceinline__ void a_ready(const Unit&) const {}
    __device__ __forceinline__ void done(const Unit&) const {}
};


typedef unsigned u32x2 __attribute__((ext_vector_type(2)));
constexpr float RMS_EPS = 1e-6f, LOG2E = 1.4426950408889634f, QSCALE = 0.125f * 1.4426950408889634f;
__device__ __forceinline__ unsigned cvt_pk_bf16(float lo, float hi) { unsigned r; asm volatile("v_cvt_pk_bf16_f32 %0, %1, %2" : "=v"(r) : "v"(lo), "v"(hi)); return r; }
__device__ __forceinline__ float fsigmoid(float x) { return __builtin_amdgcn_rcpf(1.0f + __builtin_amdgcn_exp2f(-x * LOG2E)); }
__device__ __forceinline__ float fsilu(float x) { return x * fsigmoid(x); }
__device__ __forceinline__ f32x4 silu4(f32x4 v) { return (f32x4){fsilu(v[0]), fsilu(v[1]), fsilu(v[2]), fsilu(v[3])}; }
__device__ __forceinline__ u32x4 pack8(f32x4 a, f32x4 b) { u32x4 w; w.x = cvt_pk_bf16(a[0], a[1]); w.y = cvt_pk_bf16(a[2], a[3]); w.z = cvt_pk_bf16(b[0], b[1]); w.w = cvt_pk_bf16(b[2], b[3]); return w; }
__device__ __forceinline__ float rowscale(const float* rowsq, int row) { return rowsq ? __builtin_amdgcn_rsqf(rowsq[row] * (1.0f / 1024.0f) + RMS_EPS) : 1.0f; }
template <int CTRL> __device__ __forceinline__ float dpp_mov0(float x) { return __builtin_bit_cast(float, __builtin_amdgcn_update_dpp(0, __builtin_bit_cast(int, x), CTRL, 0xf, 0xf, true)); }
__device__ __forceinline__ float row_scan16(float x) { x += dpp_mov0<0x111>(x); x += dpp_mov0<0x112>(x); x += dpp_mov0<0x114>(x); x += dpp_mov0<0x118>(x); return x; }

struct EpiSwiGLU {
    static constexpr bool PERM = false, AFTER_DRAIN = false;
    bf16_t* H; int ldh; const float* rowsq;
    __device__ __forceinline__ void operator()(f32x4 (&acc)[2][2][4][2], const Unit& u, int wr, int wc, int fr, int fq) const {
        const int row0 = u.pm * BM + wr * 64 + fr, col0 = u.pn * HALF + wc * 32 + 8 * fq;
#pragma unroll
        for (int ai = 0; ai < 2; ++ai)
#pragma unroll
            for (int m = 0; m < 4; ++m) { const int row = row0 + ai * HALF + m * 16; const float r = rowscale(rowsq, row);
                const f32x4 h0 = silu4(acc[ai][0][m][0] * r) * (acc[ai][1][m][0] * r), h1 = silu4(acc[ai][0][m][1] * r) * (acc[ai][1][m][1] * r);
                *(u32x4*)(H + (size_t)row * ldh + col0) = pack8(h0, h1); }
    }
};
template <bool WB> struct EpiRes {
    static constexpr bool PERM = false, AFTER_DRAIN = false;
    const float* base; float* out; bf16_t* xb; float* rowsq; float scale;
    __device__ __forceinline__ void operator()(f32x4 (&acc)[2][2][4][2], const Unit& u, int wr, int wc, int fr, int fq) const {
        const int row0 = u.pm * BM + wr * 64 + fr, col0 = u.pn * BM + wc * 32 + 4 * fq;
#pragma unroll
        for (int ai = 0; ai < 2; ++ai)
#pragma unroll
            for (int m = 0; m < 4; ++m) { const int row = row0 + ai * HALF + m * 16; const size_t off = (size_t)row * 1024 + col0; float ss = 0.f;
#pragma unroll
                for (int bj = 0; bj < 2; ++bj)
#pragma unroll
                    for (int n = 0; n < 2; ++n) { const size_t o = off + bj * HALF + n * 16; const f32x4 v = *(const f32x4*)(base + o) + acc[ai][bj][m][n] * scale; *(f32x4*)(out + o) = v;
                        if (WB) { u32x2 w; w.x = cvt_pk_bf16(v[0], v[1]); w.y = cvt_pk_bf16(v[2], v[3]); *(u32x2*)(xb + o) = w; ss += (v[0] * v[0] + v[1] * v[1]) + (v[2] * v[2] + v[3] * v[3]); } }
                if (WB) { ss += __shfl_xor(ss, 16); ss += __shfl_xor(ss, 32); if (fq == 0) __hip_atomic_fetch_add(rowsq + row, ss, __ATOMIC_RELAXED, __HIP_MEMORY_SCOPE_AGENT); }
                asm volatile("" ::: "memory"); }
    }
};
struct EpiWin {
    static constexpr bool PERM = false, AFTER_DRAIN = false;
    bf16_t *Q, *K, *QT, *KT, *G; float *DM, *DE; const float *rowsq, *gq, *gk, *lb;
    __device__ __forceinline__ void operator()(f32x4 (&acc)[2][2][4][2], const Unit& u, int wr, int wc, int fr, int fq) const {
        const int row0 = u.pm * BM + wr * 64 + fr, t = u.pn;
        if (t < 4) {
            const bool isq = t < 2; const int head = 4 * (t & 1) + wc; const float* gp = isq ? gq : gk; const float gs = isq ? QSCALE : 1.0f;
            f32x4 gv[2][2];
#pragma unroll
            for (int bj = 0; bj < 2; ++bj)
#pragma unroll
                for (int n = 0; n < 2; ++n) gv[bj][n] = *(const f32x4*)(gp + 32 * bj + 8 * fq + 4 * n) * gs;
            bf16_t* dst = (isq ? Q : K) + head * 64 + 8 * fq;
#pragma unroll
            for (int ai = 0; ai < 2; ++ai)
#pragma unroll
                for (int m = 0; m < 4; ++m) { const int row = row0 + ai * HALF + m * 16; const float r = rowscale(rowsq, row); float ss = 0.f;
#pragma unroll
                    for (int bj = 0; bj < 2; ++bj)
#pragma unroll
                        for (int n = 0; n < 2; ++n) { const f32x4 v = acc[ai][bj][m][n] * r; acc[ai][bj][m][n] = v; ss += (v[0] * v[0] + v[1] * v[1]) + (v[2] * v[2] + v[3] * v[3]); }
                    ss += __shfl_xor(ss, 16); ss += __shfl_xor(ss, 32);
                    const float inv = __builtin_amdgcn_rsqf(ss * (1.0f / 64.0f) + RMS_EPS);
#pragma unroll
                    for (int bj = 0; bj < 2; ++bj) *(u32x4*)(dst + (size_t)row * 512 + 32 * bj) = pack8(acc[ai][bj][m][0] * inv * gv[bj][0], acc[ai][bj][m][1] * inv * gv[bj][1]); }
        } else if (t < 8) {
            const int hh = t - 4, kbase = hh * 128 + wc * 32 + 8 * fq;
            float lbv[8]; { const f32x4 l0 = *(const f32x4*)(lb + kbase), l1 = *(const f32x4*)(lb + kbase + 4);
#pragma unroll
                for (int c = 0; c < 4; ++c) { lbv[c] = l0[c]; lbv[4 + c] = l1[c]; } }
            const int lane = fq * 16 + fr;
#pragma unroll
            for (int ai = 0; ai < 2; ++ai)
#pragma unroll
                for (int n = 0; n < 2; ++n) {
                    float omf[4][4], carry[4], bmid[4];
#pragma unroll
                    for (int m = 0; m < 4; ++m) { const int row = row0 + ai * HALF + m * 16; const float r = rowscale(rowsq, row);
#pragma unroll
                        for (int c = 0; c < 4; ++c) { const int e = 4 * n + c; const float a = acc[ai][0][m][n][c] * r, b = acc[ai][1][m][n][c] * r;
                            const float sg = fsigmoid(b), f = lbv[e] + (1.0f - lbv[e]) * sg; omf[m][c] = (1.0f - lbv[e]) * (1.0f - sg);
                            acc[ai][1][m][n][c] = __builtin_amdgcn_logf(f);
                            acc[ai][0][m][n][c] = fsilu(a); } }
#pragma unroll
                    for (int c = 0; c < 4; ++c) { carry[c] = 0.f; bmid[c] = 0.f; }
#pragma unroll
                    for (int m = 0; m < 4; ++m)
#pragma unroll
                        for (int c = 0; c < 4; ++c) { float x = row_scan16(acc[ai][1][m][n][c]) + carry[c]; acc[ai][1][m][n][c] = x;
                            carry[c] = __shfl(x, lane | 15); if (m == 1) bmid[c] = carry[c]; }
#pragma unroll
                    for (int m = 0; m < 4; ++m) { const int row = row0 + ai * HALF + m * 16; f32x4 qv, kv;
#pragma unroll
                        for (int c = 0; c < 4; ++c) { const float d = acc[ai][1][m][n][c] - bmid[c];
                            qv[c] = acc[ai][0][m][n][c] * __builtin_amdgcn_exp2f(d); kv[c] = omf[m][c] * __builtin_amdgcn_exp2f(-d); }
                        u32x2 wq, wk; wq.x = cvt_pk_bf16(qv[0], qv[1]); wq.y = cvt_pk_bf16(qv[2], qv[3]); wk.x = cvt_pk_bf16(kv[0], kv[1]); wk.y = cvt_pk_bf16(kv[2], kv[3]);
                        *(u32x2*)(QT + (size_t)row * 512 + kbase + 4 * n) = wq; *(u32x2*)(KT + (size_t)row * 512 + kbase + 4 * n) = wk; }
                    if (fr == 0) { const int chunk = (u.pm * BM + ai * HALF + wr * 64) >> 6; f32x4 a0, e0;
#pragma unroll
                        for (int c = 0; c < 4; ++c) { a0[c] = __builtin_amdgcn_exp2f(bmid[c]); e0[c] = __builtin_amdgcn_exp2f(carry[c] - bmid[c]); }
                        *(f32x4*)(DM + (size_t)chunk * 512 + kbase + 4 * n) = a0; *(f32x4*)(DE + (size_t)chunk * 512 + kbase + 4 * n) = e0; }
                    asm volatile("" ::: "memory");
                }
        } else {
            bf16_t* dst = G + (t - 8) * 256 + wc * 32 + 8 * fq;
#pragma unroll
            for (int ai = 0; ai < 2; ++ai)
#pragma unroll
                for (int m = 0; m < 4; ++m) { const int row = row0 + ai * HALF + m * 16; const float r = rowscale(rowsq, row);
#pragma unroll
                    for (int bj = 0; bj < 2; ++bj) *(u32x4*)(dst + (size_t)row * 512 + bj * HALF) = pack8(silu4(acc[ai][bj][m][0] * r), silu4(acc[ai][bj][m][1] * r)); }
        }
    }
};
struct EpiVT {
    static constexpr bool PERM = true, AFTER_DRAIN = false;
    bf16_t *VT, *VHT; const float* rowsq;
    __device__ __forceinline__ void operator()(f32x4 (&acc)[2][2][4][2], const Unit& u, int wr, int wc, int fr, int fq) const {
        const int ch0 = (u.pm & 1) * BM + wr * 64 + fr, tok0 = u.pn * BM + wc * 32 + 8 * fq, b = tok0 >> 11, s0 = tok0 & 2047;
        f32x4 rs[2][2];
#pragma unroll
        for (int bj = 0; bj < 2; ++bj)
#pragma unroll
            for (int n = 0; n < 2; ++n) { const f32x4 q = *(const f32x4*)(rowsq + tok0 + bj * HALF + 4 * n);
#pragma unroll
                for (int c = 0; c < 4; ++c) rs[bj][n][c] = __builtin_amdgcn_rsqf(q[c] * (1.0f / 1024.0f) + RMS_EPS); }
        bf16_t* dst = (u.pm < 2 ? VT : VHT) + (size_t)b * 512 * 2048 + s0;
#pragma unroll
        for (int ai = 0; ai < 2; ++ai)
#pragma unroll
            for (int m = 0; m < 4; ++m) { const int ch = ch0 + ai * HALF + m * 16;
#pragma unroll
                for (int bj = 0; bj < 2; ++bj) *(u32x4*)(dst + (size_t)ch * 2048 + bj * HALF) = pack8(acc[ai][bj][m][0] * rs[bj][0], acc[ai][bj][m][1] * rs[bj][1]); }
    }
};

template <class Epi, class Sched, bool ALIGN_EPI = false, bool SP2 = false>
__device__ __forceinline__ void gemm_phase(PG8_LAS unsigned char* lds, const Gemm g, const Sched& S, const Epi& E) {
    const int tid = threadIdx.x, wid = __builtin_amdgcn_readfirstlane(tid >> 6), lane = tid & 63, wr = wid >> 2, wc = wid & 3, fr = lane & 15, fq = lane >> 4;
    const int K = g.K, nt = K / BK;
    unsigned voffA[2], voffB[2];
#pragma unroll
    for (int i = 0; i < 2; ++i) { int R, C; stage_rc(tid * 16 + i * 8192, R, C); const int Rb = Epi::PERM ? ((R & ~31) + perm32(R & 31)) : R;
        voffA[i] = (unsigned)(R * K + C) * 2u; voffB[i] = (unsigned)(Rb * K + C) * 2u; }
    const size_t kstep = (size_t)(BK * 2);
    const size_t hstep = (size_t)HALF * K * 2;
    const size_t tstep = 2 * hstep;
    const unsigned ldsw = (unsigned)wid * 1024u;
    const int aoff = lds_byte(wr * 64 + fr, fq * 8), boff = lds_byte(wc * 32 + fr, fq * 8);
#define PG8_SA(b, h) (((b) * 2 + (h)) * HTB)
#define PG8_SB(b, h) ((4 + (b) * 2 + (h)) * HTB)
#define PG8_STAGE(bufoff, gbase, voff) do { _Pragma("unroll") for (int _i = 0; _i < 2; ++_i) \
        __builtin_amdgcn_global_load_lds((const unsigned*)((const char*)(gbase) + (voff)[_i]), (PG8_LAS unsigned*)(lds + (bufoff) + ldsw + _i * 8192), 16, 0, 0); } while (0)
#define PG8_LDA(dst, b, h) do { _Pragma("unroll") for (int m = 0; m < 4; ++m) _Pragma("unroll") for (int k = 0; k < 2; ++k) dst[m][k] = *(const PG8_LAS bf16x8*)(lds + PG8_SA(b, h) + aoff + m * 2048 + k * 1024); } while (0)
#define PG8_LDB(dst, b, h) do { _Pragma("unroll") for (int n = 0; n < 2; ++n) _Pragma("unroll") for (int k = 0; k < 2; ++k) dst[n][k] = *(const PG8_LAS bf16x8*)(lds + PG8_SB(b, h) + boff + n * 2048 + k * 1024); } while (0)
#define PG8_MMA(ai, bj, At, Bt) do { __builtin_amdgcn_s_setprio(1); _Pragma("unroll") for (int m = 0; m < 4; ++m) _Pragma("unroll") for (int n = 0; n < 2; ++n) _Pragma("unroll") for (int k = 0; k < 2; ++k) \
        acc[ai][bj][m][n] = __builtin_amdgcn_mfma_f32_16x16x32_bf16(Bt[n][k], At[m][k], acc[ai][bj][m][n], 0, 0, 0); __builtin_amdgcn_s_setprio(0); } while (0)
#define PG8_WAIT_V(n) asm volatile("s_waitcnt vmcnt(" #n ")" ::: "memory")
#define PG8_WAIT_L(n) asm volatile("s_waitcnt lgkmcnt(" #n ")" ::: "memory")
#define PG8_BAR __builtin_amdgcn_s_barrier()
#define PG8_SCHED __builtin_amdgcn_sched_barrier(0)
    Unit cur, nxt; int ui = 0;
    if (!S.next(0, cur)) return;
    f32x4 acc[2][2][4][2];
#pragma unroll
    for (int a = 0; a < 2; ++a)
#pragma unroll
        for (int b = 0; b < 2; ++b)
#pragma unroll
            for (int m = 0; m < 4; ++m)
#pragma unroll
                for (int n = 0; n < 2; ++n) acc[a][b][m][n] = (f32x4){0.f, 0.f, 0.f, 0.f};
    bf16x8 At[4][2], B0[2][2], B1[2][2];
    const char* cA = (const char*)g.A + (size_t)cur.pm * tstep; const char* cB = (const char*)g.Bt + (size_t)cur.pn * tstep;
    S.a_ready(cur);
    if constexpr (SP2) {
        PG8_STAGE(PG8_SB(0, 0), cB, voffB); PG8_STAGE(PG8_SB(0, 1), cB + hstep, voffB); PG8_STAGE(PG8_SA(0, 0), cA, voffA); PG8_STAGE(PG8_SA(0, 1), cA + hstep, voffA);
        if (wr == 1) PG8_BAR;
        PG8_WAIT_V(2); PG8_BAR;
        PG8_STAGE(PG8_SB(1, 0), cB + kstep, voffB); PG8_STAGE(PG8_SA(1, 0), cA + kstep, voffA); PG8_STAGE(PG8_SB(1, 1), cB + hstep + kstep, voffB);
        PG8_WAIT_V(6); PG8_BAR;
    } else {
        PG8_STAGE(PG8_SB(0, 0), cB, voffB); PG8_STAGE(PG8_SA(0, 0), cA, voffA); PG8_STAGE(PG8_SB(0, 1), cB + hstep, voffB); PG8_STAGE(PG8_SA(0, 1), cA + hstep, voffA);
        if (wr == 1) PG8_BAR;
        PG8_WAIT_V(4); PG8_BAR;
        PG8_STAGE(PG8_SB(1, 0), cB + kstep, voffB); PG8_STAGE(PG8_SA(1, 0), cA + kstep, voffA); PG8_STAGE(PG8_SB(1, 1), cB + hstep + kstep, voffB);
        PG8_WAIT_V(6); PG8_BAR;
    }
    for (;;) {
        const bool has_next = S.next(ui + 1, nxt);
        const char* nA = has_next ? (const char*)g.A + (size_t)nxt.pm * tstep : cA; const char* nB = has_next ? (const char*)g.Bt + (size_t)nxt.pn * tstep : cB;
        for (int t = 0; t < nt; t += 2) {
            const bool last = (t == nt - 2);
            const char* a1 = cA + (size_t)(t + 1) * kstep;
            const char* a2 = last ? nA : cA + (size_t)(t + 2) * kstep; const char* b2 = last ? nB : cB + (size_t)(t + 2) * kstep;
            const char* a3 = a2 + kstep; const char* b3 = b2 + kstep;
            if (last && has_next) S.a_ready(nxt);
            if constexpr (SP2) {
            PG8_LDB(B0, 0, 0); PG8_LDB(B1, 0, 1); PG8_SCHED; PG8_LDA(At, 0, 0); PG8_STAGE(PG8_SA(1, 1), a1 + hstep, voffA);
            PG8_WAIT_V(8); PG8_WAIT_L(0); PG8_BAR; PG8_MMA(0, 0, At, B0); PG8_MMA(0, 1, At, B1); PG8_BAR; PG8_SCHED;
            PG8_LDA(At, 0, 1); PG8_STAGE(PG8_SB(0, 0), b2, voffB); PG8_STAGE(PG8_SB(0, 1), b2 + hstep, voffB); PG8_STAGE(PG8_SA(0, 0), a2, voffA);
            PG8_WAIT_V(8); PG8_WAIT_L(0); PG8_BAR; PG8_MMA(1, 0, At, B0); PG8_MMA(1, 1, At, B1); PG8_BAR; PG8_SCHED;
            PG8_LDB(B0, 1, 0); PG8_LDB(B1, 1, 1); PG8_SCHED; PG8_LDA(At, 1, 0); PG8_STAGE(PG8_SA(0, 1), a2 + hstep, voffA);
            PG8_WAIT_V(8); PG8_WAIT_L(0); PG8_BAR; PG8_MMA(0, 0, At, B0); PG8_MMA(0, 1, At, B1); PG8_BAR; PG8_SCHED;
            PG8_LDA(At, 1, 1); PG8_STAGE(PG8_SB(1, 0), b3, voffB); PG8_STAGE(PG8_SB(1, 1), b3 + hstep, voffB); PG8_STAGE(PG8_SA(1, 0), a3, voffA);
            PG8_WAIT_V(8); PG8_WAIT_L(0); PG8_BAR; PG8_MMA(1, 0, At, B0); PG8_MMA(1, 1, At, B1); PG8_BAR; PG8_SCHED;
            } else {
            PG8_LDB(B0, 0, 0); PG8_SCHED; PG8_LDA(At, 0, 0); PG8_STAGE(PG8_SA(1, 1), a1 + hstep, voffA);
            PG8_WAIT_L(8); PG8_BAR; PG8_WAIT_L(0); PG8_MMA(0, 0, At, B0); PG8_BAR; PG8_SCHED;
            PG8_LDB(B1, 0, 1); PG8_STAGE(PG8_SB(0, 0), b2, voffB);
            PG8_BAR; PG8_WAIT_L(0); PG8_MMA(0, 1, At, B1); PG8_BAR;
            PG8_LDA(At, 0, 1); PG8_STAGE(PG8_SA(0, 0), a2, voffA);
            PG8_BAR; PG8_WAIT_L(0); PG8_MMA(1, 0, At, B0); PG8_BAR; PG8_SCHED;
            PG8_STAGE(PG8_SB(0, 1), b2 + hstep, voffB);
            PG8_WAIT_V(6); PG8_BAR; PG8_MMA(1, 1, At, B1); PG8_BAR;
            PG8_LDB(B0, 1, 0); PG8_SCHED; PG8_LDA(At, 1, 0); PG8_STAGE(PG8_SA(0, 1), a2 + hstep, voffA);
            PG8_WAIT_L(8); PG8_BAR; PG8_WAIT_L(0); PG8_MMA(0, 0, At, B0); PG8_BAR; PG8_SCHED;
            PG8_LDB(B1, 1, 1); PG8_STAGE(PG8_SB(1, 0), b3, voffB);
            PG8_BAR; PG8_WAIT_L(0); PG8_MMA(0, 1, At, B1); PG8_BAR;
            PG8_LDA(At, 1, 1); PG8_STAGE(PG8_SA(1, 0), a3, voffA);
            PG8_BAR; PG8_WAIT_L(0); PG8_MMA(1, 0, At, B0); PG8_BAR; PG8_SCHED;
            PG8_STAGE(PG8_SB(1, 1), b3 + hstep, voffB);
            PG8_WAIT_V(6); PG8_BAR; PG8_MMA(1, 1, At, B1); PG8_BAR;
            }
        }
        if constexpr (ALIGN_EPI) { if (wr == 0) PG8_BAR; }
        if constexpr (!Epi::AFTER_DRAIN) { E(acc, cur, wr, wc, fr, fq); S.done(cur); }
        if (!has_next) break;
#pragma unroll
        for (int a = 0; a < 2; ++a)
#pragma unroll
            for (int b = 0; b < 2; ++b)
#pragma unroll
                for (int m = 0; m < 4; ++m)
#pragma unroll
                    for (int n = 0; n < 2; ++n) acc[a][b][m][n] = (f32x4){0.f, 0.f, 0.f, 0.f};
        cur = nxt; cA = nA; cB = nB; ++ui;
        if constexpr (ALIGN_EPI) { if (wr == 1) PG8_BAR; }
    }
    PG8_WAIT_V(0);
    if constexpr (!ALIGN_EPI) { if (wr == 0) PG8_BAR; }
    PG8_BAR;
    if constexpr (Epi::AFTER_DRAIN) { E.fused(acc, cur, wr, wc, fr, fq, lds, wid, lane); S.done(cur); }
#undef PG8_SA
#undef PG8_SB
#undef PG8_STAGE
#undef PG8_LDA
#undef PG8_LDB
#undef PG8_MMA
#undef PG8_WAIT_V
#undef PG8_WAIT_L
#undef PG8_BAR
#undef PG8_SCHED
}
}

constexpr int NWAVES = 8;
#ifndef MK_N_LAUNCHES
#define MK_N_LAUNCHES 8
#endif
constexpr int PER_PHASE = 8;
constexpr int N_LAUNCHES = MK_N_LAUNCHES;
constexpr int BATCH = 16, SEQ = 2048, D = 1024, M = BATCH * SEQ, FF = 2816, NPROJ = 3584;
constexpr int AW = 512, HW = 512, NCHUNK = SEQ / 64;
constexpr float RMS_EPS = 1e-6f, LOG2E = 1.4426950408889634f;

constexpr size_t MiB = 1u << 20;
constexpr size_t WS_CTL = 0, CTL_ZERO_BYTES = 1 * MiB;
constexpr size_t WS_RS1 = 256 * 1024, WS_RS2 = 384 * 1024;
constexpr size_t WS_LB = 1 * MiB, WS_DM = 2 * MiB, WS_DE = 3 * MiB;
constexpr size_t WS_WGU1 = 4 * MiB, WS_WD1 = 15 * MiB, WS_WIN = 21 * MiB, WS_WINT = 26 * MiB, WS_WOUT = 28 * MiB, WS_WGU2 = 30 * MiB, WS_WD2 = 41 * MiB;
constexpr size_t WS_XB = 48 * MiB;
constexpr size_t WS_MIX = 112 * MiB;
constexpr size_t WS_HID = 176 * MiB;
constexpr size_t WS_Q = 176 * MiB, WS_K = 208 * MiB, WS_VT = 240 * MiB, WS_QT = 272 * MiB, WS_KT = 304 * MiB, WS_VHT = 336 * MiB, WS_G = 368 * MiB, WS_END = 400 * MiB;
static_assert(WS_WGU1 + (size_t)2 * FF * D * 2 <= WS_WD1 && WS_WD1 + (size_t)D * FF * 2 <= WS_WIN && WS_WIN + (size_t)2560 * D * 2 <= WS_WINT && WS_WGU2 + (size_t)2 * FF * D * 2 <= WS_WD2 && WS_WD2 + (size_t)D * FF * 2 <= WS_XB, "weight map");
static_assert(WS_HID + (size_t)M * FF * 2 <= WS_END && WS_XB + (size_t)M * D * 2 <= WS_MIX && WS_MIX + (size_t)M * D * 2 <= WS_HID, "activation map");
constexpr int CW_TMO = 0, CW_CODE = 1;
constexpr int CW_BAR = 4096;
constexpr int CW_WQ = 16384;

constexpr int RING_OFF = 0, RING_BYTES = 131072;
constexpr int LDSCTL_OFF = RING_BYTES, MISC_OFF = LDSCTL_OFF + 320;
constexpr int LDS_BYTES = 147456;
static_assert(MISC_OFF + 128 <= LDS_BYTES, "LDS map");

#define GAS __attribute__((address_space(1)))
#define LAS __attribute__((address_space(3)))
typedef unsigned short bf16;
typedef unsigned v4u __attribute__((ext_vector_type(4)));
typedef float f32x4 __attribute__((ext_vector_type(4)));
typedef short bf16x8 __attribute__((ext_vector_type(8)));
typedef GAS unsigned gu32;
#define RLX_AGENT __ATOMIC_RELAXED, __HIP_MEMORY_SCOPE_AGENT
#define LDS_WAIT() asm volatile("s_waitcnt lgkmcnt(0)" ::: "memory")
#define VM_WAIT() asm volatile("s_waitcnt vmcnt(0)" ::: "memory")
__device__ __forceinline__ unsigned f2bf(float f) { unsigned u = __builtin_bit_cast(unsigned, f); return (u + 0x7fffu + ((u >> 16) & 1u)) >> 16; }
__device__ __forceinline__ unsigned pk2(float lo, float hi) { return f2bf(lo) | (f2bf(hi) << 16); }
__device__ __forceinline__ float bf2f(unsigned short h) { return __builtin_bit_cast(float, (unsigned)h << 16); }
__device__ __forceinline__ float bflo(unsigned w) { return __builtin_bit_cast(float, w << 16); }
__device__ __forceinline__ float bfhi(unsigned w) { return __builtin_bit_cast(float, w & 0xffff0000u); }

#define XB_TMO      128
#define XB_XCNT(j)  (256  + 64 * (j))
#define XB_XSUB(j)  (1280 + 64 * (j))
#define XB_XGEN(j)  (2304 + 64 * (j))
#define XB_TOP      3328
#define XB_TOPGEN   3392
#define XCD_BAR_WORDS 3456
#define XB_SPIN_CAP (1u << 18)

__device__ __forceinline__ unsigned xb_ld(unsigned* p)              { return __hip_atomic_load(p, __ATOMIC_RELAXED, __HIP_MEMORY_SCOPE_AGENT); }
__device__ __forceinline__ unsigned xb_add(unsigned* p, unsigned v) { return __hip_atomic_fetch_add(p, v, __ATOMIC_RELAXED, __HIP_MEMORY_SCOPE_AGENT); }
__device__ __forceinline__ unsigned xb_xcc_id() { return (unsigned)__builtin_amdgcn_s_getreg((3 << 11) | 20) & 0xFu; }
#define XB_SPIN(cond, bar) do { unsigned _sp = 0; while (cond) { __builtin_amdgcn_s_sleep(1); \
    if ((++_sp & 255u) == 0u) { if (xb_ld(&(bar)[XB_TMO])) break; if (_sp > XB_SPIN_CAP) { atomicAdd(&(bar)[XB_TMO], 1u); break; } } } } while (0)

struct XcdBarrier {
    unsigned* bar; unsigned x;
    volatile LAS unsigned* st;
};

__device__ __forceinline__ XcdBarrier xcd_barrier_post(unsigned* bar, volatile LAS unsigned* st) {
    XcdBarrier b; b.bar = bar; b.x = xb_xcc_id(); b.st = st;
    if (threadIdx.x == 0) (void)xb_add(&bar[XB_XCNT(b.x)], 1u);
    return b;
}
__device__ __forceinline__ void xcd_barrier_complete(unsigned* bar, unsigned x, unsigned& nloc, unsigned& nx) {
    const unsigned G = gridDim.x * gridDim.y * gridDim.z;
    unsigned sum, cnt, mine, sp = 0u;
    for (;;) {
        sum = 0u; cnt = 0u; mine = 0u;
#pragma unroll
        for (unsigned j = 0; j < 16; ++j) { const unsigned c = xb_ld(&bar[XB_XCNT(j)]); sum += c; cnt += (c > 0u) ? 1u : 0u; mine = (j == x) ? c : mine; }
        if (sum == G) break;
        __builtin_amdgcn_s_sleep(1);
        if ((++sp & 255u) == 0u) { if (xb_ld(&bar[XB_TMO])) break; if (sp > XB_SPIN_CAP) { atomicAdd(&bar[XB_TMO], 1u); break; } }
    }
    nloc = mine > 0u ? mine : 1u; nx = cnt > 0u ? cnt : 1u;
}

__device__ __forceinline__ void xcd_barrier(const XcdBarrier& b) {
    asm volatile("s_waitcnt vmcnt(0)" ::: "memory");
    __syncthreads();
    if (threadIdx.x == 0) {
        unsigned* bar = b.bar;
        __builtin_amdgcn_s_waitcnt(0);
        unsigned nloc = b.st[0], nx = b.st[1];
        if (nloc == 0u) { xcd_barrier_complete(bar, b.x, nloc, nx); b.st[0] = nloc; b.st[1] = nx; }
        const unsigned old = xb_add(&bar[XB_XSUB(b.x)], 1u);
        const unsigned gen = old / nloc;
        if (old + 1u == (gen + 1u) * nloc) {
            __builtin_amdgcn_fence(__ATOMIC_RELEASE, "agent");
            asm volatile("s_waitcnt vmcnt(0)" ::: "memory");
            const unsigned og = xb_add(&bar[XB_TOP], 1u);
            const unsigned tg = og / nx;
            if (og + 1u == (tg + 1u) * nx) xb_add(&bar[XB_TOPGEN], 1u);
            else XB_SPIN(xb_ld(&bar[XB_TOPGEN]) == tg, bar);
            __builtin_amdgcn_fence(__ATOMIC_ACQUIRE, "agent");
            xb_add(&bar[XB_XGEN(b.x)], 1u);
            asm volatile("s_waitcnt vmcnt(0)" ::: "memory");
        } else {
            XB_SPIN(xb_ld(&bar[XB_XGEN(b.x)]) == gen, bar);
            __builtin_amdgcn_fence(__ATOMIC_ACQUIRE, "agent");
            asm volatile("s_waitcnt vmcnt(0)" ::: "memory");
        }
    }
    __syncthreads();
}

struct Frame {
    LAS unsigned char* lds;
    volatile LAS unsigned* MISC;
    gu32* ctl;
    int tid, lane, wave, G;
    const float* in[17]; float* out; unsigned char* ws;
};
__device__ __forceinline__ float wave_sum(float v) {
#pragma unroll
    for (int o = 1; o < 64; o <<= 1) v += __shfl_xor(v, o);
    return v;
}
__device__ __forceinline__ int srccol(int kind, int R, int& sel) {
    sel = 0;
    if (kind == 0) return R;
    const int t = R >> 8, p = R & 255, bj = p >> 7, q = p & 127, wc = q >> 5, pr = pg8::perm32(q & 31);
    if (kind == 1) { sel = bj; return 128 * t + 32 * wc + pr; }
    if (kind == 2) {
        if (t < 2) return 64 * (4 * t + wc) + 32 * bj + pr;
        if (t < 4) return 512 + 64 * (4 * (t - 2) + wc) + 32 * bj + pr;
        if (t < 8) return (bj ? 2048 : 1536) + 128 * (t - 4) + 32 * wc + pr;
        return 3072 + 256 * (t - 8) + 128 * bj + 32 * wc + pr;
    }
    return R < 512 ? 1024 + R : 2560 + (R - 512);
}
__device__ __forceinline__ void p0_item(const float* W0, const float* W1, int K, int N, int kind, bf16* WT, const float* gain, LAS float* scr, int item, int nblk, int lane) {
    const int kb = item / nblk, nb = item % nblk, k0 = 64 * kb, R0 = 32 * nb;
    int sel; const int c = srccol(kind, R0 + (lane & 31), sel);
    const float* W = sel ? W1 : W0;
#pragma unroll 8
    for (int i = 0; i < 32; ++i) { const int kk = 2 * i + (lane >> 5); float v = W[(size_t)(k0 + kk) * N + c]; if (gain) v *= gain[k0 + kk]; scr[kk * 33 + (lane & 31)] = v; }
    LDS_WAIT(); asm volatile("" ::: "memory");
    const int c8 = lane & 7;
#pragma unroll
    for (int j = 0; j < 4; ++j) { const int n = (lane >> 3) + 8 * j; const LAS float* s = scr + (8 * c8) * 33 + n;
        v4u o; o.x = pk2(s[0 * 33], s[1 * 33]); o.y = pk2(s[2 * 33], s[3 * 33]); o.z = pk2(s[4 * 33], s[5 * 33]); o.w = pk2(s[6 * 33], s[7 * 33]);
        *(GAS v4u*)(WT + (size_t)(R0 + n) * K + k0 + 8 * c8) = o; }
    LDS_WAIT(); asm volatile("" ::: "memory");
}
__device__ __forceinline__ void rms_row_to_bf16(const float* xrow, const float* g, bf16* orow, int lane) {
    const GAS f32x4* xr = (const GAS f32x4*)xrow + lane; const GAS f32x4* gr = (const GAS f32x4*)g + lane;
    f32x4 v[4]; float s = 0.f;
#pragma unroll
    for (int j = 0; j < 4; ++j) { v[j] = xr[64 * j]; s += (v[j].x * v[j].x + v[j].y * v[j].y) + (v[j].z * v[j].z + v[j].w * v[j].w); }
    const float r = __builtin_amdgcn_rsqf(wave_sum(s) * (1.f / D) + RMS_EPS);
    GAS unsigned long long* o8 = (GAS unsigned long long*)orow + lane;
#pragma unroll
    for (int j = 0; j < 4; ++j) { const f32x4 gg = gr[64 * j]; o8[64 * j] = (unsigned long long)pk2(v[j].x * r * gg.x, v[j].y * r * gg.y) | ((unsigned long long)pk2(v[j].z * r * gg.z, v[j].w * r * gg.w) << 32); }
}
__device__ __forceinline__ void p0_prologue(Frame& F) {
    LAS float* scr = (LAS float*)(F.lds + RING_OFF + F.wave * 16384);
    const int gw = (int)blockIdx.x * NWAVES + F.wave, NGW = F.G * NWAVES;
    bf16* const ws16 = (bf16*)F.ws;
    constexpr int I_GU = (D / 64) * (2 * FF / 32), I_D = (FF / 64) * (D / 32), I_IN = (D / 64) * (2560 / 32), I_INT = (D / 64) * (1024 / 32), I_O = (D / 64) * (D / 32);
    constexpr int NITEMS = 2 * I_GU + 2 * I_D + I_IN + I_INT + I_O;
    for (int it = gw; it < NITEMS; it += NGW) {
        int r = it;
        if (r < I_GU) { p0_item(F.in[2], F.in[3], D, FF, 1, (bf16*)(F.ws + WS_WGU1), nullptr, scr, r, 2 * FF / 32, F.lane); continue; } r -= I_GU;
        if (r < I_GU) { p0_item(F.in[14], F.in[15], D, FF, 1, (bf16*)(F.ws + WS_WGU2), F.in[13], scr, r, 2 * FF / 32, F.lane); continue; } r -= I_GU;
        if (r < I_D) { p0_item(F.in[4], F.in[4], FF, D, 0, (bf16*)(F.ws + WS_WD1), nullptr, scr, r, D / 32, F.lane); continue; } r -= I_D;
        if (r < I_D) { p0_item(F.in[16], F.in[16], FF, D, 0, (bf16*)(F.ws + WS_WD2), nullptr, scr, r, D / 32, F.lane); continue; } r -= I_D;
        if (r < I_IN) { p0_item(F.in[6], F.in[6], D, NPROJ, 2, (bf16*)(F.ws + WS_WIN), F.in[5], scr, r, 2560 / 32, F.lane); continue; } r -= I_IN;
        if (r < I_INT) { p0_item(F.in[6], F.in[6], D, NPROJ, 3, (bf16*)(F.ws + WS_WINT), F.in[5], scr, r, 1024 / 32, F.lane); continue; } r -= I_INT;
        p0_item(F.in[12], F.in[12], D, D, 0, (bf16*)(F.ws + WS_WOUT), nullptr, scr, r, D / 32, F.lane);
    }
    (void)ws16;
    for (int m = gw; m < M; m += NGW) rms_row_to_bf16(F.in[0] + (size_t)m * D, F.in[1], (bf16*)(F.ws + WS_XB) + (size_t)m * D, F.lane);
    if (blockIdx.x == 0) {
        const float l0 = F.in[10][F.tid], l1 = F.in[10][512 + F.tid], mx = fmaxf(l0, l1), e0 = __expf(l0 - mx), e1 = __expf(l1 - mx);
        ((float*)(F.ws + WS_LB))[F.tid] = e0 / (e0 + e1);
    }
}

__device__ __forceinline__ void attn_naive(Frame& F) {
    const bf16* Q = (const bf16*)(F.ws + WS_Q); const bf16* Kp = (const bf16*)(F.ws + WS_K); const bf16* VT = (const bf16*)(F.ws + WS_VT); bf16* MIX = (bf16*)(F.ws + WS_MIX);
    const float* bias = F.in[9];
    const int gw = (int)blockIdx.x * NWAVES + F.wave, NGW = F.G * NWAVES, lane = F.lane;
    int z; asm volatile("v_mov_b32 %0, 0" : "=v"(z));
    for (int item = gw; item < BATCH * NCHUNK * 8; item += NGW) {
        const int h = item & 7, c = (item >> 3) & 31, b = item >> 8, t = 64 * c + lane; const size_t row = (size_t)b * SEQ + t;
        float q[64], o[64];
#pragma unroll
        for (int i = 0; i < 8; ++i) { const v4u w = *(const v4u*)(Q + row * 512 + h * 64 + 8 * i);
            q[8 * i + 0] = bflo(w.x); q[8 * i + 1] = bfhi(w.x); q[8 * i + 2] = bflo(w.y); q[8 * i + 3] = bfhi(w.y); q[8 * i + 4] = bflo(w.z); q[8 * i + 5] = bfhi(w.z); q[8 * i + 6] = bflo(w.w); q[8 * i + 7] = bfhi(w.w); }
#pragma unroll
        for (int d = 0; d < 64; ++d) o[d] = 0.f;
        float mx = -INFINITY, l = 0.f;
        const int j0 = c >= 8 ? 64 * (c - 8) : 0, j1 = 64 * c + 63;
        for (int j = j0; j <= j1; ++j) {
            const bf16* kp = Kp + ((size_t)b * SEQ + j) * 512 + h * 64 + z;
            float s = 0.f;
#pragma unroll
            for (int i = 0; i < 8; ++i) { const v4u w = *(const v4u*)(kp + 8 * i);
                s += q[8 * i + 0] * bflo(w.x) + q[8 * i + 1] * bfhi(w.x) + q[8 * i + 2] * bflo(w.y) + q[8 * i + 3] * bfhi(w.y) + q[8 * i + 4] * bflo(w.z) + q[8 * i + 5] * bfhi(w.z) + q[8 * i + 6] * bflo(w.w) + q[8 * i + 7] * bfhi(w.w); }
            int rel = t - j; rel = rel < -128 ? -128 : (rel > 128 ? 128 : rel);
            s += bias[h * 257 + rel + 128] * LOG2E;
            const float mn = fmaxf(mx, s), a = __builtin_amdgcn_exp2f(mx - mn), p = __builtin_amdgcn_exp2f(s - mn);
            l = l * a + p; mx = mn;
            const bf16* vp = VT + ((size_t)b * 512 + h * 64) * SEQ + j + z;
#pragma unroll
            for (int d = 0; d < 64; ++d) o[d] = o[d] * a + p * bf2f(vp[(size_t)d * SEQ]);
        }
        const float inv = 1.0f / l;
#pragma unroll
        for (int i = 0; i < 8; ++i) { v4u w; w.x = pk2(o[8 * i] * inv, o[8 * i + 1] * inv); w.y = pk2(o[8 * i + 2] * inv, o[8 * i + 3] * inv); w.z = pk2(o[8 * i + 4] * inv, o[8 * i + 5] * inv); w.w = pk2(o[8 * i + 6] * inv, o[8 * i + 7] * inv);
            *(v4u*)(MIX + row * 1024 + h * 64 + 8 * i) = w; }
    }
}
__device__ __forceinline__ void hgrn_naive(Frame& F) {
    if (blockIdx.x >= 16) return;
    const bf16* QT = (const bf16*)(F.ws + WS_QT); const bf16* KT = (const bf16*)(F.ws + WS_KT); const bf16* VHT = (const bf16*)(F.ws + WS_VHT); const bf16* Gt = (const bf16*)(F.ws + WS_G);
    const float* DM = (const float*)(F.ws + WS_DM); const float* DE = (const float*)(F.ws + WS_DE); bf16* MIX = (bf16*)(F.ws + WS_MIX);
    LAS float* red = (LAS float*)(F.lds + RING_OFF);
    const int g4 = F.tid >> 7, bh = (int)blockIdx.x * 4 + g4, b = bh >> 2, hh = bh & 3, v = F.tid & 127;
    int z; asm volatile("v_mov_b32 %0, 0" : "=v"(z));
    const float gout = F.in[11][v];
    float T[128];
#pragma unroll
    for (int k = 0; k < 128; ++k) T[k] = 0.f;
    for (int c = 0; c < NCHUNK; ++c) {
        const int chunk = b * NCHUNK + c;
        if (c > 0) {
            const float* de = DE + (size_t)(chunk - 1) * 512 + hh * 128 + z; const float* dm = DM + (size_t)chunk * 512 + hh * 128 + z;
#pragma unroll
            for (int k = 0; k < 128; k += 4) { const f32x4 a = *(const f32x4*)(de + k), e = *(const f32x4*)(dm + k); T[k] *= a[0] * e[0]; T[k + 1] *= a[1] * e[1]; T[k + 2] *= a[2] * e[2]; T[k + 3] *= a[3] * e[3]; }
        }
        for (int tt = 0; tt < 64; ++tt) {
            const int t = 64 * c + tt; const size_t row = (size_t)b * SEQ + t;
            const float vv = bf2f(VHT[((size_t)b * 512 + hh * 128 + v) * SEQ + t]);
            const bf16* qp = QT + row * 512 + hh * 128 + z; const bf16* kp = KT + row * 512 + hh * 128 + z;
            float o = 0.f;
#pragma unroll
            for (int i = 0; i < 16; ++i) { const v4u kw = *(const v4u*)(kp + 8 * i), qw = *(const v4u*)(qp + 8 * i);
                T[8 * i + 0] += bflo(kw.x) * vv; o += T[8 * i + 0] * bflo(qw.x); T[8 * i + 1] += bfhi(kw.x) * vv; o += T[8 * i + 1] * bfhi(qw.x);
                T[8 * i + 2] += bflo(kw.y) * vv; o += T[8 * i + 2] * bflo(qw.y); T[8 * i + 3] += bfhi(kw.y) * vv; o += T[8 * i + 3] * bfhi(qw.y);
                T[8 * i + 4] += bflo(kw.z) * vv; o += T[8 * i + 4] * bflo(qw.z); T[8 * i + 5] += bfhi(kw.z) * vv; o += T[8 * i + 5] * bfhi(qw.z);
                T[8 * i + 6] += bflo(kw.w) * vv; o += T[8 * i + 6] * bflo(qw.w); T[8 * i + 7] += bfhi(kw.w) * vv; o += T[8 * i + 7] * bfhi(qw.w); }
            const float s = wave_sum(o * o);
            if (F.lane == 0) red[F.wave] = s;
            __syncthreads();
            const float tot = red[2 * g4] + red[2 * g4 + 1];
            __syncthreads();
            const float y = o * __builtin_amdgcn_rsqf(tot * (1.0f / 128.0f) + RMS_EPS) * gout * bf2f(Gt[row * 512 + hh * 128 + v]);
            MIX[row * 1024 + 512 + hh * 128 + v] = (bf16)f2bf(y);
        }
    }
}

struct Args { const float* in[17]; float* out; unsigned char* ws; int ph_lo, ph_hi, li, pad; };
__global__ void __launch_bounds__(NWAVES * 64, 2) mega_fwd(Args args) {
    extern __shared__ __attribute__((aligned(16))) unsigned char lds[];
    Frame F;
    F.lds = (LAS unsigned char*)lds;
    F.MISC = (volatile LAS unsigned*)(F.lds + MISC_OFF);
    F.tid = threadIdx.x; F.lane = F.tid & 63; F.wave = __builtin_amdgcn_readfirstlane(F.tid >> 6);
    F.G = gridDim.x;
#pragma unroll
    for (int i = 0; i < 17; ++i) F.in[i] = args.in[i];
    F.out = args.out; F.ws = args.ws;
    F.ctl = (gu32*)(args.ws + WS_CTL);
    for (int u = F.tid; u < (LDS_BYTES - LDSCTL_OFF) / 4; u += NWAVES * 64) ((LAS unsigned*)(F.lds + LDSCTL_OFF))[u] = 0u;
    __syncthreads();
    XcdBarrier bar; bar.bar = (unsigned*)(F.ctl + CW_BAR); bar.x = 0; bar.st = nullptr;
    if (N_LAUNCHES != PER_PHASE) bar = xcd_barrier_post((unsigned*)(F.ctl + CW_BAR), F.MISC + 8);
#define GRID_BAR(seam) do { if (N_LAUNCHES == PER_PHASE) { if (F.tid == 0) __hip_atomic_store(F.ctl + CW_TMO, 0xBADBA0u | (unsigned)(seam), RLX_AGENT); } else { xcd_barrier(bar); } } while (0)
    const int lo = args.ph_lo, hi = args.ph_hi;
#define IN(k) (lo <= (k) && (k) < hi)
#define BOTH(k) (IN(k) && IN((k) + 1))
    bf16* const XB = (bf16*)(F.ws + WS_XB); bf16* const HID = (bf16*)(F.ws + WS_HID); bf16* const MIXp = (bf16*)(F.ws + WS_MIX);
    float* const RS1 = (float*)(F.ws + WS_RS1); float* const RS2 = (float*)(F.ws + WS_RS2);

    if (IN(0)) { p0_prologue(F); if (BOTH(0)) GRID_BAR(0); }
    if (IN(1)) {
        pg8::Gemm g{XB, (const bf16*)(F.ws + WS_WGU1), M, 2 * FF, D}; pg8::StaticOrder S; S.init(M, 2 * FF, F.G, (int)blockIdx.x);
        pg8::EpiSwiGLU E{HID, FF, nullptr};
        pg8::gemm_phase<pg8::EpiSwiGLU, pg8::StaticOrder, true, true>(F.lds + RING_OFF, g, S, E);
        if (BOTH(1)) GRID_BAR(1);
    }
    if (IN(2)) {
        pg8::Gemm g{HID, (const bf16*)(F.ws + WS_WD1), M, D, FF}; pg8::StaticOrder S; S.init(M, D, F.G, (int)blockIdx.x);
        pg8::EpiRes<true> E{F.in[0], F.out, XB, RS1, 0.5f};
        pg8::gemm_phase<pg8::EpiRes<true>, pg8::StaticOrder, true, true>(F.lds + RING_OFF, g, S, E);
        if (BOTH(2)) GRID_BAR(2);
    }
    if (IN(3)) {
        { pg8::Gemm g{XB, (const bf16*)(F.ws + WS_WIN), M, 2560, D}; pg8::StaticOrder S; S.init(M, 2560, F.G, (int)blockIdx.x);
          pg8::EpiWin E{(bf16*)(F.ws + WS_Q), (bf16*)(F.ws + WS_K), (bf16*)(F.ws + WS_QT), (bf16*)(F.ws + WS_KT), (bf16*)(F.ws + WS_G), (float*)(F.ws + WS_DM), (float*)(F.ws + WS_DE), RS1, F.in[7], F.in[8], (const float*)(F.ws + WS_LB)};
          pg8::gemm_phase<pg8::EpiWin, pg8::StaticOrder, true, true>(F.lds + RING_OFF, g, S, E); }
        { pg8::Gemm g{(const bf16*)(F.ws + WS_WINT), XB, 1024, M, D}; pg8::StaticOrder S; S.init(1024, M, F.G, (int)blockIdx.x);
          pg8::EpiVT E{(bf16*)(F.ws + WS_VT), (bf16*)(F.ws + WS_VHT), RS1};
          pg8::gemm_phase<pg8::EpiVT, pg8::StaticOrder, true, true>(F.lds + RING_OFF, g, S, E); }
        if (BOTH(3)) GRID_BAR(3);
    }
    if (IN(4)) {
        hgrn_naive(F);
        attn_naive(F);
        if (BOTH(4)) GRID_BAR(4);
    }
    if (IN(5)) {
        pg8::Gemm g{MIXp, (const bf16*)(F.ws + WS_WOUT), M, D, D}; pg8::StaticOrder S; S.init(M, D, F.G, (int)blockIdx.x);
        pg8::EpiRes<true> E{F.out, F.out, XB, RS2, 1.0f};
        pg8::gemm_phase<pg8::EpiRes<true>, pg8::StaticOrder, true, true>(F.lds + RING_OFF, g, S, E);
        if (BOTH(5)) GRID_BAR(5);
    }
    if (IN(6)) {
        pg8::Gemm g{XB, (const bf16*)(F.ws + WS_WGU2), M, 2 * FF, D}; pg8::StaticOrder S; S.init(M, 2 * FF, F.G, (int)blockIdx.x);
        pg8::EpiSwiGLU E{HID, FF, RS2};
        pg8::gemm_phase<pg8::EpiSwiGLU, pg8::StaticOrder, true, true>(F.lds + RING_OFF, g, S, E);
        if (BOTH(6)) GRID_BAR(6);
    }
    if (IN(7)) {
        pg8::Gemm g{HID, (const bf16*)(F.ws + WS_WD2), M, D, FF}; pg8::StaticOrder S; S.init(M, D, F.G, (int)blockIdx.x);
        pg8::EpiRes<false> E{F.out, F.out, nullptr, nullptr, 0.5f};
        pg8::gemm_phase<pg8::EpiRes<false>, pg8::StaticOrder, true, true>(F.lds + RING_OFF, g, S, E);
    }
#undef IN
#undef BOTH
}

extern "C" void kernel_launch(void* const* d_in, const int* in_sizes, int n_in, void* d_out, int out_size, void* d_ws, size_t ws_size, hipStream_t stream) {
    static int grid = 0;
    if (grid == 0) {
        if (n_in != 17 || in_sizes[0] != M * D || out_size != M * D || ws_size < WS_END) { fprintf(stderr, "kernel_launch: unexpected shapes (n_in %d, in0 %d, out %d, ws %zu); nothing launched\n", n_in, n_in > 0 ? in_sizes[0] : -1, out_size, ws_size); grid = -1; return; }
        int dev = 0, cus = 0, per_cu = 0;
        if (hipGetDevice(&dev) != hipSuccess || hipDeviceGetAttribute(&cus, hipDeviceAttributeMultiprocessorCount, dev) != hipSuccess) { grid = -1; return; }
        if (hipFuncSetAttribute((const void*)mega_fwd, hipFuncAttributeMaxDynamicSharedMemorySize, LDS_BYTES) != hipSuccess) { fprintf(stderr, "kernel_launch: hipFuncSetAttribute failed\n"); grid = -1; return; }
        if (hipOccupancyMaxActiveBlocksPerMultiprocessor(&per_cu, (const void*)mega_fwd, NWAVES * 64, LDS_BYTES) != hipSuccess || per_cu < 1) fprintf(stderr, "kernel_launch: note: occupancy query reports %d workgroups per CU\n", per_cu);
        (void)hipGetLastError();
        grid = cus;
    }
    if (grid < 0) return;
    if (hipMemsetAsync((char*)d_ws + WS_CTL, 0, CTL_ZERO_BYTES, stream) != hipSuccess) { fprintf(stderr, "kernel_launch: hipMemsetAsync failed\n"); return; }
    Args a{};
    for (int i = 0; i < 17; ++i) a.in[i] = (const float*)d_in[i];
    a.out = (float*)d_out; a.ws = (unsigned char*)d_ws;
    for (int li = 0; li < N_LAUNCHES; ++li) {
        a.ph_lo = (N_LAUNCHES == PER_PHASE) ? li : 0; a.ph_hi = (N_LAUNCHES == PER_PHASE) ? li + 1 : PER_PHASE; a.li = li;
        hipLaunchKernelGGL(mega_fwd, dim3(grid), dim3(NWAVES * 64), LDS_BYTES, stream, a);
        const hipError_t le = hipPeekAtLastError();
        if (le != hipSuccess) { fprintf(stderr, "kernel_launch: launch %d failed: %s\n", li, hipGetErrorName(le)); break; }
    }
}
```

```cpp
#include <hip/hip_runtime.h>
#include <cstdio>
#include <cstdint>
namespace pg8 {
#define PG8_LAS __attribute__((address_space(3)))
typedef unsigned short bf16_t;
typedef short bf16x8 __attribute__((ext_vector_type(8)));
typedef float f32x4 __attribute__((ext_vector_type(4)));
typedef unsigned u32x4 __attribute__((ext_vector_type(4)));
constexpr int BM = 256, BK = 64, HALF = 128, HTB = HALF * BK * 2  , STAGE_BYTES = 8 * HTB, NXCD = 8, WGM = 8;

__host__ __device__ __forceinline__ int lds_byte(int r, int c) { const int st = (r >> 4) * 2 + (c >> 5), rr = r & 15, cc = c & 31, ob = rr * 64 + cc * 2; return st * 1024 + (ob ^ (((ob >> 9) & 1) << 5)); }
__host__ __device__ __forceinline__ void stage_rc(int b, int& R, int& C) { const int st = b / 1024, sb = b % 1024, swz = sb ^ (((sb >> 9) & 1) << 5); R = (st >> 1) * 16 + swz / 64; C = (st & 1) * 32 + (swz % 64) / 2; }
__host__ __device__ __forceinline__ int perm32(int rho) { const int n = rho >> 4, i = rho & 15; return 8 * (i >> 2) + 4 * n + (i & 3); }

struct Unit { int pm, pn; };
struct Gemm { const bf16_t* A; const bf16_t* Bt; int M, N, K; };

struct StaticOrder {
    int nM, nN, nwg, G, c;
    __host__ __device__ void init(int M, int N, int G_, int c_) { nM = M / BM; nN = N / BM; nwg = nM * nN; G = G_; c = c_; }
    __host__ __device__ bool next(int i, Unit& u) const {
        const long L = (long)i * G + c; if (L >= nwg) return false;
        int wgid = (int)L; { const int q = nwg / NXCD, r = nwg % NXCD, xcd = wgid % NXCD, off = wgid / NXCD; wgid = (xcd < r ? xcd * (q + 1) : r * (q + 1) + (xcd - r) * q) + off; }
        const int nig = WGM * nN, gid = wgid / nig, fm = gid * WGM, gsz = (nM - fm) < WGM ? (nM - fm) : WGM;
        u.pm = fm + ((wgid % nig) % gsz); u.pn = (wgid % nig) / gsz; return true;
    }
    __device__ __forceinline__ void a_ready(const Unit&) const {}
    __device__ __forceinline__ void done(const Unit&) const {}
};


typedef unsigned u32x2 __attribute__((ext_vector_type(2)));
constexpr float RMS_EPS = 1e-6f, LOG2E = 1.4426950408889634f, QSCALE = 0.125f * 1.4426950408889634f;
__device__ __forceinline__ unsigned cvt_pk_bf16(float lo, float hi) { unsigned r; asm volatile("v_cvt_pk_bf16_f32 %0, %1, %2" : "=v"(r) : "v"(lo), "v"(hi)); return r; }
__device__ __forceinline__ float fsigmoid(float x) { return __builtin_amdgcn_rcpf(1.0f + __builtin_amdgcn_exp2f(-x * LOG2E)); }
__device__ __forceinline__ float fsilu(float x) { return x * fsigmoid(x); }
__device__ __forceinline__ f32x4 silu4(f32x4 v) { return (f32x4){fsilu(v[0]), fsilu(v[1]), fsilu(v[2]), fsilu(v[3])}; }
__device__ __forceinline__ u32x4 pack8(f32x4 a, f32x4 b) { u32x4 w; w.x = cvt_pk_bf16(a[0], a[1]); w.y = cvt_pk_bf16(a[2], a[3]); w.z = cvt_pk_bf16(b[0], b[1]); w.w = cvt_pk_bf16(b[2], b[3]); return w; }
__device__ __forceinline__ float rowscale(const float* rowsq, int row) { return rowsq ? __builtin_amdgcn_rsqf(rowsq[row] * (1.0f / 1024.0f) + RMS_EPS) : 1.0f; }
template <int CTRL> __device__ __forceinline__ float dpp_mov0(float x) { return __builtin_bit_cast(float, __builtin_amdgcn_update_dpp(0, __builtin_bit_cast(int, x), CTRL, 0xf, 0xf, true)); }
__device__ __forceinline__ float row_scan16(float x) { x += dpp_mov0<0x111>(x); x += dpp_mov0<0x112>(x); x += dpp_mov0<0x114>(x); x += dpp_mov0<0x118>(x); return x; }

struct EpiSwiGLU {
    static constexpr bool PERM = false, AFTER_DRAIN = false;
    bf16_t* H; int ldh; const float* rowsq;
    __device__ __forceinline__ void operator()(f32x4 (&acc)[2][2][4][2], const Unit& u, int wr, int wc, int fr, int fq) const {
        const int row0 = u.pm * BM + wr * 64 + fr, col0 = u.pn * HALF + wc * 32 + 8 * fq;
#pragma unroll
        for (int ai = 0; ai < 2; ++ai)
#pragma unroll
            for (int m = 0; m < 4; ++m) { const int row = row0 + ai * HALF + m * 16; const float r = rowscale(rowsq, row);
                const f32x4 h0 = silu4(acc[ai][0][m][0] * r) * (acc[ai][1][m][0] * r), h1 = silu4(acc[ai][0][m][1] * r) * (acc[ai][1][m][1] * r);
                *(u32x4*)(H + (unsigned)(row * ldh + col0)) = pack8(h0, h1); }
    }
};
template <bool WB> struct EpiRes {
    static constexpr bool PERM = false, AFTER_DRAIN = false;
    const float* base; float* out; bf16_t* xb; float* rowsq; float scale;
    __device__ __forceinline__ void operator()(f32x4 (&acc)[2][2][4][2], const Unit& u, int wr, int wc, int fr, int fq) const {
        const int row0 = u.pm * BM + wr * 64 + fr, col0 = u.pn * BM + wc * 32 + 4 * fq;
#pragma unroll
        for (int ai = 0; ai < 2; ++ai)
#pragma unroll
            for (int m = 0; m < 4; ++m) { const int row = row0 + ai * HALF + m * 16; const unsigned off = (unsigned)(row * 1024 + col0); float ss = 0.f;
#pragma unroll
                for (int bj = 0; bj < 2; ++bj)
#pragma unroll
                    for (int n = 0; n < 2; ++n) { const unsigned o = off + bj * HALF + n * 16; const f32x4 v = *(const f32x4*)(base + o) + acc[ai][bj][m][n] * scale; *(f32x4*)(out + o) = v;
                        if (WB) { u32x2 w; w.x = cvt_pk_bf16(v[0], v[1]); w.y = cvt_pk_bf16(v[2], v[3]); *(u32x2*)(xb + o) = w; ss += (v[0] * v[0] + v[1] * v[1]) + (v[2] * v[2] + v[3] * v[3]); } }
                if (WB) { ss += __shfl_xor(ss, 16); ss += __shfl_xor(ss, 32); if (fq == 0) __hip_atomic_fetch_add(rowsq + row, ss, __ATOMIC_RELAXED, __HIP_MEMORY_SCOPE_AGENT); }
                asm volatile("" ::: "memory"); }
    }
};
struct EpiWin {
    static constexpr bool PERM = false, AFTER_DRAIN = false;
    bf16_t *Q, *K, *QT, *KT, *G; float *DM, *DE; const float *rowsq, *gq, *gk, *lb;
    __device__ __forceinline__ void operator()(f32x4 (&acc)[2][2][4][2], const Unit& u, int wr, int wc, int fr, int fq) const {
        const int row0 = u.pm * BM + wr * 64 + fr, t = u.pn;
        if (t < 4) {
            const bool isq = t < 2; const int head = 4 * (t & 1) + wc; const float* gp = isq ? gq : gk; const float gs = isq ? QSCALE : 1.0f;
            f32x4 gv[2][2];
#pragma unroll
            for (int bj = 0; bj < 2; ++bj)
#pragma unroll
                for (int n = 0; n < 2; ++n) gv[bj][n] = *(const f32x4*)(gp + 32 * bj + 8 * fq + 4 * n) * gs;
            bf16_t* dst = (isq ? Q : K) + head * 64 + 8 * fq;
#pragma unroll
            for (int ai = 0; ai < 2; ++ai)
#pragma unroll
                for (int m = 0; m < 4; ++m) { const int row = row0 + ai * HALF + m * 16; const float r = rowscale(rowsq, row); float ss = 0.f;
#pragma unroll
                    for (int bj = 0; bj < 2; ++bj)
#pragma unroll
                        for (int n = 0; n < 2; ++n) { const f32x4 v = acc[ai][bj][m][n] * r; acc[ai][bj][m][n] = v; ss += (v[0] * v[0] + v[1] * v[1]) + (v[2] * v[2] + v[3] * v[3]); }
                    ss += __shfl_xor(ss, 16); ss += __shfl_xor(ss, 32);
                    const float inv = __builtin_amdgcn_rsqf(ss * (1.0f / 64.0f) + RMS_EPS);
#pragma unroll
                    for (int bj = 0; bj < 2; ++bj) *(u32x4*)(dst + (unsigned)(row * 512 + 32 * bj)) = pack8(acc[ai][bj][m][0] * inv * gv[bj][0], acc[ai][bj][m][1] * inv * gv[bj][1]); }
        } else if (t < 8) {
            const int hh = t - 4, kbase = hh * 128 + wc * 32 + 8 * fq;
            float lbv[8]; { const f32x4 l0 = *(const f32x4*)(lb + kbase), l1 = *(const f32x4*)(lb + kbase + 4);
#pragma unroll
                for (int c = 0; c < 4; ++c) { lbv[c] = l0[c]; lbv[4 + c] = l1[c]; } }
            const int lane = fq * 16 + fr;
#pragma unroll
            for (int ai = 0; ai < 2; ++ai)
#pragma unroll
                for (int n = 0; n < 2; ++n) {
                    float omf[4][4], carry[4], bmid[4];
#pragma unroll
                    for (int m = 0; m < 4; ++m) { const int row = row0 + ai * HALF + m * 16; const float r = rowscale(rowsq, row);
#pragma unroll
                        for (int c = 0; c < 4; ++c) { const int e = 4 * n + c; const float a = acc[ai][0][m][n][c] * r, b = acc[ai][1][m][n][c] * r;
                            const float sg = fsigmoid(b), f = lbv[e] + (1.0f - lbv[e]) * sg; omf[m][c] = (1.0f - lbv[e]) * (1.0f - sg);
                            acc[ai][1][m][n][c] = __builtin_amdgcn_logf(f);
                            acc[ai][0][m][n][c] = fsilu(a); } }
#pragma unroll
                    for (int c = 0; c < 4; ++c) { carry[c] = 0.f; bmid[c] = 0.f; }
#pragma unroll
                    for (int m = 0; m < 4; ++m)
#pragma unroll
                        for (int c = 0; c < 4; ++c) { float x = row_scan16(acc[ai][1][m][n][c]) + carry[c]; acc[ai][1][m][n][c] = x;
                            carry[c] = __shfl(x, lane | 15); if (m == 1) bmid[c] = carry[c]; }
#pragma unroll
                    for (int m = 0; m < 4; ++m) { const int row = row0 + ai * HALF + m * 16; f32x4 qv, kv;
#pragma unroll
                        for (int c = 0; c < 4; ++c) { const float d = acc[ai][1][m][n][c] - bmid[c];
                            qv[c] = acc[ai][0][m][n][c] * __builtin_amdgcn_exp2f(d); kv[c] = omf[m][c] * __builtin_amdgcn_exp2f(-d); }
                        u32x2 wq, wk; wq.x = cvt_pk_bf16(qv[0], qv[1]); wq.y = cvt_pk_bf16(qv[2], qv[3]); wk.x = cvt_pk_bf16(kv[0], kv[1]); wk.y = cvt_pk_bf16(kv[2], kv[3]);
                        *(u32x2*)(QT + (unsigned)(row * 512 + kbase + 4 * n)) = wq; *(u32x2*)(KT + (unsigned)(row * 512 + kbase + 4 * n)) = wk; }
                    if (fr == 0) { const int chunk = (u.pm * BM + ai * HALF + wr * 64) >> 6; f32x4 a0, e0;
#pragma unroll
                        for (int c = 0; c < 4; ++c) { a0[c] = __builtin_amdgcn_exp2f(bmid[c]); e0[c] = __builtin_amdgcn_exp2f(carry[c] - bmid[c]); }
                        *(f32x4*)(DM + (unsigned)(chunk * 512 + kbase + 4 * n)) = a0; *(f32x4*)(DE + (unsigned)(chunk * 512 + kbase + 4 * n)) = e0; }
                    asm volatile("" ::: "memory");
                }
        } else {
            bf16_t* dst = G + (t - 8) * 256 + wc * 32 + 8 * fq;
#pragma unroll
            for (int ai = 0; ai < 2; ++ai)
#pragma unroll
                for (int m = 0; m < 4; ++m) { const int row = row0 + ai * HALF + m * 16; const float r = rowscale(rowsq, row);
#pragma unroll
                    for (int bj = 0; bj < 2; ++bj) *(u32x4*)(dst + (unsigned)(row * 512 + bj * HALF)) = pack8(silu4(acc[ai][bj][m][0] * r), silu4(acc[ai][bj][m][1] * r)); }
        }
    }
};
struct EpiVT {
    static constexpr bool PERM = true, AFTER_DRAIN = false;
    bf16_t *VT, *VHT; const float* rowsq;
    __device__ __forceinline__ void operator()(f32x4 (&acc)[2][2][4][2], const Unit& u, int wr, int wc, int fr, int fq) const {
        const int ch0 = (u.pm & 1) * BM + wr * 64 + fr, tok0 = u.pn * BM + wc * 32 + 8 * fq, b = tok0 >> 11, s0 = tok0 & 2047;
        f32x4 rs[2][2];
#pragma unroll
        for (int bj = 0; bj < 2; ++bj)
#pragma unroll
            for (int n = 0; n < 2; ++n) { const f32x4 q = *(const f32x4*)(rowsq + tok0 + bj * HALF + 4 * n);
#pragma unroll
                for (int c = 0; c < 4; ++c) rs[bj][n][c] = __builtin_amdgcn_rsqf(q[c] * (1.0f / 1024.0f) + RMS_EPS); }
        bf16_t* dst = (u.pm < 2 ? VT : VHT) + (size_t)b * 512 * 2048 + s0;
#pragma unroll
        for (int ai = 0; ai < 2; ++ai)
#pragma unroll
            for (int m = 0; m < 4; ++m) { const int ch = ch0 + ai * HALF + m * 16;
#pragma unroll
                for (int bj = 0; bj < 2; ++bj) *(u32x4*)(dst + (unsigned)(ch * 2048 + bj * HALF)) = pack8(acc[ai][bj][m][0] * rs[bj][0], acc[ai][bj][m][1] * rs[bj][1]); }
    }
};

template <class Epi, class Sched, bool ALIGN_EPI = false, bool SP2 = false>
__device__ __forceinline__ void gemm_phase(PG8_LAS unsigned char* lds, const Gemm g, const Sched& S, const Epi& E) {
    const int tid = threadIdx.x, wid = __builtin_amdgcn_readfirstlane(tid >> 6), lane = tid & 63, wr = wid >> 2, wc = wid & 3, fr = lane & 15, fq = lane >> 4;
    const int K = g.K, nt = K / BK;
    unsigned voffA[2], voffB[2];
#pragma unroll
    for (int i = 0; i < 2; ++i) { int R, C; stage_rc(tid * 16 + i * 8192, R, C); const int Rb = Epi::PERM ? ((R & ~31) + perm32(R & 31)) : R;
        voffA[i] = (unsigned)(R * K + C) * 2u; voffB[i] = (unsigned)(Rb * K + C) * 2u; }
    const size_t kstep = (size_t)(BK * 2);
    const size_t hstep = (size_t)HALF * K * 2;
    const size_t tstep = 2 * hstep;
    const unsigned ldsw = (unsigned)wid * 1024u;
    const int aoff = lds_byte(wr * 64 + fr, fq * 8), boff = lds_byte(wc * 32 + fr, fq * 8);
#define PG8_SA(b, h) (((b) * 2 + (h)) * HTB)
#define PG8_SB(b, h) ((4 + (b) * 2 + (h)) * HTB)
#define PG8_STAGE(bufoff, gbase, voff) do { _Pragma("unroll") for (int _i = 0; _i < 2; ++_i) \
        __builtin_amdgcn_global_load_lds((const unsigned*)((const char*)(gbase) + (voff)[_i]), (PG8_LAS unsigned*)(lds + (bufoff) + ldsw + _i * 8192), 16, 0, 0); } while (0)
#define PG8_LDA(dst, b, h) do { _Pragma("unroll") for (int m = 0; m < 4; ++m) _Pragma("unroll") for (int k = 0; k < 2; ++k) dst[m][k] = *(const PG8_LAS bf16x8*)(lds + PG8_SA(b, h) + aoff + m * 2048 + k * 1024); } while (0)
#define PG8_LDB(dst, b, h) do { _Pragma("unroll") for (int n = 0; n < 2; ++n) _Pragma("unroll") for (int k = 0; k < 2; ++k) dst[n][k] = *(const PG8_LAS bf16x8*)(lds + PG8_SB(b, h) + boff + n * 2048 + k * 1024); } while (0)
#define PG8_MMA(ai, bj, At, Bt) do { __builtin_amdgcn_s_setprio(1); _Pragma("unroll") for (int m = 0; m < 4; ++m) _Pragma("unroll") for (int n = 0; n < 2; ++n) _Pragma("unroll") for (int k = 0; k < 2; ++k) \
        acc[ai][bj][m][n] = __builtin_amdgcn_mfma_f32_16x16x32_bf16(Bt[n][k], At[m][k], acc[ai][bj][m][n], 0, 0, 0); __builtin_amdgcn_s_setprio(0); } while (0)
#define PG8_WAIT_V(n) asm volatile("s_waitcnt vmcnt(" #n ")" ::: "memory")
#define PG8_WAIT_L(n) asm volatile("s_waitcnt lgkmcnt(" #n ")" ::: "memory")
#define PG8_BAR __builtin_amdgcn_s_barrier()
#define PG8_SCHED __builtin_amdgcn_sched_barrier(0)
    Unit cur, nxt; int ui = 0;
    if (!S.next(0, cur)) return;
    f32x4 acc[2][2][4][2];
#pragma unroll
    for (int a = 0; a < 2; ++a)
#pragma unroll
        for (int b = 0; b < 2; ++b)
#pragma unroll
            for (int m = 0; m < 4; ++m)
#pragma unroll
                for (int n = 0; n < 2; ++n) acc[a][b][m][n] = (f32x4){0.f, 0.f, 0.f, 0.f};
    bf16x8 At[4][2], B0[2][2], B1[2][2];
    const char* cA = (const char*)g.A + (size_t)cur.pm * tstep; const char* cB = (const char*)g.Bt + (size_t)cur.pn * tstep;
    S.a_ready(cur);
    if constexpr (SP2) {
        PG8_STAGE(PG8_SB(0, 0), cB, voffB); PG8_STAGE(PG8_SB(0, 1), cB + hstep, voffB); PG8_STAGE(PG8_SA(0, 0), cA, voffA); PG8_STAGE(PG8_SA(0, 1), cA + hstep, voffA);
        if (wr == 1) PG8_BAR;
        PG8_WAIT_V(2); PG8_BAR;
        PG8_STAGE(PG8_SB(1, 0), cB + kstep, voffB); PG8_STAGE(PG8_SA(1, 0), cA + kstep, voffA); PG8_STAGE(PG8_SB(1, 1), cB + hstep + kstep, voffB);
        PG8_WAIT_V(6); PG8_BAR;
    } else {
        PG8_STAGE(PG8_SB(0, 0), cB, voffB); PG8_STAGE(PG8_SA(0, 0), cA, voffA); PG8_STAGE(PG8_SB(0, 1), cB + hstep, voffB); PG8_STAGE(PG8_SA(0, 1), cA + hstep, voffA);
        if (wr == 1) PG8_BAR;
        PG8_WAIT_V(4); PG8_BAR;
        PG8_STAGE(PG8_SB(1, 0), cB + kstep, voffB); PG8_STAGE(PG8_SA(1, 0), cA + kstep, voffA); PG8_STAGE(PG8_SB(1, 1), cB + hstep + kstep, voffB);
        PG8_WAIT_V(6); PG8_BAR;
    }
    for (;;) {
        const bool has_next = S.next(ui + 1, nxt);
        const char* nA = has_next ? (const char*)g.A + (size_t)nxt.pm * tstep : cA; const char* nB = has_next ? (const char*)g.Bt + (size_t)nxt.pn * tstep : cB;
        for (int t = 0; t < nt; t += 2) {
            const bool last = (t == nt - 2);
            const char* a1 = cA + (size_t)(t + 1) * kstep;
            const char* a2 = last ? nA : cA + (size_t)(t + 2) * kstep; const char* b2 = last ? nB : cB + (size_t)(t + 2) * kstep;
            const char* a3 = a2 + kstep; const char* b3 = b2 + kstep;
            if (last && has_next) S.a_ready(nxt);
            if constexpr (SP2) {
            PG8_LDB(B0, 0, 0); PG8_LDB(B1, 0, 1); PG8_SCHED; PG8_LDA(At, 0, 0); PG8_STAGE(PG8_SA(1, 1), a1 + hstep, voffA);
            PG8_WAIT_V(8); PG8_WAIT_L(0); PG8_BAR; PG8_MMA(0, 0, At, B0); PG8_MMA(0, 1, At, B1); PG8_BAR; PG8_SCHED;
            PG8_LDA(At, 0, 1); PG8_STAGE(PG8_SB(0, 0), b2, voffB); PG8_STAGE(PG8_SB(0, 1), b2 + hstep, voffB); PG8_STAGE(PG8_SA(0, 0), a2, voffA);
            PG8_WAIT_V(8); PG8_WAIT_L(0); PG8_BAR; PG8_MMA(1, 0, At, B0); PG8_MMA(1, 1, At, B1); PG8_BAR; PG8_SCHED;
            PG8_LDB(B0, 1, 0); PG8_LDB(B1, 1, 1); PG8_SCHED; PG8_LDA(At, 1, 0); PG8_STAGE(PG8_SA(0, 1), a2 + hstep, voffA);
            PG8_WAIT_V(8); PG8_WAIT_L(0); PG8_BAR; PG8_MMA(0, 0, At, B0); PG8_MMA(0, 1, At, B1); PG8_BAR; PG8_SCHED;
            PG8_LDA(At, 1, 1); PG8_STAGE(PG8_SB(1, 0), b3, voffB); PG8_STAGE(PG8_SB(1, 1), b3 + hstep, voffB); PG8_STAGE(PG8_SA(1, 0), a3, voffA);
            PG8_WAIT_V(8); PG8_WAIT_L(0); PG8_BAR; PG8_MMA(1, 0, At, B0); PG8_MMA(1, 1, At, B1); PG8_BAR; PG8_SCHED;
            } else {
            PG8_LDB(B0, 0, 0); PG8_SCHED; PG8_LDA(At, 0, 0); PG8_STAGE(PG8_SA(1, 1), a1 + hstep, voffA);
            PG8_WAIT_L(8); PG8_BAR; PG8_WAIT_L(0); PG8_MMA(0, 0, At, B0); PG8_BAR; PG8_SCHED;
            PG8_LDB(B1, 0, 1); PG8_STAGE(PG8_SB(0, 0), b2, voffB);
            PG8_BAR; PG8_WAIT_L(0); PG8_MMA(0, 1, At, B1); PG8_BAR;
            PG8_LDA(At, 0, 1); PG8_STAGE(PG8_SA(0, 0), a2, voffA);
            PG8_BAR; PG8_WAIT_L(0); PG8_MMA(1, 0, At, B0); PG8_BAR; PG8_SCHED;
            PG8_STAGE(PG8_SB(0, 1), b2 + hstep, voffB);
            PG8_WAIT_V(6); PG8_BAR; PG8_MMA(1, 1, At, B1); PG8_BAR;
            PG8_LDB(B0, 1, 0); PG8_SCHED; PG8_LDA(At, 1, 0); PG8_STAGE(PG8_SA(0, 1), a2 + hstep, voffA);
            PG8_WAIT_L(8); PG8_BAR; PG8_WAIT_L(0); PG8_MMA(0, 0, At, B0); PG8_BAR; PG8_SCHED;
            PG8_LDB(B1, 1, 1); PG8_STAGE(PG8_SB(1, 0), b3, voffB);
            PG8_BAR; PG8_WAIT_L(0); PG8_MMA(0, 1, At, B1); PG8_BAR;
            PG8_LDA(At, 1, 1); PG8_STAGE(PG8_SA(1, 0), a3, voffA);
            PG8_BAR; PG8_WAIT_L(0); PG8_MMA(1, 0, At, B0); PG8_BAR; PG8_SCHED;
            PG8_STAGE(PG8_SB(1, 1), b3 + hstep, voffB);
            PG8_WAIT_V(6); PG8_BAR; PG8_MMA(1, 1, At, B1); PG8_BAR;
            }
        }
        if constexpr (ALIGN_EPI) { if (wr == 0) PG8_BAR; }
        if constexpr (!Epi::AFTER_DRAIN) { E(acc, cur, wr, wc, fr, fq); S.done(cur); }
        if (!has_next) break;
#pragma unroll
        for (int a = 0; a < 2; ++a)
#pragma unroll
            for (int b = 0; b < 2; ++b)
#pragma unroll
                for (int m = 0; m < 4; ++m)
#pragma unroll
                    for (int n = 0; n < 2; ++n) acc[a][b][m][n] = (f32x4){0.f, 0.f, 0.f, 0.f};
        cur = nxt; cA = nA; cB = nB; ++ui;
        if constexpr (ALIGN_EPI) { if (wr == 1) PG8_BAR; }
    }
    PG8_WAIT_V(0);
    if constexpr (!ALIGN_EPI) { if (wr == 0) PG8_BAR; }
    PG8_BAR;
    if constexpr (Epi::AFTER_DRAIN) { E.fused(acc, cur, wr, wc, fr, fq, lds, wid, lane); S.done(cur); }
#undef PG8_SA
#undef PG8_SB
#undef PG8_STAGE
#undef PG8_LDA
#undef PG8_LDB
#undef PG8_MMA
#undef PG8_WAIT_V
#undef PG8_WAIT_L
#undef PG8_BAR
#undef PG8_SCHED
}
}

constexpr int NWAVES = 8;
#ifndef MK_N_LAUNCHES
#define MK_N_LAUNCHES 1
#endif
constexpr int PER_PHASE = 8;
constexpr int N_LAUNCHES = MK_N_LAUNCHES;
constexpr int BATCH = 16, SEQ = 2048, D = 1024, M = BATCH * SEQ, FF = 2816, NPROJ = 3584;
constexpr int AW = 512, HW = 512, NCHUNK = SEQ / 64;
constexpr float RMS_EPS = 1e-6f, LOG2E = 1.4426950408889634f;

constexpr size_t MiB = 1u << 20;
constexpr size_t WS_CTL = 0, CTL_ZERO_BYTES = 1 * MiB;
constexpr size_t WS_RS1 = 256 * 1024, WS_RS2 = 384 * 1024;
constexpr size_t WS_LB = 1 * MiB, WS_DM = 2 * MiB, WS_DE = 3 * MiB;
constexpr size_t WS_WGU1 = 4 * MiB, WS_WD1 = 15 * MiB, WS_WIN = 21 * MiB, WS_WINT = 26 * MiB, WS_WOUT = 28 * MiB, WS_WGU2 = 30 * MiB, WS_WD2 = 41 * MiB;
constexpr size_t WS_XB = 48 * MiB;
constexpr size_t WS_MIX = 112 * MiB;
constexpr size_t WS_HID = 176 * MiB;
constexpr size_t WS_Q = 176 * MiB, WS_K = 208 * MiB, WS_VT = 240 * MiB, WS_QT = 272 * MiB, WS_KT = 304 * MiB, WS_VHT = 336 * MiB, WS_G = 368 * MiB, WS_END = 400 * MiB;
static_assert(WS_WGU1 + (size_t)2 * FF * D * 2 <= WS_WD1 && WS_WD1 + (size_t)D * FF * 2 <= WS_WIN && WS_WIN + (size_t)2560 * D * 2 <= WS_WINT && WS_WGU2 + (size_t)2 * FF * D * 2 <= WS_WD2 && WS_WD2 + (size_t)D * FF * 2 <= WS_XB, "weight map");
static_assert(WS_HID + (size_t)M * FF * 2 <= WS_END && WS_XB + (size_t)M * D * 2 <= WS_MIX && WS_MIX + (size_t)M * D * 2 <= WS_HID, "activation map");
constexpr int CW_TMO = 0, CW_CODE = 1;
constexpr int CW_BAR = 4096;
constexpr int CW_WQ = 16384;

constexpr int RING_OFF = 0, RING_BYTES = 131072;
constexpr int LDSCTL_OFF = RING_BYTES, MISC_OFF = LDSCTL_OFF + 320;
constexpr int LDS_BYTES = 147456;
static_assert(MISC_OFF + 128 <= LDS_BYTES, "LDS map");

#define GAS __attribute__((address_space(1)))
#define LAS __attribute__((address_space(3)))
typedef unsigned short bf16;
typedef unsigned v4u __attribute__((ext_vector_type(4)));
typedef float f32x4 __attribute__((ext_vector_type(4)));
typedef short bf16x8 __attribute__((ext_vector_type(8)));
typedef GAS unsigned gu32;
#define RLX_AGENT __ATOMIC_RELAXED, __HIP_MEMORY_SCOPE_AGENT
#define LDS_WAIT() asm volatile("s_waitcnt lgkmcnt(0)" ::: "memory")
#define VM_WAIT() asm volatile("s_waitcnt vmcnt(0)" ::: "memory")
__device__ __forceinline__ unsigned f2bf(float f) { unsigned u = __builtin_bit_cast(unsigned, f); return (u + 0x7fffu + ((u >> 16) & 1u)) >> 16; }
__device__ __forceinline__ unsigned pk2(float lo, float hi) { return f2bf(lo) | (f2bf(hi) << 16); }
__device__ __forceinline__ float bf2f(unsigned short h) { return __builtin_bit_cast(float, (unsigned)h << 16); }
__device__ __forceinline__ float bflo(unsigned w) { return __builtin_bit_cast(float, w << 16); }
__device__ __forceinline__ float bfhi(unsigned w) { return __builtin_bit_cast(float, w & 0xffff0000u); }

#define XB_TMO      128
#define XB_XCNT(j)  (256  + 64 * (j))
#define XB_XSUB(j)  (1280 + 64 * (j))
#define XB_XGEN(j)  (2304 + 64 * (j))
#define XB_TOP      3328
#define XB_TOPGEN   3392
#define XCD_BAR_WORDS 3456
#define XB_SPIN_CAP (1u << 18)

__device__ __forceinline__ unsigned xb_ld(unsigned* p)              { return __hip_atomic_load(p, __ATOMIC_RELAXED, __HIP_MEMORY_SCOPE_AGENT); }
__device__ __forceinline__ unsigned xb_add(unsigned* p, unsigned v) { return __hip_atomic_fetch_add(p, v, __ATOMIC_RELAXED, __HIP_MEMORY_SCOPE_AGENT); }
__device__ __forceinline__ unsigned xb_xcc_id() { return (unsigned)__builtin_amdgcn_s_getreg((3 << 11) | 20) & 0xFu; }
#define XB_SPIN(cond, bar) do { unsigned _sp = 0; while (cond) { __builtin_amdgcn_s_sleep(1); \
    if ((++_sp & 255u) == 0u) { if (xb_ld(&(bar)[XB_TMO])) break; if (_sp > XB_SPIN_CAP) { atomicAdd(&(bar)[XB_TMO], 1u); break; } } } } while (0)

struct XcdBarrier {
    unsigned* bar; unsigned x;
    volatile LAS unsigned* st;
};

__device__ __forceinline__ XcdBarrier xcd_barrier_post(unsigned* bar, volatile LAS unsigned* st) {
    XcdBarrier b; b.bar = bar; b.x = xb_xcc_id(); b.st = st;
    if (threadIdx.x == 0) (void)xb_add(&bar[XB_XCNT(b.x)], 1u);
    return b;
}
__device__ __forceinline__ void xcd_barrier_complete(unsigned* bar, unsigned x, unsigned& nloc, unsigned& nx) {
    const unsigned G = gridDim.x * gridDim.y * gridDim.z;
    unsigned sum, cnt, mine, sp = 0u;
    for (;;) {
        sum = 0u; cnt = 0u; mine = 0u;
#pragma unroll
        for (unsigned j = 0; j < 16; ++j) { const unsigned c = xb_ld(&bar[XB_XCNT(j)]); sum += c; cnt += (c > 0u) ? 1u : 0u; mine = (j == x) ? c : mine; }
        if (sum == G) break;
        __builtin_amdgcn_s_sleep(1);
        if ((++sp & 255u) == 0u) { if (xb_ld(&bar[XB_TMO])) break; if (sp > XB_SPIN_CAP) { atomicAdd(&bar[XB_TMO], 1u); break; } }
    }
    nloc = mine > 0u ? mine : 1u; nx = cnt > 0u ? cnt : 1u;
}

__device__ __forceinline__ void xcd_barrier(const XcdBarrier& b) {
    asm volatile("s_waitcnt vmcnt(0)" ::: "memory");
    __syncthreads();
    if (threadIdx.x == 0) {
        unsigned* bar = b.bar;
        __builtin_amdgcn_s_waitcnt(0);
        unsigned nloc = b.st[0], nx = b.st[1];
        if (nloc == 0u) { xcd_barrier_complete(bar, b.x, nloc, nx); b.st[0] = nloc; b.st[1] = nx; }
        const unsigned old = xb_add(&bar[XB_XSUB(b.x)], 1u);
        const unsigned gen = old / nloc;
        if (old + 1u == (gen + 1u) * nloc) {
            __builtin_amdgcn_fence(__ATOMIC_RELEASE, "agent");
            asm volatile("s_waitcnt vmcnt(0)" ::: "memory");
            const unsigned og = xb_add(&bar[XB_TOP], 1u);
            const unsigned tg = og / nx;
            if (og + 1u == (tg + 1u) * nx) xb_add(&bar[XB_TOPGEN], 1u);
            else XB_SPIN(xb_ld(&bar[XB_TOPGEN]) == tg, bar);
            __builtin_amdgcn_fence(__ATOMIC_ACQUIRE, "agent");
            xb_add(&bar[XB_XGEN(b.x)], 1u);
            asm volatile("s_waitcnt vmcnt(0)" ::: "memory");
        } else {
            XB_SPIN(xb_ld(&bar[XB_XGEN(b.x)]) == gen, bar);
            __builtin_amdgcn_fence(__ATOMIC_ACQUIRE, "agent");
            asm volatile("s_waitcnt vmcnt(0)" ::: "memory");
        }
    }
    __syncthreads();
}

struct Frame {
    LAS unsigned char* lds;
    volatile LAS unsigned* MISC;
    gu32* ctl;
    int tid, lane, wave, G;
    const float* in[17]; float* out; unsigned char* ws;
};
__device__ __forceinline__ float wave_sum(float v) {
#pragma unroll
    for (int o = 1; o < 64; o <<= 1) v += __shfl_xor(v, o);
    return v;
}
__device__ __forceinline__ int srccol(int kind, int R, int& sel) {
    sel = 0;
    if (kind == 0) return R;
    const int t = R >> 8, p = R & 255, bj = p >> 7, q = p & 127, wc = q >> 5, pr = pg8::perm32(q & 31);
    if (kind == 1) { sel = bj; return 128 * t + 32 * wc + pr; }
    if (kind == 2) {
        if (t < 2) return 64 * (4 * t + wc) + 32 * bj + pr;
        if (t < 4) return 512 + 64 * (4 * (t - 2) + wc) + 32 * bj + pr;
        if (t < 8) return (bj ? 2048 : 1536) + 128 * (t - 4) + 32 * wc + pr;
        return 3072 + 256 * (t - 8) + 128 * bj + 32 * wc + pr;
    }
    return R < 512 ? 1024 + R : 2560 + (R - 512);
}
__device__ __forceinline__ void p0_item(const float* W0, const float* W1, int K, int N, int kind, bf16* WT, const float* gain, LAS float* scr, int item, int nblk, int lane) {
    const int kb = item / nblk, nb = item % nblk, k0 = 64 * kb, R0 = 32 * nb;
    int sel; const int c = srccol(kind, R0 + (lane & 31), sel);
    const float* W = sel ? W1 : W0;
#pragma unroll 8
    for (int i = 0; i < 32; ++i) { const int kk = 2 * i + (lane >> 5); float v = W[(size_t)(k0 + kk) * N + c]; if (gain) v *= gain[k0 + kk]; scr[kk * 33 + (lane & 31)] = v; }
    LDS_WAIT(); asm volatile("" ::: "memory");
    const int c8 = lane & 7;
#pragma unroll
    for (int j = 0; j < 4; ++j) { const int n = (lane >> 3) + 8 * j; const LAS float* s = scr + (8 * c8) * 33 + n;
        v4u o; o.x = pk2(s[0 * 33], s[1 * 33]); o.y = pk2(s[2 * 33], s[3 * 33]); o.z = pk2(s[4 * 33], s[5 * 33]); o.w = pk2(s[6 * 33], s[7 * 33]);
        *(GAS v4u*)(WT + (size_t)(R0 + n) * K + k0 + 8 * c8) = o; }
    LDS_WAIT(); asm volatile("" ::: "memory");
}
__device__ __forceinline__ void rms_row_to_bf16(const float* xrow, const float* g, bf16* orow, int lane) {
    const GAS f32x4* xr = (const GAS f32x4*)xrow + lane; const GAS f32x4* gr = (const GAS f32x4*)g + lane;
    f32x4 v[4]; float s = 0.f;
#pragma unroll
    for (int j = 0; j < 4; ++j) { v[j] = xr[64 * j]; s += (v[j].x * v[j].x + v[j].y * v[j].y) + (v[j].z * v[j].z + v[j].w * v[j].w); }
    const float r = __builtin_amdgcn_rsqf(wave_sum(s) * (1.f / D) + RMS_EPS);
    GAS unsigned long long* o8 = (GAS unsigned long long*)orow + lane;
#pragma unroll
    for (int j = 0; j < 4; ++j) { const f32x4 gg = gr[64 * j]; o8[64 * j] = (unsigned long long)pk2(v[j].x * r * gg.x, v[j].y * r * gg.y) | ((unsigned long long)pk2(v[j].z * r * gg.z, v[j].w * r * gg.w) << 32); }
}
__device__ __forceinline__ void p0_prologue(Frame& F) {
    LAS float* scr = (LAS float*)(F.lds + RING_OFF + F.wave * 16384);
    const int gw = (int)blockIdx.x * NWAVES + F.wave, NGW = F.G * NWAVES;
    bf16* const ws16 = (bf16*)F.ws;
    constexpr int I_GU = (D / 64) * (2 * FF / 32), I_D = (FF / 64) * (D / 32), I_IN = (D / 64) * (2560 / 32), I_INT = (D / 64) * (1024 / 32), I_O = (D / 64) * (D / 32);
    constexpr int NITEMS = 2 * I_GU + 2 * I_D + I_IN + I_INT + I_O;
    for (int it = gw; it < NITEMS; it += NGW) {
        int r = it;
        if (r < I_GU) { p0_item(F.in[2], F.in[3], D, FF, 1, (bf16*)(F.ws + WS_WGU1), nullptr, scr, r, 2 * FF / 32, F.lane); continue; } r -= I_GU;
        if (r < I_GU) { p0_item(F.in[14], F.in[15], D, FF, 1, (bf16*)(F.ws + WS_WGU2), F.in[13], scr, r, 2 * FF / 32, F.lane); continue; } r -= I_GU;
        if (r < I_D) { p0_item(F.in[4], F.in[4], FF, D, 0, (bf16*)(F.ws + WS_WD1), nullptr, scr, r, D / 32, F.lane); continue; } r -= I_D;
        if (r < I_D) { p0_item(F.in[16], F.in[16], FF, D, 0, (bf16*)(F.ws + WS_WD2), nullptr, scr, r, D / 32, F.lane); continue; } r -= I_D;
        if (r < I_IN) { p0_item(F.in[6], F.in[6], D, NPROJ, 2, (bf16*)(F.ws + WS_WIN), F.in[5], scr, r, 2560 / 32, F.lane); continue; } r -= I_IN;
        if (r < I_INT) { p0_item(F.in[6], F.in[6], D, NPROJ, 3, (bf16*)(F.ws + WS_WINT), F.in[5], scr, r, 1024 / 32, F.lane); continue; } r -= I_INT;
        p0_item(F.in[12], F.in[12], D, D, 0, (bf16*)(F.ws + WS_WOUT), nullptr, scr, r, D / 32, F.lane);
    }
    (void)ws16;
    for (int m = gw; m < M; m += NGW) rms_row_to_bf16(F.in[0] + (size_t)m * D, F.in[1], (bf16*)(F.ws + WS_XB) + (size_t)m * D, F.lane);
    if (blockIdx.x == 0) {
        const float l0 = F.in[10][F.tid], l1 = F.in[10][512 + F.tid], mx = fmaxf(l0, l1), e0 = __expf(l0 - mx), e1 = __expf(l1 - mx);
        ((float*)(F.ws + WS_LB))[F.tid] = e0 / (e0 + e1);
    }
}

__device__ __forceinline__ void attn_naive(Frame& F) {
    const bf16* Q = (const bf16*)(F.ws + WS_Q); const bf16* Kp = (const bf16*)(F.ws + WS_K); const bf16* VT = (const bf16*)(F.ws + WS_VT); bf16* MIX = (bf16*)(F.ws + WS_MIX);
    const float* bias = F.in[9];
    const int gw = (int)blockIdx.x * NWAVES + F.wave, NGW = F.G * NWAVES, lane = F.lane;
    int z; asm volatile("v_mov_b32 %0, 0" : "=v"(z));
    for (int item = gw; item < BATCH * NCHUNK * 8; item += NGW) {
        const int h = item & 7, c = (item >> 3) & 31, b = item >> 8, t = 64 * c + lane; const size_t row = (size_t)b * SEQ + t;
        float q[64], o[64];
#pragma unroll
        for (int i = 0; i < 8; ++i) { const v4u w = *(const v4u*)(Q + row * 512 + h * 64 + 8 * i);
            q[8 * i + 0] = bflo(w.x); q[8 * i + 1] = bfhi(w.x); q[8 * i + 2] = bflo(w.y); q[8 * i + 3] = bfhi(w.y); q[8 * i + 4] = bflo(w.z); q[8 * i + 5] = bfhi(w.z); q[8 * i + 6] = bflo(w.w); q[8 * i + 7] = bfhi(w.w); }
#pragma unroll
        for (int d = 0; d < 64; ++d) o[d] = 0.f;
        float mx = -INFINITY, l = 0.f;
        const int j0 = c >= 8 ? 64 * (c - 8) : 0, j1 = 64 * c + 63;
        for (int j = j0; j <= j1; ++j) {
            const bf16* kp = Kp + ((size_t)b * SEQ + j) * 512 + h * 64 + z;
            float s = 0.f;
#pragma unroll
            for (int i = 0; i < 8; ++i) { const v4u w = *(const v4u*)(kp + 8 * i);
                s += q[8 * i + 0] * bflo(w.x) + q[8 * i + 1] * bfhi(w.x) + q[8 * i + 2] * bflo(w.y) + q[8 * i + 3] * bfhi(w.y) + q[8 * i + 4] * bflo(w.z) + q[8 * i + 5] * bfhi(w.z) + q[8 * i + 6] * bflo(w.w) + q[8 * i + 7] * bfhi(w.w); }
            int rel = t - j; rel = rel < -128 ? -128 : (rel > 128 ? 128 : rel);
            s += bias[h * 257 + rel + 128] * LOG2E;
            const float mn = fmaxf(mx, s), a = __builtin_amdgcn_exp2f(mx - mn), p = __builtin_amdgcn_exp2f(s - mn);
            l = l * a + p; mx = mn;
            const bf16* vp = VT + ((size_t)b * 512 + h * 64) * SEQ + j + z;
#pragma unroll
            for (int d = 0; d < 64; ++d) o[d] = o[d] * a + p * bf2f(vp[(size_t)d * SEQ]);
        }
        const float inv = 1.0f / l;
#pragma unroll
        for (int i = 0; i < 8; ++i) { v4u w; w.x = pk2(o[8 * i] * inv, o[8 * i + 1] * inv); w.y = pk2(o[8 * i + 2] * inv, o[8 * i + 3] * inv); w.z = pk2(o[8 * i + 4] * inv, o[8 * i + 5] * inv); w.w = pk2(o[8 * i + 6] * inv, o[8 * i + 7] * inv);
            *(v4u*)(MIX + row * 1024 + h * 64 + 8 * i) = w; }
    }
}
__device__ __forceinline__ void hgrn_naive(Frame& F) {
    if (blockIdx.x >= 32) return;
    const bf16* QT = (const bf16*)(F.ws + WS_QT); const bf16* KT = (const bf16*)(F.ws + WS_KT); const bf16* VHT = (const bf16*)(F.ws + WS_VHT); const bf16* Gt = (const bf16*)(F.ws + WS_G);
    const float* DM = (const float*)(F.ws + WS_DM); const float* DE = (const float*)(F.ws + WS_DE); bf16* MIX = (bf16*)(F.ws + WS_MIX);
    LAS float* red = (LAS float*)(F.lds + RING_OFF);
    const int g2 = F.tid >> 8, bh = (int)blockIdx.x * 2 + g2, b = bh >> 2, hh = bh & 3, v = (F.tid & 255) >> 1, kh = F.tid & 1;
    int z; asm volatile("v_mov_b32 %0, 0" : "=v"(z));
    const float gout = F.in[11][v];
    float T[64];
#pragma unroll
    for (int k = 0; k < 64; ++k) T[k] = 0.f;
    for (int c = 0; c < NCHUNK; ++c) {
        const int chunk = b * NCHUNK + c;
        if (c > 0) {
            const float* de = DE + (size_t)(chunk - 1) * 512 + hh * 128 + 64 * kh; const float* dm = DM + (size_t)chunk * 512 + hh * 128 + 64 * kh;
#pragma unroll
            for (int k = 0; k < 64; k += 4) { const f32x4 a = *(const f32x4*)(de + k), e = *(const f32x4*)(dm + k); T[k] *= a[0] * e[0]; T[k + 1] *= a[1] * e[1]; T[k + 2] *= a[2] * e[2]; T[k + 3] *= a[3] * e[3]; }
        }
        for (int tt = 0; tt < 64; ++tt) {
            const int t = 64 * c + tt; const size_t row = (size_t)b * SEQ + t;
            const float vv = bf2f(VHT[((size_t)b * 512 + hh * 128 + v) * SEQ + t]);
            const bf16* qp = QT + row * 512 + hh * 128 + 64 * kh + z; const bf16* kp = KT + row * 512 + hh * 128 + 64 * kh + z;
            float o = 0.f;
#pragma unroll
            for (int i = 0; i < 8; ++i) { const v4u kw = *(const v4u*)(kp + 8 * i), qw = *(const v4u*)(qp + 8 * i);
                T[8 * i + 0] += bflo(kw.x) * vv; o += T[8 * i + 0] * bflo(qw.x); T[8 * i + 1] += bfhi(kw.x) * vv; o += T[8 * i + 1] * bfhi(qw.x);
                T[8 * i + 2] += bflo(kw.y) * vv; o += T[8 * i + 2] * bflo(qw.y); T[8 * i + 3] += bfhi(kw.y) * vv; o += T[8 * i + 3] * bfhi(qw.y);
                T[8 * i + 4] += bflo(kw.z) * vv; o += T[8 * i + 4] * bflo(qw.z); T[8 * i + 5] += bfhi(kw.z) * vv; o += T[8 * i + 5] * bfhi(qw.z);
                T[8 * i + 6] += bflo(kw.w) * vv; o += T[8 * i + 6] * bflo(qw.w); T[8 * i + 7] += bfhi(kw.w) * vv; o += T[8 * i + 7] * bfhi(qw.w); }
            o += __shfl_xor(o, 1);
            const float s = wave_sum(o * o) * 0.5f;
            if (F.lane == 0) red[F.wave] = s;
            __syncthreads();
            const float tot = (red[4 * g2] + red[4 * g2 + 1]) + (red[4 * g2 + 2] + red[4 * g2 + 3]);
            __syncthreads();
            const float y = o * __builtin_amdgcn_rsqf(tot * (1.0f / 128.0f) + RMS_EPS) * gout * bf2f(Gt[row * 512 + hh * 128 + v]);
            if (kh == 0) MIX[row * 1024 + 512 + hh * 128 + v] = (bf16)f2bf(y);
        }
    }
}

struct Args { const float* in[17]; float* out; unsigned char* ws; int ph_lo, ph_hi, li, pad; };
__global__ void __launch_bounds__(NWAVES * 64, 2) mega_fwd(Args args) {
    extern __shared__ __attribute__((aligned(16))) unsigned char lds[];
    Frame F;
    F.lds = (LAS unsigned char*)lds;
    F.MISC = (volatile LAS unsigned*)(F.lds + MISC_OFF);
    F.tid = threadIdx.x; F.lane = F.tid & 63; F.wave = __builtin_amdgcn_readfirstlane(F.tid >> 6);
    F.G = gridDim.x;
#pragma unroll
    for (int i = 0; i < 17; ++i) F.in[i] = args.in[i];
    F.out = args.out; F.ws = args.ws;
    F.ctl = (gu32*)(args.ws + WS_CTL);
    for (int u = F.tid; u < (LDS_BYTES - LDSCTL_OFF) / 4; u += NWAVES * 64) ((LAS unsigned*)(F.lds + LDSCTL_OFF))[u] = 0u;
    __syncthreads();
    XcdBarrier bar; bar.bar = (unsigned*)(F.ctl + CW_BAR); bar.x = 0; bar.st = nullptr;
    if (N_LAUNCHES != PER_PHASE) bar = xcd_barrier_post((unsigned*)(F.ctl + CW_BAR), F.MISC + 8);
#define GRID_BAR(seam) do { if (N_LAUNCHES == PER_PHASE) { if (F.tid == 0) __hip_atomic_store(F.ctl + CW_TMO, 0xBADBA0u | (unsigned)(seam), RLX_AGENT); } else { xcd_barrier(bar); } } while (0)
    const int lo = args.ph_lo, hi = args.ph_hi;
#define IN(k) (lo <= (k) && (k) < hi)
#define BOTH(k) (IN(k) && IN((k) + 1))
    bf16* const XB = (bf16*)(F.ws + WS_XB); bf16* const HID = (bf16*)(F.ws + WS_HID); bf16* const MIXp = (bf16*)(F.ws + WS_MIX);
    float* const RS1 = (float*)(F.ws + WS_RS1); float* const RS2 = (float*)(F.ws + WS_RS2);

    if (IN(0)) { p0_prologue(F); if (BOTH(0)) GRID_BAR(0); }
    if (IN(1)) {
        pg8::Gemm g{XB, (const bf16*)(F.ws + WS_WGU1), M, 2 * FF, D}; pg8::StaticOrder S; S.init(M, 2 * FF, F.G, (int)blockIdx.x);
        pg8::EpiSwiGLU E{HID, FF, nullptr};
        pg8::gemm_phase<pg8::EpiSwiGLU, pg8::StaticOrder, true, true>(F.lds + RING_OFF, g, S, E);
        if (BOTH(1)) GRID_BAR(1);
    }
    if (IN(2)) {
        pg8::Gemm g{HID, (const bf16*)(F.ws + WS_WD1), M, D, FF}; pg8::StaticOrder S; S.init(M, D, F.G, (int)blockIdx.x);
        pg8::EpiRes<true> E{F.in[0], F.out, XB, RS1, 0.5f};
        pg8::gemm_phase<pg8::EpiRes<true>, pg8::StaticOrder, true, true>(F.lds + RING_OFF, g, S, E);
        if (BOTH(2)) GRID_BAR(2);
    }
    if (IN(3)) {
        { pg8::Gemm g{XB, (const bf16*)(F.ws + WS_WIN), M, 2560, D}; pg8::StaticOrder S; S.init(M, 2560, F.G, (int)blockIdx.x);
          pg8::EpiWin E{(bf16*)(F.ws + WS_Q), (bf16*)(F.ws + WS_K), (bf16*)(F.ws + WS_QT), (bf16*)(F.ws + WS_KT), (bf16*)(F.ws + WS_G), (float*)(F.ws + WS_DM), (float*)(F.ws + WS_DE), RS1, F.in[7], F.in[8], (const float*)(F.ws + WS_LB)};
          pg8::gemm_phase<pg8::EpiWin, pg8::StaticOrder, true, true>(F.lds + RING_OFF, g, S, E); }
        { pg8::Gemm g{(const bf16*)(F.ws + WS_WINT), XB, 1024, M, D}; pg8::StaticOrder S; S.init(1024, M, F.G, (int)blockIdx.x);
          pg8::EpiVT E{(bf16*)(F.ws + WS_VT), (bf16*)(F.ws + WS_VHT), RS1};
          pg8::gemm_phase<pg8::EpiVT, pg8::StaticOrder, true, true>(F.lds + RING_OFF, g, S, E); }
        if (BOTH(3)) GRID_BAR(3);
    }
    if (IN(4)) {
        hgrn_naive(F);
        attn_naive(F);
        if (BOTH(4)) GRID_BAR(4);
    }
    if (IN(5)) {
        pg8::Gemm g{MIXp, (const bf16*)(F.ws + WS_WOUT), M, D, D}; pg8::StaticOrder S; S.init(M, D, F.G, (int)blockIdx.x);
        pg8::EpiRes<true> E{F.out, F.out, XB, RS2, 1.0f};
        pg8::gemm_phase<pg8::EpiRes<true>, pg8::StaticOrder, true, true>(F.lds + RING_OFF, g, S, E);
        if (BOTH(5)) GRID_BAR(5);
    }
    if (IN(6)) {
        pg8::Gemm g{XB, (const bf16*)(F.ws + WS_WGU2), M, 2 * FF, D}; pg8::StaticOrder S; S.init(M, 2 * FF, F.G, (int)blockIdx.x);
        pg8::EpiSwiGLU E{HID, FF, RS2};
        pg8::gemm_phase<pg8::EpiSwiGLU, pg8::StaticOrder, true, true>(F.lds + RING_OFF, g, S, E);
        if (BOTH(6)) GRID_BAR(6);
    }
    if (IN(7)) {
        pg8::Gemm g{HID, (const bf16*)(F.ws + WS_WD2), M, D, FF}; pg8::StaticOrder S; S.init(M, D, F.G, (int)blockIdx.x);
        pg8::EpiRes<false> E{F.out, F.out, nullptr, nullptr, 0.5f};
        pg8::gemm_phase<pg8::EpiRes<false>, pg8::StaticOrder, true, true>(F.lds + RING_OFF, g, S, E);
    }
#undef IN
#undef BOTH
}

extern "C" void kernel_launch(void* const* d_in, const int* in_sizes, int n_in, void* d_out, int out_size, void* d_ws, size_t ws_size, hipStream_t stream) {
    static int grid = 0;
    if (grid == 0) {
        if (n_in != 17 || in_sizes[0] != M * D || out_size != M * D || ws_size < WS_END) { fprintf(stderr, "kernel_launch: unexpected shapes (n_in %d, in0 %d, out %d, ws %zu); nothing launched\n", n_in, n_in > 0 ? in_sizes[0] : -1, out_size, ws_size); grid = -1; return; }
        int dev = 0, cus = 0, per_cu = 0;
        if (hipGetDevice(&dev) != hipSuccess || hipDeviceGetAttribute(&cus, hipDeviceAttributeMultiprocessorCount, dev) != hipSuccess) { grid = -1; return; }
        if (hipFuncSetAttribute((const void*)mega_fwd, hipFuncAttributeMaxDynamicSharedMemorySize, LDS_BYTES) != hipSuccess) { fprintf(stderr, "kernel_launch: hipFuncSetAttribute failed\n"); grid = -1; return; }
        if (hipOccupancyMaxActiveBlocksPerMultiprocessor(&per_cu, (const void*)mega_fwd, NWAVES * 64, LDS_BYTES) != hipSuccess || per_cu < 1) fprintf(stderr, "kernel_launch: note: occupancy query reports %d workgroups per CU\n", per_cu);
        (void)hipGetLastError();
        grid = cus;
    }
    if (grid < 0) return;
    if (hipMemsetAsync((char*)d_ws + WS_CTL, 0, CTL_ZERO_BYTES, stream) != hipSuccess) { fprintf(stderr, "kernel_launch: hipMemsetAsync failed\n"); return; }
    Args a{};
    for (int i = 0; i < 17; ++i) a.in[i] = (const float*)d_in[i];
    a.out = (float*)d_out; a.ws = (unsigned char*)d_ws;
    for (int li = 0; li < N_LAUNCHES; ++li) {
        a.ph_lo = (N_LAUNCHES == PER_PHASE) ? li : 0; a.ph_hi = (N_LAUNCHES == PER_PHASE) ? li + 1 : PER_PHASE; a.li = li;
        hipLaunchKernelGGL(mega_fwd, dim3(grid), dim3(NWAVES * 64), LDS_BYTES, stream, a);
        const hipError_t le = hipPeekAtLastError();
        if (le != hipSuccess) { fprintf(stderr, "kernel_launch: launch %d failed: %s\n", li, hipGetErrorName(le)); break; }
    }
}
```

```cpp
#include <hip/hip_runtime.h>
#include <cstdio>
#include <cstdint>
namespace pg8 {
#define PG8_LAS __attribute__((address_space(3)))
typedef unsigned short bf16_t;
typedef short bf16x8 __attribute__((ext_vector_type(8)));
typedef float f32x4 __attribute__((ext_vector_type(4)));
typedef unsigned u32x4 __attribute__((ext_vector_type(4)));
constexpr int BM = 256, BK = 64, HALF = 128, HTB = HALF * BK * 2  , STAGE_BYTES = 8 * HTB, NXCD = 8, WGM = 8;

__host__ __device__ __forceinline__ int lds_byte(int r, int c) { const int st = (r >> 4) * 2 + (c >> 5), rr = r & 15, cc = c & 31, ob = rr * 64 + cc * 2; return st * 1024 + (ob ^ (((ob >> 9) & 1) << 5)); }
__host__ __device__ __forceinline__ void stage_rc(int b, int& R, int& C) { const int st = b / 1024, sb = b % 1024, swz = sb ^ (((sb >> 9) & 1) << 5); R = (st >> 1) * 16 + swz / 64; C = (st & 1) * 32 + (swz % 64) / 2; }
__host__ __device__ __forceinline__ int perm32(int rho) { const int n = rho >> 4, i = rho & 15; return 8 * (i >> 2) + 4 * n + (i & 3); }

struct Unit { int pm, pn; };
struct Gemm { const bf16_t* A; const bf16_t* Bt; int M, N, K; };

struct StaticOrder {
    int nM, nN, nwg, G, c;
    __host__ __device__ void init(int M, int N, int G_, int c_) { nM = M / BM; nN = N / BM; nwg = nM * nN; G = G_; c = c_; }
    __host__ __device__ bool next(int i, Unit& u) const {
        const long L = (long)i * G + c; if (L >= nwg) return false;
        int wgid = (int)L; { const int q = nwg / NXCD, r = nwg % NXCD, xcd = wgid % NXCD, off = wgid / NXCD; wgid = (xcd < r ? xcd * (q + 1) : r * (q + 1) + (xcd - r) * q) + off; }
        const int nig = WGM * nN, gid = wgid / nig, fm = gid * WGM, gsz = (nM - fm) < WGM ? (nM - fm) : WGM;
        u.pm = fm + ((wgid % nig) % gsz); u.pn = (wgid % nig) / gsz; return true;
    }
    __device__ __forceinline__ void a_ready(const Unit&) const {}
    __device__ __forceinline__ void done(const Unit&) const {}
};


typedef unsigned u32x2 __attribute__((ext_vector_type(2)));
constexpr float RMS_EPS = 1e-6f, LOG2E = 1.4426950408889634f, QSCALE = 0.125f * 1.4426950408889634f;
__device__ __forceinline__ unsigned cvt_pk_bf16(float lo, float hi) { unsigned r; asm volatile("v_cvt_pk_bf16_f32 %0, %1, %2" : "=v"(r) : "v"(lo), "v"(hi)); return r; }
__device__ __forceinline__ float fsigmoid(float x) { return __builtin_amdgcn_rcpf(1.0f + __builtin_amdgcn_exp2f(-x * LOG2E)); }
__device__ __forceinline__ float fsilu(float x) { return x * fsigmoid(x); }
__device__ __forceinline__ f32x4 silu4(f32x4 v) { return (f32x4){fsilu(v[0]), fsilu(v[1]), fsilu(v[2]), fsilu(v[3])}; }
__device__ __forceinline__ u32x4 pack8(f32x4 a, f32x4 b) { u32x4 w; w.x = cvt_pk_bf16(a[0], a[1]); w.y = cvt_pk_bf16(a[2], a[3]); w.z = cvt_pk_bf16(b[0], b[1]); w.w = cvt_pk_bf16(b[2], b[3]); return w; }
__device__ __forceinline__ float rowscale(const float* rowsq, int row) { return rowsq ? __builtin_amdgcn_rsqf(rowsq[row] * (1.0f / 1024.0f) + RMS_EPS) : 1.0f; }
template <int CTRL> __device__ __forceinline__ float dpp_mov0(float x) { return __builtin_bit_cast(float, __builtin_amdgcn_update_dpp(0, __builtin_bit_cast(int, x), CTRL, 0xf, 0xf, true)); }
__device__ __forceinline__ float row_scan16(float x) { x += dpp_mov0<0x111>(x); x += dpp_mov0<0x112>(x); x += dpp_mov0<0x114>(x); x += dpp_mov0<0x118>(x); return x; }

struct EpiSwiGLU {
    static constexpr bool PERM = false, AFTER_DRAIN = false;
    bf16_t* H; int ldh; const float* rowsq;
    __device__ __forceinline__ void operator()(f32x4 (&acc)[2][2][4][2], const Unit& u, int wr, int wc, int fr, int fq) const {
        const int row0 = u.pm * BM + wr * 64 + fr, col0 = u.pn * HALF + wc * 32 + 8 * fq;
#pragma unroll
        for (int ai = 0; ai < 2; ++ai)
#pragma unroll
            for (int m = 0; m < 4; ++m) { const int row = row0 + ai * HALF + m * 16; const float r = rowscale(rowsq, row);
                const f32x4 h0 = silu4(acc[ai][0][m][0] * r) * (acc[ai][1][m][0] * r), h1 = silu4(acc[ai][0][m][1] * r) * (acc[ai][1][m][1] * r);
                *(u32x4*)(H + (unsigned)(row * ldh + col0)) = pack8(h0, h1); }
    }
};
template <bool WB> struct EpiRes {
    static constexpr bool PERM = false, AFTER_DRAIN = false;
    const float* base; float* out; bf16_t* xb; float* rowsq; float scale;
    __device__ __forceinline__ void operator()(f32x4 (&acc)[2][2][4][2], const Unit& u, int wr, int wc, int fr, int fq) const {
        const int row0 = u.pm * BM + wr * 64 + fr, col0 = u.pn * BM + wc * 32 + 4 * fq;
#pragma unroll
        for (int ai = 0; ai < 2; ++ai)
#pragma unroll
            for (int m = 0; m < 4; ++m) { const int row = row0 + ai * HALF + m * 16; const unsigned off = (unsigned)(row * 1024 + col0); float ss = 0.f;
#pragma unroll
                for (int bj = 0; bj < 2; ++bj)
#pragma unroll
                    for (int n = 0; n < 2; ++n) { const unsigned o = off + bj * HALF + n * 16; const f32x4 v = *(const f32x4*)(base + o) + acc[ai][bj][m][n] * scale; *(f32x4*)(out + o) = v;
                        if (WB) { u32x2 w; w.x = cvt_pk_bf16(v[0], v[1]); w.y = cvt_pk_bf16(v[2], v[3]); *(u32x2*)(xb + o) = w; ss += (v[0] * v[0] + v[1] * v[1]) + (v[2] * v[2] + v[3] * v[3]); } }
                if (WB) { ss += __shfl_xor(ss, 16); ss += __shfl_xor(ss, 32); if (fq == 0) __hip_atomic_fetch_add(rowsq + row, ss, __ATOMIC_RELAXED, __HIP_MEMORY_SCOPE_AGENT); }
                asm volatile("" ::: "memory"); }
    }
};
struct EpiWin {
    static constexpr bool PERM = false, AFTER_DRAIN = false;
    bf16_t *Q, *K, *QT, *KT, *G; float *DM, *DE; const float *rowsq, *gq, *gk, *lb;
    __device__ __forceinline__ void operator()(f32x4 (&acc)[2][2][4][2], const Unit& u, int wr, int wc, int fr, int fq) const {
        const int row0 = u.pm * BM + wr * 64 + fr, t = u.pn;
        if (t < 4) {
            const bool isq = t < 2; const int head = 4 * (t & 1) + wc; const float* gp = isq ? gq : gk; const float gs = isq ? QSCALE : 1.0f;
            f32x4 gv[2][2];
#pragma unroll
            for (int bj = 0; bj < 2; ++bj)
#pragma unroll
                for (int n = 0; n < 2; ++n) gv[bj][n] = *(const f32x4*)(gp + 32 * bj + 8 * fq + 4 * n) * gs;
            bf16_t* dst = (isq ? Q : K) + head * 64 + 8 * fq;
#pragma unroll
            for (int ai = 0; ai < 2; ++ai)
#pragma unroll
                for (int m = 0; m < 4; ++m) { const int row = row0 + ai * HALF + m * 16; const float r = rowscale(rowsq, row); float ss = 0.f;
#pragma unroll
                    for (int bj = 0; bj < 2; ++bj)
#pragma unroll
                        for (int n = 0; n < 2; ++n) { const f32x4 v = acc[ai][bj][m][n] * r; acc[ai][bj][m][n] = v; ss += (v[0] * v[0] + v[1] * v[1]) + (v[2] * v[2] + v[3] * v[3]); }
                    ss += __shfl_xor(ss, 16); ss += __shfl_xor(ss, 32);
                    const float inv = __builtin_amdgcn_rsqf(ss * (1.0f / 64.0f) + RMS_EPS);
#pragma unroll
                    for (int bj = 0; bj < 2; ++bj) *(u32x4*)(dst + (unsigned)(row * 512 + 32 * bj)) = pack8(acc[ai][bj][m][0] * inv * gv[bj][0], acc[ai][bj][m][1] * inv * gv[bj][1]); }
        } else if (t < 8) {
            const int hh = t - 4, kbase = hh * 128 + wc * 32 + 8 * fq;
            float lbv[8]; { const f32x4 l0 = *(const f32x4*)(lb + kbase), l1 = *(const f32x4*)(lb + kbase + 4);
#pragma unroll
                for (int c = 0; c < 4; ++c) { lbv[c] = l0[c]; lbv[4 + c] = l1[c]; } }
            const int lane = fq * 16 + fr;
#pragma unroll
            for (int ai = 0; ai < 2; ++ai)
#pragma unroll
                for (int n = 0; n < 2; ++n) {
                    float omf[4][4], carry[4], bmid[4];
#pragma unroll
                    for (int m = 0; m < 4; ++m) { const int row = row0 + ai * HALF + m * 16; const float r = rowscale(rowsq, row);
#pragma unroll
                        for (int c = 0; c < 4; ++c) { const int e = 4 * n + c; const float a = acc[ai][0][m][n][c] * r, b = acc[ai][1][m][n][c] * r;
                            const float sg = fsigmoid(b), f = lbv[e] + (1.0f - lbv[e]) * sg; omf[m][c] = (1.0f - lbv[e]) * (1.0f - sg);
                            acc[ai][1][m][n][c] = __builtin_amdgcn_logf(f);
                            acc[ai][0][m][n][c] = fsilu(a); } }
#pragma unroll
                    for (int c = 0; c < 4; ++c) { carry[c] = 0.f; bmid[c] = 0.f; }
#pragma unroll
                    for (int m = 0; m < 4; ++m)
#pragma unroll
                        for (int c = 0; c < 4; ++c) { float x = row_scan16(acc[ai][1][m][n][c]) + carry[c]; acc[ai][1][m][n][c] = x;
                            carry[c] = __shfl(x, lane | 15); if (m == 1) bmid[c] = carry[c]; }
#pragma unroll
                    for (int m = 0; m < 4; ++m) { const int row = row0 + ai * HALF + m * 16; f32x4 qv, kv;
#pragma unroll
                        for (int c = 0; c < 4; ++c) { const float d = acc[ai][1][m][n][c] - bmid[c];
                            qv[c] = acc[ai][0][m][n][c] * __builtin_amdgcn_exp2f(d); kv[c] = omf[m][c] * __builtin_amdgcn_exp2f(-d); }
                        u32x2 wq, wk; wq.x = cvt_pk_bf16(qv[0], qv[1]); wq.y = cvt_pk_bf16(qv[2], qv[3]); wk.x = cvt_pk_bf16(kv[0], kv[1]); wk.y = cvt_pk_bf16(kv[2], kv[3]);
                        *(u32x2*)(QT + (unsigned)(row * 512 + kbase + 4 * n)) = wq; *(u32x2*)(KT + (unsigned)(row * 512 + kbase + 4 * n)) = wk; }
                    if (fr == 0) { const int chunk = (u.pm * BM + ai * HALF + wr * 64) >> 6; f32x4 a0, e0;
#pragma unroll
                        for (int c = 0; c < 4; ++c) { a0[c] = __builtin_amdgcn_exp2f(bmid[c]); e0[c] = __builtin_amdgcn_exp2f(carry[c] - bmid[c]); }
                        *(f32x4*)(DM + (unsigned)(chunk * 512 + kbase + 4 * n)) = a0; *(f32x4*)(DE + (unsigned)(chunk * 512 + kbase + 4 * n)) = e0; }
                    asm volatile("" ::: "memory");
                }
        } else {
            bf16_t* dst = G + (t - 8) * 256 + wc * 32 + 8 * fq;
#pragma unroll
            for (int ai = 0; ai < 2; ++ai)
#pragma unroll
                for (int m = 0; m < 4; ++m) { const int row = row0 + ai * HALF + m * 16; const float r = rowscale(rowsq, row);
#pragma unroll
                    for (int bj = 0; bj < 2; ++bj) *(u32x4*)(dst + (unsigned)(row * 512 + bj * HALF)) = pack8(silu4(acc[ai][bj][m][0] * r), silu4(acc[ai][bj][m][1] * r)); }
        }
    }
};
struct EpiVT {
    static constexpr bool PERM = true, AFTER_DRAIN = false;
    bf16_t *VT, *VHT; const float* rowsq;
    __device__ __forceinline__ void operator()(f32x4 (&acc)[2][2][4][2], const Unit& u, int wr, int wc, int fr, int fq) const {
        const int ch0 = (u.pm & 1) * BM + wr * 64 + fr, tok0 = u.pn * BM + wc * 32 + 8 * fq, b = tok0 >> 11, s0 = tok0 & 2047;
        f32x4 rs[2][2];
#pragma unroll
        for (int bj = 0; bj < 2; ++bj)
#pragma unroll
            for (int n = 0; n < 2; ++n) { const f32x4 q = *(const f32x4*)(rowsq + tok0 + bj * HALF + 4 * n);
#pragma unroll
                for (int c = 0; c < 4; ++c) rs[bj][n][c] = __builtin_amdgcn_rsqf(q[c] * (1.0f / 1024.0f) + RMS_EPS); }
        bf16_t* dst = (u.pm < 2 ? VT : VHT) + (size_t)b * 512 * 2048 + s0;
#pragma unroll
        for (int ai = 0; ai < 2; ++ai)
#pragma unroll
            for (int m = 0; m < 4; ++m) { const int ch = ch0 + ai * HALF + m * 16;
#pragma unroll
                for (int bj = 0; bj < 2; ++bj) *(u32x4*)(dst + (unsigned)(ch * 2048 + bj * HALF)) = pack8(acc[ai][bj][m][0] * rs[bj][0], acc[ai][bj][m][1] * rs[bj][1]); }
    }
};

template <class Epi, class Sched, bool ALIGN_EPI = false, bool SP2 = false>
__device__ __forceinline__ void gemm_phase(PG8_LAS unsigned char* lds, const Gemm g, const Sched& S, const Epi& E) {
    const int tid = threadIdx.x, wid = __builtin_amdgcn_readfirstlane(tid >> 6), lane = tid & 63, wr = wid >> 2, wc = wid & 3, fr = lane & 15, fq = lane >> 4;
    const int K = g.K, nt = K / BK;
    unsigned voffA[2], voffB[2];
#pragma unroll
    for (int i = 0; i < 2; ++i) { int R, C; stage_rc(tid * 16 + i * 8192, R, C); const int Rb = Epi::PERM ? ((R & ~31) + perm32(R & 31)) : R;
        voffA[i] = (unsigned)(R * K + C) * 2u; voffB[i] = (unsigned)(Rb * K + C) * 2u; }
    const size_t kstep = (size_t)(BK * 2);
    const size_t hstep = (size_t)HALF * K * 2;
    const size_t tstep = 2 * hstep;
    const unsigned ldsw = (unsigned)wid * 1024u;
    const int aoff = lds_byte(wr * 64 + fr, fq * 8), boff = lds_byte(wc * 32 + fr, fq * 8);
#define PG8_SA(b, h) (((b) * 2 + (h)) * HTB)
#define PG8_SB(b, h) ((4 + (b) * 2 + (h)) * HTB)
#define PG8_STAGE(bufoff, gbase, voff) do { _Pragma("unroll") for (int _i = 0; _i < 2; ++_i) \
        __builtin_amdgcn_global_load_lds((const unsigned*)((const char*)(gbase) + (voff)[_i]), (PG8_LAS unsigned*)(lds + (bufoff) + ldsw + _i * 8192), 16, 0, 0); } while (0)
#define PG8_LDA(dst, b, h) do { _Pragma("unroll") for (int m = 0; m < 4; ++m) _Pragma("unroll") for (int k = 0; k < 2; ++k) dst[m][k] = *(const PG8_LAS bf16x8*)(lds + PG8_SA(b, h) + aoff + m * 2048 + k * 1024); } while (0)
#define PG8_LDB(dst, b, h) do { _Pragma("unroll") for (int n = 0; n < 2; ++n) _Pragma("unroll") for (int k = 0; k < 2; ++k) dst[n][k] = *(const PG8_LAS bf16x8*)(lds + PG8_SB(b, h) + boff + n * 2048 + k * 1024); } while (0)
#define PG8_MMA(ai, bj, At, Bt) do { __builtin_amdgcn_s_setprio(1); _Pragma("unroll") for (int m = 0; m < 4; ++m) _Pragma("unroll") for (int n = 0; n < 2; ++n) _Pragma("unroll") for (int k = 0; k < 2; ++k) \
        acc[ai][bj][m][n] = __builtin_amdgcn_mfma_f32_16x16x32_bf16(Bt[n][k], At[m][k], acc[ai][bj][m][n], 0, 0, 0); __builtin_amdgcn_s_setprio(0); } while (0)
#define PG8_WAIT_V(n) asm volatile("s_waitcnt vmcnt(" #n ")" ::: "memory")
#define PG8_WAIT_L(n) asm volatile("s_waitcnt lgkmcnt(" #n ")" ::: "memory")
#define PG8_BAR __builtin_amdgcn_s_barrier()
#define PG8_SCHED __builtin_amdgcn_sched_barrier(0)
    Unit cur, nxt; int ui = 0;
    if (!S.next(0, cur)) return;
    f32x4 acc[2][2][4][2];
#pragma unroll
    for (int a = 0; a < 2; ++a)
#pragma unroll
        for (int b = 0; b < 2; ++b)
#pragma unroll
            for (int m = 0; m < 4; ++m)
#pragma unroll
                for (int n = 0; n < 2; ++n) acc[a][b][m][n] = (f32x4){0.f, 0.f, 0.f, 0.f};
    bf16x8 At[4][2], B0[2][2], B1[2][2];
    const char* cA = (const char*)g.A + (size_t)cur.pm * tstep; const char* cB = (const char*)g.Bt + (size_t)cur.pn * tstep;
    S.a_ready(cur);
    if constexpr (SP2) {
        PG8_STAGE(PG8_SB(0, 0), cB, voffB); PG8_STAGE(PG8_SB(0, 1), cB + hstep, voffB); PG8_STAGE(PG8_SA(0, 0), cA, voffA); PG8_STAGE(PG8_SA(0, 1), cA + hstep, voffA);
        if (wr == 1) PG8_BAR;
        PG8_WAIT_V(2); PG8_BAR;
        PG8_STAGE(PG8_SB(1, 0), cB + kstep, voffB); PG8_STAGE(PG8_SA(1, 0), cA + kstep, voffA); PG8_STAGE(PG8_SB(1, 1), cB + hstep + kstep, voffB);
        PG8_WAIT_V(6); PG8_BAR;
    } else {
        PG8_STAGE(PG8_SB(0, 0), cB, voffB); PG8_STAGE(PG8_SA(0, 0), cA, voffA); PG8_STAGE(PG8_SB(0, 1), cB + hstep, voffB); PG8_STAGE(PG8_SA(0, 1), cA + hstep, voffA);
        if (wr == 1) PG8_BAR;
        PG8_WAIT_V(4); PG8_BAR;
        PG8_STAGE(PG8_SB(1, 0), cB + kstep, voffB); PG8_STAGE(PG8_SA(1, 0), cA + kstep, voffA); PG8_STAGE(PG8_SB(1, 1), cB + hstep + kstep, voffB);
        PG8_WAIT_V(6); PG8_BAR;
    }
    for (;;) {
        const bool has_next = S.next(ui + 1, nxt);
        const char* nA = has_next ? (const char*)g.A + (size_t)nxt.pm * tstep : cA; const char* nB = has_next ? (const char*)g.Bt + (size_t)nxt.pn * tstep : cB;
        for (int t = 0; t < nt; t += 2) {
            const bool last = (t == nt - 2);
            const char* a1 = cA + (size_t)(t + 1) * kstep;
            const char* a2 = last ? nA : cA + (size_t)(t + 2) * kstep; const char* b2 = last ? nB : cB + (size_t)(t + 2) * kstep;
            const char* a3 = a2 + kstep; const char* b3 = b2 + kstep;
            if (last && has_next) S.a_ready(nxt);
            if constexpr (SP2) {
            PG8_LDB(B0, 0, 0); PG8_LDB(B1, 0, 1); PG8_SCHED; PG8_LDA(At, 0, 0); PG8_STAGE(PG8_SA(1, 1), a1 + hstep, voffA);
            PG8_WAIT_V(8); PG8_WAIT_L(0); PG8_BAR; PG8_MMA(0, 0, At, B0); PG8_MMA(0, 1, At, B1); PG8_BAR; PG8_SCHED;
            PG8_LDA(At, 0, 1); PG8_STAGE(PG8_SB(0, 0), b2, voffB); PG8_STAGE(PG8_SB(0, 1), b2 + hstep, voffB); PG8_STAGE(PG8_SA(0, 0), a2, voffA);
            PG8_WAIT_V(8); PG8_WAIT_L(0); PG8_BAR; PG8_MMA(1, 0, At, B0); PG8_MMA(1, 1, At, B1); PG8_BAR; PG8_SCHED;
            PG8_LDB(B0, 1, 0); PG8_LDB(B1, 1, 1); PG8_SCHED; PG8_LDA(At, 1, 0); PG8_STAGE(PG8_SA(0, 1), a2 + hstep, voffA);
            PG8_WAIT_V(8); PG8_WAIT_L(0); PG8_BAR; PG8_MMA(0, 0, At, B0); PG8_MMA(0, 1, At, B1); PG8_BAR; PG8_SCHED;
            PG8_LDA(At, 1, 1); PG8_STAGE(PG8_SB(1, 0), b3, voffB); PG8_STAGE(PG8_SB(1, 1), b3 + hstep, voffB); PG8_STAGE(PG8_SA(1, 0), a3, voffA);
            PG8_WAIT_V(8); PG8_WAIT_L(0); PG8_BAR; PG8_MMA(1, 0, At, B0); PG8_MMA(1, 1, At, B1); PG8_BAR; PG8_SCHED;
            } else {
            PG8_LDB(B0, 0, 0); PG8_SCHED; PG8_LDA(At, 0, 0); PG8_STAGE(PG8_SA(1, 1), a1 + hstep, voffA);
            PG8_WAIT_L(8); PG8_BAR; PG8_WAIT_L(0); PG8_MMA(0, 0, At, B0); PG8_BAR; PG8_SCHED;
            PG8_LDB(B1, 0, 1); PG8_STAGE(PG8_SB(0, 0), b2, voffB);
            PG8_BAR; PG8_WAIT_L(0); PG8_MMA(0, 1, At, B1); PG8_BAR;
            PG8_LDA(At, 0, 1); PG8_STAGE(PG8_SA(0, 0), a2, voffA);
            PG8_BAR; PG8_WAIT_L(0); PG8_MMA(1, 0, At, B0); PG8_BAR; PG8_SCHED;
            PG8_STAGE(PG8_SB(0, 1), b2 + hstep, voffB);
            PG8_WAIT_V(6); PG8_BAR; PG8_MMA(1, 1, At, B1); PG8_BAR;
            PG8_LDB(B0, 1, 0); PG8_SCHED; PG8_LDA(At, 1, 0); PG8_STAGE(PG8_SA(0, 1), a2 + hstep, voffA);
            PG8_WAIT_L(8); PG8_BAR; PG8_WAIT_L(0); PG8_MMA(0, 0, At, B0); PG8_BAR; PG8_SCHED;
            PG8_LDB(B1, 1, 1); PG8_STAGE(PG8_SB(1, 0), b3, voffB);
            PG8_BAR; PG8_WAIT_L(0); PG8_MMA(0, 1, At, B1); PG8_BAR;
            PG8_LDA(At, 1, 1); PG8_STAGE(PG8_SA(1, 0), a3, voffA);
            PG8_BAR; PG8_WAIT_L(0); PG8_MMA(1, 0, At, B0); PG8_BAR; PG8_SCHED;
            PG8_STAGE(PG8_SB(1, 1), b3 + hstep, voffB);
            PG8_WAIT_V(6); PG8_BAR; PG8_MMA(1, 1, At, B1); PG8_BAR;
            }
        }
        if constexpr (ALIGN_EPI) { if (wr == 0) PG8_BAR; }
        if constexpr (!Epi::AFTER_DRAIN) { E(acc, cur, wr, wc, fr, fq); S.done(cur); }
        if (!has_next) break;
#pragma unroll
        for (int a = 0; a < 2; ++a)
#pragma unroll
            for (int b = 0; b < 2; ++b)
#pragma unroll
                for (int m = 0; m < 4; ++m)
#pragma unroll
                    for (int n = 0; n < 2; ++n) acc[a][b][m][n] = (f32x4){0.f, 0.f, 0.f, 0.f};
        cur = nxt; cA = nA; cB = nB; ++ui;
        if constexpr (ALIGN_EPI) { if (wr == 1) PG8_BAR; }
    }
    PG8_WAIT_V(0);
    if constexpr (!ALIGN_EPI) { if (wr == 0) PG8_BAR; }
    PG8_BAR;
    if constexpr (Epi::AFTER_DRAIN) { E.fused(acc, cur, wr, wc, fr, fq, lds, wid, lane); S.done(cur); }
#undef PG8_SA
#undef PG8_SB
#undef PG8_STAGE
#undef PG8_LDA
#undef PG8_LDB
#undef PG8_MMA
#undef PG8_WAIT_V
#undef PG8_WAIT_L
#undef PG8_BAR
#undef PG8_SCHED
}
}

constexpr int NWAVES = 8;
#ifndef MK_N_LAUNCHES
#define MK_N_LAUNCHES 1
#endif
constexpr int PER_PHASE = 8;
constexpr int N_LAUNCHES = MK_N_LAUNCHES;
constexpr int BATCH = 16, SEQ = 2048, D = 1024, M = BATCH * SEQ, FF = 2816, NPROJ = 3584;
constexpr int AW = 512, HW = 512, NCHUNK = SEQ / 64;
constexpr float RMS_EPS = 1e-6f, LOG2E = 1.4426950408889634f;

constexpr size_t MiB = 1u << 20;
constexpr size_t WS_CTL = 0, CTL_ZERO_BYTES = 1 * MiB;
constexpr size_t WS_RS1 = 256 * 1024, WS_RS2 = 384 * 1024;
constexpr size_t WS_LB = 1 * MiB, WS_DM = 2 * MiB, WS_DE = 3 * MiB;
constexpr size_t WS_WGU1 = 4 * MiB, WS_WD1 = 15 * MiB, WS_WIN = 21 * MiB, WS_WINT = 26 * MiB, WS_WOUT = 28 * MiB, WS_WGU2 = 30 * MiB, WS_WD2 = 41 * MiB;
constexpr size_t WS_XB = 48 * MiB;
constexpr size_t WS_MIX = 112 * MiB;
constexpr size_t WS_HID = 176 * MiB;
constexpr size_t WS_Q = 176 * MiB, WS_K = 208 * MiB, WS_VT = 240 * MiB, WS_QT = 272 * MiB, WS_KT = 304 * MiB, WS_VHT = 336 * MiB, WS_G = 368 * MiB, WS_END = 400 * MiB;
static_assert(WS_WGU1 + (size_t)2 * FF * D * 2 <= WS_WD1 && WS_WD1 + (size_t)D * FF * 2 <= WS_WIN && WS_WIN + (size_t)2560 * D * 2 <= WS_WINT && WS_WGU2 + (size_t)2 * FF * D * 2 <= WS_WD2 && WS_WD2 + (size_t)D * FF * 2 <= WS_XB, "weight map");
static_assert(WS_HID + (size_t)M * FF * 2 <= WS_END && WS_XB + (size_t)M * D * 2 <= WS_MIX && WS_MIX + (size_t)M * D * 2 <= WS_HID, "activation map");
constexpr int CW_TMO = 0, CW_CODE = 1;
constexpr int CW_BAR = 4096;
constexpr int CW_WQ = 16384;

constexpr int RING_OFF = 0, RING_BYTES = 131072;
constexpr int LDSCTL_OFF = RING_BYTES, MISC_OFF = LDSCTL_OFF + 320;
constexpr int LDS_BYTES = 147456;
static_assert(MISC_OFF + 128 <= LDS_BYTES, "LDS map");

#define GAS __attribute__((address_space(1)))
#define LAS __attribute__((address_space(3)))
typedef unsigned short bf16;
typedef unsigned v4u __attribute__((ext_vector_type(4)));
typedef float f32x4 __attribute__((ext_vector_type(4)));
typedef short bf16x8 __attribute__((ext_vector_type(8)));
typedef GAS unsigned gu32;
#define RLX_AGENT __ATOMIC_RELAXED, __HIP_MEMORY_SCOPE_AGENT
#define LDS_WAIT() asm volatile("s_waitcnt lgkmcnt(0)" ::: "memory")
#define VM_WAIT() asm volatile("s_waitcnt vmcnt(0)" ::: "memory")
__device__ __forceinline__ unsigned f2bf(float f) { unsigned u = __builtin_bit_cast(unsigned, f); return (u + 0x7fffu + ((u >> 16) & 1u)) >> 16; }
__device__ __forceinline__ unsigned pk2(float lo, float hi) { return f2bf(lo) | (f2bf(hi) << 16); }
__device__ __forceinline__ float bf2f(unsigned short h) { return __builtin_bit_cast(float, (unsigned)h << 16); }
__device__ __forceinline__ float bflo(unsigned w) { return __builtin_bit_cast(float, w << 16); }
__device__ __forceinline__ float bfhi(unsigned w) { return __builtin_bit_cast(float, w & 0xffff0000u); }

#define XB_TMO      128
#define XB_XCNT(j)  (256  + 64 * (j))
#define XB_XSUB(j)  (1280 + 64 * (j))
#define XB_XGEN(j)  (2304 + 64 * (j))
#define XB_TOP      3328
#define XB_TOPGEN   3392
#define XCD_BAR_WORDS 3456
#define XB_SPIN_CAP (1u << 18)

__device__ __forceinline__ unsigned xb_ld(unsigned* p)              { return __hip_atomic_load(p, __ATOMIC_RELAXED, __HIP_MEMORY_SCOPE_AGENT); }
__device__ __forceinline__ unsigned xb_add(unsigned* p, unsigned v) { return __hip_atomic_fetch_add(p, v, __ATOMIC_RELAXED, __HIP_MEMORY_SCOPE_AGENT); }
__device__ __forceinline__ unsigned xb_xcc_id() { return (unsigned)__builtin_amdgcn_s_getreg((3 << 11) | 20) & 0xFu; }
#define XB_SPIN(cond, bar) do { unsigned _sp = 0; while (cond) { __builtin_amdgcn_s_sleep(1); \
    if ((++_sp & 255u) == 0u) { if (xb_ld(&(bar)[XB_TMO])) break; if (_sp > XB_SPIN_CAP) { atomicAdd(&(bar)[XB_TMO], 1u); break; } } } } while (0)

struct XcdBarrier {
    unsigned* bar; unsigned x;
    volatile LAS unsigned* st;
};

__device__ __forceinline__ XcdBarrier xcd_barrier_post(unsigned* bar, volatile LAS unsigned* st) {
    XcdBarrier b; b.bar = bar; b.x = xb_xcc_id(); b.st = st;
    if (threadIdx.x == 0) (void)xb_add(&bar[XB_XCNT(b.x)], 1u);
    return b;
}
__device__ __forceinline__ void xcd_barrier_complete(unsigned* bar, unsigned x, unsigned& nloc, unsigned& nx) {
    const unsigned G = gridDim.x * gridDim.y * gridDim.z;
    unsigned sum, cnt, mine, sp = 0u;
    for (;;) {
        sum = 0u; cnt = 0u; mine = 0u;
#pragma unroll
        for (unsigned j = 0; j < 16; ++j) { const unsigned c = xb_ld(&bar[XB_XCNT(j)]); sum += c; cnt += (c > 0u) ? 1u : 0u; mine = (j == x) ? c : mine; }
        if (sum == G) break;
        __builtin_amdgcn_s_sleep(1);
        if ((++sp & 255u) == 0u) { if (xb_ld(&bar[XB_TMO])) break; if (sp > XB_SPIN_CAP) { atomicAdd(&bar[XB_TMO], 1u); break; } }
    }
    nloc = mine > 0u ? mine : 1u; nx = cnt > 0u ? cnt : 1u;
}

__device__ __forceinline__ void xcd_barrier(const XcdBarrier& b) {
    asm volatile("s_waitcnt vmcnt(0)" ::: "memory");
    __syncthreads();
    if (threadIdx.x == 0) {
        unsigned* bar = b.bar;
        __builtin_amdgcn_s_waitcnt(0);
        unsigned nloc = b.st[0], nx = b.st[1];
        if (nloc == 0u) { xcd_barrier_complete(bar, b.x, nloc, nx); b.st[0] = nloc; b.st[1] = nx; }
        const unsigned old = xb_add(&bar[XB_XSUB(b.x)], 1u);
        const unsigned gen = old / nloc;
        if (old + 1u == (gen + 1u) * nloc) {
            __builtin_amdgcn_fence(__ATOMIC_RELEASE, "agent");
            asm volatile("s_waitcnt vmcnt(0)" ::: "memory");
            const unsigned og = xb_add(&bar[XB_TOP], 1u);
            const unsigned tg = og / nx;
            if (og + 1u == (tg + 1u) * nx) xb_add(&bar[XB_TOPGEN], 1u);
            else XB_SPIN(xb_ld(&bar[XB_TOPGEN]) == tg, bar);
            __builtin_amdgcn_fence(__ATOMIC_ACQUIRE, "agent");
            xb_add(&bar[XB_XGEN(b.x)], 1u);
            asm volatile("s_waitcnt vmcnt(0)" ::: "memory");
        } else {
            XB_SPIN(xb_ld(&bar[XB_XGEN(b.x)]) == gen, bar);
            __builtin_amdgcn_fence(__ATOMIC_ACQUIRE, "agent");
            asm volatile("s_waitcnt vmcnt(0)" ::: "memory");
        }
    }
    __syncthreads();
}

struct Frame {
    LAS unsigned char* lds;
    volatile LAS unsigned* MISC;
    gu32* ctl;
    int tid, lane, wave, G;
    const float* in[17]; float* out; unsigned char* ws;
};
__device__ __forceinline__ float wave_sum(float v) {
#pragma unroll
    for (int o = 1; o < 64; o <<= 1) v += __shfl_xor(v, o);
    return v;
}
__device__ __forceinline__ int srccol(int kind, int R, int& sel) {
    sel = 0;
    if (kind == 0) return R;
    const int t = R >> 8, p = R & 255, bj = p >> 7, q = p & 127, wc = q >> 5, pr = pg8::perm32(q & 31);
    if (kind == 1) { sel = bj; return 128 * t + 32 * wc + pr; }
    if (kind == 2) {
        if (t < 2) return 64 * (4 * t + wc) + 32 * bj + pr;
        if (t < 4) return 512 + 64 * (4 * (t - 2) + wc) + 32 * bj + pr;
        if (t < 8) return (bj ? 2048 : 1536) + 128 * (t - 4) + 32 * wc + pr;
        return 3072 + 256 * (t - 8) + 128 * bj + 32 * wc + pr;
    }
    return R < 512 ? 1024 + R : 2560 + (R - 512);
}
__device__ __forceinline__ void p0_item(const float* W0, const float* W1, int K, int N, int kind, bf16* WT, const float* gain, LAS float* scr, int item, int nblk, int lane) {
    const int kb = item / nblk, nb = item % nblk, k0 = 64 * kb, R0 = 32 * nb;
    int sel; const int c = srccol(kind, R0 + (lane & 31), sel);
    const float* W = sel ? W1 : W0;
#pragma unroll 8
    for (int i = 0; i < 32; ++i) { const int kk = 2 * i + (lane >> 5); float v = W[(size_t)(k0 + kk) * N + c]; if (gain) v *= gain[k0 + kk]; scr[kk * 33 + (lane & 31)] = v; }
    LDS_WAIT(); asm volatile("" ::: "memory");
    const int c8 = lane & 7;
#pragma unroll
    for (int j = 0; j < 4; ++j) { const int n = (lane >> 3) + 8 * j; const LAS float* s = scr + (8 * c8) * 33 + n;
        v4u o; o.x = pk2(s[0 * 33], s[1 * 33]); o.y = pk2(s[2 * 33], s[3 * 33]); o.z = pk2(s[4 * 33], s[5 * 33]); o.w = pk2(s[6 * 33], s[7 * 33]);
        *(GAS v4u*)(WT + (size_t)(R0 + n) * K + k0 + 8 * c8) = o; }
    LDS_WAIT(); asm volatile("" ::: "memory");
}
__device__ __forceinline__ void rms_row_to_bf16(const float* xrow, const float* g, bf16* orow, int lane) {
    const GAS f32x4* xr = (const GAS f32x4*)xrow + lane; const GAS f32x4* gr = (const GAS f32x4*)g + lane;
    f32x4 v[4]; float s = 0.f;
#pragma unroll
    for (int j = 0; j < 4; ++j) { v[j] = xr[64 * j]; s += (v[j].x * v[j].x + v[j].y * v[j].y) + (v[j].z * v[j].z + v[j].w * v[j].w); }
    const float r = __builtin_amdgcn_rsqf(wave_sum(s) * (1.f / D) + RMS_EPS);
    GAS unsigned long long* o8 = (GAS unsigned long long*)orow + lane;
#pragma unroll
    for (int j = 0; j < 4; ++j) { const f32x4 gg = gr[64 * j]; o8[64 * j] = (unsigned long long)pk2(v[j].x * r * gg.x, v[j].y * r * gg.y) | ((unsigned long long)pk2(v[j].z * r * gg.z, v[j].w * r * gg.w) << 32); }
}
__device__ __forceinline__ void p0_prologue(Frame& F) {
    LAS float* scr = (LAS float*)(F.lds + RING_OFF + F.wave * 16384);
    const int gw = (int)blockIdx.x * NWAVES + F.wave, NGW = F.G * NWAVES;
    bf16* const ws16 = (bf16*)F.ws;
    constexpr int I_GU = (D / 64) * (2 * FF / 32), I_D = (FF / 64) * (D / 32), I_IN = (D / 64) * (2560 / 32), I_INT = (D / 64) * (1024 / 32), I_O = (D / 64) * (D / 32);
    constexpr int NITEMS = 2 * I_GU + 2 * I_D + I_IN + I_INT + I_O;
    for (int it = gw; it < NITEMS; it += NGW) {
        int r = it;
        if (r < I_GU) { p0_item(F.in[2], F.in[3], D, FF, 1, (bf16*)(F.ws + WS_WGU1), nullptr, scr, r, 2 * FF / 32, F.lane); continue; } r -= I_GU;
        if (r < I_GU) { p0_item(F.in[14], F.in[15], D, FF, 1, (bf16*)(F.ws + WS_WGU2), F.in[13], scr, r, 2 * FF / 32, F.lane); continue; } r -= I_GU;
        if (r < I_D) { p0_item(F.in[4], F.in[4], FF, D, 0, (bf16*)(F.ws + WS_WD1), nullptr, scr, r, D / 32, F.lane); continue; } r -= I_D;
        if (r < I_D) { p0_item(F.in[16], F.in[16], FF, D, 0, (bf16*)(F.ws + WS_WD2), nullptr, scr, r, D / 32, F.lane); continue; } r -= I_D;
        if (r < I_IN) { p0_item(F.in[6], F.in[6], D, NPROJ, 2, (bf16*)(F.ws + WS_WIN), F.in[5], scr, r, 2560 / 32, F.lane); continue; } r -= I_IN;
        if (r < I_INT) { p0_item(F.in[6], F.in[6], D, NPROJ, 3, (bf16*)(F.ws + WS_WINT), F.in[5], scr, r, 1024 / 32, F.lane); continue; } r -= I_INT;
        p0_item(F.in[12], F.in[12], D, D, 0, (bf16*)(F.ws + WS_WOUT), nullptr, scr, r, D / 32, F.lane);
    }
    (void)ws16;
    for (int m = gw; m < M; m += NGW) rms_row_to_bf16(F.in[0] + (size_t)m * D, F.in[1], (bf16*)(F.ws + WS_XB) + (size_t)m * D, F.lane);
    if (blockIdx.x == 0) {
        const float l0 = F.in[10][F.tid], l1 = F.in[10][512 + F.tid], mx = fmaxf(l0, l1), e0 = __expf(l0 - mx), e1 = __expf(l1 - mx);
        ((float*)(F.ws + WS_LB))[F.tid] = e0 / (e0 + e1);
    }
}

typedef float f32x16 __attribute__((ext_vector_type(16)));
typedef float f32x2_t __attribute__((ext_vector_type(2))); typedef __bf16 bf16x2_t __attribute__((ext_vector_type(2)));
__device__ __forceinline__ unsigned cvtpk_s(float lo, float hi) { f32x2_t v = {lo, hi}; bf16x2_t b = __builtin_convertvector(v, bf16x2_t); return __builtin_bit_cast(unsigned, b); }
__device__ __forceinline__ bf16x8 pack_step(const f32x16& x, int s) { v4u p; p.x = cvtpk_s(x[8 * s], x[8 * s + 1]); p.y = cvtpk_s(x[8 * s + 2], x[8 * s + 3]); p.z = cvtpk_s(x[8 * s + 4], x[8 * s + 5]); p.w = cvtpk_s(x[8 * s + 6], x[8 * s + 7]); return __builtin_bit_cast(bf16x8, p); }
__device__ __forceinline__ float swapmax(float m) { auto rr = __builtin_amdgcn_permlane32_swap(__float_as_uint(m), __float_as_uint(m), false, false); return fmaxf(__uint_as_float(rr[0]), __uint_as_float(rr[1])); }
__device__ __forceinline__ float swapsum(float m) { auto rr = __builtin_amdgcn_permlane32_swap(__float_as_uint(m), __float_as_uint(m), false, false); return __uint_as_float(rr[0]) + __uint_as_float(rr[1]); }
__device__ __forceinline__ int pi32(int x) { return (x & 0x13) | ((x & 4) << 1) | ((x & 8) >> 1); }
#define MFMA32(a, b, c) __builtin_amdgcn_mfma_f32_32x32x16_bf16((a), (b), (c), 0, 0, 0)
constexpr int ATT_ETAB_OFF = 0;
__device__ __forceinline__ void attn_item(Frame& F, int b, int c, int h, const LAS float* etab) {
    const bf16* Q = (const bf16*)(F.ws + WS_Q); const bf16* Kp = (const bf16*)(F.ws + WS_K); const bf16* VT = (const bf16*)(F.ws + WS_VT); bf16* MIX = (bf16*)(F.ws + WS_MIX);
    const int lane = F.lane, r32 = lane & 31, hi = lane >> 5;
    const float cfar = F.in[9][h * 257 + 256] * LOG2E;
    bf16x8 qf[2][4];
#pragma unroll
    for (int qb = 0; qb < 2; ++qb)
#pragma unroll
        for (int d0 = 0; d0 < 4; ++d0) qf[qb][d0] = *(const bf16x8*)(Q + (unsigned)(((b * SEQ + 64 * c + 32 * qb + r32) * 512) + h * 64 + 16 * d0 + 8 * hi));
    f32x16 o[2][2];
#pragma unroll
    for (int db = 0; db < 2; ++db)
#pragma unroll
        for (int qb = 0; qb < 2; ++qb)
#pragma unroll
            for (int r = 0; r < 16; ++r) o[db][qb][r] = 0.f;
    float mrun[2] = {-INFINITY, -INFINITY}, lrun[2] = {0.f, 0.f};
    const int kt0 = c >= 8 ? c - 8 : 0;
    const unsigned kbase = (unsigned)((b * SEQ + pi32(r32)) * 512 + h * 64 + 8 * hi);
    const unsigned vbase = (unsigned)((b * 512 + h * 64 + r32) * SEQ + 8 * hi);
    const LAS float* et = etab + h * 256;
    for (int kt = kt0; kt <= c; ++kt) {
        const int j = c - kt;
        bf16x8 kf[2][4], vf[2][4];
#pragma unroll
        for (int kb = 0; kb < 2; ++kb)
#pragma unroll
            for (int d0 = 0; d0 < 4; ++d0) kf[kb][d0] = *(const bf16x8*)(Kp + kbase + (unsigned)((64 * kt + 32 * kb) * 512 + 16 * d0));
#pragma unroll
        for (int db = 0; db < 2; ++db)
#pragma unroll
            for (int ks = 0; ks < 4; ++ks) vf[db][ks] = *(const bf16x8*)(VT + vbase + (unsigned)(32 * db * SEQ + 64 * kt + 16 * ks));
#pragma unroll
        for (int qb = 0; qb < 2; ++qb) {
            f32x16 s[2];
            const float c0 = j >= 3 ? cfar : 0.f;
#pragma unroll
            for (int r = 0; r < 16; ++r) { s[0][r] = c0; s[1][r] = c0; }
#pragma unroll
            for (int d0 = 0; d0 < 4; ++d0) { s[0] = MFMA32(kf[0][d0], qf[qb][d0], s[0]); s[1] = MFMA32(kf[1][d0], qf[qb][d0], s[1]); }
            if (j < 3) {
                const int ib = 64 * j + 32 * qb + r32 - 8 * hi + 63;
#pragma unroll
                for (int kb = 0; kb < 2; ++kb)
#pragma unroll
                    for (int r = 0; r < 16; ++r) s[kb][r] += et[ib - 32 * kb - 16 * (r >> 3) - (r & 7)];
            }
            float tm = fmaxf(s[0][0], s[1][0]);
#pragma unroll
            for (int r = 1; r < 16; ++r) tm = fmaxf(tm, fmaxf(s[0][r], s[1][r]));
            tm = swapmax(tm);
            const float mn = fmaxf(mrun[qb], tm), alpha = __builtin_amdgcn_exp2f(mrun[qb] - mn); mrun[qb] = mn;
            float ls = 0.f;
#pragma unroll
            for (int kb = 0; kb < 2; ++kb)
#pragma unroll
                for (int r = 0; r < 16; ++r) { const float p = __builtin_amdgcn_exp2f(s[kb][r] - mn); s[kb][r] = p; ls += p; }
            lrun[qb] = lrun[qb] * alpha + ls;
#pragma unroll
            for (int db = 0; db < 2; ++db)
#pragma unroll
                for (int r = 0; r < 16; ++r) o[db][qb][r] *= alpha;
            bf16x8 pk[2][2];
#pragma unroll
            for (int kb = 0; kb < 2; ++kb) { pk[kb][0] = pack_step(s[kb], 0); pk[kb][1] = pack_step(s[kb], 1); }
#pragma unroll
            for (int db = 0; db < 2; ++db)
#pragma unroll
                for (int kb = 0; kb < 2; ++kb)
#pragma unroll
                    for (int sp = 0; sp < 2; ++sp) o[db][qb] = MFMA32(vf[db][2 * kb + sp], pk[kb][sp], o[db][qb]);
        }
    }
#pragma unroll
    for (int qb = 0; qb < 2; ++qb) {
        const float inv = 1.0f / swapsum(lrun[qb]);
        bf16* orow = MIX + (unsigned)((b * SEQ + 64 * c + 32 * qb + r32) * 1024 + h * 64 + 4 * hi);
#pragma unroll
        for (int db = 0; db < 2; ++db)
#pragma unroll
            for (int g = 0; g < 4; ++g) { pg8::u32x2 w; w.x = cvtpk_s(o[db][qb][4 * g] * inv, o[db][qb][4 * g + 1] * inv); w.y = cvtpk_s(o[db][qb][4 * g + 2] * inv, o[db][qb][4 * g + 3] * inv);
                *(pg8::u32x2*)(orow + 32 * db + 8 * g) = w; }
    }
}
__device__ __forceinline__ void attn_phase(Frame& F) {
    LAS float* etab = (LAS float*)(F.lds + RING_OFF + ATT_ETAB_OFF);
    for (int i = F.tid; i < 8 * 256; i += NWAVES * 64) { const int h = i >> 8; int rel = (i & 255) - 63; rel = rel > 128 ? 128 : rel; etab[i] = F.in[9][h * 257 + rel + 128] * LOG2E; }
    __syncthreads();
    const int gw = (int)blockIdx.x * NWAVES + F.wave, NGW = F.G * NWAVES;
    for (int it = gw; it < BATCH * NCHUNK * 8; it += NGW) {
        const int c = 31 - (it >> 7), b = (it & 127) >> 3, h = it & 7;
        attn_item(F, b, c, h, etab);
    }
    __syncthreads();
}

__device__ __forceinline__ void hgrn_naive(Frame& F) {
    if (blockIdx.x >= 32) return;
    const bf16* QT = (const bf16*)(F.ws + WS_QT); const bf16* KT = (const bf16*)(F.ws + WS_KT); const bf16* VHT = (const bf16*)(F.ws + WS_VHT); const bf16* Gt = (const bf16*)(F.ws + WS_G);
    const float* DM = (const float*)(F.ws + WS_DM); const float* DE = (const float*)(F.ws + WS_DE); bf16* MIX = (bf16*)(F.ws + WS_MIX);
    LAS float* red = (LAS float*)(F.lds + RING_OFF);
    const int g2 = F.tid >> 8, bh = (int)blockIdx.x * 2 + g2, b = bh >> 2, hh = bh & 3, v = (F.tid & 255) >> 1, kh = F.tid & 1;
    int z; asm volatile("v_mov_b32 %0, 0" : "=v"(z));
    const float gout = F.in[11][v];
    float T[64];
#pragma unroll
    for (int k = 0; k < 64; ++k) T[k] = 0.f;
    for (int c = 0; c < NCHUNK; ++c) {
        const int chunk = b * NCHUNK + c;
        if (c > 0) {
            const float* de = DE + (size_t)(chunk - 1) * 512 + hh * 128 + 64 * kh; const float* dm = DM + (size_t)chunk * 512 + hh * 128 + 64 * kh;
#pragma unroll
            for (int k = 0; k < 64; k += 4) { const f32x4 a = *(const f32x4*)(de + k), e = *(const f32x4*)(dm + k); T[k] *= a[0] * e[0]; T[k + 1] *= a[1] * e[1]; T[k + 2] *= a[2] * e[2]; T[k + 3] *= a[3] * e[3]; }
        }
        for (int tt = 0; tt < 64; ++tt) {
            const int t = 64 * c + tt; const size_t row = (size_t)b * SEQ + t;
            const float vv = bf2f(VHT[((size_t)b * 512 + hh * 128 + v) * SEQ + t]);
            const bf16* qp = QT + row * 512 + hh * 128 + 64 * kh + z; const bf16* kp = KT + row * 512 + hh * 128 + 64 * kh + z;
            float o = 0.f;
#pragma unroll
            for (int i = 0; i < 8; ++i) { const v4u kw = *(const v4u*)(kp + 8 * i), qw = *(const v4u*)(qp + 8 * i);
                T[8 * i + 0] += bflo(kw.x) * vv; o += T[8 * i + 0] * bflo(qw.x); T[8 * i + 1] += bfhi(kw.x) * vv; o += T[8 * i + 1] * bfhi(qw.x);
                T[8 * i + 2] += bflo(kw.y) * vv; o += T[8 * i + 2] * bflo(qw.y); T[8 * i + 3] += bfhi(kw.y) * vv; o += T[8 * i + 3] * bfhi(qw.y);
                T[8 * i + 4] += bflo(kw.z) * vv; o += T[8 * i + 4] * bflo(qw.z); T[8 * i + 5] += bfhi(kw.z) * vv; o += T[8 * i + 5] * bfhi(qw.z);
                T[8 * i + 6] += bflo(kw.w) * vv; o += T[8 * i + 6] * bflo(qw.w); T[8 * i + 7] += bfhi(kw.w) * vv; o += T[8 * i + 7] * bfhi(qw.w); }
            o += __shfl_xor(o, 1);
            const float s = wave_sum(o * o) * 0.5f;
            if (F.lane == 0) red[F.wave] = s;
            __syncthreads();
            const float tot = (red[4 * g2] + red[4 * g2 + 1]) + (red[4 * g2 + 2] + red[4 * g2 + 3]);
            __syncthreads();
            const float y = o * __builtin_amdgcn_rsqf(tot * (1.0f / 128.0f) + RMS_EPS) * gout * bf2f(Gt[row * 512 + hh * 128 + v]);
            if (kh == 0) MIX[row * 1024 + 512 + hh * 128 + v] = (bf16)f2bf(y);
        }
    }
}

struct Args { const float* in[17]; float* out; unsigned char* ws; int ph_lo, ph_hi, li, pad; };
__global__ void __launch_bounds__(NWAVES * 64, 2) mega_fwd(Args args) {
    extern __shared__ __attribute__((aligned(16))) unsigned char lds[];
    Frame F;
    F.lds = (LAS unsigned char*)lds;
    F.MISC = (volatile LAS unsigned*)(F.lds + MISC_OFF);
    F.tid = threadIdx.x; F.lane = F.tid & 63; F.wave = __builtin_amdgcn_readfirstlane(F.tid >> 6);
    F.G = gridDim.x;
#pragma unroll
    for (int i = 0; i < 17; ++i) F.in[i] = args.in[i];
    F.out = args.out; F.ws = args.ws;
    F.ctl = (gu32*)(args.ws + WS_CTL);
    for (int u = F.tid; u < (LDS_BYTES - LDSCTL_OFF) / 4; u += NWAVES * 64) ((LAS unsigned*)(F.lds + LDSCTL_OFF))[u] = 0u;
    __syncthreads();
    XcdBarrier bar; bar.bar = (unsigned*)(F.ctl + CW_BAR); bar.x = 0; bar.st = nullptr;
    if (N_LAUNCHES != PER_PHASE) bar = xcd_barrier_post((unsigned*)(F.ctl + CW_BAR), F.MISC + 8);
#define GRID_BAR(seam) do { if (N_LAUNCHES == PER_PHASE) { if (F.tid == 0) __hip_atomic_store(F.ctl + CW_TMO, 0xBADBA0u | (unsigned)(seam), RLX_AGENT); } else { xcd_barrier(bar); } } while (0)
    const int lo = args.ph_lo, hi = args.ph_hi;
#define IN(k) (lo <= (k) && (k) < hi)
#define BOTH(k) (IN(k) && IN((k) + 1))
    bf16* const XB = (bf16*)(F.ws + WS_XB); bf16* const HID = (bf16*)(F.ws + WS_HID); bf16* const MIXp = (bf16*)(F.ws + WS_MIX);
    float* const RS1 = (float*)(F.ws + WS_RS1); float* const RS2 = (float*)(F.ws + WS_RS2);

    if (IN(0)) { p0_prologue(F); if (BOTH(0)) GRID_BAR(0); }
    if (IN(1)) {
        pg8::Gemm g{XB, (const bf16*)(F.ws + WS_WGU1), M, 2 * FF, D}; pg8::StaticOrder S; S.init(M, 2 * FF, F.G, (int)blockIdx.x);
        pg8::EpiSwiGLU E{HID, FF, nullptr};
        pg8::gemm_phase<pg8::EpiSwiGLU, pg8::StaticOrder, true, true>(F.lds + RING_OFF, g, S, E);
        if (BOTH(1)) GRID_BAR(1);
    }
    if (IN(2)) {
        pg8::Gemm g{HID, (const bf16*)(F.ws + WS_WD1), M, D, FF}; pg8::StaticOrder S; S.init(M, D, F.G, (int)blockIdx.x);
        pg8::EpiRes<true> E{F.in[0], F.out, XB, RS1, 0.5f};
        pg8::gemm_phase<pg8::EpiRes<true>, pg8::StaticOrder, true, true>(F.lds + RING_OFF, g, S, E);
        if (BOTH(2)) GRID_BAR(2);
    }
    if (IN(3)) {
        { pg8::Gemm g{XB, (const bf16*)(F.ws + WS_WIN), M, 2560, D}; pg8::StaticOrder S; S.init(M, 2560, F.G, (int)blockIdx.x);
          pg8::EpiWin E{(bf16*)(F.ws + WS_Q), (bf16*)(F.ws + WS_K), (bf16*)(F.ws + WS_QT), (bf16*)(F.ws + WS_KT), (bf16*)(F.ws + WS_G), (float*)(F.ws + WS_DM), (float*)(F.ws + WS_DE), RS1, F.in[7], F.in[8], (const float*)(F.ws + WS_LB)};
          pg8::gemm_phase<pg8::EpiWin, pg8::StaticOrder, true, true>(F.lds + RING_OFF, g, S, E); }
        { pg8::Gemm g{(const bf16*)(F.ws + WS_WINT), XB, 1024, M, D}; pg8::StaticOrder S; S.init(1024, M, F.G, (int)blockIdx.x);
          pg8::EpiVT E{(bf16*)(F.ws + WS_VT), (bf16*)(F.ws + WS_VHT), RS1};
          pg8::gemm_phase<pg8::EpiVT, pg8::StaticOrder, true, true>(F.lds + RING_OFF, g, S, E); }
        if (BOTH(3)) GRID_BAR(3);
    }
    if (IN(4)) {
        hgrn_naive(F);
        attn_phase(F);
        if (BOTH(4)) GRID_BAR(4);
    }
    if (IN(5)) {
        pg8::Gemm g{MIXp, (const bf16*)(F.ws + WS_WOUT), M, D, D}; pg8::StaticOrder S; S.init(M, D, F.G, (int)blockIdx.x);
        pg8::EpiRes<true> E{F.out, F.out, XB, RS2, 1.0f};
        pg8::gemm_phase<pg8::EpiRes<true>, pg8::StaticOrder, true, true>(F.lds + RING_OFF, g, S, E);
        if (BOTH(5)) GRID_BAR(5);
    }
    if (IN(6)) {
        pg8::Gemm g{XB, (const bf16*)(F.ws + WS_WGU2), M, 2 * FF, D}; pg8::StaticOrder S; S.init(M, 2 * FF, F.G, (int)blockIdx.x);
        pg8::EpiSwiGLU E{HID, FF, RS2};
        pg8::gemm_phase<pg8::EpiSwiGLU, pg8::StaticOrder, true, true>(F.lds + RING_OFF, g, S, E);
        if (BOTH(6)) GRID_BAR(6);
    }
    if (IN(7)) {
        pg8::Gemm g{HID, (const bf16*)(F.ws + WS_WD2), M, D, FF}; pg8::StaticOrder S; S.init(M, D, F.G, (int)blockIdx.x);
        pg8::EpiRes<false> E{F.out, F.out, nullptr, nullptr, 0.5f};
        pg8::gemm_phase<pg8::EpiRes<false>, pg8::StaticOrder, true, true>(F.lds + RING_OFF, g, S, E);
    }
#undef IN
#undef BOTH
}

extern "C" void kernel_launch(void* const* d_in, const int* in_sizes, int n_in, void* d_out, int out_size, void* d_ws, size_t ws_size, hipStream_t stream) {
    static int grid = 0;
    if (grid == 0) {
        if (n_in != 17 || in_sizes[0] != M * D || out_size != M * D || ws_size < WS_END) { fprintf(stderr, "kernel_launch: unexpected shapes (n_in %d, in0 %d, out %d, ws %zu); nothing launched\n", n_in, n_in > 0 ? in_sizes[0] : -1, out_size, ws_size); grid = -1; return; }
        int dev = 0, cus = 0, per_cu = 0;
        if (hipGetDevice(&dev) != hipSuccess || hipDeviceGetAttribute(&cus, hipDeviceAttributeMultiprocessorCount, dev) != hipSuccess) { grid = -1; return; }
        if (hipFuncSetAttribute((const void*)mega_fwd, hipFuncAttributeMaxDynamicSharedMemorySize, LDS_BYTES) != hipSuccess) { fprintf(stderr, "kernel_launch: hipFuncSetAttribute failed\n"); grid = -1; return; }
        if (hipOccupancyMaxActiveBlocksPerMultiprocessor(&per_cu, (const void*)mega_fwd, NWAVES * 64, LDS_BYTES) != hipSuccess || per_cu < 1) fprintf(stderr, "kernel_launch: note: occupancy query reports %d workgroups per CU\n", per_cu);
        (void)hipGetLastError();
        grid = cus;
    }
    if (grid < 0) return;
    if (hipMemsetAsync((char*)d_ws + WS_CTL, 0, CTL_ZERO_BYTES, stream) != hipSuccess) { fprintf(stderr, "kernel_launch: hipMemsetAsync failed\n"); return; }
    Args a{};
    for (int i = 0; i < 17; ++i) a.in[i] = (const float*)d_in[i];
    a.out = (float*)d_out; a.ws = (unsigned char*)d_ws;
    for (int li = 0; li < N_LAUNCHES; ++li) {
        a.ph_lo = (N_LAUNCHES == PER_PHASE) ? li : 0; a.ph_hi = (N_LAUNCHES == PER_PHASE) ? li + 1 : PER_PHASE; a.li = li;
        hipLaunchKernelGGL(mega_fwd, dim3(grid), dim3(NWAVES * 64), LDS_BYTES, stream, a);
        const hipError_t le = hipPeekAtLastError();
        if (le != hipSuccess) { fprintf(stderr, "kernel_launch: launch %d failed: %s\n", li, hipGetErrorName(le)); break; }
    }
}
```

```cpp
#include <hip/hip_runtime.h>
#include <cstdio>
#include <cstdint>
namespace pg8 {
#define PG8_LAS __attribute__((address_space(3)))
typedef unsigned short bf16_t;
typedef short bf16x8 __attribute__((ext_vector_type(8)));
typedef float f32x4 __attribute__((ext_vector_type(4)));
typedef unsigned u32x4 __attribute__((ext_vector_type(4)));
constexpr int BM = 256, BK = 64, HALF = 128, HTB = HALF * BK * 2  , STAGE_BYTES = 8 * HTB, NXCD = 8, WGM = 8;

__host__ __device__ __forceinline__ int lds_byte(int r, int c) { const int st = (r >> 4) * 2 + (c >> 5), rr = r & 15, cc = c & 31, ob = rr * 64 + cc * 2; return st * 1024 + (ob ^ (((ob >> 9) & 1) << 5)); }
__host__ __device__ __forceinline__ void stage_rc(int b, int& R, int& C) { const int st = b / 1024, sb = b % 1024, swz = sb ^ (((sb >> 9) & 1) << 5); R = (st >> 1) * 16 + swz / 64; C = (st & 1) * 32 + (swz % 64) / 2; }
__host__ __device__ __forceinline__ int perm32(int rho) { const int n = rho >> 4, i = rho & 15; return 8 * (i >> 2) + 4 * n + (i & 3); }

struct Unit { int pm, pn; };
struct Gemm { const bf16_t* A; const bf16_t* Bt; int M, N, K; };

struct StaticOrder {
    int nM, nN, nwg, G, c;
    __host__ __device__ void init(int M, int N, int G_, int c_) { nM = M / BM; nN = N / BM; nwg = nM * nN; G = G_; c = c_; }
    __host__ __device__ bool next(int i, Unit& u) const {
        const long L = (long)i * G + c; if (L >= nwg) return false;
        int wgid = (int)L; { const int q = nwg / NXCD, r = nwg % NXCD, xcd = wgid % NXCD, off = wgid / NXCD; wgid = (xcd < r ? xcd * (q + 1) : r * (q + 1) + (xcd - r) * q) + off; }
        const int nig = WGM * nN, gid = wgid / nig, fm = gid * WGM, gsz = (nM - fm) < WGM ? (nM - fm) : WGM;
        u.pm = fm + ((wgid % nig) % gsz); u.pn = (wgid % nig) / gsz; return true;
    }
    __device__ __forceinline__ void a_ready(const Unit&) const {}
    __device__ __forceinline__ void done(const Unit&) const {}
};


typedef unsigned u32x2 __attribute__((ext_vector_type(2)));
constexpr float RMS_EPS = 1e-6f, LOG2E = 1.4426950408889634f, QSCALE = 0.125f * 1.4426950408889634f;
__device__ __forceinline__ unsigned cvt_pk_bf16(float lo, float hi) { unsigned r; asm volatile("v_cvt_pk_bf16_f32 %0, %1, %2" : "=v"(r) : "v"(lo), "v"(hi)); return r; }
__device__ __forceinline__ float fsigmoid(float x) { return __builtin_amdgcn_rcpf(1.0f + __builtin_amdgcn_exp2f(-x * LOG2E)); }
__device__ __forceinline__ float fsilu(float x) { return x * fsigmoid(x); }
__device__ __forceinline__ f32x4 silu4(f32x4 v) { return (f32x4){fsilu(v[0]), fsilu(v[1]), fsilu(v[2]), fsilu(v[3])}; }
__device__ __forceinline__ u32x4 pack8(f32x4 a, f32x4 b) { u32x4 w; w.x = cvt_pk_bf16(a[0], a[1]); w.y = cvt_pk_bf16(a[2], a[3]); w.z = cvt_pk_bf16(b[0], b[1]); w.w = cvt_pk_bf16(b[2], b[3]); return w; }
__device__ __forceinline__ float rowscale(const float* rowsq, int row) { return rowsq ? __builtin_amdgcn_rsqf(rowsq[row] * (1.0f / 1024.0f) + RMS_EPS) : 1.0f; }
template <int CTRL> __device__ __forceinline__ float dpp_mov0(float x) { return __builtin_bit_cast(float, __builtin_amdgcn_update_dpp(0, __builtin_bit_cast(int, x), CTRL, 0xf, 0xf, true)); }
__device__ __forceinline__ float row_scan16(float x) { x += dpp_mov0<0x111>(x); x += dpp_mov0<0x112>(x); x += dpp_mov0<0x114>(x); x += dpp_mov0<0x118>(x); return x; }

struct EpiSwiGLU {
    static constexpr bool PERM = false, AFTER_DRAIN = false;
    bf16_t* H; int ldh; const float* rowsq;
    __device__ __forceinline__ void operator()(f32x4 (&acc)[2][2][4][2], const Unit& u, int wr, int wc, int fr, int fq) const {
        const int row0 = u.pm * BM + wr * 64 + fr, col0 = u.pn * HALF + wc * 32 + 8 * fq;
#pragma unroll
        for (int ai = 0; ai < 2; ++ai)
#pragma unroll
            for (int m = 0; m < 4; ++m) { const int row = row0 + ai * HALF + m * 16; const float r = rowscale(rowsq, row);
                const f32x4 h0 = silu4(acc[ai][0][m][0] * r) * (acc[ai][1][m][0] * r), h1 = silu4(acc[ai][0][m][1] * r) * (acc[ai][1][m][1] * r);
                *(u32x4*)(H + (unsigned)(row * ldh + col0)) = pack8(h0, h1); }
    }
};
template <bool WB> struct EpiRes {
    static constexpr bool PERM = false, AFTER_DRAIN = false;
    const float* base; float* out; bf16_t* xb; float* rowsq; float scale;
    __device__ __forceinline__ void operator()(f32x4 (&acc)[2][2][4][2], const Unit& u, int wr, int wc, int fr, int fq) const {
        const int row0 = u.pm * BM + wr * 64 + fr, col0 = u.pn * BM + wc * 32 + 4 * fq;
#pragma unroll
        for (int ai = 0; ai < 2; ++ai)
#pragma unroll
            for (int m = 0; m < 4; ++m) { const int row = row0 + ai * HALF + m * 16; const unsigned off = (unsigned)(row * 1024 + col0); float ss = 0.f;
#pragma unroll
                for (int bj = 0; bj < 2; ++bj)
#pragma unroll
                    for (int n = 0; n < 2; ++n) { const unsigned o = off + bj * HALF + n * 16; const f32x4 v = *(const f32x4*)(base + o) + acc[ai][bj][m][n] * scale; *(f32x4*)(out + o) = v;
                        if (WB) { u32x2 w; w.x = cvt_pk_bf16(v[0], v[1]); w.y = cvt_pk_bf16(v[2], v[3]); *(u32x2*)(xb + o) = w; ss += (v[0] * v[0] + v[1] * v[1]) + (v[2] * v[2] + v[3] * v[3]); } }
                if (WB) { ss += __shfl_xor(ss, 16); ss += __shfl_xor(ss, 32); if (fq == 0) __hip_atomic_fetch_add(rowsq + row, ss, __ATOMIC_RELAXED, __HIP_MEMORY_SCOPE_AGENT); }
                asm volatile("" ::: "memory"); }
    }
};
struct EpiWin {
    static constexpr bool PERM = false, AFTER_DRAIN = false;
    bf16_t *Q, *K, *QT, *KT, *QD, *KH, *G; float *DM, *DE; const float *rowsq, *gq, *gk, *lb;
    __device__ __forceinline__ void operator()(f32x4 (&acc)[2][2][4][2], const Unit& u, int wr, int wc, int fr, int fq) const {
        const int row0 = u.pm * BM + wr * 64 + fr, t = u.pn;
        if (t < 4) {
            const bool isq = t < 2; const int head = 4 * (t & 1) + wc; const float* gp = isq ? gq : gk; const float gs = isq ? QSCALE : 1.0f;
            f32x4 gv[2][2];
#pragma unroll
            for (int bj = 0; bj < 2; ++bj)
#pragma unroll
                for (int n = 0; n < 2; ++n) gv[bj][n] = *(const f32x4*)(gp + 32 * bj + 8 * fq + 4 * n) * gs;
            bf16_t* dst = (isq ? Q : K) + head * 64 + 8 * fq;
#pragma unroll
            for (int ai = 0; ai < 2; ++ai)
#pragma unroll
                for (int m = 0; m < 4; ++m) { const int row = row0 + ai * HALF + m * 16; const float r = rowscale(rowsq, row); float ss = 0.f;
#pragma unroll
                    for (int bj = 0; bj < 2; ++bj)
#pragma unroll
                        for (int n = 0; n < 2; ++n) { const f32x4 v = acc[ai][bj][m][n] * r; acc[ai][bj][m][n] = v; ss += (v[0] * v[0] + v[1] * v[1]) + (v[2] * v[2] + v[3] * v[3]); }
                    ss += __shfl_xor(ss, 16); ss += __shfl_xor(ss, 32);
                    const float inv = __builtin_amdgcn_rsqf(ss * (1.0f / 64.0f) + RMS_EPS);
#pragma unroll
                    for (int bj = 0; bj < 2; ++bj) *(u32x4*)(dst + (unsigned)(row * 512 + 32 * bj)) = pack8(acc[ai][bj][m][0] * inv * gv[bj][0], acc[ai][bj][m][1] * inv * gv[bj][1]); }
        } else if (t < 8) {
            const int hh = t - 4, kbase = hh * 128 + wc * 32 + 8 * fq;
            float lbv[8]; { const f32x4 l0 = *(const f32x4*)(lb + kbase), l1 = *(const f32x4*)(lb + kbase + 4);
#pragma unroll
                for (int c = 0; c < 4; ++c) { lbv[c] = l0[c]; lbv[4 + c] = l1[c]; } }
            const int lane = fq * 16 + fr;
#pragma unroll
            for (int ai = 0; ai < 2; ++ai)
#pragma unroll
                for (int n = 0; n < 2; ++n) {
                    float omf[4][4], carry[4], bmid[4];
#pragma unroll
                    for (int m = 0; m < 4; ++m) { const int row = row0 + ai * HALF + m * 16; const float r = rowscale(rowsq, row);
#pragma unroll
                        for (int c = 0; c < 4; ++c) { const int e = 4 * n + c; const float a = acc[ai][0][m][n][c] * r, b = acc[ai][1][m][n][c] * r;
                            const float sg = fsigmoid(b), f = lbv[e] + (1.0f - lbv[e]) * sg; omf[m][c] = (1.0f - lbv[e]) * (1.0f - sg);
                            acc[ai][1][m][n][c] = __builtin_amdgcn_logf(f);
                            acc[ai][0][m][n][c] = fsilu(a); } }
#pragma unroll
                    for (int c = 0; c < 4; ++c) { carry[c] = 0.f; bmid[c] = 0.f; }
#pragma unroll
                    for (int m = 0; m < 4; ++m)
#pragma unroll
                        for (int c = 0; c < 4; ++c) { float x = row_scan16(acc[ai][1][m][n][c]) + carry[c]; acc[ai][1][m][n][c] = x;
                            carry[c] = __shfl(x, lane | 15); if (m == 1) bmid[c] = carry[c]; }
#pragma unroll
                    for (int m = 0; m < 4; ++m) { const int row = row0 + ai * HALF + m * 16; f32x4 qv, kv, qd, kh;
#pragma unroll
                        for (int c = 0; c < 4; ++c) { const float bc = acc[ai][1][m][n][c], d = bc - bmid[c];
                            qv[c] = acc[ai][0][m][n][c] * __builtin_amdgcn_exp2f(d); kv[c] = omf[m][c] * __builtin_amdgcn_exp2f(-d);
                            qd[c] = acc[ai][0][m][n][c] * __builtin_amdgcn_exp2f(bc); kh[c] = omf[m][c] * __builtin_amdgcn_exp2f(carry[c] - bc); }
                        const unsigned o = (unsigned)(row * 512 + kbase + 4 * n);
                        u32x2 w; w.x = cvt_pk_bf16(qv[0], qv[1]); w.y = cvt_pk_bf16(qv[2], qv[3]); *(u32x2*)(QT + o) = w;
                        w.x = cvt_pk_bf16(kv[0], kv[1]); w.y = cvt_pk_bf16(kv[2], kv[3]); *(u32x2*)(KT + o) = w;
                        w.x = cvt_pk_bf16(qd[0], qd[1]); w.y = cvt_pk_bf16(qd[2], qd[3]); *(u32x2*)(QD + o) = w;
                        w.x = cvt_pk_bf16(kh[0], kh[1]); w.y = cvt_pk_bf16(kh[2], kh[3]); *(u32x2*)(KH + o) = w; }
                    if (fr == 0) { const int chunk = (u.pm * BM + ai * HALF + wr * 64) >> 6; f32x4 a0, e0;
#pragma unroll
                        for (int c = 0; c < 4; ++c) { a0[c] = __builtin_amdgcn_exp2f(bmid[c]); e0[c] = __builtin_amdgcn_exp2f(carry[c] - bmid[c]); }
                        *(f32x4*)(DM + (unsigned)(chunk * 512 + kbase + 4 * n)) = a0; *(f32x4*)(DE + (unsigned)(chunk * 512 + kbase + 4 * n)) = e0; }
                    asm volatile("" ::: "memory");
                }
        } else {
            bf16_t* dst = G + (t - 8) * 256 + wc * 32 + 8 * fq;
#pragma unroll
            for (int ai = 0; ai < 2; ++ai)
#pragma unroll
                for (int m = 0; m < 4; ++m) { const int row = row0 + ai * HALF + m * 16; const float r = rowscale(rowsq, row);
#pragma unroll
                    for (int bj = 0; bj < 2; ++bj) *(u32x4*)(dst + (unsigned)(row * 512 + bj * HALF)) = pack8(silu4(acc[ai][bj][m][0] * r), silu4(acc[ai][bj][m][1] * r)); }
        }
    }
};
struct EpiVT {
    static constexpr bool PERM = true, AFTER_DRAIN = false;
    bf16_t *VT, *VHT; const float* rowsq;
    __device__ __forceinline__ void operator()(f32x4 (&acc)[2][2][4][2], const Unit& u, int wr, int wc, int fr, int fq) const {
        const int ch0 = (u.pm & 1) * BM + wr * 64 + fr, tok0 = u.pn * BM + wc * 32 + 8 * fq, b = tok0 >> 11, s0 = tok0 & 2047;
        f32x4 rs[2][2];
#pragma unroll
        for (int bj = 0; bj < 2; ++bj)
#pragma unroll
            for (int n = 0; n < 2; ++n) { const f32x4 q = *(const f32x4*)(rowsq + tok0 + bj * HALF + 4 * n);
#pragma unroll
                for (int c = 0; c < 4; ++c) rs[bj][n][c] = __builtin_amdgcn_rsqf(q[c] * (1.0f / 1024.0f) + RMS_EPS); }
        bf16_t* dst = (u.pm < 2 ? VT : VHT) + (size_t)b * 512 * 2048 + s0;
#pragma unroll
        for (int ai = 0; ai < 2; ++ai)
#pragma unroll
            for (int m = 0; m < 4; ++m) { const int ch = ch0 + ai * HALF + m * 16;
#pragma unroll
                for (int bj = 0; bj < 2; ++bj) *(u32x4*)(dst + (unsigned)(ch * 2048 + bj * HALF)) = pack8(acc[ai][bj][m][0] * rs[bj][0], acc[ai][bj][m][1] * rs[bj][1]); }
    }
};

template <class Epi, class Sched, bool ALIGN_EPI = false, bool SP2 = false>
__device__ __forceinline__ void gemm_phase(PG8_LAS unsigned char* lds, const Gemm g, const Sched& S, const Epi& E) {
    const int tid = threadIdx.x, wid = __builtin_amdgcn_readfirstlane(tid >> 6), lane = tid & 63, wr = wid >> 2, wc = wid & 3, fr = lane & 15, fq = lane >> 4;
    const int K = g.K, nt = K / BK;
    unsigned voffA[2], voffB[2];
#pragma unroll
    for (int i = 0; i < 2; ++i) { int R, C; stage_rc(tid * 16 + i * 8192, R, C); const int Rb = Epi::PERM ? ((R & ~31) + perm32(R & 31)) : R;
        voffA[i] = (unsigned)(R * K + C) * 2u; voffB[i] = (unsigned)(Rb * K + C) * 2u; }
    const size_t kstep = (size_t)(BK * 2);
    const size_t hstep = (size_t)HALF * K * 2;
    const size_t tstep = 2 * hstep;
    const unsigned ldsw = (unsigned)wid * 1024u;
    const int aoff = lds_byte(wr * 64 + fr, fq * 8), boff = lds_byte(wc * 32 + fr, fq * 8);
#define PG8_SA(b, h) (((b) * 2 + (h)) * HTB)
#define PG8_SB(b, h) ((4 + (b) * 2 + (h)) * HTB)
#define PG8_STAGE(bufoff, gbase, voff) do { _Pragma("unroll") for (int _i = 0; _i < 2; ++_i) \
        __builtin_amdgcn_global_load_lds((const unsigned*)((const char*)(gbase) + (voff)[_i]), (PG8_LAS unsigned*)(lds + (bufoff) + ldsw + _i * 8192), 16, 0, 0); } while (0)
#define PG8_LDA(dst, b, h) do { _Pragma("unroll") for (int m = 0; m < 4; ++m) _Pragma("unroll") for (int k = 0; k < 2; ++k) dst[m][k] = *(const PG8_LAS bf16x8*)(lds + PG8_SA(b, h) + aoff + m * 2048 + k * 1024); } while (0)
#define PG8_LDB(dst, b, h) do { _Pragma("unroll") for (int n = 0; n < 2; ++n) _Pragma("unroll") for (int k = 0; k < 2; ++k) dst[n][k] = *(const PG8_LAS bf16x8*)(lds + PG8_SB(b, h) + boff + n * 2048 + k * 1024); } while (0)
#define PG8_MMA(ai, bj, At, Bt) do { __builtin_amdgcn_s_setprio(1); _Pragma("unroll") for (int m = 0; m < 4; ++m) _Pragma("unroll") for (int n = 0; n < 2; ++n) _Pragma("unroll") for (int k = 0; k < 2; ++k) \
        acc[ai][bj][m][n] = __builtin_amdgcn_mfma_f32_16x16x32_bf16(Bt[n][k], At[m][k], acc[ai][bj][m][n], 0, 0, 0); __builtin_amdgcn_s_setprio(0); } while (0)
#define PG8_WAIT_V(n) asm volatile("s_waitcnt vmcnt(" #n ")" ::: "memory")
#define PG8_WAIT_L(n) asm volatile("s_waitcnt lgkmcnt(" #n ")" ::: "memory")
#define PG8_BAR __builtin_amdgcn_s_barrier()
#define PG8_SCHED __builtin_amdgcn_sched_barrier(0)
    Unit cur, nxt; int ui = 0;
    if (!S.next(0, cur)) return;
    f32x4 acc[2][2][4][2];
#pragma unroll
    for (int a = 0; a < 2; ++a)
#pragma unroll
        for (int b = 0; b < 2; ++b)
#pragma unroll
            for (int m = 0; m < 4; ++m)
#pragma unroll
                for (int n = 0; n < 2; ++n) acc[a][b][m][n] = (f32x4){0.f, 0.f, 0.f, 0.f};
    bf16x8 At[4][2], B0[2][2], B1[2][2];
    const char* cA = (const char*)g.A + (size_t)cur.pm * tstep; const char* cB = (const char*)g.Bt + (size_t)cur.pn * tstep;
    S.a_ready(cur);
    if constexpr (SP2) {
        PG8_STAGE(PG8_SB(0, 0), cB, voffB); PG8_STAGE(PG8_SB(0, 1), cB + hstep, voffB); PG8_STAGE(PG8_SA(0, 0), cA, voffA); PG8_STAGE(PG8_SA(0, 1), cA + hstep, voffA);
        if (wr == 1) PG8_BAR;
        PG8_WAIT_V(2); PG8_BAR;
        PG8_STAGE(PG8_SB(1, 0), cB + kstep, voffB); PG8_STAGE(PG8_SA(1, 0), cA + kstep, voffA); PG8_STAGE(PG8_SB(1, 1), cB + hstep + kstep, voffB);
        PG8_WAIT_V(6); PG8_BAR;
    } else {
        PG8_STAGE(PG8_SB(0, 0), cB, voffB); PG8_STAGE(PG8_SA(0, 0), cA, voffA); PG8_STAGE(PG8_SB(0, 1), cB + hstep, voffB); PG8_STAGE(PG8_SA(0, 1), cA + hstep, voffA);
        if (wr == 1) PG8_BAR;
        PG8_WAIT_V(4); PG8_BAR;
        PG8_STAGE(PG8_SB(1, 0), cB + kstep, voffB); PG8_STAGE(PG8_SA(1, 0), cA + kstep, voffA); PG8_STAGE(PG8_SB(1, 1), cB + hstep + kstep, voffB);
        PG8_WAIT_V(6); PG8_BAR;
    }
    for (;;) {
        const bool has_next = S.next(ui + 1, nxt);
        const char* nA = has_next ? (const char*)g.A + (size_t)nxt.pm * tstep : cA; const char* nB = has_next ? (const char*)g.Bt + (size_t)nxt.pn * tstep : cB;
        for (int t = 0; t < nt; t += 2) {
            const bool last = (t == nt - 2);
            const char* a1 = cA + (size_t)(t + 1) * kstep;
            const char* a2 = last ? nA : cA + (size_t)(t + 2) * kstep; const char* b2 = last ? nB : cB + (size_t)(t + 2) * kstep;
            const char* a3 = a2 + kstep; const char* b3 = b2 + kstep;
            if (last && has_next) S.a_ready(nxt);
            if constexpr (SP2) {
            PG8_LDB(B0, 0, 0); PG8_LDB(B1, 0, 1); PG8_SCHED; PG8_LDA(At, 0, 0); PG8_STAGE(PG8_SA(1, 1), a1 + hstep, voffA);
            PG8_WAIT_V(8); PG8_WAIT_L(0); PG8_BAR; PG8_MMA(0, 0, At, B0); PG8_MMA(0, 1, At, B1); PG8_BAR; PG8_SCHED;
            PG8_LDA(At, 0, 1); PG8_STAGE(PG8_SB(0, 0), b2, voffB); PG8_STAGE(PG8_SB(0, 1), b2 + hstep, voffB); PG8_STAGE(PG8_SA(0, 0), a2, voffA);
            PG8_WAIT_V(8); PG8_WAIT_L(0); PG8_BAR; PG8_MMA(1, 0, At, B0); PG8_MMA(1, 1, At, B1); PG8_BAR; PG8_SCHED;
            PG8_LDB(B0, 1, 0); PG8_LDB(B1, 1, 1); PG8_SCHED; PG8_LDA(At, 1, 0); PG8_STAGE(PG8_SA(0, 1), a2 + hstep, voffA);
            PG8_WAIT_V(8); PG8_WAIT_L(0); PG8_BAR; PG8_MMA(0, 0, At, B0); PG8_MMA(0, 1, At, B1); PG8_BAR; PG8_SCHED;
            PG8_LDA(At, 1, 1); PG8_STAGE(PG8_SB(1, 0), b3, voffB); PG8_STAGE(PG8_SB(1, 1), b3 + hstep, voffB); PG8_STAGE(PG8_SA(1, 0), a3, voffA);
            PG8_WAIT_V(8); PG8_WAIT_L(0); PG8_BAR; PG8_MMA(1, 0, At, B0); PG8_MMA(1, 1, At, B1); PG8_BAR; PG8_SCHED;
            } else {
            PG8_LDB(B0, 0, 0); PG8_SCHED; PG8_LDA(At, 0, 0); PG8_STAGE(PG8_SA(1, 1), a1 + hstep, voffA);
            PG8_WAIT_L(8); PG8_BAR; PG8_WAIT_L(0); PG8_MMA(0, 0, At, B0); PG8_BAR; PG8_SCHED;
            PG8_LDB(B1, 0, 1); PG8_STAGE(PG8_SB(0, 0), b2, voffB);
            PG8_BAR; PG8_WAIT_L(0); PG8_MMA(0, 1, At, B1); PG8_BAR;
            PG8_LDA(At, 0, 1); PG8_STAGE(PG8_SA(0, 0), a2, voffA);
            PG8_BAR; PG8_WAIT_L(0); PG8_MMA(1, 0, At, B0); PG8_BAR; PG8_SCHED;
            PG8_STAGE(PG8_SB(0, 1), b2 + hstep, voffB);
            PG8_WAIT_V(6); PG8_BAR; PG8_MMA(1, 1, At, B1); PG8_BAR;
            PG8_LDB(B0, 1, 0); PG8_SCHED; PG8_LDA(At, 1, 0); PG8_STAGE(PG8_SA(0, 1), a2 + hstep, voffA);
            PG8_WAIT_L(8); PG8_BAR; PG8_WAIT_L(0); PG8_MMA(0, 0, At, B0); PG8_BAR; PG8_SCHED;
            PG8_LDB(B1, 1, 1); PG8_STAGE(PG8_SB(1, 0), b3, voffB);
            PG8_BAR; PG8_WAIT_L(0); PG8_MMA(0, 1, At, B1); PG8_BAR;
            PG8_LDA(At, 1, 1); PG8_STAGE(PG8_SA(1, 0), a3, voffA);
            PG8_BAR; PG8_WAIT_L(0); PG8_MMA(1, 0, At, B0); PG8_BAR; PG8_SCHED;
            PG8_STAGE(PG8_SB(1, 1), b3 + hstep, voffB);
            PG8_WAIT_V(6); PG8_BAR; PG8_MMA(1, 1, At, B1); PG8_BAR;
            }
        }
        if constexpr (ALIGN_EPI) { if (wr == 0) PG8_BAR; }
        if constexpr (!Epi::AFTER_DRAIN) { E(acc, cur, wr, wc, fr, fq); S.done(cur); }
        if (!has_next) break;
#pragma unroll
        for (int a = 0; a < 2; ++a)
#pragma unroll
            for (int b = 0; b < 2; ++b)
#pragma unroll
                for (int m = 0; m < 4; ++m)
#pragma unroll
                    for (int n = 0; n < 2; ++n) acc[a][b][m][n] = (f32x4){0.f, 0.f, 0.f, 0.f};
        cur = nxt; cA = nA; cB = nB; ++ui;
        if constexpr (ALIGN_EPI) { if (wr == 1) PG8_BAR; }
    }
    PG8_WAIT_V(0);
    if constexpr (!ALIGN_EPI) { if (wr == 0) PG8_BAR; }
    PG8_BAR;
    if constexpr (Epi::AFTER_DRAIN) { E.fused(acc, cur, wr, wc, fr, fq, lds, wid, lane); S.done(cur); }
#undef PG8_SA
#undef PG8_SB
#undef PG8_STAGE
#undef PG8_LDA
#undef PG8_LDB
#undef PG8_MMA
#undef PG8_WAIT_V
#undef PG8_WAIT_L
#undef PG8_BAR
#undef PG8_SCHED
}
}

constexpr int NWAVES = 8;
#ifndef MK_N_LAUNCHES
#define MK_N_LAUNCHES 1
#endif
constexpr int PER_PHASE = 8;
constexpr int N_LAUNCHES = MK_N_LAUNCHES;
constexpr int BATCH = 16, SEQ = 2048, D = 1024, M = BATCH * SEQ, FF = 2816, NPROJ = 3584;
constexpr int AW = 512, HW = 512, NCHUNK = SEQ / 64;
constexpr float RMS_EPS = 1e-6f, LOG2E = 1.4426950408889634f;

constexpr size_t MiB = 1u << 20;
constexpr size_t WS_CTL = 0, CTL_ZERO_BYTES = 1 * MiB;
constexpr size_t WS_RS1 = 256 * 1024, WS_RS2 = 384 * 1024;
constexpr size_t WS_LB = 1 * MiB, WS_DM = 2 * MiB, WS_DE = 3 * MiB;
constexpr size_t WS_WGU1 = 4 * MiB, WS_WD1 = 15 * MiB, WS_WIN = 21 * MiB, WS_WINT = 26 * MiB, WS_WOUT = 28 * MiB, WS_WGU2 = 30 * MiB, WS_WD2 = 41 * MiB;
constexpr size_t WS_XB = 48 * MiB;
constexpr size_t WS_MIX = 112 * MiB;
constexpr size_t WS_HID = 176 * MiB;
constexpr size_t WS_Q = 176 * MiB, WS_K = 208 * MiB, WS_VT = 240 * MiB, WS_QT = 272 * MiB, WS_KT = 304 * MiB, WS_VHT = 336 * MiB, WS_G = 368 * MiB, WS_QD = 400 * MiB, WS_KH = 432 * MiB, WS_END = 464 * MiB;
static_assert(WS_WGU1 + (size_t)2 * FF * D * 2 <= WS_WD1 && WS_WD1 + (size_t)D * FF * 2 <= WS_WIN && WS_WIN + (size_t)2560 * D * 2 <= WS_WINT && WS_WGU2 + (size_t)2 * FF * D * 2 <= WS_WD2 && WS_WD2 + (size_t)D * FF * 2 <= WS_XB, "weight map");
static_assert(WS_HID + (size_t)M * FF * 2 <= WS_END && WS_XB + (size_t)M * D * 2 <= WS_MIX && WS_MIX + (size_t)M * D * 2 <= WS_HID, "activation map");
constexpr int CW_TMO = 0, CW_CODE = 1;
constexpr int CW_BAR = 4096;
constexpr int CW_WQ = 16384;

constexpr int RING_OFF = 0, RING_BYTES = 131072;
constexpr int LDSCTL_OFF = RING_BYTES, MISC_OFF = LDSCTL_OFF + 320;
constexpr int LDS_BYTES = 147456;
static_assert(MISC_OFF + 128 <= LDS_BYTES, "LDS map");

#define GAS __attribute__((address_space(1)))
#define LAS __attribute__((address_space(3)))
typedef unsigned short bf16;
typedef unsigned v4u __attribute__((ext_vector_type(4)));
typedef float f32x4 __attribute__((ext_vector_type(4)));
typedef short bf16x8 __attribute__((ext_vector_type(8)));
typedef GAS unsigned gu32;
#define RLX_AGENT __ATOMIC_RELAXED, __HIP_MEMORY_SCOPE_AGENT
#define LDS_WAIT() asm volatile("s_waitcnt lgkmcnt(0)" ::: "memory")
#define VM_WAIT() asm volatile("s_waitcnt vmcnt(0)" ::: "memory")
__device__ __forceinline__ unsigned f2bf(float f) { unsigned u = __builtin_bit_cast(unsigned, f); return (u + 0x7fffu + ((u >> 16) & 1u)) >> 16; }
__device__ __forceinline__ unsigned pk2(float lo, float hi) { return f2bf(lo) | (f2bf(hi) << 16); }
__device__ __forceinline__ float bf2f(unsigned short h) { return __builtin_bit_cast(float, (unsigned)h << 16); }
__device__ __forceinline__ float bflo(unsigned w) { return __builtin_bit_cast(float, w << 16); }
__device__ __forceinline__ float bfhi(unsigned w) { return __builtin_bit_cast(float, w & 0xffff0000u); }

#define XB_TMO      128
#define XB_XCNT(j)  (256  + 64 * (j))
#define XB_XSUB(j)  (1280 + 64 * (j))
#define XB_XGEN(j)  (2304 + 64 * (j))
#define XB_TOP      3328
#define XB_TOPGEN   3392
#define XCD_BAR_WORDS 3456
#define XB_SPIN_CAP (1u << 18)

__device__ __forceinline__ unsigned xb_ld(unsigned* p)              { return __hip_atomic_load(p, __ATOMIC_RELAXED, __HIP_MEMORY_SCOPE_AGENT); }
__device__ __forceinline__ unsigned xb_add(unsigned* p, unsigned v) { return __hip_atomic_fetch_add(p, v, __ATOMIC_RELAXED, __HIP_MEMORY_SCOPE_AGENT); }
__device__ __forceinline__ unsigned xb_xcc_id() { return (unsigned)__builtin_amdgcn_s_getreg((3 << 11) | 20) & 0xFu; }
#define XB_SPIN(cond, bar) do { unsigned _sp = 0; while (cond) { __builtin_amdgcn_s_sleep(1); \
    if ((++_sp & 255u) == 0u) { if (xb_ld(&(bar)[XB_TMO])) break; if (_sp > XB_SPIN_CAP) { atomicAdd(&(bar)[XB_TMO], 1u); break; } } } } while (0)

struct XcdBarrier {
    unsigned* bar; unsigned x;
    volatile LAS unsigned* st;
};

__device__ __forceinline__ XcdBarrier xcd_barrier_post(unsigned* bar, volatile LAS unsigned* st) {
    XcdBarrier b; b.bar = bar; b.x = xb_xcc_id(); b.st = st;
    if (threadIdx.x == 0) (void)xb_add(&bar[XB_XCNT(b.x)], 1u);
    return b;
}
__device__ __forceinline__ void xcd_barrier_complete(unsigned* bar, unsigned x, unsigned& nloc, unsigned& nx) {
    const unsigned G = gridDim.x * gridDim.y * gridDim.z;
    unsigned sum, cnt, mine, sp = 0u;
    for (;;) {
        sum = 0u; cnt = 0u; mine = 0u;
#pragma unroll
        for (unsigned j = 0; j < 16; ++j) { const unsigned c = xb_ld(&bar[XB_XCNT(j)]); sum += c; cnt += (c > 0u) ? 1u : 0u; mine = (j == x) ? c : mine; }
        if (sum == G) break;
        __builtin_amdgcn_s_sleep(1);
        if ((++sp & 255u) == 0u) { if (xb_ld(&bar[XB_TMO])) break; if (sp > XB_SPIN_CAP) { atomicAdd(&bar[XB_TMO], 1u); break; } }
    }
    nloc = mine > 0u ? mine : 1u; nx = cnt > 0u ? cnt : 1u;
}

__device__ __forceinline__ void xcd_barrier(const XcdBarrier& b) {
    asm volatile("s_waitcnt vmcnt(0)" ::: "memory");
    __syncthreads();
    if (threadIdx.x == 0) {
        unsigned* bar = b.bar;
        __builtin_amdgcn_s_waitcnt(0);
        unsigned nloc = b.st[0], nx = b.st[1];
        if (nloc == 0u) { xcd_barrier_complete(bar, b.x, nloc, nx); b.st[0] = nloc; b.st[1] = nx; }
        const unsigned old = xb_add(&bar[XB_XSUB(b.x)], 1u);
        const unsigned gen = old / nloc;
        if (old + 1u == (gen + 1u) * nloc) {
            __builtin_amdgcn_fence(__ATOMIC_RELEASE, "agent");
            asm volatile("s_waitcnt vmcnt(0)" ::: "memory");
            const unsigned og = xb_add(&bar[XB_TOP], 1u);
            const unsigned tg = og / nx;
            if (og + 1u == (tg + 1u) * nx) xb_add(&bar[XB_TOPGEN], 1u);
            else XB_SPIN(xb_ld(&bar[XB_TOPGEN]) == tg, bar);
            __builtin_amdgcn_fence(__ATOMIC_ACQUIRE, "agent");
            xb_add(&bar[XB_XGEN(b.x)], 1u);
            asm volatile("s_waitcnt vmcnt(0)" ::: "memory");
        } else {
            XB_SPIN(xb_ld(&bar[XB_XGEN(b.x)]) == gen, bar);
            __builtin_amdgcn_fence(__ATOMIC_ACQUIRE, "agent");
            asm volatile("s_waitcnt vmcnt(0)" ::: "memory");
        }
    }
    __syncthreads();
}

struct Frame {
    LAS unsigned char* lds;
    volatile LAS unsigned* MISC;
    gu32* ctl;
    int tid, lane, wave, G;
    const float* in[17]; float* out; unsigned char* ws;
};
__device__ __forceinline__ float wave_sum(float v) {
#pragma unroll
    for (int o = 1; o < 64; o <<= 1) v += __shfl_xor(v, o);
    return v;
}
__device__ __forceinline__ int srccol(int kind, int R, int& sel) {
    sel = 0;
    if (kind == 0) return R;
    const int t = R >> 8, p = R & 255, bj = p >> 7, q = p & 127, wc = q >> 5, pr = pg8::perm32(q & 31);
    if (kind == 1) { sel = bj; return 128 * t + 32 * wc + pr; }
    if (kind == 2) {
        if (t < 2) return 64 * (4 * t + wc) + 32 * bj + pr;
        if (t < 4) return 512 + 64 * (4 * (t - 2) + wc) + 32 * bj + pr;
        if (t < 8) return (bj ? 2048 : 1536) + 128 * (t - 4) + 32 * wc + pr;
        return 3072 + 256 * (t - 8) + 128 * bj + 32 * wc + pr;
    }
    return R < 512 ? 1024 + R : 2560 + (R - 512);
}
__device__ __forceinline__ void p0_item(const float* W0, const float* W1, int K, int N, int kind, bf16* WT, const float* gain, LAS float* scr, int item, int nblk, int lane) {
    const int kb = item / nblk, nb = item % nblk, k0 = 64 * kb, R0 = 32 * nb;
    int sel; const int c = srccol(kind, R0 + (lane & 31), sel);
    const float* W = sel ? W1 : W0;
#pragma unroll 8
    for (int i = 0; i < 32; ++i) { const int kk = 2 * i + (lane >> 5); float v = W[(size_t)(k0 + kk) * N + c]; if (gain) v *= gain[k0 + kk]; scr[kk * 33 + (lane & 31)] = v; }
    LDS_WAIT(); asm volatile("" ::: "memory");
    const int c8 = lane & 7;
#pragma unroll
    for (int j = 0; j < 4; ++j) { const int n = (lane >> 3) + 8 * j; const LAS float* s = scr + (8 * c8) * 33 + n;
        v4u o; o.x = pk2(s[0 * 33], s[1 * 33]); o.y = pk2(s[2 * 33], s[3 * 33]); o.z = pk2(s[4 * 33], s[5 * 33]); o.w = pk2(s[6 * 33], s[7 * 33]);
        *(GAS v4u*)(WT + (size_t)(R0 + n) * K + k0 + 8 * c8) = o; }
    LDS_WAIT(); asm volatile("" ::: "memory");
}
__device__ __forceinline__ void rms_row_to_bf16(const float* xrow, const float* g, bf16* orow, int lane) {
    const GAS f32x4* xr = (const GAS f32x4*)xrow + lane; const GAS f32x4* gr = (const GAS f32x4*)g + lane;
    f32x4 v[4]; float s = 0.f;
#pragma unroll
    for (int j = 0; j < 4; ++j) { v[j] = xr[64 * j]; s += (v[j].x * v[j].x + v[j].y * v[j].y) + (v[j].z * v[j].z + v[j].w * v[j].w); }
    const float r = __builtin_amdgcn_rsqf(wave_sum(s) * (1.f / D) + RMS_EPS);
    GAS unsigned long long* o8 = (GAS unsigned long long*)orow + lane;
#pragma unroll
    for (int j = 0; j < 4; ++j) { const f32x4 gg = gr[64 * j]; o8[64 * j] = (unsigned long long)pk2(v[j].x * r * gg.x, v[j].y * r * gg.y) | ((unsigned long long)pk2(v[j].z * r * gg.z, v[j].w * r * gg.w) << 32); }
}
__device__ __forceinline__ void p0_prologue(Frame& F) {
    LAS float* scr = (LAS float*)(F.lds + RING_OFF + F.wave * 16384);
    const int gw = (int)blockIdx.x * NWAVES + F.wave, NGW = F.G * NWAVES;
    bf16* const ws16 = (bf16*)F.ws;
    constexpr int I_GU = (D / 64) * (2 * FF / 32), I_D = (FF / 64) * (D / 32), I_IN = (D / 64) * (2560 / 32), I_INT = (D / 64) * (1024 / 32), I_O = (D / 64) * (D / 32);
    constexpr int NITEMS = 2 * I_GU + 2 * I_D + I_IN + I_INT + I_O;
    for (int it = gw; it < NITEMS; it += NGW) {
        int r = it;
        if (r < I_GU) { p0_item(F.in[2], F.in[3], D, FF, 1, (bf16*)(F.ws + WS_WGU1), nullptr, scr, r, 2 * FF / 32, F.lane); continue; } r -= I_GU;
        if (r < I_GU) { p0_item(F.in[14], F.in[15], D, FF, 1, (bf16*)(F.ws + WS_WGU2), F.in[13], scr, r, 2 * FF / 32, F.lane); continue; } r -= I_GU;
        if (r < I_D) { p0_item(F.in[4], F.in[4], FF, D, 0, (bf16*)(F.ws + WS_WD1), nullptr, scr, r, D / 32, F.lane); continue; } r -= I_D;
        if (r < I_D) { p0_item(F.in[16], F.in[16], FF, D, 0, (bf16*)(F.ws + WS_WD2), nullptr, scr, r, D / 32, F.lane); continue; } r -= I_D;
        if (r < I_IN) { p0_item(F.in[6], F.in[6], D, NPROJ, 2, (bf16*)(F.ws + WS_WIN), F.in[5], scr, r, 2560 / 32, F.lane); continue; } r -= I_IN;
        if (r < I_INT) { p0_item(F.in[6], F.in[6], D, NPROJ, 3, (bf16*)(F.ws + WS_WINT), F.in[5], scr, r, 1024 / 32, F.lane); continue; } r -= I_INT;
        p0_item(F.in[12], F.in[12], D, D, 0, (bf16*)(F.ws + WS_WOUT), nullptr, scr, r, D / 32, F.lane);
    }
    (void)ws16;
    for (int m = gw; m < M; m += NGW) rms_row_to_bf16(F.in[0] + (size_t)m * D, F.in[1], (bf16*)(F.ws + WS_XB) + (size_t)m * D, F.lane);
    if (blockIdx.x == 0) {
        const float l0 = F.in[10][F.tid], l1 = F.in[10][512 + F.tid], mx = fmaxf(l0, l1), e0 = __expf(l0 - mx), e1 = __expf(l1 - mx);
        ((float*)(F.ws + WS_LB))[F.tid] = e0 / (e0 + e1);
    }
}

typedef float f32x16 __attribute__((ext_vector_type(16)));
typedef float f32x2_t __attribute__((ext_vector_type(2))); typedef __bf16 bf16x2_t __attribute__((ext_vector_type(2)));
__device__ __forceinline__ unsigned cvtpk_s(float lo, float hi) { f32x2_t v = {lo, hi}; bf16x2_t b = __builtin_convertvector(v, bf16x2_t); return __builtin_bit_cast(unsigned, b); }
__device__ __forceinline__ bf16x8 pack_step(const f32x16& x, int s) { v4u p; p.x = cvtpk_s(x[8 * s], x[8 * s + 1]); p.y = cvtpk_s(x[8 * s + 2], x[8 * s + 3]); p.z = cvtpk_s(x[8 * s + 4], x[8 * s + 5]); p.w = cvtpk_s(x[8 * s + 6], x[8 * s + 7]); return __builtin_bit_cast(bf16x8, p); }
__device__ __forceinline__ float swapmax(float m) { auto rr = __builtin_amdgcn_permlane32_swap(__float_as_uint(m), __float_as_uint(m), false, false); return fmaxf(__uint_as_float(rr[0]), __uint_as_float(rr[1])); }
__device__ __forceinline__ float swapsum(float m) { auto rr = __builtin_amdgcn_permlane32_swap(__float_as_uint(m), __float_as_uint(m), false, false); return __uint_as_float(rr[0]) + __uint_as_float(rr[1]); }
__device__ __forceinline__ int pi32(int x) { return (x & 0x13) | ((x & 4) << 1) | ((x & 8) >> 1); }
#define MFMA32(a, b, c) __builtin_amdgcn_mfma_f32_32x32x16_bf16((a), (b), (c), 0, 0, 0)
constexpr int ATT_ETAB_OFF = 0;
__device__ __forceinline__ void attn_item(Frame& F, int b, int c, int h, const LAS float* etab) {
    const bf16* Q = (const bf16*)(F.ws + WS_Q); const bf16* Kp = (const bf16*)(F.ws + WS_K); const bf16* VT = (const bf16*)(F.ws + WS_VT); bf16* MIX = (bf16*)(F.ws + WS_MIX);
    const int lane = F.lane, r32 = lane & 31, hi = lane >> 5;
    const float cfar = F.in[9][h * 257 + 256] * LOG2E;
    bf16x8 qf[2][4];
#pragma unroll
    for (int qb = 0; qb < 2; ++qb)
#pragma unroll
        for (int d0 = 0; d0 < 4; ++d0) qf[qb][d0] = *(const bf16x8*)(Q + (unsigned)(((b * SEQ + 64 * c + 32 * qb + r32) * 512) + h * 64 + 16 * d0 + 8 * hi));
    f32x16 o[2][2];
#pragma unroll
    for (int db = 0; db < 2; ++db)
#pragma unroll
        for (int qb = 0; qb < 2; ++qb)
#pragma unroll
            for (int r = 0; r < 16; ++r) o[db][qb][r] = 0.f;
    float mrun[2] = {-INFINITY, -INFINITY}, lrun[2] = {0.f, 0.f};
    const int kt0 = c >= 8 ? c - 8 : 0;
    const unsigned kbase = (unsigned)((b * SEQ + pi32(r32)) * 512 + h * 64 + 8 * hi);
    const unsigned vbase = (unsigned)((b * 512 + h * 64 + r32) * SEQ + 8 * hi);
    const LAS float* et = etab + h * 256;
    for (int kt = kt0; kt <= c; ++kt) {
        const int j = c - kt;
        bf16x8 kf[2][4], vf[2][4];
#pragma unroll
        for (int kb = 0; kb < 2; ++kb)
#pragma unroll
            for (int d0 = 0; d0 < 4; ++d0) kf[kb][d0] = *(const bf16x8*)(Kp + kbase + (unsigned)((64 * kt + 32 * kb) * 512 + 16 * d0));
#pragma unroll
        for (int db = 0; db < 2; ++db)
#pragma unroll
            for (int ks = 0; ks < 4; ++ks) vf[db][ks] = *(const bf16x8*)(VT + vbase + (unsigned)(32 * db * SEQ + 64 * kt + 16 * ks));
#pragma unroll
        for (int qb = 0; qb < 2; ++qb) {
            f32x16 s[2];
            const float c0 = j >= 3 ? cfar : 0.f;
#pragma unroll
            for (int r = 0; r < 16; ++r) { s[0][r] = c0; s[1][r] = c0; }
#pragma unroll
            for (int d0 = 0; d0 < 4; ++d0) { s[0] = MFMA32(kf[0][d0], qf[qb][d0], s[0]); s[1] = MFMA32(kf[1][d0], qf[qb][d0], s[1]); }
            if (j < 3) {
                const int ib = 64 * j + 32 * qb + r32 - 8 * hi + 63;
#pragma unroll
                for (int kb = 0; kb < 2; ++kb)
#pragma unroll
                    for (int r = 0; r < 16; ++r) s[kb][r] += et[ib - 32 * kb - 16 * (r >> 3) - (r & 7)];
            }
            float tm = fmaxf(s[0][0], s[1][0]);
#pragma unroll
            for (int r = 1; r < 16; ++r) tm = fmaxf(tm, fmaxf(s[0][r], s[1][r]));
            tm = swapmax(tm);
            const float mn = fmaxf(mrun[qb], tm), alpha = __builtin_amdgcn_exp2f(mrun[qb] - mn); mrun[qb] = mn;
            float ls = 0.f;
#pragma unroll
            for (int kb = 0; kb < 2; ++kb)
#pragma unroll
                for (int r = 0; r < 16; ++r) { const float p = __builtin_amdgcn_exp2f(s[kb][r] - mn); s[kb][r] = p; ls += p; }
            lrun[qb] = lrun[qb] * alpha + ls;
#pragma unroll
            for (int db = 0; db < 2; ++db)
#pragma unroll
                for (int r = 0; r < 16; ++r) o[db][qb][r] *= alpha;
            bf16x8 pk[2][2];
#pragma unroll
            for (int kb = 0; kb < 2; ++kb) { pk[kb][0] = pack_step(s[kb], 0); pk[kb][1] = pack_step(s[kb], 1); }
#pragma unroll
            for (int db = 0; db < 2; ++db)
#pragma unroll
                for (int kb = 0; kb < 2; ++kb)
#pragma unroll
                    for (int sp = 0; sp < 2; ++sp) o[db][qb] = MFMA32(vf[db][2 * kb + sp], pk[kb][sp], o[db][qb]);
        }
    }
#pragma unroll
    for (int qb = 0; qb < 2; ++qb) {
        const float inv = 1.0f / swapsum(lrun[qb]);
        bf16* orow = MIX + (unsigned)((b * SEQ + 64 * c + 32 * qb + r32) * 1024 + h * 64 + 4 * hi);
#pragma unroll
        for (int db = 0; db < 2; ++db)
#pragma unroll
            for (int g = 0; g < 4; ++g) { pg8::u32x2 w; w.x = cvtpk_s(o[db][qb][4 * g] * inv, o[db][qb][4 * g + 1] * inv); w.y = cvtpk_s(o[db][qb][4 * g + 2] * inv, o[db][qb][4 * g + 3] * inv);
                *(pg8::u32x2*)(orow + 32 * db + 8 * g) = w; }
    }
}
__device__ __forceinline__ void attn_phase(Frame& F) {
    LAS float* etab = (LAS float*)(F.lds + RING_OFF + ATT_ETAB_OFF);
    for (int i = F.tid; i < 8 * 256; i += NWAVES * 64) { const int h = i >> 8; int rel = (i & 255) - 63; rel = rel > 128 ? 128 : rel; etab[i] = F.in[9][h * 257 + rel + 128] * LOG2E; }
    __syncthreads();
    for (int k = 0; k < 8; ++k) {
        const int shard = ((int)blockIdx.x + k) & 7;
        gu32* head = F.ctl + CW_WQ + 64 * shard;
        for (;;) {
            unsigned n = 0; if (F.lane == 0) n = __hip_atomic_fetch_add(head, 1u, RLX_AGENT);
            n = (unsigned)__builtin_amdgcn_readfirstlane((int)n);
            if (n >= 512u) break;
            const int it = 8 * (int)n + shard, c = 31 - (it >> 7), b = (it & 127) >> 3, h = it & 7;
            attn_item(F, b, c, h, etab);
        }
    }
    __syncthreads();
}

constexpr int HG_PS_OFF = 8192, HG_KH_OFF = 16384;
__device__ __forceinline__ unsigned off_b(unsigned row, unsigned ch) { return 256u * row + 16u * (ch ^ (((row & 3) << 2) | ((row >> 2) & 3))); }
__device__ __forceinline__ unsigned tr_read_addr_b(unsigned lane, unsigned c, unsigned ks, unsigned t) {
    const unsigned h = lane >> 5, blk = (lane >> 4) & 1, q = (lane & 15) >> 2, p = lane & 3;
    return off_b(16 * ks + 8 * h + 4 * t + q, 4 * c + 2 * blk + (p >> 1)) + 8 * (p & 1);
}
typedef short v4i16_t __attribute__((ext_vector_type(4)));
__device__ __forceinline__ v4i16_t lds_tr(const LAS unsigned char* p) { return __builtin_amdgcn_ds_read_tr16_b64_v4i16((LAS v4i16_t*)p); }
__device__ __forceinline__ int crow(int r, int hi) { return (r & 3) + 8 * (r >> 2) + 4 * hi; }
__device__ __forceinline__ void hgrn_finalize(Frame& F, const f32x16& o, int b, int hh, int c, int vb, int tb) {
    const bf16* Gt = (const bf16*)(F.ws + WS_G); bf16* MIX = (bf16*)(F.ws + WS_MIX);
    const int r32 = F.lane & 31, hi = F.lane >> 5;
    const LAS float* ps = (const LAS float*)(F.lds + RING_OFF + HG_PS_OFF) + ((c & 1) * 2 + tb) * 128 + r32;
    const float tot = (ps[0] + ps[32]) + (ps[64] + ps[96]);
    const float rs = __builtin_amdgcn_rsqf(tot * (1.0f / 128.0f) + RMS_EPS);
    const unsigned row = (unsigned)(b * SEQ + 64 * c + 32 * tb + r32);
#pragma unroll
    for (int g = 0; g < 4; ++g) { const int v0 = 32 * vb + 8 * g + 4 * hi;
        const pg8::u32x2 gw = *(const pg8::u32x2*)(Gt + row * 512 + hh * 128 + v0); const f32x4 gn = *(const f32x4*)(F.in[11] + v0);
        pg8::u32x2 w; w.x = cvtpk_s(o[4 * g] * rs * gn[0] * bflo(gw.x), o[4 * g + 1] * rs * gn[1] * bfhi(gw.x)); w.y = cvtpk_s(o[4 * g + 2] * rs * gn[2] * bflo(gw.y), o[4 * g + 3] * rs * gn[3] * bfhi(gw.y));
        *(pg8::u32x2*)(MIX + row * 1024 + 512 + hh * 128 + v0) = w; }
}
__device__ __forceinline__ void hgrn_phase(Frame& F, int bh) {
    const bf16* QT = (const bf16*)(F.ws + WS_QT); const bf16* KT = (const bf16*)(F.ws + WS_KT); const bf16* QD = (const bf16*)(F.ws + WS_QD); const bf16* KH = (const bf16*)(F.ws + WS_KH);
    const bf16* VHT = (const bf16*)(F.ws + WS_VHT); const float* DM = (const float*)(F.ws + WS_DM); const float* DE = (const float*)(F.ws + WS_DE);
    const int b = bh >> 2, hh = bh & 3, lane = F.lane, r32 = lane & 31, hi = lane >> 5, vb = F.wave & 3, tb = F.wave >> 2;
    LAS unsigned char* khl = F.lds + RING_OFF + HG_KH_OFF;
    LAS float* psw = (LAS float*)(F.lds + RING_OFF + HG_PS_OFF);
    const int srow = F.tid >> 3, sc = F.tid & 7;
    const unsigned st_src = (unsigned)((b * SEQ + srow) * 512 + hh * 128 + 16 * sc);
    const unsigned st_dst0 = (unsigned)((srow >> 5) * 8192) + off_b(srow & 31, 2 * sc), st_dst1 = (unsigned)((srow >> 5) * 8192) + off_b(srow & 31, 2 * sc + 1);
    { const v4u a0 = *(const v4u*)(KH + st_src), a1 = *(const v4u*)(KH + st_src + 8); *(LAS v4u*)(khl + st_dst0) = a0; *(LAS v4u*)(khl + st_dst1) = a1; }
    v4u st0 = *(const v4u*)(KH + st_src + 64 * 512), st1 = *(const v4u*)(KH + st_src + 64 * 512 + 8);
    __syncthreads();
    f32x16 S[4], oprev;
#pragma unroll
    for (int kb = 0; kb < 4; ++kb)
#pragma unroll
        for (int r = 0; r < 16; ++r) S[kb][r] = 0.f;
#pragma unroll
    for (int r = 0; r < 16; ++r) oprev[r] = 0.f;
    const unsigned tq = (unsigned)((b * SEQ + 32 * tb + r32) * 512 + hh * 128);
    const unsigned tk = (unsigned)((b * SEQ + pi32(r32)) * 512 + hh * 128 + 8 * hi);
    const unsigned tv = (unsigned)((b * 512 + hh * 128 + 32 * vb + r32) * SEQ + 8 * hi);
    for (int c = 0; c < NCHUNK; ++c) {
        if (c > 0) hgrn_finalize(F, oprev, b, hh, c - 1, vb, tb);
        const unsigned co = (unsigned)(64 * c * 512);
        bf16x8 qn[8], xs[2][2];
#pragma unroll
        for (int ks = 0; ks < 8; ++ks) qn[ks] = *(const bf16x8*)(QT + tq + co + 16 * ks + 8 * hi);
#pragma unroll
        for (int sb = 0; sb < 2; ++sb) {
            if (sb <= tb) {
                f32x16 X;
#pragma unroll
                for (int r = 0; r < 16; ++r) X[r] = 0.f;
#pragma unroll
                for (int ks = 0; ks < 8; ++ks) { const bf16x8 kf = *(const bf16x8*)(KT + tk + co + (unsigned)(32 * sb * 512 + 16 * ks)); X = MFMA32(kf, qn[ks], X); }
                if (sb == tb) {
#pragma unroll
                    for (int r = 0; r < 16; ++r) { const int sl = 16 * (r >> 3) + 8 * hi + (r & 7); X[r] = sl <= r32 ? X[r] : 0.f; }
                }
                xs[sb][0] = pack_step(X, 0); xs[sb][1] = pack_step(X, 1);
            }
        }
        bf16x8 vfr[4];
#pragma unroll
        for (int k4 = 0; k4 < 4; ++k4) vfr[k4] = *(const bf16x8*)(VHT + tv + (unsigned)(64 * c + 16 * k4));
        f32x16 o;
#pragma unroll
        for (int r = 0; r < 16; ++r) o[r] = 0.f;
#pragma unroll
        for (int sb = 0; sb < 2; ++sb)
            if (sb <= tb) { o = MFMA32(vfr[2 * sb], xs[sb][0], o); o = MFMA32(vfr[2 * sb + 1], xs[sb][1], o); }
#pragma unroll
        for (int kb = 0; kb < 4; ++kb)
#pragma unroll
            for (int sp = 0; sp < 2; ++sp) {
                const pg8::u32x2 q0 = *(const pg8::u32x2*)(QD + tq + co + 32 * kb + 16 * sp + 4 * hi), q1 = *(const pg8::u32x2*)(QD + tq + co + 32 * kb + 16 * sp + 4 * hi + 8);
                v4u qq; qq.x = q0.x; qq.y = q0.y; qq.z = q1.x; qq.w = q1.y;
                o = MFMA32(pack_step(S[kb], sp), __builtin_bit_cast(bf16x8, qq), o);
            }
        const LAS unsigned char* img = khl + (c & 1) * 16384;
        const unsigned dmo = (unsigned)((b * NCHUNK + c) * 512 + hh * 128 + 4 * hi);
#pragma unroll
        for (int kb = 0; kb < 4; ++kb) {
#pragma unroll
            for (int g = 0; g < 4; ++g) { const f32x4 a = *(const f32x4*)(DM + dmo + 32 * kb + 8 * g), e = *(const f32x4*)(DE + dmo + 32 * kb + 8 * g);
#pragma unroll
                for (int i = 0; i < 4; ++i) S[kb][4 * g + i] *= a[i] * e[i]; }
#pragma unroll
            for (int k4 = 0; k4 < 4; ++k4) {
                const LAS unsigned char* ip = img + (k4 >> 1) * 8192;
                const v4i16_t lo = lds_tr(ip + tr_read_addr_b(lane, kb, k4 & 1, 0)), hi4 = lds_tr(ip + tr_read_addr_b(lane, kb, k4 & 1, 1));
                const bf16x8 af = __builtin_shufflevector(lo, hi4, 0, 1, 2, 3, 4, 5, 6, 7);
                S[kb] = MFMA32(af, vfr[k4], S[kb]);
            }
        }
        { float q = 0.f;
#pragma unroll
          for (int r = 0; r < 16; ++r) q += o[r] * o[r];
          q = swapsum(q);
          if (hi == 0) psw[((c & 1) * 2 + tb) * 128 + vb * 32 + r32] = q; }
        oprev = o;
        if (c + 1 < NCHUNK) { LAS unsigned char* nb = khl + ((c + 1) & 1) * 16384; *(LAS v4u*)(nb + st_dst0) = st0; *(LAS v4u*)(nb + st_dst1) = st1; }
        if (c + 2 < NCHUNK) { st0 = *(const v4u*)(KH + st_src + (unsigned)((c + 2) * 64 * 512)); st1 = *(const v4u*)(KH + st_src + (unsigned)((c + 2) * 64 * 512) + 8); }
        __syncthreads();
    }
    hgrn_finalize(F, oprev, b, hh, NCHUNK - 1, vb, tb);
    __syncthreads();
}

struct Args { const float* in[17]; float* out; unsigned char* ws; int ph_lo, ph_hi, li, pad; };
__global__ void __launch_bounds__(NWAVES * 64, 2) mega_fwd(Args args) {
    extern __shared__ __attribute__((aligned(16))) unsigned char lds[];
    Frame F;
    F.lds = (LAS unsigned char*)lds;
    F.MISC = (volatile LAS unsigned*)(F.lds + MISC_OFF);
    F.tid = threadIdx.x; F.lane = F.tid & 63; F.wave = __builtin_amdgcn_readfirstlane(F.tid >> 6);
    F.G = gridDim.x;
#pragma unroll
    for (int i = 0; i < 17; ++i) F.in[i] = args.in[i];
    F.out = args.out; F.ws = args.ws;
    F.ctl = (gu32*)(args.ws + WS_CTL);
    for (int u = F.tid; u < (LDS_BYTES - LDSCTL_OFF) / 4; u += NWAVES * 64) ((LAS unsigned*)(F.lds + LDSCTL_OFF))[u] = 0u;
    __syncthreads();
    XcdBarrier bar; bar.bar = (unsigned*)(F.ctl + CW_BAR); bar.x = 0; bar.st = nullptr;
    if (N_LAUNCHES != PER_PHASE) bar = xcd_barrier_post((unsigned*)(F.ctl + CW_BAR), F.MISC + 8);
#define GRID_BAR(seam) do { if (N_LAUNCHES == PER_PHASE) { if (F.tid == 0) __hip_atomic_store(F.ctl + CW_TMO, 0xBADBA0u | (unsigned)(seam), RLX_AGENT); } else { xcd_barrier(bar); } } while (0)
    const int lo = args.ph_lo, hi = args.ph_hi;
#define IN(k) (lo <= (k) && (k) < hi)
#define BOTH(k) (IN(k) && IN((k) + 1))
    bf16* const XB = (bf16*)(F.ws + WS_XB); bf16* const HID = (bf16*)(F.ws + WS_HID); bf16* const MIXp = (bf16*)(F.ws + WS_MIX);
    float* const RS1 = (float*)(F.ws + WS_RS1); float* const RS2 = (float*)(F.ws + WS_RS2);

    if (IN(0)) { p0_prologue(F); if (BOTH(0)) GRID_BAR(0); }
    if (IN(1)) {
        pg8::Gemm g{XB, (const bf16*)(F.ws + WS_WGU1), M, 2 * FF, D}; pg8::StaticOrder S; S.init(M, 2 * FF, F.G, (int)blockIdx.x);
        pg8::EpiSwiGLU E{HID, FF, nullptr};
        pg8::gemm_phase<pg8::EpiSwiGLU, pg8::StaticOrder, true, true>(F.lds + RING_OFF, g, S, E);
        if (BOTH(1)) GRID_BAR(1);
    }
    if (IN(2)) {
        pg8::Gemm g{HID, (const bf16*)(F.ws + WS_WD1), M, D, FF}; pg8::StaticOrder S; S.init(M, D, F.G, (int)blockIdx.x);
        pg8::EpiRes<true> E{F.in[0], F.out, XB, RS1, 0.5f};
        pg8::gemm_phase<pg8::EpiRes<true>, pg8::StaticOrder, true, true>(F.lds + RING_OFF, g, S, E);
        if (BOTH(2)) GRID_BAR(2);
    }
    if (IN(3)) {
        { pg8::Gemm g{XB, (const bf16*)(F.ws + WS_WIN), M, 2560, D}; pg8::StaticOrder S; S.init(M, 2560, F.G, (int)blockIdx.x);
          pg8::EpiWin E{(bf16*)(F.ws + WS_Q), (bf16*)(F.ws + WS_K), (bf16*)(F.ws + WS_QT), (bf16*)(F.ws + WS_KT), (bf16*)(F.ws + WS_QD), (bf16*)(F.ws + WS_KH), (bf16*)(F.ws + WS_G), (float*)(F.ws + WS_DM), (float*)(F.ws + WS_DE), RS1, F.in[7], F.in[8], (const float*)(F.ws + WS_LB)};
          pg8::gemm_phase<pg8::EpiWin, pg8::StaticOrder, true, true>(F.lds + RING_OFF, g, S, E); }
        { pg8::Gemm g{(const bf16*)(F.ws + WS_WINT), XB, 1024, M, D}; pg8::StaticOrder S; S.init(1024, M, F.G, (int)blockIdx.x);
          pg8::EpiVT E{(bf16*)(F.ws + WS_VT), (bf16*)(F.ws + WS_VHT), RS1};
          pg8::gemm_phase<pg8::EpiVT, pg8::StaticOrder, true, true>(F.lds + RING_OFF, g, S, E); }
        if (BOTH(3)) GRID_BAR(3);
    }
    if (IN(4)) {
        if (blockIdx.x < 64) hgrn_phase(F, (int)blockIdx.x);
        attn_phase(F);
        if (BOTH(4)) GRID_BAR(4);
    }
    if (IN(5)) {
        pg8::Gemm g{MIXp, (const bf16*)(F.ws + WS_WOUT), M, D, D}; pg8::StaticOrder S; S.init(M, D, F.G, (int)blockIdx.x);
        pg8::EpiRes<true> E{F.out, F.out, XB, RS2, 1.0f};
        pg8::gemm_phase<pg8::EpiRes<true>, pg8::StaticOrder, true, true>(F.lds + RING_OFF, g, S, E);
        if (BOTH(5)) GRID_BAR(5);
    }
    if (IN(6)) {
        pg8::Gemm g{XB, (const bf16*)(F.ws + WS_WGU2), M, 2 * FF, D}; pg8::StaticOrder S; S.init(M, 2 * FF, F.G, (int)blockIdx.x);
        pg8::EpiSwiGLU E{HID, FF, RS2};
        pg8::gemm_phase<pg8::EpiSwiGLU, pg8::StaticOrder, true, true>(F.lds + RING_OFF, g, S, E);
        if (BOTH(6)) GRID_BAR(6);
    }
    if (IN(7)) {
        pg8::Gemm g{HID, (const bf16*)(F.ws + WS_WD2), M, D, FF}; pg8::StaticOrder S; S.init(M, D, F.G, (int)blockIdx.x);
        pg8::EpiRes<false> E{F.out, F.out, nullptr, nullptr, 0.5f};
        pg8::gemm_phase<pg8::EpiRes<false>, pg8::StaticOrder, true, true>(F.lds + RING_OFF, g, S, E);
    }
#undef IN
#undef BOTH
}

extern "C" void kernel_launch(void* const* d_in, const int* in_sizes, int n_in, void* d_out, int out_size, void* d_ws, size_t ws_size, hipStream_t stream) {
    static int grid = 0;
    if (grid == 0) {
        if (n_in != 17 || in_sizes[0] != M * D || out_size != M * D || ws_size < WS_END) { fprintf(stderr, "kernel_launch: unexpected shapes (n_in %d, in0 %d, out %d, ws %zu); nothing launched\n", n_in, n_in > 0 ? in_sizes[0] : -1, out_size, ws_size); grid = -1; return; }
        int dev = 0, cus = 0, per_cu = 0;
        if (hipGetDevice(&dev) != hipSuccess || hipDeviceGetAttribute(&cus, hipDeviceAttributeMultiprocessorCount, dev) != hipSuccess) { grid = -1; return; }
        if (hipFuncSetAttribute((const void*)mega_fwd, hipFuncAttributeMaxDynamicSharedMemorySize, LDS_BYTES) != hipSuccess) { fprintf(stderr, "kernel_launch: hipFuncSetAttribute failed\n"); grid = -1; return; }
        if (hipOccupancyMaxActiveBlocksPerMultiprocessor(&per_cu, (const void*)mega_fwd, NWAVES * 64, LDS_BYTES) != hipSuccess || per_cu < 1) fprintf(stderr, "kernel_launch: note: occupancy query reports %d workgroups per CU\n", per_cu);
        (void)hipGetLastError();
        grid = cus;
    }
    if (grid < 0) return;
    if (hipMemsetAsync((char*)d_ws + WS_CTL, 0, CTL_ZERO_BYTES, stream) != hipSuccess) { fprintf(stderr, "kernel_launch: hipMemsetAsync failed\n"); return; }
    Args a{};
    for (int i = 0; i < 17; ++i) a.in[i] = (const float*)d_in[i];
    a.out = (float*)d_out; a.ws = (unsigned char*)d_ws;
    for (int li = 0; li < N_LAUNCHES; ++li) {
        a.ph_lo = (N_LAUNCHES == PER_PHASE) ? li : 0; a.ph_hi = (N_LAUNCHES == PER_PHASE) ? li + 1 : PER_PHASE; a.li = li;
        hipLaunchKernelGGL(mega_fwd, dim3(grid), dim3(NWAVES * 64), LDS_BYTES, stream, a);
        const hipError_t le = hipPeekAtLastError();
        if (le != hipSuccess) { fprintf(stderr, "kernel_launch: launch %d failed: %s\n", li, hipGetErrorName(le)); break; }
    }
}
```

```cpp
#include <hip/hip_runtime.h>
#include <cstdio>
#include <cstdint>
namespace pg8 {
#define PG8_LAS __attribute__((address_space(3)))
typedef unsigned short bf16_t;
typedef short bf16x8 __attribute__((ext_vector_type(8)));
typedef float f32x4 __attribute__((ext_vector_type(4)));
typedef unsigned u32x4 __attribute__((ext_vector_type(4)));
constexpr int BM = 256, BK = 64, HALF = 128, HTB = HALF * BK * 2  , STAGE_BYTES = 8 * HTB, NXCD = 8, WGM = 4;

__host__ __device__ __forceinline__ int lds_byte(int r, int c) { const int st = (r >> 4) * 2 + (c >> 5), rr = r & 15, cc = c & 31, ob = rr * 64 + cc * 2; return st * 1024 + (ob ^ (((ob >> 9) & 1) << 5)); }
__host__ __device__ __forceinline__ void stage_rc(int b, int& R, int& C) { const int st = b / 1024, sb = b % 1024, swz = sb ^ (((sb >> 9) & 1) << 5); R = (st >> 1) * 16 + swz / 64; C = (st & 1) * 32 + (swz % 64) / 2; }
__host__ __device__ __forceinline__ int perm32(int rho) { const int n = rho >> 4, i = rho & 15; return 8 * (i >> 2) + 4 * n + (i & 3); }

struct Unit { int pm, pn, par; };
struct Gemm { const bf16_t* A; const bf16_t* Bt; int M, N, K; };

struct StaticOrder {
    int nM, nN, nwg, G, c;
    __host__ __device__ void init(int M, int N, int G_, int c_) { nM = M / BM; nN = N / BM; nwg = nM * nN; G = G_; c = c_; }
    __host__ __device__ bool next(int i, Unit& u) const {
        const long L = (long)i * G + c; if (L >= nwg) return false;
        int wgid = (int)L; { const int q = nwg / NXCD, r = nwg % NXCD, xcd = wgid % NXCD, off = wgid / NXCD; wgid = (xcd < r ? xcd * (q + 1) : r * (q + 1) + (xcd - r) * q) + off; }
        const int nig = WGM * nN, gid = wgid / nig, fm = gid * WGM, gsz = (nM - fm) < WGM ? (nM - fm) : WGM;
        u.pm = fm + ((wgid % nig) % gsz); u.pn = (wgid % nig) / gsz; return true;
    }
    __device__ __forceinline__ void a_ready(const Unit&) const {}
    __device__ __forceinline__ void done(const Unit&) const {}
};


typedef unsigned u32x2 __attribute__((ext_vector_type(2)));
constexpr float RMS_EPS = 1e-6f, LOG2E = 1.4426950408889634f, QSCALE = 0.125f * 1.4426950408889634f;
__device__ __forceinline__ unsigned cvt_pk_bf16(float lo, float hi) { unsigned r; asm volatile("v_cvt_pk_bf16_f32 %0, %1, %2" : "=v"(r) : "v"(lo), "v"(hi)); return r; }
__device__ __forceinline__ float fsigmoid(float x) { return __builtin_amdgcn_rcpf(1.0f + __builtin_amdgcn_exp2f(-x * LOG2E)); }
__device__ __forceinline__ float fsilu(float x) { return x * fsigmoid(x); }
__device__ __forceinline__ f32x4 silu4(f32x4 v) { return (f32x4){fsilu(v[0]), fsilu(v[1]), fsilu(v[2]), fsilu(v[3])}; }
__device__ __forceinline__ u32x4 pack8(f32x4 a, f32x4 b) { u32x4 w; w.x = cvt_pk_bf16(a[0], a[1]); w.y = cvt_pk_bf16(a[2], a[3]); w.z = cvt_pk_bf16(b[0], b[1]); w.w = cvt_pk_bf16(b[2], b[3]); return w; }
__device__ __forceinline__ float rowscale(const float* rowsq, const PG8_LAS float* slot, int rl) { return rowsq ? __builtin_amdgcn_rsqf(slot[rl] * (1.0f / 1024.0f) + RMS_EPS) : 1.0f; }
template <int CTRL> __device__ __forceinline__ float dpp_mov0(float x) { return __builtin_bit_cast(float, __builtin_amdgcn_update_dpp(0, __builtin_bit_cast(int, x), CTRL, 0xf, 0xf, true)); }
__device__ __forceinline__ float row_scan16(float x) { x += dpp_mov0<0x111>(x); x += dpp_mov0<0x112>(x); x += dpp_mov0<0x114>(x); x += dpp_mov0<0x118>(x); return x; }

struct EpiSwiGLU {
    static constexpr bool PERM = false, AFTER_DRAIN = false; static constexpr int SCALE = 1;
    bf16_t* H; const float* rowsq; const PG8_LAS float* scl; int ldh;
    __device__ __forceinline__ void operator()(f32x4 (&acc)[2][2][4][2], const Unit& u, int wr, int wc, int fr, int fq) const {
        const int row0 = u.pm * BM + wr * 64 + fr, col0 = u.pn * HALF + wc * 32 + 8 * fq; const PG8_LAS float* slot = scl + u.par * 256 + wr * 64 + fr;
#pragma unroll
        for (int ai = 0; ai < 2; ++ai)
#pragma unroll
            for (int m = 0; m < 4; ++m) { const int row = row0 + ai * HALF + m * 16; const float r = rowscale(rowsq, slot, ai * HALF + m * 16);
                f32x4 hh[2];
#pragma unroll
                for (int n = 0; n < 2; ++n) { const f32x4 g = acc[ai][0][m][n] * r, gu = g * (acc[ai][1][m][n] * r);
#pragma unroll
                    for (int c = 0; c < 4; ++c) hh[n][c] = gu[c] * __builtin_amdgcn_rcpf(1.0f + __builtin_amdgcn_exp2f(-g[c])); }
                *(u32x4*)(H + (unsigned)(row * ldh + col0)) = pack8(hh[0], hh[1]); }
    }
};
template <int MODE> struct EpiRes {
    static constexpr bool PERM = false, AFTER_DRAIN = false; static constexpr int SCALE = 0;
    const float* base; float* out; bf16_t* xb; float* rowsq; float scale;
    __device__ __forceinline__ void operator()(f32x4 (&acc)[2][2][4][2], const Unit& u, int wr, int wc, int fr, int fq) const {
        const int row0 = u.pm * BM + wr * 64 + fr, col0 = u.pn * BM + wc * 32 + 4 * fq;
#pragma unroll
        for (int ai = 0; ai < 2; ++ai)
#pragma unroll
            for (int m = 0; m < 4; ++m) { const int row = row0 + ai * HALF + m * 16; const unsigned off = (unsigned)(row * 1024 + col0); float ss = 0.f;
#pragma unroll
                for (int bj = 0; bj < 2; ++bj)
#pragma unroll
                    for (int n = 0; n < 2; ++n) { const unsigned o = off + bj * HALF + n * 16; f32x4 v;
                        if (MODE == 0) v = *(const f32x4*)(base + o);
                        else { const u32x2 w = *(const u32x2*)(xb + o); v = (f32x4){__builtin_bit_cast(float, w.x << 16), __builtin_bit_cast(float, w.x & 0xffff0000u), __builtin_bit_cast(float, w.y << 16), __builtin_bit_cast(float, w.y & 0xffff0000u)}; }
                        v = v + acc[ai][bj][m][n] * scale;
                        if (MODE == 2) *(f32x4*)(out + o) = v;
                        else { u32x2 w; w.x = cvt_pk_bf16(v[0], v[1]); w.y = cvt_pk_bf16(v[2], v[3]); *(u32x2*)(xb + o) = w; ss += (v[0] * v[0] + v[1] * v[1]) + (v[2] * v[2] + v[3] * v[3]); } }
                if (MODE != 2) { ss += __shfl_xor(ss, 16); ss += __shfl_xor(ss, 32); if (fq == 0) __hip_atomic_fetch_add(rowsq + row, ss, __ATOMIC_RELAXED, __HIP_MEMORY_SCOPE_AGENT); }
                asm volatile("" ::: "memory"); }
    }
};
struct EpiWin {
    static constexpr bool PERM = false, AFTER_DRAIN = false; static constexpr int SCALE = 1;
    bf16_t *Q, *K, *QT, *KT, *G; float *DM, *DE; const float *rowsq, *gq, *gk, *lb; const PG8_LAS float* scl;
    __device__ __forceinline__ void operator()(f32x4 (&acc)[2][2][4][2], const Unit& u, int wr, int wc, int fr, int fq) const {
        const int row0 = u.pm * BM + wr * 64 + fr, t = u.pn; const PG8_LAS float* slot = scl + u.par * 256 + wr * 64 + fr;
        if (t < 4) {
            const bool isq = t < 2; const int head = 4 * (t & 1) + wc; const float* gp = isq ? gq : gk; const float gs = isq ? QSCALE : 1.0f;
            f32x4 gv[2][2];
#pragma unroll
            for (int bj = 0; bj < 2; ++bj)
#pragma unroll
                for (int n = 0; n < 2; ++n) gv[bj][n] = *(const f32x4*)(gp + 32 * bj + 8 * fq + 4 * n) * gs;
            bf16_t* dst = (isq ? Q : K) + (head * 32 * 8) * 512 + (fq >> 1) * 512 + (fq & 1) * 256;
#pragma unroll
            for (int ai = 0; ai < 2; ++ai)
#pragma unroll
                for (int m = 0; m < 4; ++m) { const int row = row0 + ai * HALF + m * 16; const float r = rowscale(rowsq, slot, ai * HALF + m * 16); float ss = 0.f;
#pragma unroll
                    for (int bj = 0; bj < 2; ++bj)
#pragma unroll
                        for (int n = 0; n < 2; ++n) { const f32x4 v = acc[ai][bj][m][n] * r; acc[ai][bj][m][n] = v; ss += (v[0] * v[0] + v[1] * v[1]) + (v[2] * v[2] + v[3] * v[3]); }
                    ss += __shfl_xor(ss, 16); ss += __shfl_xor(ss, 32);
                    const float inv = __builtin_amdgcn_rsqf(ss * (1.0f / 64.0f) + RMS_EPS);
                    const int tk = row & 2047, t5 = tk & 31, r32 = isq ? t5 : ((t5 & 0x13) | ((t5 & 4) << 1) | ((t5 & 8) >> 1));
                    const unsigned o = (unsigned)((((row >> 11) * 8 * 32 + (tk >> 6)) * 2 + ((tk >> 5) & 1)) * 4 * 512 + r32 * 8);
#pragma unroll
                    for (int bj = 0; bj < 2; ++bj) *(u32x4*)(dst + o + (unsigned)(2 * bj * 512)) = pack8(acc[ai][bj][m][0] * inv * gv[bj][0], acc[ai][bj][m][1] * inv * gv[bj][1]); }
        } else if (t < 8) {
            const int hh = t - 4, kbase = hh * 128 + wc * 32 + 8 * fq;
            float lbv[8]; { const f32x4 l0 = *(const f32x4*)(lb + kbase), l1 = *(const f32x4*)(lb + kbase + 4);
#pragma unroll
                for (int c = 0; c < 4; ++c) { lbv[c] = l0[c]; lbv[4 + c] = l1[c]; } }
            const int lane = fq * 16 + fr;
#pragma unroll
            for (int ai = 0; ai < 2; ++ai)
#pragma unroll
                for (int n = 0; n < 2; ++n) {
                    float omf[4][4], carry[4], bmid[4];
#pragma unroll
                    for (int m = 0; m < 4; ++m) { const float r = rowscale(rowsq, slot, ai * HALF + m * 16);
#pragma unroll
                        for (int c = 0; c < 4; ++c) { const int e = 4 * n + c; const float a = acc[ai][0][m][n][c] * r, b = acc[ai][1][m][n][c] * r;
                            const float sg = fsigmoid(b), f = lbv[e] + (1.0f - lbv[e]) * sg; omf[m][c] = (1.0f - lbv[e]) * (1.0f - sg);
                            acc[ai][1][m][n][c] = __builtin_amdgcn_logf(f);
                            acc[ai][0][m][n][c] = fsilu(a); } }
#pragma unroll
                    for (int c = 0; c < 4; ++c) { carry[c] = 0.f; bmid[c] = 0.f; }
#pragma unroll
                    for (int m = 0; m < 4; ++m)
#pragma unroll
                        for (int c = 0; c < 4; ++c) { float x = row_scan16(acc[ai][1][m][n][c]) + carry[c]; acc[ai][1][m][n][c] = x;
                            carry[c] = __shfl(x, lane | 15); if (m == 1) bmid[c] = carry[c]; }
#pragma unroll
                    for (int m = 0; m < 4; ++m) { const int row = row0 + ai * HALF + m * 16; f32x4 qv, kv;
#pragma unroll
                        for (int c = 0; c < 4; ++c) { const float d = acc[ai][1][m][n][c] - bmid[c];
                            qv[c] = acc[ai][0][m][n][c] * __builtin_amdgcn_exp2f(d); kv[c] = omf[m][c] * __builtin_amdgcn_exp2f(-d); }
                        const unsigned o = (unsigned)(row * 512 + kbase + 4 * n);
                        u32x2 w; w.x = cvt_pk_bf16(qv[0], qv[1]); w.y = cvt_pk_bf16(qv[2], qv[3]); *(u32x2*)(QT + o) = w;
                        w.x = cvt_pk_bf16(kv[0], kv[1]); w.y = cvt_pk_bf16(kv[2], kv[3]); *(u32x2*)(KT + o) = w; }
                    if (fr == 0) { const int chunk = (u.pm * BM + ai * HALF + wr * 64) >> 6; f32x4 a0, e0;
#pragma unroll
                        for (int c = 0; c < 4; ++c) { a0[c] = __builtin_amdgcn_exp2f(bmid[c]); e0[c] = __builtin_amdgcn_exp2f(carry[c] - bmid[c]); }
                        *(f32x4*)(DM + (unsigned)(chunk * 512 + kbase + 4 * n)) = a0; *(f32x4*)(DE + (unsigned)(chunk * 512 + kbase + 4 * n)) = e0; }
                    asm volatile("" ::: "memory");
                }
        } else {
            bf16_t* dst = G + (t - 8) * 256 + wc * 32 + 8 * fq;
#pragma unroll
            for (int ai = 0; ai < 2; ++ai)
#pragma unroll
                for (int m = 0; m < 4; ++m) { const int row = row0 + ai * HALF + m * 16; const float r = rowscale(rowsq, slot, ai * HALF + m * 16);
#pragma unroll
                    for (int bj = 0; bj < 2; ++bj) *(u32x4*)(dst + (unsigned)(row * 512 + bj * HALF)) = pack8(silu4(acc[ai][bj][m][0] * r), silu4(acc[ai][bj][m][1] * r)); }
        }
    }
};
struct EpiVT {
    static constexpr bool PERM = true, AFTER_DRAIN = false; static constexpr int SCALE = 2;
    bf16_t *VT, *VHT; const float* rowsq; const PG8_LAS float* scl;
    __device__ __forceinline__ void operator()(f32x4 (&acc)[2][2][4][2], const Unit& u, int wr, int wc, int fr, int fq) const {
        const int ch0 = (u.pm & 1) * BM + wr * 64 + fr, tok0 = u.pn * BM + wc * 32 + 8 * fq, b = tok0 >> 11, s0 = tok0 & 2047;
        f32x4 rs[2][2];
#pragma unroll
        for (int bj = 0; bj < 2; ++bj)
#pragma unroll
            for (int n = 0; n < 2; ++n) { const f32x4 q = *(const PG8_LAS f32x4*)(scl + u.par * 256 + wc * 32 + 8 * fq + bj * HALF + 4 * n);
#pragma unroll
                for (int c = 0; c < 4; ++c) rs[bj][n][c] = __builtin_amdgcn_rsqf(q[c] * (1.0f / 1024.0f) + RMS_EPS); }
        if (u.pm < 2) {
#pragma unroll
            for (int ai = 0; ai < 2; ++ai)
#pragma unroll
                for (int m = 0; m < 4; ++m) { const int ch = ch0 + ai * HALF + m * 16;
#pragma unroll
                    for (int bj = 0; bj < 2; ++bj) { const int sk = s0 + bj * HALF;
                        const unsigned o = (unsigned)((((((b * 8 + (ch >> 6)) * 32 + (sk >> 6)) * 2 + ((ch >> 5) & 1)) * 4 + ((sk >> 4) & 3)) * 64 + ((sk >> 3) & 1) * 32 + (ch & 31)) * 8);
                        *(u32x4*)(VT + o) = pack8(acc[ai][bj][m][0] * rs[bj][0], acc[ai][bj][m][1] * rs[bj][1]); } }
        } else {
            bf16_t* dst = VHT + (size_t)b * 512 * 2048 + s0;
#pragma unroll
            for (int ai = 0; ai < 2; ++ai)
#pragma unroll
                for (int m = 0; m < 4; ++m) { const int ch = ch0 + ai * HALF + m * 16;
#pragma unroll
                    for (int bj = 0; bj < 2; ++bj) *(u32x4*)(dst + (unsigned)(ch * 2048 + bj * HALF)) = pack8(acc[ai][bj][m][0] * rs[bj][0], acc[ai][bj][m][1] * rs[bj][1]); }
        }
    }
};

template <class Epi, class Sched, bool ALIGN_EPI = false, bool SP2 = false>
__device__ __forceinline__ void gemm_phase(PG8_LAS unsigned char* lds, const Gemm g, const Sched& S, const Epi& E) {
    const int tid = threadIdx.x, wid = __builtin_amdgcn_readfirstlane(tid >> 6), lane = tid & 63, wr = wid >> 2, wc = wid & 3, fr = lane & 15, fq = lane >> 4;
    const int K = g.K, nt = K / BK;
    unsigned voffA[2], voffB[2];
#pragma unroll
    for (int i = 0; i < 2; ++i) { int R, C; stage_rc(tid * 16 + i * 8192, R, C); const int Rb = Epi::PERM ? ((R & ~31) + perm32(R & 31)) : R;
        voffA[i] = (unsigned)(R * K + C) * 2u; voffB[i] = (unsigned)(Rb * K + C) * 2u; }
    const size_t kstep = (size_t)(BK * 2);
    const size_t hstep = (size_t)HALF * K * 2;
    const size_t tstep = 2 * hstep;
    const unsigned ldsw = (unsigned)wid * 1024u;
    const int aoff = lds_byte(wr * 64 + fr, fq * 8), boff = lds_byte(wc * 32 + fr, fq * 8);
#define PG8_SA(b, h) (((b) * 2 + (h)) * HTB)
#define PG8_SB(b, h) ((4 + (b) * 2 + (h)) * HTB)
#define PG8_STAGE(bufoff, gbase, voff) do { _Pragma("unroll") for (int _i = 0; _i < 2; ++_i) \
        __builtin_amdgcn_global_load_lds((const unsigned*)((const char*)(gbase) + (voff)[_i]), (PG8_LAS unsigned*)(lds + (bufoff) + ldsw + _i * 8192), 16, 0, 0); } while (0)
#define PG8_LDA(dst, b, h) do { _Pragma("unroll") for (int m = 0; m < 4; ++m) _Pragma("unroll") for (int k = 0; k < 2; ++k) dst[m][k] = *(const PG8_LAS bf16x8*)(lds + PG8_SA(b, h) + aoff + m * 2048 + k * 1024); } while (0)
#define PG8_LDB(dst, b, h) do { _Pragma("unroll") for (int n = 0; n < 2; ++n) _Pragma("unroll") for (int k = 0; k < 2; ++k) dst[n][k] = *(const PG8_LAS bf16x8*)(lds + PG8_SB(b, h) + boff + n * 2048 + k * 1024); } while (0)
#define PG8_MMA(ai, bj, At, Bt) do { __builtin_amdgcn_s_setprio(1); _Pragma("unroll") for (int m = 0; m < 4; ++m) _Pragma("unroll") for (int n = 0; n < 2; ++n) _Pragma("unroll") for (int k = 0; k < 2; ++k) \
        acc[ai][bj][m][n] = __builtin_amdgcn_mfma_f32_16x16x32_bf16(Bt[n][k], At[m][k], acc[ai][bj][m][n], 0, 0, 0); __builtin_amdgcn_s_setprio(0); } while (0)
#define PG8_WAIT_V(n) asm volatile("s_waitcnt vmcnt(" #n ")" ::: "memory")
#define PG8_WAIT_L(n) asm volatile("s_waitcnt lgkmcnt(" #n ")" ::: "memory")
#define PG8_BAR __builtin_amdgcn_s_barrier()
#define PG8_SCHED __builtin_amdgcn_sched_barrier(0)
    Unit cur, nxt; int ui = 0;
    if (!S.next(0, cur)) return;
    cur.par = 0;
#define PG8_SCALE_DMA(u_) do { if (Epi::SCALE != 0 && wid == 0 && E.rowsq != nullptr) \
        __builtin_amdgcn_global_load_lds((const unsigned*)(E.rowsq + ((Epi::SCALE == 1 ? (u_).pm : (u_).pn) * BM + lane * 4)), (PG8_LAS unsigned*)(lds + STAGE_BYTES + (u_).par * 1024), 16, 0, 0); } while (0)
    PG8_SCALE_DMA(cur);
    f32x4 acc[2][2][4][2];
#pragma unroll
    for (int a = 0; a < 2; ++a)
#pragma unroll
        for (int b = 0; b < 2; ++b)
#pragma unroll
            for (int m = 0; m < 4; ++m)
#pragma unroll
                for (int n = 0; n < 2; ++n) acc[a][b][m][n] = (f32x4){0.f, 0.f, 0.f, 0.f};
    bf16x8 At[4][2], B0[2][2], B1[2][2];
    const char* cA = (const char*)g.A + (size_t)cur.pm * tstep; const char* cB = (const char*)g.Bt + (size_t)cur.pn * tstep;
    S.a_ready(cur);
    if constexpr (SP2) {
        PG8_STAGE(PG8_SB(0, 0), cB, voffB); PG8_STAGE(PG8_SB(0, 1), cB + hstep, voffB); PG8_STAGE(PG8_SA(0, 0), cA, voffA); PG8_STAGE(PG8_SA(0, 1), cA + hstep, voffA);
        if (wr == 1) PG8_BAR;
        PG8_WAIT_V(2); PG8_BAR;
        PG8_STAGE(PG8_SB(1, 0), cB + kstep, voffB); PG8_STAGE(PG8_SA(1, 0), cA + kstep, voffA); PG8_STAGE(PG8_SB(1, 1), cB + hstep + kstep, voffB);
        PG8_WAIT_V(6); PG8_BAR;
    } else {
        PG8_STAGE(PG8_SB(0, 0), cB, voffB); PG8_STAGE(PG8_SA(0, 0), cA, voffA); PG8_STAGE(PG8_SB(0, 1), cB + hstep, voffB); PG8_STAGE(PG8_SA(0, 1), cA + hstep, voffA);
        if (wr == 1) PG8_BAR;
        PG8_WAIT_V(4); PG8_BAR;
        PG8_STAGE(PG8_SB(1, 0), cB + kstep, voffB); PG8_STAGE(PG8_SA(1, 0), cA + kstep, voffA); PG8_STAGE(PG8_SB(1, 1), cB + hstep + kstep, voffB);
        PG8_WAIT_V(6); PG8_BAR;
    }
    for (;;) {
        const bool has_next = S.next(ui + 1, nxt); nxt.par = (ui + 1) & 1;
        const char* nA = has_next ? (const char*)g.A + (size_t)nxt.pm * tstep : cA; const char* nB = has_next ? (const char*)g.Bt + (size_t)nxt.pn * tstep : cB;
        for (int t = 0; t < nt; t += 2) {
            const bool last = (t == nt - 2);
            const char* a1 = cA + (size_t)(t + 1) * kstep;
            const char* a2 = last ? nA : cA + (size_t)(t + 2) * kstep; const char* b2 = last ? nB : cB + (size_t)(t + 2) * kstep;
            const char* a3 = a2 + kstep; const char* b3 = b2 + kstep;
            if (last && has_next) { S.a_ready(nxt); PG8_SCALE_DMA(nxt); }
            if constexpr (SP2) {
            PG8_LDB(B0, 0, 0); PG8_LDB(B1, 0, 1); PG8_SCHED; PG8_LDA(At, 0, 0); PG8_STAGE(PG8_SA(1, 1), a1 + hstep, voffA);
            PG8_WAIT_V(8); PG8_WAIT_L(0); PG8_BAR; PG8_MMA(0, 0, At, B0); PG8_MMA(0, 1, At, B1); PG8_BAR; PG8_SCHED;
            PG8_LDA(At, 0, 1); PG8_STAGE(PG8_SB(0, 0), b2, voffB); PG8_STAGE(PG8_SB(0, 1), b2 + hstep, voffB); PG8_STAGE(PG8_SA(0, 0), a2, voffA);
            PG8_WAIT_V(8); PG8_WAIT_L(0); PG8_BAR; PG8_MMA(1, 0, At, B0); PG8_MMA(1, 1, At, B1); PG8_BAR; PG8_SCHED;
            PG8_LDB(B0, 1, 0); PG8_LDB(B1, 1, 1); PG8_SCHED; PG8_LDA(At, 1, 0); PG8_STAGE(PG8_SA(0, 1), a2 + hstep, voffA);
            PG8_WAIT_V(8); PG8_WAIT_L(0); PG8_BAR; PG8_MMA(0, 0, At, B0); PG8_MMA(0, 1, At, B1); PG8_BAR; PG8_SCHED;
            PG8_LDA(At, 1, 1); PG8_STAGE(PG8_SB(1, 0), b3, voffB); PG8_STAGE(PG8_SB(1, 1), b3 + hstep, voffB); PG8_STAGE(PG8_SA(1, 0), a3, voffA);
            PG8_WAIT_V(8); PG8_WAIT_L(0); PG8_BAR; PG8_MMA(1, 0, At, B0); PG8_MMA(1, 1, At, B1); PG8_BAR; PG8_SCHED;
            } else {
            PG8_LDB(B0, 0, 0); PG8_SCHED; PG8_LDA(At, 0, 0); PG8_STAGE(PG8_SA(1, 1), a1 + hstep, voffA);
            PG8_WAIT_L(8); PG8_BAR; PG8_WAIT_L(0); PG8_MMA(0, 0, At, B0); PG8_BAR; PG8_SCHED;
            PG8_LDB(B1, 0, 1); PG8_STAGE(PG8_SB(0, 0), b2, voffB);
            PG8_BAR; PG8_WAIT_L(0); PG8_MMA(0, 1, At, B1); PG8_BAR;
            PG8_LDA(At, 0, 1); PG8_STAGE(PG8_SA(0, 0), a2, voffA);
            PG8_BAR; PG8_WAIT_L(0); PG8_MMA(1, 0, At, B0); PG8_BAR; PG8_SCHED;
            PG8_STAGE(PG8_SB(0, 1), b2 + hstep, voffB);
            PG8_WAIT_V(6); PG8_BAR; PG8_MMA(1, 1, At, B1); PG8_BAR;
            PG8_LDB(B0, 1, 0); PG8_SCHED; PG8_LDA(At, 1, 0); PG8_STAGE(PG8_SA(0, 1), a2 + hstep, voffA);
            PG8_WAIT_L(8); PG8_BAR; PG8_WAIT_L(0); PG8_MMA(0, 0, At, B0); PG8_BAR; PG8_SCHED;
            PG8_LDB(B1, 1, 1); PG8_STAGE(PG8_SB(1, 0), b3, voffB);
            PG8_BAR; PG8_WAIT_L(0); PG8_MMA(0, 1, At, B1); PG8_BAR;
            PG8_LDA(At, 1, 1); PG8_STAGE(PG8_SA(1, 0), a3, voffA);
            PG8_BAR; PG8_WAIT_L(0); PG8_MMA(1, 0, At, B0); PG8_BAR; PG8_SCHED;
            PG8_STAGE(PG8_SB(1, 1), b3 + hstep, voffB);
            PG8_WAIT_V(6); PG8_BAR; PG8_MMA(1, 1, At, B1); PG8_BAR;
            }
        }
        if constexpr (ALIGN_EPI) { if (wr == 0) PG8_BAR; }
        if constexpr (!Epi::AFTER_DRAIN) { E(acc, cur, wr, wc, fr, fq); S.done(cur); }
        if (!has_next) break;
#pragma unroll
        for (int a = 0; a < 2; ++a)
#pragma unroll
            for (int b = 0; b < 2; ++b)
#pragma unroll
                for (int m = 0; m < 4; ++m)
#pragma unroll
                    for (int n = 0; n < 2; ++n) acc[a][b][m][n] = (f32x4){0.f, 0.f, 0.f, 0.f};
        cur = nxt; cA = nA; cB = nB; ++ui;
        if constexpr (ALIGN_EPI) { if (wr == 1) PG8_BAR; }
    }
    PG8_WAIT_V(0);
    if constexpr (!ALIGN_EPI) { if (wr == 0) PG8_BAR; }
    PG8_BAR;
    if constexpr (Epi::AFTER_DRAIN) { E.fused(acc, cur, wr, wc, fr, fq, lds, wid, lane); S.done(cur); }
#undef PG8_SCALE_DMA
#undef PG8_SA
#undef PG8_SB
#undef PG8_STAGE
#undef PG8_LDA
#undef PG8_LDB
#undef PG8_MMA
#undef PG8_WAIT_V
#undef PG8_WAIT_L
#undef PG8_BAR
#undef PG8_SCHED
}
}

constexpr int NWAVES = 8;
#ifndef MK_N_LAUNCHES
#define MK_N_LAUNCHES 1
#endif
constexpr int PER_PHASE = 8;
constexpr int N_LAUNCHES = MK_N_LAUNCHES;
constexpr int BATCH = 16, SEQ = 2048, D = 1024, M = BATCH * SEQ, FF = 2816, NPROJ = 3584;
constexpr int AW = 512, HW = 512, NCHUNK = SEQ / 64;
constexpr float RMS_EPS = 1e-6f, LOG2E = 1.4426950408889634f;

constexpr size_t MiB = 1u << 20;
constexpr size_t WS_CTL = 0, CTL_ZERO_BYTES = 1 * MiB;
constexpr size_t WS_RS1 = 256 * 1024, WS_RS2 = 384 * 1024;
constexpr size_t WS_LB = 1 * MiB, WS_DM = 2 * MiB, WS_DE = 3 * MiB;
constexpr size_t WS_WGU1 = 4 * MiB, WS_WD1 = 15 * MiB, WS_WIN = 21 * MiB, WS_WINT = 26 * MiB, WS_WOUT = 28 * MiB, WS_WGU2 = 30 * MiB, WS_WD2 = 41 * MiB;
constexpr size_t WS_XB = 48 * MiB;
constexpr size_t WS_MIX = 112 * MiB;
constexpr size_t WS_HID = 176 * MiB;
constexpr size_t WS_Q = 176 * MiB, WS_K = 208 * MiB, WS_VT = 240 * MiB, WS_QT = 272 * MiB, WS_KT = 304 * MiB, WS_VHT = 336 * MiB, WS_G = 368 * MiB, WS_END = 400 * MiB;
static_assert(WS_WGU1 + (size_t)2 * FF * D * 2 <= WS_WD1 && WS_WD1 + (size_t)D * FF * 2 <= WS_WIN && WS_WIN + (size_t)2560 * D * 2 <= WS_WINT && WS_WGU2 + (size_t)2 * FF * D * 2 <= WS_WD2 && WS_WD2 + (size_t)D * FF * 2 <= WS_XB, "weight map");
static_assert(WS_HID + (size_t)M * FF * 2 <= WS_END && WS_XB + (size_t)M * D * 2 <= WS_MIX && WS_MIX + (size_t)M * D * 2 <= WS_HID, "activation map");
constexpr int CW_TMO = 0, CW_CODE = 1;
constexpr int CW_BAR = 4096;
constexpr int CW_WQ = 16384;

constexpr int RING_OFF = 0, RING_BYTES = 131072;
constexpr int LDS_BYTES = 163840;
constexpr int LDSCTL_OFF = LDS_BYTES - 1024, MISC_OFF = LDSCTL_OFF + 320;
static_assert(MISC_OFF + 128 <= LDS_BYTES, "LDS map");

#define GAS __attribute__((address_space(1)))
#define LAS __attribute__((address_space(3)))
typedef unsigned short bf16;
typedef unsigned v4u __attribute__((ext_vector_type(4)));
typedef float f32x4 __attribute__((ext_vector_type(4)));
typedef short bf16x8 __attribute__((ext_vector_type(8)));
typedef GAS unsigned gu32;
#define RLX_AGENT __ATOMIC_RELAXED, __HIP_MEMORY_SCOPE_AGENT
#define LDS_WAIT() asm volatile("s_waitcnt lgkmcnt(0)" ::: "memory")
#define VM_WAIT() asm volatile("s_waitcnt vmcnt(0)" ::: "memory")
__device__ __forceinline__ unsigned f2bf(float f) { unsigned u = __builtin_bit_cast(unsigned, f); return (u + 0x7fffu + ((u >> 16) & 1u)) >> 16; }
__device__ __forceinline__ unsigned pk2(float lo, float hi) { return f2bf(lo) | (f2bf(hi) << 16); }
__device__ __forceinline__ float bf2f(unsigned short h) { return __builtin_bit_cast(float, (unsigned)h << 16); }
__device__ __forceinline__ float bflo(unsigned w) { return __builtin_bit_cast(float, w << 16); }
__device__ __forceinline__ float bfhi(unsigned w) { return __builtin_bit_cast(float, w & 0xffff0000u); }

#define XB_TMO      128
#define XB_XCNT(j)  (256  + 64 * (j))
#define XB_XSUB(j)  (1280 + 64 * (j))
#define XB_XGEN(j)  (2304 + 64 * (j))
#define XB_TOP      3328
#define XB_TOPGEN   3392
#define XCD_BAR_WORDS 3456
#define XB_SPIN_CAP (1u << 18)

__device__ __forceinline__ unsigned xb_ld(unsigned* p)              { return __hip_atomic_load(p, __ATOMIC_RELAXED, __HIP_MEMORY_SCOPE_AGENT); }
__device__ __forceinline__ unsigned xb_add(unsigned* p, unsigned v) { return __hip_atomic_fetch_add(p, v, __ATOMIC_RELAXED, __HIP_MEMORY_SCOPE_AGENT); }
__device__ __forceinline__ unsigned xb_xcc_id() { return (unsigned)__builtin_amdgcn_s_getreg((3 << 11) | 20) & 0xFu; }
#define XB_SPIN(cond, bar) do { unsigned _sp = 0; while (cond) { __builtin_amdgcn_s_sleep(1); \
    if ((++_sp & 255u) == 0u) { if (xb_ld(&(bar)[XB_TMO])) break; if (_sp > XB_SPIN_CAP) { atomicAdd(&(bar)[XB_TMO], 1u); break; } } } } while (0)

struct XcdBarrier {
    unsigned* bar; unsigned x;
    volatile LAS unsigned* st;
};

__device__ __forceinline__ XcdBarrier xcd_barrier_post(unsigned* bar, volatile LAS unsigned* st) {
    XcdBarrier b; b.bar = bar; b.x = xb_xcc_id(); b.st = st;
    if (threadIdx.x == 0) (void)xb_add(&bar[XB_XCNT(b.x)], 1u);
    return b;
}
__device__ __forceinline__ void xcd_barrier_complete(unsigned* bar, unsigned x, unsigned& nloc, unsigned& nx) {
    const unsigned G = gridDim.x * gridDim.y * gridDim.z;
    unsigned sum, cnt, mine, sp = 0u;
    for (;;) {
        sum = 0u; cnt = 0u; mine = 0u;
#pragma unroll
        for (unsigned j = 0; j < 16; ++j) { const unsigned c = xb_ld(&bar[XB_XCNT(j)]); sum += c; cnt += (c > 0u) ? 1u : 0u; mine = (j == x) ? c : mine; }
        if (sum == G) break;
        __builtin_amdgcn_s_sleep(1);
        if ((++sp & 255u) == 0u) { if (xb_ld(&bar[XB_TMO])) break; if (sp > XB_SPIN_CAP) { atomicAdd(&bar[XB_TMO], 1u); break; } }
    }
    nloc = mine > 0u ? mine : 1u; nx = cnt > 0u ? cnt : 1u;
}

__device__ __forceinline__ void xcd_barrier(const XcdBarrier& b) {
    asm volatile("s_waitcnt vmcnt(0)" ::: "memory");
    __syncthreads();
    if (threadIdx.x == 0) {
        unsigned* bar = b.bar;
        __builtin_amdgcn_s_waitcnt(0);
        unsigned nloc = b.st[0], nx = b.st[1];
        if (nloc == 0u) { xcd_barrier_complete(bar, b.x, nloc, nx); b.st[0] = nloc; b.st[1] = nx; }
        const unsigned old = xb_add(&bar[XB_XSUB(b.x)], 1u);
        const unsigned gen = old / nloc;
        if (old + 1u == (gen + 1u) * nloc) {
            __builtin_amdgcn_fence(__ATOMIC_RELEASE, "agent");
            asm volatile("s_waitcnt vmcnt(0)" ::: "memory");
            const unsigned og = xb_add(&bar[XB_TOP], 1u);
            const unsigned tg = og / nx;
            if (og + 1u == (tg + 1u) * nx) xb_add(&bar[XB_TOPGEN], 1u);
            else XB_SPIN(xb_ld(&bar[XB_TOPGEN]) == tg, bar);
            __builtin_amdgcn_fence(__ATOMIC_ACQUIRE, "agent");
            xb_add(&bar[XB_XGEN(b.x)], 1u);
            asm volatile("s_waitcnt vmcnt(0)" ::: "memory");
        } else {
            XB_SPIN(xb_ld(&bar[XB_XGEN(b.x)]) == gen, bar);
            __builtin_amdgcn_fence(__ATOMIC_ACQUIRE, "agent");
            asm volatile("s_waitcnt vmcnt(0)" ::: "memory");
        }
    }
    __syncthreads();
}

struct Frame {
    LAS unsigned char* lds;
    volatile LAS unsigned* MISC;
    gu32* ctl;
    int tid, lane, wave, G;
    const float* in[17]; float* out; unsigned char* ws;
};
__device__ __forceinline__ float wave_sum(float v) {
#pragma unroll
    for (int o = 1; o < 64; o <<= 1) v += __shfl_xor(v, o);
    return v;
}
__device__ __forceinline__ int srccol(int kind, int R, int& sel) {
    sel = 0;
    if (kind == 0) return R;
    const int t = R >> 8, p = R & 255, bj = p >> 7, q = p & 127, wc = q >> 5, pr = pg8::perm32(q & 31);
    if (kind == 1) { sel = bj; return 128 * t + 32 * wc + pr; }
    if (kind == 2) {
        if (t < 2) return 64 * (4 * t + wc) + 32 * bj + pr;
        if (t < 4) return 512 + 64 * (4 * (t - 2) + wc) + 32 * bj + pr;
        if (t < 8) return (bj ? 2048 : 1536) + 128 * (t - 4) + 32 * wc + pr;
        return 3072 + 256 * (t - 8) + 128 * bj + 32 * wc + pr;
    }
    return R < 512 ? 1024 + R : 2560 + (R - 512);
}
struct P0Blk { f32x4 v[8]; };
__device__ __forceinline__ void p0_load(P0Blk& t, const float* W0, const float* W1, int N, int kind, int item, int nblk, int lane) {
    const int kb = item / nblk, nb = item % nblk, k0 = 64 * kb + 8 * (lane >> 3), R = 32 * nb + 4 * (lane & 7);
    int sel; const int c = srccol(kind, R, sel);
    const float* W = (sel ? W1 : W0) + (size_t)k0 * N + c;
#pragma unroll
    for (int i = 0; i < 8; ++i) t.v[i] = *(const f32x4*)(W + (size_t)i * N);
}
__device__ __forceinline__ void p0_store(const P0Blk& t, int K, bf16* WT, const float* gain, int kind, int item, int nblk, int lane) {
    const int kb = item / nblk, nb = item % nblk, k0 = 64 * kb + 8 * (lane >> 3), R = 32 * nb + 4 * (lane & 7);
    float gk[8];
    const float ws = kind == 1 ? (((R >> 7) & 1) ? 1.0f / LOG2E : LOG2E) : 1.0f;
#pragma unroll
    for (int i = 0; i < 8; ++i) gk[i] = ws;
    if (gain) { const f32x4 g0 = *(const f32x4*)(gain + k0), g1 = *(const f32x4*)(gain + k0 + 4);
#pragma unroll
        for (int i = 0; i < 4; ++i) { gk[i] = g0[i] * ws; gk[4 + i] = g1[i] * ws; } }
#pragma unroll
    for (int j = 0; j < 4; ++j) { v4u o; o.x = pk2(t.v[0][j] * gk[0], t.v[1][j] * gk[1]); o.y = pk2(t.v[2][j] * gk[2], t.v[3][j] * gk[3]); o.z = pk2(t.v[4][j] * gk[4], t.v[5][j] * gk[5]); o.w = pk2(t.v[6][j] * gk[6], t.v[7][j] * gk[7]);
        *(GAS v4u*)(WT + (size_t)(R + j) * K + k0) = o; }
}
struct P0Job { const float* W0; const float* W1; const float* gain; bf16* WT; int K, N, kind, nblk, item; };
__device__ __forceinline__ P0Job p0_job(Frame& F, int it) {
    constexpr int I_GU = (D / 64) * (2 * FF / 32), I_D = (FF / 64) * (D / 32), I_IN = (D / 64) * (2560 / 32), I_INT = (D / 64) * (1024 / 32);
    int r = it;
    if (r < I_GU) return P0Job{F.in[2], F.in[3], nullptr, (bf16*)(F.ws + WS_WGU1), D, FF, 1, 2 * FF / 32, r}; r -= I_GU;
    if (r < I_GU) return P0Job{F.in[14], F.in[15], F.in[13], (bf16*)(F.ws + WS_WGU2), D, FF, 1, 2 * FF / 32, r}; r -= I_GU;
    if (r < I_D) return P0Job{F.in[4], F.in[4], nullptr, (bf16*)(F.ws + WS_WD1), FF, D, 0, D / 32, r}; r -= I_D;
    if (r < I_D) return P0Job{F.in[16], F.in[16], nullptr, (bf16*)(F.ws + WS_WD2), FF, D, 0, D / 32, r}; r -= I_D;
    if (r < I_IN) return P0Job{F.in[6], F.in[6], F.in[5], (bf16*)(F.ws + WS_WIN), D, NPROJ, 2, 2560 / 32, r}; r -= I_IN;
    if (r < I_INT) return P0Job{F.in[6], F.in[6], F.in[5], (bf16*)(F.ws + WS_WINT), D, NPROJ, 3, 1024 / 32, r}; r -= I_INT;
    return P0Job{F.in[12], F.in[12], nullptr, (bf16*)(F.ws + WS_WOUT), D, D, 0, D / 32, r};
}
__device__ __forceinline__ void rms_rows4_to_bf16(const float* x, const float* g, bf16* o, int lane) {
    f32x4 v[4][4]; float s[4];
#pragma unroll
    for (int r = 0; r < 4; ++r)
#pragma unroll
        for (int j = 0; j < 4; ++j) v[r][j] = *((const GAS f32x4*)(x + (size_t)r * D) + lane + 64 * j);
#pragma unroll
    for (int r = 0; r < 4; ++r) { s[r] = 0.f;
#pragma unroll
        for (int j = 0; j < 4; ++j) s[r] += (v[r][j].x * v[r][j].x + v[r][j].y * v[r][j].y) + (v[r][j].z * v[r][j].z + v[r][j].w * v[r][j].w); }
#pragma unroll
    for (int of = 1; of < 64; of <<= 1) {
#pragma unroll
        for (int r = 0; r < 4; ++r) s[r] += __shfl_xor(s[r], of); }
    f32x4 gg[4];
#pragma unroll
    for (int j = 0; j < 4; ++j) gg[j] = *((const GAS f32x4*)g + lane + 64 * j);
#pragma unroll
    for (int r = 0; r < 4; ++r) { const float rr = __builtin_amdgcn_rsqf(s[r] * (1.f / D) + RMS_EPS);
        GAS unsigned long long* o8 = (GAS unsigned long long*)(o + (size_t)r * D) + lane;
#pragma unroll
        for (int j = 0; j < 4; ++j) o8[64 * j] = (unsigned long long)pk2(v[r][j].x * rr * gg[j].x, v[r][j].y * rr * gg[j].y) | ((unsigned long long)pk2(v[r][j].z * rr * gg[j].z, v[r][j].w * rr * gg[j].w) << 32); }
}
__device__ __forceinline__ void p0_prologue(Frame& F, unsigned long long& p0_probe) {
    const int gw = (int)blockIdx.x * NWAVES + F.wave, NGW = F.G * NWAVES;
#if defined(PROBE_PHASE) && (PROBE_PHASE == 13 || PROBE_PHASE == 14)
    const unsigned long long p0_t0 = __builtin_amdgcn_s_memrealtime();
#endif
    constexpr int I_GU = (D / 64) * (2 * FF / 32), I_D = (FF / 64) * (D / 32), I_IN = (D / 64) * (2560 / 32), I_INT = (D / 64) * (1024 / 32), I_O = (D / 64) * (D / 32);
    constexpr int NITEMS = 2 * I_GU + 2 * I_D + I_IN + I_INT + I_O;
    int it = gw;
    if (it < NITEMS) {
        P0Job j0 = p0_job(F, it); P0Blk t0; p0_load(t0, j0.W0, j0.W1, j0.N, j0.kind, j0.item, j0.nblk, F.lane);
        for (;;) {
            const int it1 = it + NGW; const bool more = it1 < NITEMS;
            P0Job j1 = j0; P0Blk t1;
            if (more) { j1 = p0_job(F, it1); p0_load(t1, j1.W0, j1.W1, j1.N, j1.kind, j1.item, j1.nblk, F.lane); }
            p0_store(t0, j0.K, j0.WT, j0.gain, j0.kind, j0.item, j0.nblk, F.lane);
            if (!more) break;
            it = it1; j0 = j1;
#pragma unroll
            for (int i = 0; i < 8; ++i) t0.v[i] = t1.v[i];
        }
    }
#if defined(PROBE_PHASE) && (PROBE_PHASE == 13 || PROBE_PHASE == 14)
    const unsigned long long tp1_ = __builtin_amdgcn_s_memrealtime();
    if (PROBE_PHASE == 13) p0_probe = tp1_ - p0_t0;
#endif
    for (int m = 4 * gw; m < M; m += 4 * NGW) rms_rows4_to_bf16(F.in[0] + (size_t)m * D, F.in[1], (bf16*)(F.ws + WS_XB) + (size_t)m * D, F.lane);
#if defined(PROBE_PHASE) && (PROBE_PHASE == 13 || PROBE_PHASE == 14)
    if (PROBE_PHASE == 14) p0_probe = __builtin_amdgcn_s_memrealtime() - tp1_;
#endif
    if (blockIdx.x == 0) {
        const float l0 = F.in[10][F.tid], l1 = F.in[10][512 + F.tid], mx = fmaxf(l0, l1), e0 = __expf(l0 - mx), e1 = __expf(l1 - mx);
        ((float*)(F.ws + WS_LB))[F.tid] = e0 / (e0 + e1);
    }
}

typedef float f32x16 __attribute__((ext_vector_type(16)));
typedef float f32x2_t __attribute__((ext_vector_type(2))); typedef __bf16 bf16x2_t __attribute__((ext_vector_type(2)));
__device__ __forceinline__ unsigned cvtpk_s(float lo, float hi) { f32x2_t v = {lo, hi}; bf16x2_t b = __builtin_convertvector(v, bf16x2_t); return __builtin_bit_cast(unsigned, b); }
__device__ __forceinline__ bf16x8 pack_step(const f32x16& x, int s) { v4u p; p.x = cvtpk_s(x[8 * s], x[8 * s + 1]); p.y = cvtpk_s(x[8 * s + 2], x[8 * s + 3]); p.z = cvtpk_s(x[8 * s + 4], x[8 * s + 5]); p.w = cvtpk_s(x[8 * s + 6], x[8 * s + 7]); return __builtin_bit_cast(bf16x8, p); }
__device__ __forceinline__ float swapmax(float m) { auto rr = __builtin_amdgcn_permlane32_swap(__float_as_uint(m), __float_as_uint(m), false, false); return fmaxf(__uint_as_float(rr[0]), __uint_as_float(rr[1])); }
__device__ __forceinline__ float swapsum(float m) { auto rr = __builtin_amdgcn_permlane32_swap(__float_as_uint(m), __float_as_uint(m), false, false); return __uint_as_float(rr[0]) + __uint_as_float(rr[1]); }
__device__ __forceinline__ int pi32(int x) { return (x & 0x13) | ((x & 4) << 1) | ((x & 8) >> 1); }
#define MFMA32(a, b, c) __builtin_amdgcn_mfma_f32_32x32x16_bf16((a), (b), (c), 0, 0, 0)
constexpr int ATT_ETAB_OFF = 0;
__device__ __forceinline__ void attn_item(Frame& F, int b, int c, int h, const LAS float* etab) {
    const bf16* Q = (const bf16*)(F.ws + WS_Q); const bf16* Kp = (const bf16*)(F.ws + WS_K); const bf16* VT = (const bf16*)(F.ws + WS_VT); bf16* MIX = (bf16*)(F.ws + WS_MIX);
    const int lane = F.lane, r32 = lane & 31, hi = lane >> 5;
    const float cfar = F.in[9][h * 257 + 256] * LOG2E;
    bf16x8 qf[2][4];
#pragma unroll
    for (int qb = 0; qb < 2; ++qb)
#pragma unroll
        for (int d0 = 0; d0 < 4; ++d0) qf[qb][d0] = *(const bf16x8*)(Q + (unsigned)((((((b * 8 + h) * 32 + c) * 2 + qb) * 4 + d0) * 64 + lane) * 8));
    f32x16 o[2][2];
#pragma unroll
    for (int db = 0; db < 2; ++db)
#pragma unroll
        for (int qb = 0; qb < 2; ++qb)
#pragma unroll
            for (int r = 0; r < 16; ++r) o[db][qb][r] = 0.f;
    float mrun[2] = {-INFINITY, -INFINITY}, lrun[2] = {0.f, 0.f};
    const int kt0 = c >= 8 ? c - 8 : 0;
    const unsigned fbase = (unsigned)(((b * 8 + h) * 32 * 8 * 64 + lane) * 8);
    const LAS float* et = etab + h * 256;
    bf16x8 kf[2][4], vf[2][4];
#define AT_LOADK(kt_) do { _Pragma("unroll") for (int kb = 0; kb < 2; ++kb) _Pragma("unroll") for (int d0 = 0; d0 < 4; ++d0) kf[kb][d0] = *(const bf16x8*)(Kp + fbase + (unsigned)((((kt_) * 2 + kb) * 4 + d0) * 512)); } while (0)
#define AT_LOADV(kt_) do { _Pragma("unroll") for (int db = 0; db < 2; ++db) _Pragma("unroll") for (int ks = 0; ks < 4; ++ks) vf[db][ks] = *(const bf16x8*)(VT + fbase + (unsigned)((((kt_) * 2 + db) * 4 + ks) * 512)); } while (0)
    AT_LOADK(kt0); AT_LOADV(kt0);
    for (int kt = kt0; kt <= c; ++kt) {
        const int j = c - kt, ktn = kt < c ? kt + 1 : c;
#pragma unroll
        for (int qb = 0; qb < 2; ++qb) {
            f32x16 s[2]; bf16x8 pk[2][2];
            const float c0 = j >= 3 ? cfar : 0.f;
#pragma unroll
            for (int r = 0; r < 16; ++r) { s[0][r] = c0; s[1][r] = c0; }
#pragma unroll
            for (int d0 = 0; d0 < 4; ++d0) { s[0] = MFMA32(kf[0][d0], qf[qb][d0], s[0]); s[1] = MFMA32(kf[1][d0], qf[qb][d0], s[1]); }
            if (qb == 1) { __builtin_amdgcn_sched_barrier(0); AT_LOADK(ktn); __builtin_amdgcn_sched_barrier(0); }
            if (j < 3) {
                const int ib = 64 * j + 32 * qb + r32 - 8 * hi + 63;
#pragma unroll
                for (int kb = 0; kb < 2; ++kb)
#pragma unroll
                    for (int r = 0; r < 16; ++r) s[kb][r] += et[ib - 32 * kb - 16 * (r >> 3) - (r & 7)];
            }
            float tm = fmaxf(s[0][0], s[1][0]);
#pragma unroll
            for (int r = 1; r < 16; ++r) tm = fmaxf(tm, fmaxf(s[0][r], s[1][r]));
            tm = swapmax(tm);
            const float mn = fmaxf(mrun[qb], tm), alpha = __builtin_amdgcn_exp2f(mrun[qb] - mn); mrun[qb] = mn;
            float ls = 0.f;
#pragma unroll
            for (int kb = 0; kb < 2; ++kb)
#pragma unroll
                for (int r = 0; r < 16; ++r) { const float p = __builtin_amdgcn_exp2f(s[kb][r] - mn); s[kb][r] = p; ls += p; }
            lrun[qb] = lrun[qb] * alpha + ls;
#pragma unroll
            for (int db = 0; db < 2; ++db)
#pragma unroll
                for (int r = 0; r < 16; ++r) o[db][qb][r] *= alpha;
#pragma unroll
            for (int kb = 0; kb < 2; ++kb) { pk[kb][0] = pack_step(s[kb], 0); pk[kb][1] = pack_step(s[kb], 1); }
#pragma unroll
            for (int db = 0; db < 2; ++db)
#pragma unroll
                for (int kb = 0; kb < 2; ++kb)
#pragma unroll
                    for (int sp = 0; sp < 2; ++sp) o[db][qb] = MFMA32(vf[db][2 * kb + sp], pk[kb][sp], o[db][qb]);
        }
        __builtin_amdgcn_sched_barrier(0); AT_LOADV(ktn); __builtin_amdgcn_sched_barrier(0);
    }
#undef AT_LOADK
#undef AT_LOADV
#pragma unroll
    for (int qb = 0; qb < 2; ++qb) {
        const float inv = 1.0f / swapsum(lrun[qb]);
        bf16* orow = MIX + (unsigned)((b * SEQ + 64 * c + 32 * qb + r32) * 1024 + h * 64 + 4 * hi);
#pragma unroll
        for (int db = 0; db < 2; ++db)
#pragma unroll
            for (int g = 0; g < 4; ++g) { pg8::u32x2 w; w.x = cvtpk_s(o[db][qb][4 * g] * inv, o[db][qb][4 * g + 1] * inv); w.y = cvtpk_s(o[db][qb][4 * g + 2] * inv, o[db][qb][4 * g + 3] * inv);
                *(pg8::u32x2*)(orow + 32 * db + 8 * g) = w; }
    }
}
__device__ __forceinline__ void attn_phase(Frame& F) {
    LAS float* etab = (LAS float*)(F.lds + RING_OFF + ATT_ETAB_OFF);
    for (int i = F.tid; i < 8 * 256; i += NWAVES * 64) { const int h = i >> 8; int rel = (i & 255) - 63; rel = rel > 128 ? 128 : rel; etab[i] = F.in[9][h * 257 + rel + 128] * LOG2E; }
    __syncthreads();
    for (int k = 0; k < 8; ++k) {
        const int shard = ((int)blockIdx.x + k) & 7;
        gu32* head = F.ctl + CW_WQ + 64 * shard;
        for (;;) {
            unsigned n = 0; if (F.lane == 0) n = __hip_atomic_fetch_add(head, 1u, RLX_AGENT);
            n = (unsigned)__builtin_amdgcn_readfirstlane((int)n);
            if (n >= 512u) break;
            const int bh = 8 * (int)(n >> 5) + shard, c = 31 - (int)(n & 31);
            attn_item(F, bh >> 3, c, bh & 7, etab);
        }
    }
    __syncthreads();
}

__device__ __forceinline__ unsigned off_b(unsigned row, unsigned ch) { return 256u * row + 16u * (ch ^ (((row & 3) << 2) | ((row >> 2) & 3))); }
__device__ __forceinline__ unsigned tr_read_addr_b(unsigned lane, unsigned c, unsigned ks, unsigned t) {
    const unsigned h = lane >> 5, blk = (lane >> 4) & 1, q = (lane & 15) >> 2, p = lane & 3;
    return off_b(16 * ks + 8 * h + 4 * t + q, 4 * c + 2 * blk + (p >> 1)) + 8 * (p & 1);
}
typedef short v4i16_t __attribute__((ext_vector_type(4)));
__device__ __forceinline__ v4i16_t lds_tr(const LAS unsigned char* p) { return __builtin_amdgcn_ds_read_tr16_b64_v4i16((LAS v4i16_t*)p); }
__device__ __forceinline__ bf16x8 krow_frag(bf16x8 nat) {
    const v4u d = __builtin_bit_cast(v4u, nat);
    auto a = __builtin_amdgcn_permlane32_swap(d.x, d.z, false, false); auto b = __builtin_amdgcn_permlane32_swap(d.y, d.w, false, false);
    v4u r; r.x = a[0]; r.y = b[0]; r.z = a[1]; r.w = b[1]; return __builtin_bit_cast(bf16x8, r);
}
constexpr int HG_PS_OFF = 8192, HG_DD_OFF = 10240, HG_GN_OFF = 12288, HG_BUF_OFF = 16384;
constexpr int HG_QT_OFF = 16384, HG_VT_OFF = 32768, HG_BUF_BYTES = 49152;
constexpr int HG_OX_OFF = HG_BUF_OFF + 2 * HG_BUF_BYTES, HG_OX_BYTES = 64 * 264;
constexpr int HG_XS_OFF = HG_OX_OFF + 2 * HG_OX_BYTES;
static_assert(HG_XS_OFF + 3 * 2048 <= LDSCTL_OFF && HG_OX_OFF % 16 == 0 && HG_XS_OFF % 16 == 0, "HGRN LDS map");
__device__ __forceinline__ void dma16(const void* g, LAS unsigned char* l) { __builtin_amdgcn_global_load_lds((const unsigned*)g, (LAS unsigned*)l, 16, 0, 0); }
__device__ __forceinline__ void hgrn_finalize(Frame& F, const v4u& g0, const v4u& g1, int b, int hh, int c) {
    bf16* MIX = (bf16*)(F.ws + WS_MIX);
    const int tok = F.tid >> 3, pc = F.tid & 7;
    const LAS float* ps = (const LAS float*)(F.lds + RING_OFF + HG_PS_OFF) + ((c & 1) * 2 + (tok >> 5)) * 128 + (tok & 31);
    const float tot = (ps[0] + ps[32]) + (ps[64] + ps[96]);
    const float rs = __builtin_amdgcn_rsqf(tot * (1.0f / 128.0f) + RMS_EPS);
    const LAS unsigned char* ox = F.lds + RING_OFF + HG_OX_OFF + (c & 1) * HG_OX_BYTES + tok * 264 + 32 * pc;
    const LAS f32x4* gn = (const LAS f32x4*)(F.lds + RING_OFF + HG_GN_OFF) + 4 * pc;
    unsigned ow[8]; const unsigned gw[8] = {g0.x, g0.y, g0.z, g0.w, g1.x, g1.y, g1.z, g1.w};
#pragma unroll
    for (int i = 0; i < 4; ++i) { const pg8::u32x2 o2 = *(const LAS pg8::u32x2*)(ox + 8 * i); const f32x4 g4 = gn[i];
        ow[2 * i] = cvtpk_s(bflo(o2.x) * rs * g4[0] * bflo(gw[2 * i]), bfhi(o2.x) * rs * g4[1] * bfhi(gw[2 * i]));
        ow[2 * i + 1] = cvtpk_s(bflo(o2.y) * rs * g4[2] * bflo(gw[2 * i + 1]), bfhi(o2.y) * rs * g4[3] * bfhi(gw[2 * i + 1])); }
    bf16* dst = MIX + (unsigned)((b * SEQ + 64 * c + tok) * 1024 + 512 + hh * 128 + 16 * pc);
    *(v4u*)dst = (v4u){ow[0], ow[1], ow[2], ow[3]}; *(v4u*)(dst + 8) = (v4u){ow[4], ow[5], ow[6], ow[7]};
}
__device__ __forceinline__ void hgrn_phase(Frame& F, int bh, unsigned long long& hg_wait_acc) {
    const unsigned char* QT = F.ws + WS_QT; const unsigned char* KT = F.ws + WS_KT; const unsigned char* VHT = F.ws + WS_VHT; const bf16* Gt = (const bf16*)(F.ws + WS_G);
    const unsigned char* DM = F.ws + WS_DM; const unsigned char* DE = F.ws + WS_DE;
    const int b = bh >> 2, hh = bh & 3, lane = F.lane, r32 = lane & 31, hi = lane >> 5, w = F.wave, vb = w & 3, tb = w >> 2, tid = F.tid;
    LAS unsigned char* const bufs = F.lds + RING_OFF + HG_BUF_OFF;
    LAS float* const psw = (LAS float*)(F.lds + RING_OFF + HG_PS_OFF);
    LAS float* const ddw = (LAS float*)(F.lds + RING_OFF + HG_DD_OFF);
    unsigned so_k[2], so_v[2];
#pragma unroll
    for (int j = 0; j < 2; ++j) { const unsigned ii = (unsigned)(w + 8 * j), sl = ii * 64 + lane;
        { const unsigned img = sl >> 9, s9 = sl & 511, row = s9 >> 4, ch = (s9 & 15) ^ (((row & 3) << 2) | ((row >> 2) & 3)); so_k[j] = ((32 * img + row) * 512 + hh * 128) * 2 + ch * 16; }
        { const unsigned row = sl >> 3, ch = (sl & 7) ^ (row & 7); so_v[j] = ((hh * 128 + row) * SEQ) * 2 + ch * 16; } }
    const unsigned so_d = (unsigned)((hh * 128) * 4 + (lane & 31) * 16);
    const unsigned char* const ddsrc = (lane < 32 ? DM : DE) + (size_t)(b * NCHUNK) * 2048 + so_d;
    const unsigned char* const ktb = KT + (size_t)(b * SEQ) * 1024; const unsigned char* const qtb = QT + (size_t)(b * SEQ) * 1024; const unsigned char* const vtb = VHT + (size_t)(b * 512) * SEQ * 2;
#define HG_DMA(c_) do { LAS unsigned char* nb_ = bufs + ((c_) & 1) * HG_BUF_BYTES + w * 1024; const size_t ck_ = (size_t)(c_) * 65536, cv_ = (size_t)(c_) * 128; \
        dma16(ktb + ck_ + so_k[0], nb_); dma16(ktb + ck_ + so_k[1], nb_ + 8192); dma16(qtb + ck_ + so_k[0], nb_ + HG_QT_OFF); dma16(qtb + ck_ + so_k[1], nb_ + HG_QT_OFF + 8192); \
        dma16(vtb + cv_ + so_v[0], nb_ + HG_VT_OFF); dma16(vtb + cv_ + so_v[1], nb_ + HG_VT_OFF + 8192); \
        if (w == 0) dma16(ddsrc + (size_t)(c_) * 2048, (LAS unsigned char*)(ddw + ((c_) & 1) * 256)); } while (0)
    HG_DMA(0);
    if (tid < 128) ((LAS float*)(F.lds + RING_OFF + HG_GN_OFF))[tid] = F.in[11][tid];
    f32x16 S[4];
#pragma unroll
    for (int kb = 0; kb < 4; ++kb)
#pragma unroll
        for (int r = 0; r < 16; ++r) S[kb][r] = 0.f;
    unsigned rd_tr[4][2], rd_vt[4];
    const unsigned rk_ = (unsigned)pi32(r32), sk_ = ((rk_ & 3) << 2) | ((rk_ >> 2) & 3), sq_ = (((unsigned)r32 & 3) << 2) | (((unsigned)r32 >> 2) & 3);
    const unsigned kt_base = 256u * rk_ + 16u * ((unsigned)hi ^ (sk_ & 1)), kt_e = sk_ >> 1, qt_base = (unsigned)(HG_QT_OFF + tb * 8192) + 256u * (unsigned)r32 + 16u * ((unsigned)hi ^ (sq_ & 1)), qt_e = sq_ >> 1;
#pragma unroll
    for (int kb = 0; kb < 4; ++kb) { rd_tr[kb][0] = tr_read_addr_b((unsigned)lane, (unsigned)kb, 0u, 0u); rd_tr[kb][1] = tr_read_addr_b((unsigned)lane, (unsigned)kb, 0u, 1u); }
#pragma unroll
    for (int k4 = 0; k4 < 4; ++k4) rd_vt[k4] = (unsigned)(HG_VT_OFF + (32 * vb + r32) * 128 + (((2 * k4 + hi) ^ (r32 & 7)) << 4));
    const unsigned wr_ox = (unsigned)(HG_OX_OFF + (32 * tb + r32) * 264 + (32 * vb + 4 * hi) * 2);
    const unsigned src_g = (unsigned)((b * SEQ + (tid >> 3)) * 512 + hh * 128 + 16 * (tid & 7));
    asm volatile("s_waitcnt vmcnt(0) lgkmcnt(0)" ::: "memory"); __builtin_amdgcn_s_barrier(); asm volatile("" ::: "memory");
    for (int c = 0; c < NCHUNK; ++c) {
        const LAS unsigned char* buf = bufs + (c & 1) * HG_BUF_BYTES;
        { const int cn = c + 1 < NCHUNK ? c + 1 : NCHUNK - 1; HG_DMA(cn); }
        v4u gc0 = {0u, 0u, 0u, 0u}, gc1 = {0u, 0u, 0u, 0u};
        if (c > 0) { const bf16* gcp = Gt + (size_t)((c - 1) * 64 * 512); gc0 = *(const v4u*)(gcp + src_g); gc1 = *(const v4u*)(gcp + src_g + 8); }
        __builtin_amdgcn_sched_barrier(0);
        const LAS float* dd = ddw + (c & 1) * 256 + 4 * hi;
#pragma unroll
        for (int kb = 0; kb < 4; ++kb) {
#pragma unroll
            for (int g = 0; g < 4; ++g) { const f32x4 a = *(const LAS f32x4*)(dd + 32 * kb + 8 * g);
#pragma unroll
                for (int i = 0; i < 4; ++i) S[kb][4 * g + i] *= a[i]; }
            }
        unsigned ek = kt_e, eq = qt_e; asm volatile("" : "+v"(ek), "+v"(eq));
#define HG_RDKT(ks_) (kt_base + (((unsigned)(ks_) ^ ek) << 5))
#define HG_RDQT(ks_) (qt_base + (((unsigned)(ks_) ^ eq) << 5))
        if (w < 3) {
            const int sbx = w >> 1, tbx = (w + 1) >> 1;
            const unsigned qtx = (unsigned)(HG_QT_OFF + tbx * 8192) + 256u * (unsigned)r32 + 16u * ((unsigned)hi ^ (sq_ & 1));
            f32x16 X;
#pragma unroll
            for (int r = 0; r < 16; ++r) X[r] = 0.f;
#pragma unroll
            for (int ks = 0; ks < 8; ++ks) { const bf16x8 kf = *(const LAS bf16x8*)(buf + sbx * 8192 + HG_RDKT(ks)), qf = *(const LAS bf16x8*)(buf + qtx + (((unsigned)ks ^ eq) << 5)); X = MFMA32(kf, qf, X); }
            if (sbx == tbx) {
                int thr = r32 - 8 * hi; asm volatile("" : "+v"(thr));
#pragma unroll
                for (int r = 0; r < 16; ++r) X[r] = thr >= 16 * (r >> 3) + (r & 7) ? X[r] : 0.f;
            }
            LAS unsigned char* xw = F.lds + RING_OFF + HG_XS_OFF + w * 2048 + lane * 16;
            *(LAS bf16x8*)xw = pack_step(X, 0); *(LAS bf16x8*)(xw + 1024) = pack_step(X, 1);
        }
        __builtin_amdgcn_sched_barrier(0);
        bf16x8 vfr[4];
#pragma unroll
        for (int k4 = 0; k4 < 4; ++k4) vfr[k4] = *(const LAS bf16x8*)(buf + rd_vt[k4]);
        f32x16 o;
#pragma unroll
        for (int r = 0; r < 16; ++r) o[r] = 0.f;
#pragma unroll
        for (int kb = 0; kb < 4; ++kb)
#pragma unroll
            for (int sp = 0; sp < 2; ++sp) { const bf16x8 qq = *(const LAS bf16x8*)(buf + HG_RDQT(2 * kb + sp)); o = MFMA32(pack_step(S[kb], sp), krow_frag(qq), o); }
        __builtin_amdgcn_sched_barrier(0);
#pragma unroll
        for (int kb = 0; kb < 4; ++kb) {
#pragma unroll
            for (int k4 = 0; k4 < 4; ++k4) {
                const LAS unsigned char* ip = buf + (k4 >> 1) * 8192 + (k4 & 1) * 4096;
                const v4i16_t lo = lds_tr(ip + rd_tr[kb][0]), hi4 = lds_tr(ip + rd_tr[kb][1]);
                const bf16x8 af = __builtin_shufflevector(lo, hi4, 0, 1, 2, 3, 4, 5, 6, 7);
                S[kb] = MFMA32(af, vfr[k4], S[kb]);
            }
#pragma unroll
            for (int g = 0; g < 4; ++g) { const f32x4 a = *(const LAS f32x4*)(dd + 128 + 32 * kb + 8 * g);
#pragma unroll
                for (int i = 0; i < 4; ++i) S[kb][4 * g + i] *= a[i]; }
        }
        asm volatile("s_waitcnt lgkmcnt(0)" ::: "memory"); __builtin_amdgcn_s_barrier(); asm volatile("" ::: "memory");
        { const LAS unsigned char* xr = F.lds + RING_OFF + HG_XS_OFF + lane * 16;
          if (tb == 0) { o = MFMA32(vfr[0], *(const LAS bf16x8*)(xr), o); o = MFMA32(vfr[1], *(const LAS bf16x8*)(xr + 1024), o); }
          else { o = MFMA32(vfr[0], *(const LAS bf16x8*)(xr + 2048), o); o = MFMA32(vfr[1], *(const LAS bf16x8*)(xr + 3072), o);
                 o = MFMA32(vfr[2], *(const LAS bf16x8*)(xr + 4096), o); o = MFMA32(vfr[3], *(const LAS bf16x8*)(xr + 5120), o); } }
        { float q = 0.f;
#pragma unroll
          for (int r = 0; r < 16; ++r) q += o[r] * o[r];
          q = swapsum(q);
          if (hi == 0) psw[((c & 1) * 2 + tb) * 128 + vb * 32 + r32] = q;
          LAS unsigned char* oxw = F.lds + RING_OFF + (c & 1) * HG_OX_BYTES + wr_ox;
#pragma unroll
          for (int g = 0; g < 4; ++g) *(LAS pg8::u32x2*)(oxw + 16 * g) = (pg8::u32x2){cvtpk_s(o[4 * g], o[4 * g + 1]), cvtpk_s(o[4 * g + 2], o[4 * g + 3])}; }
        __builtin_amdgcn_sched_barrier(0);
        if (c > 0) hgrn_finalize(F, gc0, gc1, b, hh, c - 1);
#if defined(PROBE_PHASE) && (PROBE_PHASE == 11 || PROBE_PHASE == 12)
        { const unsigned long long tw0_ = __builtin_amdgcn_s_memrealtime();
          asm volatile("s_waitcnt vmcnt(0) lgkmcnt(0)" ::: "memory");
          const unsigned long long tw1_ = __builtin_amdgcn_s_memrealtime();
          __builtin_amdgcn_s_barrier(); asm volatile("" ::: "memory");
          const unsigned long long tw2_ = __builtin_amdgcn_s_memrealtime();
          hg_wait_acc += (PROBE_PHASE == 11) ? (tw1_ - tw0_) : (tw2_ - tw1_); }
#else
        asm volatile("s_waitcnt vmcnt(0) lgkmcnt(0)" ::: "memory"); __builtin_amdgcn_s_barrier(); asm volatile("" ::: "memory");
#endif
    }
    { const bf16* gcp = Gt + (size_t)((NCHUNK - 1) * 64 * 512); const v4u gc0 = *(const v4u*)(gcp + src_g), gc1 = *(const v4u*)(gcp + src_g + 8);
      hgrn_finalize(F, gc0, gc1, b, hh, NCHUNK - 1); }
    __syncthreads();
#undef HG_DMA
#undef HG_RDKT
#undef HG_RDQT
}

struct Args { const float* in[17]; float* out; unsigned char* ws; int ph_lo, ph_hi, li, pad; };
__global__ void __launch_bounds__(NWAVES * 64, 2) mega_fwd(Args args) {
    extern __shared__ __attribute__((aligned(16))) unsigned char lds[];
    Frame F;
    F.lds = (LAS unsigned char*)lds;
    F.MISC = (volatile LAS unsigned*)(F.lds + MISC_OFF);
    F.tid = threadIdx.x; F.lane = F.tid & 63; F.wave = __builtin_amdgcn_readfirstlane(F.tid >> 6);
    F.G = gridDim.x;
#pragma unroll
    for (int i = 0; i < 17; ++i) F.in[i] = args.in[i];
    F.out = args.out; F.ws = args.ws;
    F.ctl = (gu32*)(args.ws + WS_CTL);
    for (int u = F.tid; u < (LDS_BYTES - LDSCTL_OFF) / 4; u += NWAVES * 64) ((LAS unsigned*)(F.lds + LDSCTL_OFF))[u] = 0u;
    __syncthreads();
    XcdBarrier bar; bar.bar = (unsigned*)(F.ctl + CW_BAR); bar.x = 0; bar.st = nullptr;
    if (N_LAUNCHES != PER_PHASE) bar = xcd_barrier_post((unsigned*)(F.ctl + CW_BAR), F.MISC + 8);
#define GRID_BAR(seam) do { if (N_LAUNCHES == PER_PHASE) { if (F.tid == 0) __hip_atomic_store(F.ctl + CW_TMO, 0xBADBA0u | (unsigned)(seam), RLX_AGENT); } else { xcd_barrier(bar); } } while (0)
    const int lo = args.ph_lo, hi = args.ph_hi;
#ifdef PROBE_PHASE
    unsigned long long ts_prev = __builtin_amdgcn_s_memrealtime(), ts_dt = 0ull; int ts_k = 0;
#define STAMP() do { const unsigned long long t_ = __builtin_amdgcn_s_memrealtime(); if (ts_k == PROBE_PHASE) ts_dt = t_ - ts_prev; ts_prev = t_; ++ts_k; } while (0)
#else
#define STAMP() do {} while (0)
#endif
#define IN(k) (lo <= (k) && (k) < hi)
#define BOTH(k) (IN(k) && IN((k) + 1))
    bf16* const XB = (bf16*)(F.ws + WS_XB); bf16* const HID = (bf16*)(F.ws + WS_HID); bf16* const MIXp = (bf16*)(F.ws + WS_MIX);
    float* const RS1 = (float*)(F.ws + WS_RS1); float* const RS2 = (float*)(F.ws + WS_RS2);
    const LAS float* const SCL = (const LAS float*)(F.lds + RING_OFF + RING_BYTES);

    if (IN(0)) { unsigned long long p0_probe = 0ull; p0_prologue(F, p0_probe);
#if defined(PROBE_PHASE) && (PROBE_PHASE == 13 || PROBE_PHASE == 14)
        ts_dt = p0_probe;
#endif
        if (BOTH(0)) GRID_BAR(0); STAMP(); }
    if (IN(1)) {
        pg8::Gemm g{XB, (const bf16*)(F.ws + WS_WGU1), M, 2 * FF, D}; pg8::StaticOrder S; S.init(M, 2 * FF, F.G, (int)blockIdx.x);
        pg8::EpiSwiGLU E{HID, nullptr, SCL, FF};
        pg8::gemm_phase<pg8::EpiSwiGLU, pg8::StaticOrder, true, true>(F.lds + RING_OFF, g, S, E);
        if (BOTH(1)) GRID_BAR(1); STAMP();
    }
    if (IN(2)) {
        pg8::Gemm g{HID, (const bf16*)(F.ws + WS_WD1), M, D, FF}; pg8::StaticOrder S; S.init(M, D, F.G, (int)blockIdx.x);
        pg8::EpiRes<0> E{F.in[0], nullptr, XB, RS1, 0.5f};
        pg8::gemm_phase<pg8::EpiRes<0>, pg8::StaticOrder, true, true>(F.lds + RING_OFF, g, S, E);
        if (BOTH(2)) GRID_BAR(2); STAMP();
    }
    if (IN(3)) {
        { pg8::Gemm g{XB, (const bf16*)(F.ws + WS_WIN), M, 2560, D}; pg8::StaticOrder S; S.init(M, 2560, F.G, (int)blockIdx.x);
          pg8::EpiWin E{(bf16*)(F.ws + WS_Q), (bf16*)(F.ws + WS_K), (bf16*)(F.ws + WS_QT), (bf16*)(F.ws + WS_KT), (bf16*)(F.ws + WS_G), (float*)(F.ws + WS_DM), (float*)(F.ws + WS_DE), RS1, F.in[7], F.in[8], (const float*)(F.ws + WS_LB), SCL};
          pg8::gemm_phase<pg8::EpiWin, pg8::StaticOrder, true, true>(F.lds + RING_OFF, g, S, E); }
        { pg8::Gemm g{(const bf16*)(F.ws + WS_WINT), XB, 1024, M, D}; pg8::StaticOrder S; S.init(1024, M, F.G, (int)blockIdx.x);
          pg8::EpiVT E{(bf16*)(F.ws + WS_VT), (bf16*)(F.ws + WS_VHT), RS1, SCL};
          pg8::gemm_phase<pg8::EpiVT, pg8::StaticOrder, true, true>(F.lds + RING_OFF, g, S, E); }
        if (BOTH(3)) GRID_BAR(3); STAMP();
    }
    if (IN(4)) {
#ifdef PROBE_PHASE
        const unsigned long long th00_ = __builtin_amdgcn_s_memrealtime();
#endif
#ifdef PROBE_PHASE
        const unsigned long long th0_ = __builtin_amdgcn_s_memrealtime();
        if (PROBE_PHASE == 9) ts_dt = th0_ - th00_;
#endif
        unsigned long long hg_wait_acc = 0ull;
        if (blockIdx.x < 64) hgrn_phase(F, (int)blockIdx.x, hg_wait_acc);
#ifdef PROBE_PHASE
        if (PROBE_PHASE == 11 || PROBE_PHASE == 12) ts_dt = hg_wait_acc;
#endif
#ifdef PROBE_PHASE
        if (PROBE_PHASE == 8) ts_dt = __builtin_amdgcn_s_memrealtime() - th0_;
#endif
#ifdef PROBE_PHASE
        const unsigned long long ta0_ = __builtin_amdgcn_s_memrealtime();
#endif
        attn_phase(F);
#ifdef PROBE_PHASE
        if (PROBE_PHASE == 10) ts_dt = __builtin_amdgcn_s_memrealtime() - ta0_;
#endif
        if (BOTH(4)) GRID_BAR(4); STAMP();
    }
    if (IN(5)) {
        pg8::Gemm g{MIXp, (const bf16*)(F.ws + WS_WOUT), M, D, D}; pg8::StaticOrder S; S.init(M, D, F.G, (int)blockIdx.x);
        pg8::EpiRes<1> E{nullptr, nullptr, XB, RS2, 1.0f};
        pg8::gemm_phase<pg8::EpiRes<1>, pg8::StaticOrder, true, true>(F.lds + RING_OFF, g, S, E);
        if (BOTH(5)) GRID_BAR(5); STAMP();
    }
    if (IN(6)) {
        pg8::Gemm g{XB, (const bf16*)(F.ws + WS_WGU2), M, 2 * FF, D}; pg8::StaticOrder S; S.init(M, 2 * FF, F.G, (int)blockIdx.x);
        pg8::EpiSwiGLU E{HID, RS2, SCL, FF};
        pg8::gemm_phase<pg8::EpiSwiGLU, pg8::StaticOrder, true, true>(F.lds + RING_OFF, g, S, E);
        if (BOTH(6)) GRID_BAR(6); STAMP();
    }
    if (IN(7)) {
        pg8::Gemm g{HID, (const bf16*)(F.ws + WS_WD2), M, D, FF}; pg8::StaticOrder S; S.init(M, D, F.G, (int)blockIdx.x);
        pg8::EpiRes<2> E{nullptr, F.out, XB, nullptr, 0.5f};
        pg8::gemm_phase<pg8::EpiRes<2>, pg8::StaticOrder, true, true>(F.lds + RING_OFF, g, S, E);
    }
#ifdef PROBE_PHASE
    __syncthreads(); STAMP();
    if (blockIdx.x == (PROBE_PHASE == 10 ? 255 : 0) && F.tid == 0) { const unsigned long long t0_ = __builtin_amdgcn_s_memrealtime(); while (__builtin_amdgcn_s_memrealtime() - t0_ < 4ull * ts_dt) __builtin_amdgcn_s_sleep(8); }
#endif
#undef IN
#undef BOTH
}

extern "C" void kernel_launch(void* const* d_in, const int* in_sizes, int n_in, void* d_out, int out_size, void* d_ws, size_t ws_size, hipStream_t stream) {
    static int grid = 0;
    if (grid == 0) {
        if (n_in != 17 || in_sizes[0] != M * D || out_size != M * D || ws_size < WS_END) { fprintf(stderr, "kernel_launch: unexpected shapes (n_in %d, in0 %d, out %d, ws %zu); nothing launched\n", n_in, n_in > 0 ? in_sizes[0] : -1, out_size, ws_size); grid = -1; return; }
        int dev = 0, cus = 0, per_cu = 0;
        if (hipGetDevice(&dev) != hipSuccess || hipDeviceGetAttribute(&cus, hipDeviceAttributeMultiprocessorCount, dev) != hipSuccess) { grid = -1; return; }
        if (hipFuncSetAttribute((const void*)mega_fwd, hipFuncAttributeMaxDynamicSharedMemorySize, LDS_BYTES) != hipSuccess) { fprintf(stderr, "kernel_launch: hipFuncSetAttribute failed\n"); grid = -1; return; }
        if (hipOccupancyMaxActiveBlocksPerMultiprocessor(&per_cu, (const void*)mega_fwd, NWAVES * 64, LDS_BYTES) != hipSuccess || per_cu < 1) fprintf(stderr, "kernel_launch: note: occupancy query reports %d workgroups per CU\n", per_cu);
        (void)hipGetLastError();
        grid = cus;
    }
    if (grid < 0) return;
    if (hipMemsetAsync((char*)d_ws + WS_CTL, 0, CTL_ZERO_BYTES, stream) != hipSuccess) { fprintf(stderr, "kernel_launch: hipMemsetAsync failed\n"); return; }
    Args a{};
    for (int i = 0; i < 17; ++i) a.in[i] = (const float*)d_in[i];
    a.out = (float*)d_out; a.ws = (unsigned char*)d_ws;
    for (int li = 0; li < N_LAUNCHES; ++li) {
        a.ph_lo = (N_LAUNCHES == PER_PHASE) ? li : 0; a.ph_hi = (N_LAUNCHES == PER_PHASE) ? li + 1 : PER_PHASE; a.li = li;
        hipLaunchKernelGGL(mega_fwd, dim3(grid), dim3(NWAVES * 64), LDS_BYTES, stream, a);
        const hipError_t le = hipPeekAtLastError();
        if (le != hipSuccess) { fprintf(stderr, "kernel_launch: launch %d failed: %s\n", li, hipGetErrorName(le)); break; }
    }
}
```

```cpp
#include <hip/hip_runtime.h>
#include <cstdio>
#include <cstdint>
namespace pg8 {
#define PG8_LAS __attribute__((address_space(3)))
typedef unsigned short bf16_t;
typedef short bf16x8 __attribute__((ext_vector_type(8)));
typedef float f32x4 __attribute__((ext_vector_type(4)));
typedef unsigned u32x4 __attribute__((ext_vector_type(4)));
constexpr int BM = 256, BK = 64, HALF = 128, HTB = HALF * BK * 2  , STAGE_BYTES = 8 * HTB, NXCD = 8, WGM = 4;

__host__ __device__ __forceinline__ int lds_byte(int r, int c) { const int st = (r >> 4) * 2 + (c >> 5), rr = r & 15, cc = c & 31, ob = rr * 64 + cc * 2; return st * 1024 + (ob ^ (((ob >> 9) & 1) << 5)); }
__host__ __device__ __forceinline__ void stage_rc(int b, int& R, int& C) { const int st = b / 1024, sb = b % 1024, swz = sb ^ (((sb >> 9) & 1) << 5); R = (st >> 1) * 16 + swz / 64; C = (st & 1) * 32 + (swz % 64) / 2; }
__host__ __device__ __forceinline__ int perm32(int rho) { const int n = rho >> 4, i = rho & 15; return 8 * (i >> 2) + 4 * n + (i & 3); }

struct Unit { int pm, pn, par; };
struct Gemm { const bf16_t* A; const bf16_t* Bt; int M, N, K; };

struct StaticOrder {
    int nM, nN, nwg, G, c, wgm;
    __host__ __device__ void init(int M, int N, int G_, int c_, int wgm_ = WGM) { nM = M / BM; nN = N / BM; nwg = nM * nN; G = G_; c = c_; wgm = wgm_; }
    __host__ __device__ bool next(int i, Unit& u) const {
        const long L = (long)i * G + c; if (L >= nwg) return false;
        int wgid = (int)L; { const int q = nwg / NXCD, r = nwg % NXCD, xcd = wgid % NXCD, off = wgid / NXCD; wgid = (xcd < r ? xcd * (q + 1) : r * (q + 1) + (xcd - r) * q) + off; }
        const int nig = wgm * nN, gid = wgid / nig, fm = gid * wgm, gsz = (nM - fm) < wgm ? (nM - fm) : wgm;
        u.pm = fm + ((wgid % nig) % gsz); u.pn = (wgid % nig) / gsz; return true;
    }
    __device__ __forceinline__ void a_ready(const Unit&) const {}
    __device__ __forceinline__ void done(const Unit&) const {}
};


typedef unsigned u32x2 __attribute__((ext_vector_type(2)));
constexpr float RMS_EPS = 1e-6f, LOG2E = 1.4426950408889634f, QSCALE = 0.125f * 1.4426950408889634f;
__device__ __forceinline__ unsigned cvt_pk_bf16(float lo, float hi) { unsigned r; asm volatile("v_cvt_pk_bf16_f32 %0, %1, %2" : "=v"(r) : "v"(lo), "v"(hi)); return r; }
__device__ __forceinline__ float fsigmoid(float x) { return __builtin_amdgcn_rcpf(1.0f + __builtin_amdgcn_exp2f(-x * LOG2E)); }
__device__ __forceinline__ float fsilu(float x) { return x * fsigmoid(x); }
__device__ __forceinline__ f32x4 silu4(f32x4 v) { return (f32x4){fsilu(v[0]), fsilu(v[1]), fsilu(v[2]), fsilu(v[3])}; }
__device__ __forceinline__ u32x4 pack8(f32x4 a, f32x4 b) { u32x4 w; w.x = cvt_pk_bf16(a[0], a[1]); w.y = cvt_pk_bf16(a[2], a[3]); w.z = cvt_pk_bf16(b[0], b[1]); w.w = cvt_pk_bf16(b[2], b[3]); return w; }
__device__ __forceinline__ float rowscale(const float* rowsq, const PG8_LAS float* slot, int rl) { return rowsq ? __builtin_amdgcn_rsqf(slot[rl] * (1.0f / 1024.0f) + RMS_EPS) : 1.0f; }
template <int CTRL> __device__ __forceinline__ float dpp_mov0(float x) { return __builtin_bit_cast(float, __builtin_amdgcn_update_dpp(0, __builtin_bit_cast(int, x), CTRL, 0xf, 0xf, true)); }
__device__ __forceinline__ float row_scan16(float x) { x += dpp_mov0<0x111>(x); x += dpp_mov0<0x112>(x); x += dpp_mov0<0x114>(x); x += dpp_mov0<0x118>(x); return x; }

struct EpiSwiGLU {
    static constexpr bool PERM = false, AFTER_DRAIN = false; static constexpr int SCALE = 1;
    bf16_t* H; const float* rowsq; const PG8_LAS float* scl; int ldh;
    __device__ __forceinline__ void operator()(f32x4 (&acc)[2][2][4][2], const Unit& u, int wr, int wc, int fr, int fq) const {
        const int row0 = u.pm * BM + wr * 64 + fr, col0 = u.pn * HALF + wc * 32 + 8 * fq; const PG8_LAS float* slot = scl + u.par * 256 + wr * 64 + fr;
#pragma unroll
        for (int ai = 0; ai < 2; ++ai)
#pragma unroll
            for (int m = 0; m < 4; ++m) { const int row = row0 + ai * HALF + m * 16; const float r = rowscale(rowsq, slot, ai * HALF + m * 16);
                f32x4 hh[2];
#pragma unroll
                for (int n = 0; n < 2; ++n) { const f32x4 g = acc[ai][0][m][n] * r, gu = g * (acc[ai][1][m][n] * r);
#pragma unroll
                    for (int c = 0; c < 4; ++c) hh[n][c] = gu[c] * __builtin_amdgcn_rcpf(1.0f + __builtin_amdgcn_exp2f(-g[c])); }
                *(u32x4*)(H + (unsigned)(row * ldh + col0)) = pack8(hh[0], hh[1]); }
    }
};
template <int MODE> struct EpiRes {
    static constexpr bool PERM = false, AFTER_DRAIN = false; static constexpr int SCALE = 0;
    const float* base; float* out; bf16_t* xb; float* rowsq; float scale;
    __device__ __forceinline__ void operator()(f32x4 (&acc)[2][2][4][2], const Unit& u, int wr, int wc, int fr, int fq) const {
        const int row0 = u.pm * BM + wr * 64 + fr, col0 = u.pn * BM + wc * 32 + 4 * fq;
#pragma unroll
        for (int ai = 0; ai < 2; ++ai)
#pragma unroll
            for (int m = 0; m < 4; ++m) { const int row = row0 + ai * HALF + m * 16; const unsigned off = (unsigned)(row * 1024 + col0); float ss = 0.f;
#pragma unroll
                for (int bj = 0; bj < 2; ++bj)
#pragma unroll
                    for (int n = 0; n < 2; ++n) { const unsigned o = off + bj * HALF + n * 16; f32x4 v;
                        if (MODE == 0) v = *(const f32x4*)(base + o);
                        else { const u32x2 w = *(const u32x2*)(xb + o); v = (f32x4){__builtin_bit_cast(float, w.x << 16), __builtin_bit_cast(float, w.x & 0xffff0000u), __builtin_bit_cast(float, w.y << 16), __builtin_bit_cast(float, w.y & 0xffff0000u)}; }
                        v = v + acc[ai][bj][m][n] * scale;
                        if (MODE == 2) *(f32x4*)(out + o) = v;
                        else { u32x2 w; w.x = cvt_pk_bf16(v[0], v[1]); w.y = cvt_pk_bf16(v[2], v[3]); *(u32x2*)(xb + o) = w; ss += (v[0] * v[0] + v[1] * v[1]) + (v[2] * v[2] + v[3] * v[3]); } }
                if (MODE != 2) { ss += __shfl_xor(ss, 16); ss += __shfl_xor(ss, 32); if (fq == 0) __hip_atomic_fetch_add(rowsq + row, ss, __ATOMIC_RELAXED, __HIP_MEMORY_SCOPE_AGENT); }
                asm volatile("" ::: "memory"); }
    }
};
struct EpiWin {
    static constexpr bool PERM = false, AFTER_DRAIN = false; static constexpr int SCALE = 1;
    bf16_t *Q, *K, *QT, *KT, *G; float *DM, *DE; const float *rowsq, *gq, *gk, *lb; const PG8_LAS float* scl;
    __device__ __forceinline__ void operator()(f32x4 (&acc)[2][2][4][2], const Unit& u, int wr, int wc, int fr, int fq) const {
        const int row0 = u.pm * BM + wr * 64 + fr, t = u.pn; const PG8_LAS float* slot = scl + u.par * 256 + wr * 64 + fr;
        if (t < 4) {
            const bool isq = t < 2; const int head = 4 * (t & 1) + wc; const float* gp = isq ? gq : gk; const float gs = isq ? QSCALE : 1.0f;
            f32x4 gv[2][2];
#pragma unroll
            for (int bj = 0; bj < 2; ++bj)
#pragma unroll
                for (int n = 0; n < 2; ++n) gv[bj][n] = *(const f32x4*)(gp + 32 * bj + 8 * fq + 4 * n) * gs;
            bf16_t* dst = (isq ? Q : K) + (head * 32 * 8) * 512 + (fq >> 1) * 512 + (fq & 1) * 256;
#pragma unroll
            for (int ai = 0; ai < 2; ++ai)
#pragma unroll
                for (int m = 0; m < 4; ++m) { const int row = row0 + ai * HALF + m * 16; const float r = rowscale(rowsq, slot, ai * HALF + m * 16); float ss = 0.f;
#pragma unroll
                    for (int bj = 0; bj < 2; ++bj)
#pragma unroll
                        for (int n = 0; n < 2; ++n) { const f32x4 v = acc[ai][bj][m][n] * r; acc[ai][bj][m][n] = v; ss += (v[0] * v[0] + v[1] * v[1]) + (v[2] * v[2] + v[3] * v[3]); }
                    ss += __shfl_xor(ss, 16); ss += __shfl_xor(ss, 32);
                    const float inv = __builtin_amdgcn_rsqf(ss * (1.0f / 64.0f) + RMS_EPS);
                    const int tk = row & 2047, t5 = tk & 31, r32 = isq ? t5 : ((t5 & 0x13) | ((t5 & 4) << 1) | ((t5 & 8) >> 1));
                    const unsigned o = (unsigned)((((row >> 11) * 8 * 32 + (tk >> 6)) * 2 + ((tk >> 5) & 1)) * 4 * 512 + r32 * 8);
#pragma unroll
                    for (int bj = 0; bj < 2; ++bj) *(u32x4*)(dst + o + (unsigned)(2 * bj * 512)) = pack8(acc[ai][bj][m][0] * inv * gv[bj][0], acc[ai][bj][m][1] * inv * gv[bj][1]); }
        } else if (t < 8) {
            const int hh = t - 4, kbase = hh * 128 + wc * 32 + 8 * fq;
            float lbv[8]; { const f32x4 l0 = *(const f32x4*)(lb + kbase), l1 = *(const f32x4*)(lb + kbase + 4);
#pragma unroll
                for (int c = 0; c < 4; ++c) { lbv[c] = l0[c]; lbv[4 + c] = l1[c]; } }
            const int lane = fq * 16 + fr;
#pragma unroll
            for (int ai = 0; ai < 2; ++ai)
#pragma unroll
                for (int n = 0; n < 2; ++n) {
                    float omf[4][4], carry[4], bmid[4];
#pragma unroll
                    for (int m = 0; m < 4; ++m) { const float r = rowscale(rowsq, slot, ai * HALF + m * 16);
#pragma unroll
                        for (int c = 0; c < 4; ++c) { const int e = 4 * n + c; const float a = acc[ai][0][m][n][c] * r, b = acc[ai][1][m][n][c] * r;
                            const float sg = fsigmoid(b), f = lbv[e] + (1.0f - lbv[e]) * sg; omf[m][c] = (1.0f - lbv[e]) * (1.0f - sg);
                            acc[ai][1][m][n][c] = __builtin_amdgcn_logf(f);
                            acc[ai][0][m][n][c] = fsilu(a); } }
#pragma unroll
                    for (int c = 0; c < 4; ++c) { carry[c] = 0.f; bmid[c] = 0.f; }
#pragma unroll
                    for (int m = 0; m < 4; ++m)
#pragma unroll
                        for (int c = 0; c < 4; ++c) { float x = row_scan16(acc[ai][1][m][n][c]) + carry[c]; acc[ai][1][m][n][c] = x;
                            carry[c] = __shfl(x, lane | 15); if (m == 1) bmid[c] = carry[c]; }
#pragma unroll
                    for (int m = 0; m < 4; ++m) { const int row = row0 + ai * HALF + m * 16; f32x4 qv, kv;
#pragma unroll
                        for (int c = 0; c < 4; ++c) { const float d = acc[ai][1][m][n][c] - bmid[c];
                            qv[c] = acc[ai][0][m][n][c] * __builtin_amdgcn_exp2f(d); kv[c] = omf[m][c] * __builtin_amdgcn_exp2f(-d); }
                        const unsigned o = (unsigned)(row * 512 + kbase + 4 * n);
                        u32x2 w; w.x = cvt_pk_bf16(qv[0], qv[1]); w.y = cvt_pk_bf16(qv[2], qv[3]); *(u32x2*)(QT + o) = w;
                        w.x = cvt_pk_bf16(kv[0], kv[1]); w.y = cvt_pk_bf16(kv[2], kv[3]); *(u32x2*)(KT + o) = w; }
                    if (fr == 0) { const int chunk = (u.pm * BM + ai * HALF + wr * 64) >> 6; f32x4 a0, e0;
#pragma unroll
                        for (int c = 0; c < 4; ++c) { a0[c] = __builtin_amdgcn_exp2f(bmid[c]); e0[c] = __builtin_amdgcn_exp2f(carry[c] - bmid[c]); }
                        *(f32x4*)(DM + (unsigned)(chunk * 512 + kbase + 4 * n)) = a0; *(f32x4*)(DE + (unsigned)(chunk * 512 + kbase + 4 * n)) = e0; }
                    asm volatile("" ::: "memory");
                }
        } else {
            bf16_t* dst = G + (t - 8) * 256 + wc * 32 + 8 * fq;
#pragma unroll
            for (int ai = 0; ai < 2; ++ai)
#pragma unroll
                for (int m = 0; m < 4; ++m) { const int row = row0 + ai * HALF + m * 16; const float r = rowscale(rowsq, slot, ai * HALF + m * 16);
#pragma unroll
                    for (int bj = 0; bj < 2; ++bj) *(u32x4*)(dst + (unsigned)(row * 512 + bj * HALF)) = pack8(silu4(acc[ai][bj][m][0] * r), silu4(acc[ai][bj][m][1] * r)); }
        }
    }
};
struct EpiVT {
    static constexpr bool PERM = true, AFTER_DRAIN = false; static constexpr int SCALE = 2;
    bf16_t *VT, *VHT; const float* rowsq; const PG8_LAS float* scl;
    __device__ __forceinline__ void operator()(f32x4 (&acc)[2][2][4][2], const Unit& u, int wr, int wc, int fr, int fq) const {
        const int ch0 = (u.pm & 1) * BM + wr * 64 + fr, tok0 = u.pn * BM + wc * 32 + 8 * fq, b = tok0 >> 11, s0 = tok0 & 2047;
        f32x4 rs[2][2];
#pragma unroll
        for (int bj = 0; bj < 2; ++bj)
#pragma unroll
            for (int n = 0; n < 2; ++n) { const f32x4 q = *(const PG8_LAS f32x4*)(scl + u.par * 256 + wc * 32 + 8 * fq + bj * HALF + 4 * n);
#pragma unroll
                for (int c = 0; c < 4; ++c) rs[bj][n][c] = __builtin_amdgcn_rsqf(q[c] * (1.0f / 1024.0f) + RMS_EPS); }
        if (u.pm < 2) {
#pragma unroll
            for (int ai = 0; ai < 2; ++ai)
#pragma unroll
                for (int m = 0; m < 4; ++m) { const int ch = ch0 + ai * HALF + m * 16;
#pragma unroll
                    for (int bj = 0; bj < 2; ++bj) { const int sk = s0 + bj * HALF;
                        const unsigned o = (unsigned)((((((b * 8 + (ch >> 6)) * 32 + (sk >> 6)) * 2 + ((ch >> 5) & 1)) * 4 + ((sk >> 4) & 3)) * 64 + ((sk >> 3) & 1) * 32 + (ch & 31)) * 8);
                        *(u32x4*)(VT + o) = pack8(acc[ai][bj][m][0] * rs[bj][0], acc[ai][bj][m][1] * rs[bj][1]); } }
        } else {
            bf16_t* dst = VHT + (size_t)b * 512 * 2048 + s0;
#pragma unroll
            for (int ai = 0; ai < 2; ++ai)
#pragma unroll
                for (int m = 0; m < 4; ++m) { const int ch = ch0 + ai * HALF + m * 16;
#pragma unroll
                    for (int bj = 0; bj < 2; ++bj) *(u32x4*)(dst + (unsigned)(ch * 2048 + bj * HALF)) = pack8(acc[ai][bj][m][0] * rs[bj][0], acc[ai][bj][m][1] * rs[bj][1]); }
        }
    }
};

template <class Epi, class Sched, bool ALIGN_EPI = false, bool SP2 = false>
__device__ __forceinline__ void gemm_phase(PG8_LAS unsigned char* lds, const Gemm g, const Sched& S, const Epi& E) {
    const int tid = threadIdx.x, wid = __builtin_amdgcn_readfirstlane(tid >> 6), lane = tid & 63, wr = wid >> 2, wc = wid & 3, fr = lane & 15, fq = lane >> 4;
    const int K = g.K, nt = K / BK;
    unsigned voffA[2], voffB[2];
#pragma unroll
    for (int i = 0; i < 2; ++i) { int R, C; stage_rc(tid * 16 + i * 8192, R, C); const int Rb = Epi::PERM ? ((R & ~31) + perm32(R & 31)) : R;
        voffA[i] = (unsigned)(R * K + C) * 2u; voffB[i] = (unsigned)(Rb * K + C) * 2u; }
    const size_t kstep = (size_t)(BK * 2);
    const size_t hstep = (size_t)HALF * K * 2;
    const size_t tstep = 2 * hstep;
    const unsigned ldsw = (unsigned)wid * 1024u;
    const int aoff = lds_byte(wr * 64 + fr, fq * 8), boff = lds_byte(wc * 32 + fr, fq * 8);
#define PG8_SA(b, h) (((b) * 2 + (h)) * HTB)
#define PG8_SB(b, h) ((4 + (b) * 2 + (h)) * HTB)
#define PG8_STAGE(bufoff, gbase, voff) do { _Pragma("unroll") for (int _i = 0; _i < 2; ++_i) \
        __builtin_amdgcn_global_load_lds((const unsigned*)((const char*)(gbase) + (voff)[_i]), (PG8_LAS unsigned*)(lds + (bufoff) + ldsw + _i * 8192), 16, 0, 0); } while (0)
#define PG8_LDA(dst, b, h) do { _Pragma("unroll") for (int m = 0; m < 4; ++m) _Pragma("unroll") for (int k = 0; k < 2; ++k) dst[m][k] = *(const PG8_LAS bf16x8*)(lds + PG8_SA(b, h) + aoff + m * 2048 + k * 1024); } while (0)
#define PG8_LDB(dst, b, h) do { _Pragma("unroll") for (int n = 0; n < 2; ++n) _Pragma("unroll") for (int k = 0; k < 2; ++k) dst[n][k] = *(const PG8_LAS bf16x8*)(lds + PG8_SB(b, h) + boff + n * 2048 + k * 1024); } while (0)
#define PG8_MMA(ai, bj, At, Bt) do { __builtin_amdgcn_s_setprio(1); _Pragma("unroll") for (int m = 0; m < 4; ++m) _Pragma("unroll") for (int n = 0; n < 2; ++n) _Pragma("unroll") for (int k = 0; k < 2; ++k) \
        acc[ai][bj][m][n] = __builtin_amdgcn_mfma_f32_16x16x32_bf16(Bt[n][k], At[m][k], acc[ai][bj][m][n], 0, 0, 0); __builtin_amdgcn_s_setprio(0); } while (0)
#define PG8_WAIT_V(n) asm volatile("s_waitcnt vmcnt(" #n ")" ::: "memory")
#define PG8_WAIT_L(n) asm volatile("s_waitcnt lgkmcnt(" #n ")" ::: "memory")
#define PG8_BAR __builtin_amdgcn_s_barrier()
#define PG8_SCHED __builtin_amdgcn_sched_barrier(0)
    Unit cur, nxt; int ui = 0;
    if (!S.next(0, cur)) return;
    cur.par = 0;
#define PG8_SCALE_DMA(u_) do { if (Epi::SCALE != 0 && wid == 0 && E.rowsq != nullptr) \
        __builtin_amdgcn_global_load_lds((const unsigned*)(E.rowsq + ((Epi::SCALE == 1 ? (u_).pm : (u_).pn) * BM + lane * 4)), (PG8_LAS unsigned*)(lds + STAGE_BYTES + (u_).par * 1024), 16, 0, 0); } while (0)
    PG8_SCALE_DMA(cur);
    f32x4 acc[2][2][4][2];
#pragma unroll
    for (int a = 0; a < 2; ++a)
#pragma unroll
        for (int b = 0; b < 2; ++b)
#pragma unroll
            for (int m = 0; m < 4; ++m)
#pragma unroll
                for (int n = 0; n < 2; ++n) acc[a][b][m][n] = (f32x4){0.f, 0.f, 0.f, 0.f};
    bf16x8 At[4][2], B0[2][2], B1[2][2];
    const char* cA = (const char*)g.A + (size_t)cur.pm * tstep; const char* cB = (const char*)g.Bt + (size_t)cur.pn * tstep;
    S.a_ready(cur);
    if constexpr (SP2) {
        PG8_STAGE(PG8_SB(0, 0), cB, voffB); PG8_STAGE(PG8_SB(0, 1), cB + hstep, voffB); PG8_STAGE(PG8_SA(0, 0), cA, voffA); PG8_STAGE(PG8_SA(0, 1), cA + hstep, voffA);
        if (wr == 1) PG8_BAR;
        PG8_WAIT_V(2); PG8_BAR;
        PG8_STAGE(PG8_SB(1, 0), cB + kstep, voffB); PG8_STAGE(PG8_SA(1, 0), cA + kstep, voffA); PG8_STAGE(PG8_SB(1, 1), cB + hstep + kstep, voffB);
        PG8_WAIT_V(6); PG8_BAR;
    } else {
        PG8_STAGE(PG8_SB(0, 0), cB, voffB); PG8_STAGE(PG8_SA(0, 0), cA, voffA); PG8_STAGE(PG8_SB(0, 1), cB + hstep, voffB); PG8_STAGE(PG8_SA(0, 1), cA + hstep, voffA);
        if (wr == 1) PG8_BAR;
        PG8_WAIT_V(4); PG8_BAR;
        PG8_STAGE(PG8_SB(1, 0), cB + kstep, voffB); PG8_STAGE(PG8_SA(1, 0), cA + kstep, voffA); PG8_STAGE(PG8_SB(1, 1), cB + hstep + kstep, voffB);
        PG8_WAIT_V(6); PG8_BAR;
    }
    for (;;) {
        const bool has_next = S.next(ui + 1, nxt); nxt.par = (ui + 1) & 1;
        const char* nA = has_next ? (const char*)g.A + (size_t)nxt.pm * tstep : cA; const char* nB = has_next ? (const char*)g.Bt + (size_t)nxt.pn * tstep : cB;
        for (int t = 0; t < nt; t += 2) {
            const bool last = (t == nt - 2);
            const char* a1 = cA + (size_t)(t + 1) * kstep;
            const char* a2 = last ? nA : cA + (size_t)(t + 2) * kstep; const char* b2 = last ? nB : cB + (size_t)(t + 2) * kstep;
            const char* a3 = a2 + kstep; const char* b3 = b2 + kstep;
            if (last && has_next) { S.a_ready(nxt); PG8_SCALE_DMA(nxt); }
            if constexpr (SP2) {
            PG8_LDB(B0, 0, 0); PG8_LDB(B1, 0, 1); PG8_SCHED; PG8_LDA(At, 0, 0); PG8_STAGE(PG8_SA(1, 1), a1 + hstep, voffA);
            PG8_WAIT_V(8); PG8_WAIT_L(0); PG8_BAR; PG8_MMA(0, 0, At, B0); PG8_MMA(0, 1, At, B1); PG8_BAR; PG8_SCHED;
            PG8_LDA(At, 0, 1); PG8_STAGE(PG8_SB(0, 0), b2, voffB); PG8_STAGE(PG8_SB(0, 1), b2 + hstep, voffB); PG8_STAGE(PG8_SA(0, 0), a2, voffA);
            PG8_WAIT_V(8); PG8_WAIT_L(0); PG8_BAR; PG8_MMA(1, 0, At, B0); PG8_MMA(1, 1, At, B1); PG8_BAR; PG8_SCHED;
            PG8_LDB(B0, 1, 0); PG8_LDB(B1, 1, 1); PG8_SCHED; PG8_LDA(At, 1, 0); PG8_STAGE(PG8_SA(0, 1), a2 + hstep, voffA);
            PG8_WAIT_V(8); PG8_WAIT_L(0); PG8_BAR; PG8_MMA(0, 0, At, B0); PG8_MMA(0, 1, At, B1); PG8_BAR; PG8_SCHED;
            PG8_LDA(At, 1, 1); PG8_STAGE(PG8_SB(1, 0), b3, voffB); PG8_STAGE(PG8_SB(1, 1), b3 + hstep, voffB); PG8_STAGE(PG8_SA(1, 0), a3, voffA);
            PG8_WAIT_V(8); PG8_WAIT_L(0); PG8_BAR; PG8_MMA(1, 0, At, B0); PG8_MMA(1, 1, At, B1); PG8_BAR; PG8_SCHED;
            } else {
            PG8_LDB(B0, 0, 0); PG8_SCHED; PG8_LDA(At, 0, 0); PG8_STAGE(PG8_SA(1, 1), a1 + hstep, voffA);
            PG8_WAIT_L(8); PG8_BAR; PG8_WAIT_L(0); PG8_MMA(0, 0, At, B0); PG8_BAR; PG8_SCHED;
            PG8_LDB(B1, 0, 1); PG8_STAGE(PG8_SB(0, 0), b2, voffB);
            PG8_BAR; PG8_WAIT_L(0); PG8_MMA(0, 1, At, B1); PG8_BAR;
            PG8_LDA(At, 0, 1); PG8_STAGE(PG8_SA(0, 0), a2, voffA);
            PG8_BAR; PG8_WAIT_L(0); PG8_MMA(1, 0, At, B0); PG8_BAR; PG8_SCHED;
            PG8_STAGE(PG8_SB(0, 1), b2 + hstep, voffB);
            PG8_WAIT_V(6); PG8_BAR; PG8_MMA(1, 1, At, B1); PG8_BAR;
            PG8_LDB(B0, 1, 0); PG8_SCHED; PG8_LDA(At, 1, 0); PG8_STAGE(PG8_SA(0, 1), a2 + hstep, voffA);
            PG8_WAIT_L(8); PG8_BAR; PG8_WAIT_L(0); PG8_MMA(0, 0, At, B0); PG8_BAR; PG8_SCHED;
            PG8_LDB(B1, 1, 1); PG8_STAGE(PG8_SB(1, 0), b3, voffB);
            PG8_BAR; PG8_WAIT_L(0); PG8_MMA(0, 1, At, B1); PG8_BAR;
            PG8_LDA(At, 1, 1); PG8_STAGE(PG8_SA(1, 0), a3, voffA);
            PG8_BAR; PG8_WAIT_L(0); PG8_MMA(1, 0, At, B0); PG8_BAR; PG8_SCHED;
            PG8_STAGE(PG8_SB(1, 1), b3 + hstep, voffB);
            PG8_WAIT_V(6); PG8_BAR; PG8_MMA(1, 1, At, B1); PG8_BAR;
            }
        }
        if constexpr (ALIGN_EPI) { if (wr == 0) PG8_BAR; }
        if constexpr (!Epi::AFTER_DRAIN) { E(acc, cur, wr, wc, fr, fq); S.done(cur); }
        if (!has_next) break;
#pragma unroll
        for (int a = 0; a < 2; ++a)
#pragma unroll
            for (int b = 0; b < 2; ++b)
#pragma unroll
                for (int m = 0; m < 4; ++m)
#pragma unroll
                    for (int n = 0; n < 2; ++n) acc[a][b][m][n] = (f32x4){0.f, 0.f, 0.f, 0.f};
        cur = nxt; cA = nA; cB = nB; ++ui;
        if constexpr (ALIGN_EPI) { if (wr == 1) PG8_BAR; }
    }
    PG8_WAIT_V(0);
    if constexpr (!ALIGN_EPI) { if (wr == 0) PG8_BAR; }
    PG8_BAR;
    if constexpr (Epi::AFTER_DRAIN) { E.fused(acc, cur, wr, wc, fr, fq, lds, wid, lane); S.done(cur); }
#undef PG8_SCALE_DMA
#undef PG8_SA
#undef PG8_SB
#undef PG8_STAGE
#undef PG8_LDA
#undef PG8_LDB
#undef PG8_MMA
#undef PG8_WAIT_V
#undef PG8_WAIT_L
#undef PG8_BAR
#undef PG8_SCHED
}
}

constexpr int NWAVES = 8;
#ifndef MK_N_LAUNCHES
#define MK_N_LAUNCHES 1
#endif
constexpr int PER_PHASE = 8;
constexpr int N_LAUNCHES = MK_N_LAUNCHES;
constexpr int BATCH = 16, SEQ = 2048, D = 1024, M = BATCH * SEQ, FF = 2816, NPROJ = 3584;
constexpr int AW = 512, HW = 512, NCHUNK = SEQ / 64;
constexpr float RMS_EPS = 1e-6f, LOG2E = 1.4426950408889634f;
#ifndef WGM_GU
#define WGM_GU 4
#endif
#ifndef WGM_DOWN
#define WGM_DOWN 4
#endif
#ifndef WGM_OUT
#define WGM_OUT 4
#endif
#ifndef WGM_IN
#define WGM_IN 4
#endif
#ifndef WGM_INT
#define WGM_INT 4
#endif

constexpr size_t MiB = 1u << 20;
constexpr size_t WS_CTL = 0, CTL_ZERO_BYTES = 1 * MiB;
constexpr size_t WS_RS1 = 256 * 1024, WS_RS2 = 384 * 1024;
constexpr size_t WS_LB = 1 * MiB, WS_DM = 2 * MiB, WS_DE = 3 * MiB;
constexpr size_t WS_WGU1 = 4 * MiB, WS_WD1 = 15 * MiB, WS_WIN = 21 * MiB, WS_WINT = 26 * MiB, WS_WOUT = 28 * MiB, WS_WGU2 = 30 * MiB, WS_WD2 = 41 * MiB;
constexpr size_t WS_XB = 48 * MiB;
constexpr size_t WS_MIX = 112 * MiB;
constexpr size_t WS_HID = 176 * MiB;
constexpr size_t WS_Q = 176 * MiB, WS_K = 208 * MiB, WS_VT = 240 * MiB, WS_QT = 272 * MiB, WS_KT = 304 * MiB, WS_VHT = 336 * MiB, WS_G = 368 * MiB, WS_END = 400 * MiB;
static_assert(WS_WGU1 + (size_t)2 * FF * D * 2 <= WS_WD1 && WS_WD1 + (size_t)D * FF * 2 <= WS_WIN && WS_WIN + (size_t)2560 * D * 2 <= WS_WINT && WS_WGU2 + (size_t)2 * FF * D * 2 <= WS_WD2 && WS_WD2 + (size_t)D * FF * 2 <= WS_XB, "weight map");
static_assert(WS_HID + (size_t)M * FF * 2 <= WS_END && WS_XB + (size_t)M * D * 2 <= WS_MIX && WS_MIX + (size_t)M * D * 2 <= WS_HID, "activation map");
constexpr int CW_TMO = 0, CW_CODE = 1;
constexpr int CW_BAR = 4096;
constexpr int CW_WQ = 16384;

constexpr int RING_OFF = 0, RING_BYTES = 131072;
constexpr int LDS_BYTES = 163840;
constexpr int LDSCTL_OFF = LDS_BYTES - 1024, MISC_OFF = LDSCTL_OFF + 320;
static_assert(MISC_OFF + 128 <= LDS_BYTES, "LDS map");

#define GAS __attribute__((address_space(1)))
#define LAS __attribute__((address_space(3)))
typedef unsigned short bf16;
typedef unsigned v4u __attribute__((ext_vector_type(4)));
typedef float f32x4 __attribute__((ext_vector_type(4)));
typedef short bf16x8 __attribute__((ext_vector_type(8)));
typedef GAS unsigned gu32;
#define RLX_AGENT __ATOMIC_RELAXED, __HIP_MEMORY_SCOPE_AGENT
#define LDS_WAIT() asm volatile("s_waitcnt lgkmcnt(0)" ::: "memory")
#define VM_WAIT() asm volatile("s_waitcnt vmcnt(0)" ::: "memory")
__device__ __forceinline__ unsigned f2bf(float f) { unsigned u = __builtin_bit_cast(unsigned, f); return (u + 0x7fffu + ((u >> 16) & 1u)) >> 16; }
__device__ __forceinline__ unsigned pk2(float lo, float hi) { return f2bf(lo) | (f2bf(hi) << 16); }
__device__ __forceinline__ float bf2f(unsigned short h) { return __builtin_bit_cast(float, (unsigned)h << 16); }
__device__ __forceinline__ float bflo(unsigned w) { return __builtin_bit_cast(float, w << 16); }
__device__ __forceinline__ float bfhi(unsigned w) { return __builtin_bit_cast(float, w & 0xffff0000u); }

#define XB_TMO      128
#define XB_XCNT(j)  (256  + 64 * (j))
#define XB_XSUB(j)  (1280 + 64 * (j))
#define XB_XGEN(j)  (2304 + 64 * (j))
#define XB_TOP      3328
#define XB_TOPGEN   3392
#define XCD_BAR_WORDS 3456
#define XB_SPIN_CAP (1u << 18)

__device__ __forceinline__ unsigned xb_ld(unsigned* p)              { return __hip_atomic_load(p, __ATOMIC_RELAXED, __HIP_MEMORY_SCOPE_AGENT); }
__device__ __forceinline__ unsigned xb_add(unsigned* p, unsigned v) { return __hip_atomic_fetch_add(p, v, __ATOMIC_RELAXED, __HIP_MEMORY_SCOPE_AGENT); }
__device__ __forceinline__ unsigned xb_xcc_id() { return (unsigned)__builtin_amdgcn_s_getreg((3 << 11) | 20) & 0xFu; }
#define XB_SPIN(cond, bar) do { unsigned _sp = 0; while (cond) { __builtin_amdgcn_s_sleep(1); \
    if ((++_sp & 255u) == 0u) { if (xb_ld(&(bar)[XB_TMO])) break; if (_sp > XB_SPIN_CAP) { atomicAdd(&(bar)[XB_TMO], 1u); break; } } } } while (0)

struct XcdBarrier {
    unsigned* bar; unsigned x;
    volatile LAS unsigned* st;
};

__device__ __forceinline__ XcdBarrier xcd_barrier_post(unsigned* bar, volatile LAS unsigned* st) {
    XcdBarrier b; b.bar = bar; b.x = xb_xcc_id(); b.st = st;
    if (threadIdx.x == 0) (void)xb_add(&bar[XB_XCNT(b.x)], 1u);
    return b;
}
__device__ __forceinline__ void xcd_barrier_complete(unsigned* bar, unsigned x, unsigned& nloc, unsigned& nx) {
    const unsigned G = gridDim.x * gridDim.y * gridDim.z;
    unsigned sum, cnt, mine, sp = 0u;
    for (;;) {
        sum = 0u; cnt = 0u; mine = 0u;
#pragma unroll
        for (unsigned j = 0; j < 16; ++j) { const unsigned c = xb_ld(&bar[XB_XCNT(j)]); sum += c; cnt += (c > 0u) ? 1u : 0u; mine = (j == x) ? c : mine; }
        if (sum == G) break;
        __builtin_amdgcn_s_sleep(1);
        if ((++sp & 255u) == 0u) { if (xb_ld(&bar[XB_TMO])) break; if (sp > XB_SPIN_CAP) { atomicAdd(&bar[XB_TMO], 1u); break; } }
    }
    nloc = mine > 0u ? mine : 1u; nx = cnt > 0u ? cnt : 1u;
}

__device__ __forceinline__ void xcd_barrier(const XcdBarrier& b) {
    asm volatile("s_waitcnt vmcnt(0)" ::: "memory");
    __syncthreads();
    if (threadIdx.x == 0) {
        unsigned* bar = b.bar;
        __builtin_amdgcn_s_waitcnt(0);
        unsigned nloc = b.st[0], nx = b.st[1];
        if (nloc == 0u) { xcd_barrier_complete(bar, b.x, nloc, nx); b.st[0] = nloc; b.st[1] = nx; }
        const unsigned old = xb_add(&bar[XB_XSUB(b.x)], 1u);
        const unsigned gen = old / nloc;
        if (old + 1u == (gen + 1u) * nloc) {
            __builtin_amdgcn_fence(__ATOMIC_RELEASE, "agent");
            asm volatile("s_waitcnt vmcnt(0)" ::: "memory");
            const unsigned og = xb_add(&bar[XB_TOP], 1u);
            const unsigned tg = og / nx;
            if (og + 1u == (tg + 1u) * nx) xb_add(&bar[XB_TOPGEN], 1u);
            else XB_SPIN(xb_ld(&bar[XB_TOPGEN]) == tg, bar);
            __builtin_amdgcn_fence(__ATOMIC_ACQUIRE, "agent");
            xb_add(&bar[XB_XGEN(b.x)], 1u);
            asm volatile("s_waitcnt vmcnt(0)" ::: "memory");
        } else {
            XB_SPIN(xb_ld(&bar[XB_XGEN(b.x)]) == gen, bar);
            __builtin_amdgcn_fence(__ATOMIC_ACQUIRE, "agent");
            asm volatile("s_waitcnt vmcnt(0)" ::: "memory");
        }
    }
    __syncthreads();
}

struct Frame {
    LAS unsigned char* lds;
    volatile LAS unsigned* MISC;
    gu32* ctl;
    int tid, lane, wave, G;
    const float* in[17]; float* out; unsigned char* ws;
};
__device__ __forceinline__ float wave_sum(float v) {
#pragma unroll
    for (int o = 1; o < 64; o <<= 1) v += __shfl_xor(v, o);
    return v;
}
__device__ __forceinline__ int srccol(int kind, int R, int& sel) {
    sel = 0;
    if (kind == 0) return R;
    const int t = R >> 8, p = R & 255, bj = p >> 7, q = p & 127, wc = q >> 5, pr = pg8::perm32(q & 31);
    if (kind == 1) { sel = bj; return 128 * t + 32 * wc + pr; }
    if (kind == 2) {
        if (t < 2) return 64 * (4 * t + wc) + 32 * bj + pr;
        if (t < 4) return 512 + 64 * (4 * (t - 2) + wc) + 32 * bj + pr;
        if (t < 8) return (bj ? 2048 : 1536) + 128 * (t - 4) + 32 * wc + pr;
        return 3072 + 256 * (t - 8) + 128 * bj + 32 * wc + pr;
    }
    return R < 512 ? 1024 + R : 2560 + (R - 512);
}
struct P0Blk { f32x4 v[8]; };
__device__ __forceinline__ void p0_load(P0Blk& t, const float* W0, const float* W1, int N, int kind, int item, int nblk, int lane) {
    const int kb = item / nblk, nb = item % nblk, k0 = 64 * kb + 8 * (lane >> 3), R = 32 * nb + 4 * (lane & 7);
    int sel; const int c = srccol(kind, R, sel);
    const float* W = (sel ? W1 : W0) + (size_t)k0 * N + c;
#pragma unroll
    for (int i = 0; i < 8; ++i) t.v[i] = *(const f32x4*)(W + (size_t)i * N);
}
__device__ __forceinline__ void p0_store(const P0Blk& t, int K, bf16* WT, const float* gain, int kind, int item, int nblk, int lane) {
    const int kb = item / nblk, nb = item % nblk, k0 = 64 * kb + 8 * (lane >> 3), R = 32 * nb + 4 * (lane & 7);
    float gk[8];
    const float ws = kind == 1 ? (((R >> 7) & 1) ? 1.0f / LOG2E : LOG2E) : 1.0f;
#pragma unroll
    for (int i = 0; i < 8; ++i) gk[i] = ws;
    if (gain) { const f32x4 g0 = *(const f32x4*)(gain + k0), g1 = *(const f32x4*)(gain + k0 + 4);
#pragma unroll
        for (int i = 0; i < 4; ++i) { gk[i] = g0[i] * ws; gk[4 + i] = g1[i] * ws; } }
#pragma unroll
    for (int j = 0; j < 4; ++j) { v4u o; o.x = pk2(t.v[0][j] * gk[0], t.v[1][j] * gk[1]); o.y = pk2(t.v[2][j] * gk[2], t.v[3][j] * gk[3]); o.z = pk2(t.v[4][j] * gk[4], t.v[5][j] * gk[5]); o.w = pk2(t.v[6][j] * gk[6], t.v[7][j] * gk[7]);
        *(GAS v4u*)(WT + (size_t)(R + j) * K + k0) = o; }
}
struct P0Job { const float* W0; const float* W1; const float* gain; bf16* WT; int K, N, kind, nblk, item; };
__device__ __forceinline__ P0Job p0_job(Frame& F, int it) {
    constexpr int I_GU = (D / 64) * (2 * FF / 32), I_D = (FF / 64) * (D / 32), I_IN = (D / 64) * (2560 / 32), I_INT = (D / 64) * (1024 / 32);
    int r = it;
    if (r < I_GU) return P0Job{F.in[2], F.in[3], nullptr, (bf16*)(F.ws + WS_WGU1), D, FF, 1, 2 * FF / 32, r}; r -= I_GU;
    if (r < I_GU) return P0Job{F.in[14], F.in[15], F.in[13], (bf16*)(F.ws + WS_WGU2), D, FF, 1, 2 * FF / 32, r}; r -= I_GU;
    if (r < I_D) return P0Job{F.in[4], F.in[4], nullptr, (bf16*)(F.ws + WS_WD1), FF, D, 0, D / 32, r}; r -= I_D;
    if (r < I_D) return P0Job{F.in[16], F.in[16], nullptr, (bf16*)(F.ws + WS_WD2), FF, D, 0, D / 32, r}; r -= I_D;
    if (r < I_IN) return P0Job{F.in[6], F.in[6], F.in[5], (bf16*)(F.ws + WS_WIN), D, NPROJ, 2, 2560 / 32, r}; r -= I_IN;
    if (r < I_INT) return P0Job{F.in[6], F.in[6], F.in[5], (bf16*)(F.ws + WS_WINT), D, NPROJ, 3, 1024 / 32, r}; r -= I_INT;
    return P0Job{F.in[12], F.in[12], nullptr, (bf16*)(F.ws + WS_WOUT), D, D, 0, D / 32, r};
}
__device__ __forceinline__ void rms_rows4_to_bf16(const float* x, const float* g, bf16* o, int lane) {
    f32x4 v[4][4]; float s[4];
#pragma unroll
    for (int r = 0; r < 4; ++r)
#pragma unroll
        for (int j = 0; j < 4; ++j) v[r][j] = *((const GAS f32x4*)(x + (size_t)r * D) + lane + 64 * j);
#pragma unroll
    for (int r = 0; r < 4; ++r) { s[r] = 0.f;
#pragma unroll
        for (int j = 0; j < 4; ++j) s[r] += (v[r][j].x * v[r][j].x + v[r][j].y * v[r][j].y) + (v[r][j].z * v[r][j].z + v[r][j].w * v[r][j].w); }
#pragma unroll
    for (int of = 1; of < 64; of <<= 1) {
#pragma unroll
        for (int r = 0; r < 4; ++r) s[r] += __shfl_xor(s[r], of); }
    f32x4 gg[4];
#pragma unroll
    for (int j = 0; j < 4; ++j) gg[j] = *((const GAS f32x4*)g + lane + 64 * j);
#pragma unroll
    for (int r = 0; r < 4; ++r) { const float rr = __builtin_amdgcn_rsqf(s[r] * (1.f / D) + RMS_EPS);
        GAS unsigned long long* o8 = (GAS unsigned long long*)(o + (size_t)r * D) + lane;
#pragma unroll
        for (int j = 0; j < 4; ++j) o8[64 * j] = (unsigned long long)pk2(v[r][j].x * rr * gg[j].x, v[r][j].y * rr * gg[j].y) | ((unsigned long long)pk2(v[r][j].z * rr * gg[j].z, v[r][j].w * rr * gg[j].w) << 32); }
}
__device__ __forceinline__ void p0_prologue(Frame& F, unsigned long long& p0_probe) {
    const int gw = (int)blockIdx.x * NWAVES + F.wave, NGW = F.G * NWAVES;
#if defined(PROBE_PHASE) && (PROBE_PHASE == 13 || PROBE_PHASE == 14)
    const unsigned long long p0_t0 = __builtin_amdgcn_s_memrealtime();
#endif
    constexpr int I_GU = (D / 64) * (2 * FF / 32), I_D = (FF / 64) * (D / 32), I_IN = (D / 64) * (2560 / 32), I_INT = (D / 64) * (1024 / 32), I_O = (D / 64) * (D / 32);
    constexpr int NITEMS = 2 * I_GU + 2 * I_D + I_IN + I_INT + I_O;
    int it = gw;
    if (it < NITEMS) {
        P0Job j0 = p0_job(F, it); P0Blk t0; p0_load(t0, j0.W0, j0.W1, j0.N, j0.kind, j0.item, j0.nblk, F.lane);
        for (;;) {
            const int it1 = it + NGW; const bool more = it1 < NITEMS;
            P0Job j1 = j0; P0Blk t1;
            if (more) { j1 = p0_job(F, it1); p0_load(t1, j1.W0, j1.W1, j1.N, j1.kind, j1.item, j1.nblk, F.lane); }
            p0_store(t0, j0.K, j0.WT, j0.gain, j0.kind, j0.item, j0.nblk, F.lane);
            if (!more) break;
            it = it1; j0 = j1;
#pragma unroll
            for (int i = 0; i < 8; ++i) t0.v[i] = t1.v[i];
        }
    }
#if defined(PROBE_PHASE) && (PROBE_PHASE == 13 || PROBE_PHASE == 14)
    const unsigned long long tp1_ = __builtin_amdgcn_s_memrealtime();
    if (PROBE_PHASE == 13) p0_probe = tp1_ - p0_t0;
#endif
    for (int m = 4 * gw; m < M; m += 4 * NGW) rms_rows4_to_bf16(F.in[0] + (size_t)m * D, F.in[1], (bf16*)(F.ws + WS_XB) + (size_t)m * D, F.lane);
#if defined(PROBE_PHASE) && (PROBE_PHASE == 13 || PROBE_PHASE == 14)
    if (PROBE_PHASE == 14) p0_probe = __builtin_amdgcn_s_memrealtime() - tp1_;
#endif
    if (blockIdx.x == 0) {
        const float l0 = F.in[10][F.tid], l1 = F.in[10][512 + F.tid], mx = fmaxf(l0, l1), e0 = __expf(l0 - mx), e1 = __expf(l1 - mx);
        ((float*)(F.ws + WS_LB))[F.tid] = e0 / (e0 + e1);
    }
}

typedef float f32x16 __attribute__((ext_vector_type(16)));
typedef float f32x2_t __attribute__((ext_vector_type(2))); typedef __bf16 bf16x2_t __attribute__((ext_vector_type(2)));
__device__ __forceinline__ unsigned cvtpk_s(float lo, float hi) { f32x2_t v = {lo, hi}; bf16x2_t b = __builtin_convertvector(v, bf16x2_t); return __builtin_bit_cast(unsigned, b); }
__device__ __forceinline__ bf16x8 pack_step(const f32x16& x, int s) { v4u p; p.x = cvtpk_s(x[8 * s], x[8 * s + 1]); p.y = cvtpk_s(x[8 * s + 2], x[8 * s + 3]); p.z = cvtpk_s(x[8 * s + 4], x[8 * s + 5]); p.w = cvtpk_s(x[8 * s + 6], x[8 * s + 7]); return __builtin_bit_cast(bf16x8, p); }
__device__ __forceinline__ float swapmax(float m) { auto rr = __builtin_amdgcn_permlane32_swap(__float_as_uint(m), __float_as_uint(m), false, false); return fmaxf(__uint_as_float(rr[0]), __uint_as_float(rr[1])); }
__device__ __forceinline__ float swapsum(float m) { auto rr = __builtin_amdgcn_permlane32_swap(__float_as_uint(m), __float_as_uint(m), false, false); return __uint_as_float(rr[0]) + __uint_as_float(rr[1]); }
__device__ __forceinline__ int pi32(int x) { return (x & 0x13) | ((x & 4) << 1) | ((x & 8) >> 1); }
#define MFMA32(a, b, c) __builtin_amdgcn_mfma_f32_32x32x16_bf16((a), (b), (c), 0, 0, 0)
constexpr int ATT_ETAB_OFF = 0;
__device__ __forceinline__ void attn_item(Frame& F, int b, int c, int h, const LAS float* etab) {
    const bf16* Q = (const bf16*)(F.ws + WS_Q); const bf16* Kp = (const bf16*)(F.ws + WS_K); const bf16* VT = (const bf16*)(F.ws + WS_VT); bf16* MIX = (bf16*)(F.ws + WS_MIX);
    const int lane = F.lane, r32 = lane & 31, hi = lane >> 5;
    const float cfar = F.in[9][h * 257 + 256] * LOG2E;
    bf16x8 qf[2][4];
#pragma unroll
    for (int qb = 0; qb < 2; ++qb)
#pragma unroll
        for (int d0 = 0; d0 < 4; ++d0) qf[qb][d0] = *(const bf16x8*)(Q + (unsigned)((((((b * 8 + h) * 32 + c) * 2 + qb) * 4 + d0) * 64 + lane) * 8));
    f32x16 o[2][2];
#pragma unroll
    for (int db = 0; db < 2; ++db)
#pragma unroll
        for (int qb = 0; qb < 2; ++qb)
#pragma unroll
            for (int r = 0; r < 16; ++r) o[db][qb][r] = 0.f;
    float mrun[2] = {-INFINITY, -INFINITY}, lrun[2] = {0.f, 0.f};
    const int kt0 = c >= 8 ? c - 8 : 0;
    const unsigned fbase = (unsigned)(((b * 8 + h) * 32 * 8 * 64 + lane) * 8);
    const LAS float* et = etab + h * 256;
    bf16x8 kf[2][4], vf[2][4];
#define AT_LOADK(kt_) do { _Pragma("unroll") for (int kb = 0; kb < 2; ++kb) _Pragma("unroll") for (int d0 = 0; d0 < 4; ++d0) kf[kb][d0] = *(const bf16x8*)(Kp + fbase + (unsigned)((((kt_) * 2 + kb) * 4 + d0) * 512)); } while (0)
#define AT_LOADV(kt_) do { _Pragma("unroll") for (int db = 0; db < 2; ++db) _Pragma("unroll") for (int ks = 0; ks < 4; ++ks) vf[db][ks] = *(const bf16x8*)(VT + fbase + (unsigned)((((kt_) * 2 + db) * 4 + ks) * 512)); } while (0)
    AT_LOADK(kt0); AT_LOADV(kt0);
    for (int kt = kt0; kt <= c; ++kt) {
        const int j = c - kt, ktn = kt < c ? kt + 1 : c;
#pragma unroll
        for (int qb = 0; qb < 2; ++qb) {
            f32x16 s[2]; bf16x8 pk[2][2];
            const float c0 = j >= 3 ? cfar : 0.f;
#pragma unroll
            for (int r = 0; r < 16; ++r) { s[0][r] = c0; s[1][r] = c0; }
#pragma unroll
            for (int d0 = 0; d0 < 4; ++d0) { s[0] = MFMA32(kf[0][d0], qf[qb][d0], s[0]); s[1] = MFMA32(kf[1][d0], qf[qb][d0], s[1]); }
            if (qb == 1) { __builtin_amdgcn_sched_barrier(0); AT_LOADK(ktn); __builtin_amdgcn_sched_barrier(0); }
            if (j < 3) {
                const int ib = 64 * j + 32 * qb + r32 - 8 * hi + 63;
#pragma unroll
                for (int kb = 0; kb < 2; ++kb)
#pragma unroll
                    for (int r = 0; r < 16; ++r) s[kb][r] += et[ib - 32 * kb - 16 * (r >> 3) - (r & 7)];
            }
            float tm = fmaxf(s[0][0], s[1][0]);
#pragma unroll
            for (int r = 1; r < 16; ++r) tm = fmaxf(tm, fmaxf(s[0][r], s[1][r]));
            tm = swapmax(tm);
            const float mn = fmaxf(mrun[qb], tm), alpha = __builtin_amdgcn_exp2f(mrun[qb] - mn); mrun[qb] = mn;
            float ls = 0.f;
#pragma unroll
            for (int kb = 0; kb < 2; ++kb)
#pragma unroll
                for (int r = 0; r < 16; ++r) { const float p = __builtin_amdgcn_exp2f(s[kb][r] - mn); s[kb][r] = p; ls += p; }
            lrun[qb] = lrun[qb] * alpha + ls;
#pragma unroll
            for (int db = 0; db < 2; ++db)
#pragma unroll
                for (int r = 0; r < 16; ++r) o[db][qb][r] *= alpha;
#pragma unroll
            for (int kb = 0; kb < 2; ++kb) { pk[kb][0] = pack_step(s[kb], 0); pk[kb][1] = pack_step(s[kb], 1); }
#pragma unroll
            for (int db = 0; db < 2; ++db)
#pragma unroll
                for (int kb = 0; kb < 2; ++kb)
#pragma unroll
                    for (int sp = 0; sp < 2; ++sp) o[db][qb] = MFMA32(vf[db][2 * kb + sp], pk[kb][sp], o[db][qb]);
        }
        __builtin_amdgcn_sched_barrier(0); AT_LOADV(ktn); __builtin_amdgcn_sched_barrier(0);
    }
#undef AT_LOADK
#undef AT_LOADV
#pragma unroll
    for (int qb = 0; qb < 2; ++qb) {
        const float inv = 1.0f / swapsum(lrun[qb]);
        bf16* orow = MIX + (unsigned)((b * SEQ + 64 * c + 32 * qb + r32) * 1024 + h * 64 + 16 * hi);
#pragma unroll
        for (int db = 0; db < 2; ++db) {
            unsigned wx[4], wy[4];
#pragma unroll
            for (int g = 0; g < 4; ++g) { wx[g] = cvtpk_s(o[db][qb][4 * g] * inv, o[db][qb][4 * g + 1] * inv); wy[g] = cvtpk_s(o[db][qb][4 * g + 2] * inv, o[db][qb][4 * g + 3] * inv); }
#pragma unroll
            for (int p = 0; p < 2; ++p) {
                auto ax = __builtin_amdgcn_permlane32_swap(wx[p], wx[p + 2], false, false); auto ay = __builtin_amdgcn_permlane32_swap(wy[p], wy[p + 2], false, false);
                *(v4u*)(orow + 32 * db + 8 * p) = (v4u){ax[0], ay[0], ax[1], ay[1]}; }
        }
    }
}
__device__ __forceinline__ void attn_phase(Frame& F) {
    LAS float* etab = (LAS float*)(F.lds + RING_OFF + ATT_ETAB_OFF);
    for (int i = F.tid; i < 8 * 256; i += NWAVES * 64) { const int h = i >> 8; int rel = (i & 255) - 63; rel = rel > 128 ? 128 : rel; etab[i] = F.in[9][h * 257 + rel + 128] * LOG2E; }
    __syncthreads();
    for (int k = 0; k < 8; ++k) {
        const int shard = ((int)blockIdx.x + k) & 7;
        gu32* head = F.ctl + CW_WQ + 64 * shard;
        for (;;) {
            unsigned n = 0; if (F.lane == 0) n = __hip_atomic_fetch_add(head, 1u, RLX_AGENT);
            n = (unsigned)__builtin_amdgcn_readfirstlane((int)n);
            if (n >= 512u) break;
            const int bh = 8 * (int)(n >> 5) + shard, c = 31 - (int)(n & 31);
            attn_item(F, bh >> 3, c, bh & 7, etab);
        }
    }
    __syncthreads();
}

__device__ __forceinline__ unsigned off_b(unsigned row, unsigned ch) { return 256u * row + 16u * (ch ^ (((row & 3) << 2) | ((row >> 2) & 3))); }
__device__ __forceinline__ unsigned tr_read_addr_b(unsigned lane, unsigned c, unsigned ks, unsigned t) {
    const unsigned h = lane >> 5, blk = (lane >> 4) & 1, q = (lane & 15) >> 2, p = lane & 3;
    return off_b(16 * ks + 8 * h + 4 * t + q, 4 * c + 2 * blk + (p >> 1)) + 8 * (p & 1);
}
typedef short v4i16_t __attribute__((ext_vector_type(4)));
__device__ __forceinline__ v4i16_t lds_tr(const LAS unsigned char* p) { return __builtin_amdgcn_ds_read_tr16_b64_v4i16((LAS v4i16_t*)p); }
__device__ __forceinline__ bf16x8 krow_frag(bf16x8 nat) {
    const v4u d = __builtin_bit_cast(v4u, nat);
    auto a = __builtin_amdgcn_permlane32_swap(d.x, d.z, false, false); auto b = __builtin_amdgcn_permlane32_swap(d.y, d.w, false, false);
    v4u r; r.x = a[0]; r.y = b[0]; r.z = a[1]; r.w = b[1]; return __builtin_bit_cast(bf16x8, r);
}
constexpr int HG_PS_OFF = 8192, HG_DD_OFF = 10240, HG_GN_OFF = 12288, HG_BUF_OFF = 16384;
constexpr int HG_QT_OFF = 16384, HG_VT_OFF = 32768, HG_BUF_BYTES = 49152;
constexpr int HG_OX_OFF = HG_BUF_OFF + 2 * HG_BUF_BYTES, HG_OX_BYTES = 64 * 264;
constexpr int HG_XS_OFF = HG_OX_OFF + 2 * HG_OX_BYTES;
static_assert(HG_XS_OFF + 3 * 2048 <= LDSCTL_OFF && HG_OX_OFF % 16 == 0 && HG_XS_OFF % 16 == 0, "HGRN LDS map");
__device__ __forceinline__ void dma16(const void* g, LAS unsigned char* l) { __builtin_amdgcn_global_load_lds((const unsigned*)g, (LAS unsigned*)l, 16, 0, 0); }
__device__ __forceinline__ void hgrn_finalize(Frame& F, const v4u (&gw)[4], int b, int hh, int c) {
    bf16* MIX = (bf16*)(F.ws + WS_MIX);
    const int ht = F.tid - 256, tok = ht >> 2, pc = ht & 3;
    const LAS float* ps = (const LAS float*)(F.lds + RING_OFF + HG_PS_OFF) + ((c & 1) * 2 + (tok >> 5)) * 128 + (tok & 31);
    const float tot = (ps[0] + ps[32]) + (ps[64] + ps[96]);
    const float rs = __builtin_amdgcn_rsqf(tot * (1.0f / 128.0f) + RMS_EPS);
    const LAS unsigned char* ox = F.lds + RING_OFF + HG_OX_OFF + (c & 1) * HG_OX_BYTES + tok * 264 + 64 * pc;
    const LAS f32x4* gn = (const LAS f32x4*)(F.lds + RING_OFF + HG_GN_OFF) + 8 * pc;
    bf16* dst = MIX + (unsigned)((b * SEQ + 64 * c + tok) * 1024 + 512 + hh * 128 + 32 * pc);
#pragma unroll
    for (int q = 0; q < 4; ++q) { unsigned ow[4]; const unsigned g4w[4] = {gw[q].x, gw[q].y, gw[q].z, gw[q].w};
#pragma unroll
        for (int i = 0; i < 2; ++i) { const pg8::u32x2 o2 = *(const LAS pg8::u32x2*)(ox + 16 * q + 8 * i); const f32x4 g4 = gn[2 * q + i];
            ow[2 * i] = cvtpk_s(bflo(o2.x) * rs * g4[0] * bflo(g4w[2 * i]), bfhi(o2.x) * rs * g4[1] * bfhi(g4w[2 * i]));
            ow[2 * i + 1] = cvtpk_s(bflo(o2.y) * rs * g4[2] * bflo(g4w[2 * i + 1]), bfhi(o2.y) * rs * g4[3] * bfhi(g4w[2 * i + 1])); }
        *(v4u*)(dst + 8 * q) = (v4u){ow[0], ow[1], ow[2], ow[3]}; }
}
__device__ __forceinline__ void hgrn_phase(Frame& F, int bh, unsigned long long& hg_wait_acc) {
    (void)hg_wait_acc;
    const unsigned char* QT = F.ws + WS_QT; const unsigned char* KT = F.ws + WS_KT; const unsigned char* VHT = F.ws + WS_VHT; const bf16* Gt = (const bf16*)(F.ws + WS_G);
    const unsigned char* DM = F.ws + WS_DM; const unsigned char* DE = F.ws + WS_DE;
    const int b = bh >> 2, hh = bh & 3, lane = F.lane, r32 = lane & 31, hi = lane >> 5, w = F.wave, tid = F.tid;
    LAS unsigned char* const bufs = F.lds + RING_OFF + HG_BUF_OFF;
    LAS float* const psw = (LAS float*)(F.lds + RING_OFF + HG_PS_OFF);
    LAS float* const ddw = (LAS float*)(F.lds + RING_OFF + HG_DD_OFF);
    if (tid < 128) ((LAS float*)(F.lds + RING_OFF + HG_GN_OFF))[tid] = F.in[11][tid];
    if (w >= 4) {
        const int hw = w - 4;
        unsigned so_k[4], so_v[4];
#pragma unroll
        for (int j = 0; j < 4; ++j) { const unsigned ii = (unsigned)(hw + 4 * j), sl = ii * 64 + lane;
            { const unsigned img = sl >> 9, s9 = sl & 511, row = s9 >> 4, ch = (s9 & 15) ^ (((row & 3) << 2) | ((row >> 2) & 3)); so_k[j] = ((32 * img + row) * 512 + hh * 128) * 2 + ch * 16; }
            { const unsigned row = sl >> 3, ch = (sl & 7) ^ (row & 7); so_v[j] = ((hh * 128 + row) * SEQ) * 2 + ch * 16; } }
        const unsigned so_d = (unsigned)((hh * 128) * 4 + (lane & 31) * 16);
        const unsigned char* const ddsrc = (lane < 32 ? DM : DE) + (size_t)(b * NCHUNK) * 2048 + so_d;
        const unsigned char* const ktb = KT + (size_t)(b * SEQ) * 1024; const unsigned char* const qtb = QT + (size_t)(b * SEQ) * 1024; const unsigned char* const vtb = VHT + (size_t)(b * 512) * SEQ * 2;
#define HG_DMA(c_) do { LAS unsigned char* nb_ = bufs + ((c_) & 1) * HG_BUF_BYTES + hw * 1024; const size_t ck_ = (size_t)(c_) * 65536, cv_ = (size_t)(c_) * 128; \
        _Pragma("unroll") for (int j_ = 0; j_ < 4; ++j_) { dma16(ktb + ck_ + so_k[j_], nb_ + j_ * 4096); dma16(qtb + ck_ + so_k[j_], nb_ + HG_QT_OFF + j_ * 4096); dma16(vtb + cv_ + so_v[j_], nb_ + HG_VT_OFF + j_ * 4096); } \
        if (hw == 0) dma16(ddsrc + (size_t)(c_) * 2048, (LAS unsigned char*)(ddw + ((c_) & 1) * 256)); } while (0)
        const unsigned src_g = (unsigned)((b * SEQ + ((tid - 256) >> 2)) * 512 + hh * 128 + 32 * (tid & 3));
        const unsigned rk_ = (unsigned)pi32(r32), sk_ = ((rk_ & 3) << 2) | ((rk_ >> 2) & 3), sq_ = (((unsigned)r32 & 3) << 2) | (((unsigned)r32 >> 2) & 3);
        const unsigned kt_base = 256u * rk_ + 16u * ((unsigned)hi ^ (sk_ & 1)), kt_e = sk_ >> 1, qt_base = (unsigned)HG_QT_OFF + 256u * (unsigned)r32 + 16u * ((unsigned)hi ^ (sq_ & 1)), qt_e = sq_ >> 1;
        HG_DMA(0);
        asm volatile("s_waitcnt vmcnt(0) lgkmcnt(0)" ::: "memory"); __builtin_amdgcn_s_barrier(); asm volatile("" ::: "memory");
        for (int c = 0; c <= NCHUNK; ++c) {
            if (c + 1 < NCHUNK) HG_DMA(c + 1);
            if (hw < 3 && c < NCHUNK) {
                const LAS unsigned char* buf = bufs + (c & 1) * HG_BUF_BYTES;
                const int sbx = hw >> 1, tbx = (hw + 1) >> 1;
                unsigned ek = kt_e, eq = qt_e; asm volatile("" : "+v"(ek), "+v"(eq));
                f32x16 X;
#pragma unroll
                for (int r = 0; r < 16; ++r) X[r] = 0.f;
#pragma unroll
                for (int ks = 0; ks < 8; ++ks) { const bf16x8 kf = *(const LAS bf16x8*)(buf + sbx * 8192 + kt_base + (((unsigned)ks ^ ek) << 5)), qf = *(const LAS bf16x8*)(buf + tbx * 8192 + qt_base + (((unsigned)ks ^ eq) << 5)); X = MFMA32(kf, qf, X); }
                if (sbx == tbx) {
                    int thr = r32 - 8 * hi; asm volatile("" : "+v"(thr));
#pragma unroll
                    for (int r = 0; r < 16; ++r) X[r] = thr >= 16 * (r >> 3) + (r & 7) ? X[r] : 0.f;
                }
                LAS unsigned char* xw = F.lds + RING_OFF + HG_XS_OFF + hw * 2048 + lane * 16;
                *(LAS bf16x8*)xw = pack_step(X, 0); *(LAS bf16x8*)(xw + 1024) = pack_step(X, 1);
            }
            if (c > 0) { const bf16* gcp = Gt + (size_t)((c - 1) * 64 * 512); v4u gc[4];
#pragma unroll
                for (int q = 0; q < 4; ++q) gc[q] = *(const v4u*)(gcp + src_g + 8 * q);
                hgrn_finalize(F, gc, b, hh, c - 1); }
            asm volatile("s_waitcnt lgkmcnt(0)" ::: "memory"); __builtin_amdgcn_s_barrier(); asm volatile("" ::: "memory");
            asm volatile("s_waitcnt vmcnt(0) lgkmcnt(0)" ::: "memory"); __builtin_amdgcn_s_barrier(); asm volatile("" ::: "memory");
        }
#undef HG_DMA
    } else {
        const int vb = w;
        f32x16 S[4];
#pragma unroll
        for (int kb = 0; kb < 4; ++kb)
#pragma unroll
            for (int r = 0; r < 16; ++r) S[kb][r] = 0.f;
        const unsigned rk_ = (unsigned)pi32(r32), sk_ = ((rk_ & 3) << 2) | ((rk_ >> 2) & 3), sq_ = (((unsigned)r32 & 3) << 2) | (((unsigned)r32 >> 2) & 3);
        const unsigned kt_base = 256u * rk_ + 16u * ((unsigned)hi ^ (sk_ & 1)), kt_e = sk_ >> 1, qt_base = (unsigned)HG_QT_OFF + 256u * (unsigned)r32 + 16u * ((unsigned)hi ^ (sq_ & 1)), qt_e = sq_ >> 1;
        unsigned rd_tr[4][2], rd_vt[4];
#pragma unroll
        for (int kb = 0; kb < 4; ++kb) { rd_tr[kb][0] = tr_read_addr_b((unsigned)lane, (unsigned)kb, 0u, 0u); rd_tr[kb][1] = tr_read_addr_b((unsigned)lane, (unsigned)kb, 0u, 1u); }
#pragma unroll
        for (int k4 = 0; k4 < 4; ++k4) rd_vt[k4] = (unsigned)(HG_VT_OFF + (32 * vb + r32) * 128 + (((2 * k4 + hi) ^ (r32 & 7)) << 4));
        const unsigned wr_ox = (unsigned)(HG_OX_OFF + r32 * 264 + (32 * vb + 4 * hi) * 2);
        asm volatile("s_waitcnt vmcnt(0) lgkmcnt(0)" ::: "memory"); __builtin_amdgcn_s_barrier(); asm volatile("" ::: "memory");
        for (int c = 0; c <= NCHUNK; ++c) {
            const LAS unsigned char* buf = bufs + (c & 1) * HG_BUF_BYTES;
            f32x16 o[2]; bf16x8 vfr[4];
            if (c < NCHUNK) {
            const LAS float* dd = ddw + (c & 1) * 256 + 4 * hi;
#pragma unroll
            for (int kb = 0; kb < 4; ++kb)
#pragma unroll
                for (int g = 0; g < 4; ++g) { const f32x4 a = *(const LAS f32x4*)(dd + 32 * kb + 8 * g);
#pragma unroll
                    for (int i = 0; i < 4; ++i) S[kb][4 * g + i] *= a[i]; }
            unsigned ek = kt_e, eq = qt_e; asm volatile("" : "+v"(ek), "+v"(eq));
#define HG_RDKT(ks_) (kt_base + (((unsigned)(ks_) ^ ek) << 5))
#define HG_RDQT(ks_) (qt_base + (((unsigned)(ks_) ^ eq) << 5))
            __builtin_amdgcn_sched_barrier(0);
#pragma unroll
            for (int k4 = 0; k4 < 4; ++k4) vfr[k4] = *(const LAS bf16x8*)(buf + rd_vt[k4]);
#pragma unroll
            for (int r = 0; r < 16; ++r) { o[0][r] = 0.f; o[1][r] = 0.f; }
#pragma unroll
            for (int kb = 0; kb < 4; ++kb)
#pragma unroll
                for (int sp = 0; sp < 2; ++sp) { const bf16x8 sf = pack_step(S[kb], sp);
                    const bf16x8 q0 = *(const LAS bf16x8*)(buf + HG_RDQT(2 * kb + sp)), q1 = *(const LAS bf16x8*)(buf + 8192 + HG_RDQT(2 * kb + sp));
                    o[0] = MFMA32(sf, krow_frag(q0), o[0]); o[1] = MFMA32(sf, krow_frag(q1), o[1]); }
            __builtin_amdgcn_sched_barrier(0);
#pragma unroll
            for (int kb = 0; kb < 4; ++kb) {
#pragma unroll
                for (int k4 = 0; k4 < 4; ++k4) {
                    const LAS unsigned char* ip = buf + (k4 >> 1) * 8192 + (k4 & 1) * 4096;
                    const v4i16_t lo = lds_tr(ip + rd_tr[kb][0]), hi4 = lds_tr(ip + rd_tr[kb][1]);
                    const bf16x8 af = __builtin_shufflevector(lo, hi4, 0, 1, 2, 3, 4, 5, 6, 7);
                    S[kb] = MFMA32(af, vfr[k4], S[kb]);
                }
#pragma unroll
                for (int g = 0; g < 4; ++g) { const f32x4 a = *(const LAS f32x4*)(dd + 128 + 32 * kb + 8 * g);
#pragma unroll
                    for (int i = 0; i < 4; ++i) S[kb][4 * g + i] *= a[i]; }
            }
            }
            asm volatile("s_waitcnt lgkmcnt(0)" ::: "memory"); __builtin_amdgcn_s_barrier(); asm volatile("" ::: "memory");
            if (c < NCHUNK) {
            { const LAS unsigned char* xr = F.lds + RING_OFF + HG_XS_OFF + lane * 16;
              o[0] = MFMA32(vfr[0], *(const LAS bf16x8*)(xr), o[0]); o[0] = MFMA32(vfr[1], *(const LAS bf16x8*)(xr + 1024), o[0]);
              o[1] = MFMA32(vfr[0], *(const LAS bf16x8*)(xr + 2048), o[1]); o[1] = MFMA32(vfr[1], *(const LAS bf16x8*)(xr + 3072), o[1]);
              o[1] = MFMA32(vfr[2], *(const LAS bf16x8*)(xr + 4096), o[1]); o[1] = MFMA32(vfr[3], *(const LAS bf16x8*)(xr + 5120), o[1]); }
#pragma unroll
            for (int tbi = 0; tbi < 2; ++tbi) { float q = 0.f;
#pragma unroll
              for (int r = 0; r < 16; ++r) q += o[tbi][r] * o[tbi][r];
              q = swapsum(q);
              if (hi == 0) psw[((c & 1) * 2 + tbi) * 128 + vb * 32 + r32] = q;
              LAS unsigned char* oxw = F.lds + RING_OFF + (c & 1) * HG_OX_BYTES + wr_ox + tbi * 32 * 264;
#pragma unroll
              for (int g = 0; g < 4; ++g) *(LAS pg8::u32x2*)(oxw + 16 * g) = (pg8::u32x2){cvtpk_s(o[tbi][4 * g], o[tbi][4 * g + 1]), cvtpk_s(o[tbi][4 * g + 2], o[tbi][4 * g + 3])}; }
            }
            asm volatile("s_waitcnt vmcnt(0) lgkmcnt(0)" ::: "memory"); __builtin_amdgcn_s_barrier(); asm volatile("" ::: "memory");
        }
#undef HG_RDKT
#undef HG_RDQT
    }
    __syncthreads();
}

struct Args { const float* in[17]; float* out; unsigned char* ws; int ph_lo, ph_hi, li, pad; };
__global__ void __launch_bounds__(NWAVES * 64, 2) mega_fwd(Args args) {
    extern __shared__ __attribute__((aligned(16))) unsigned char lds[];
    Frame F;
    F.lds = (LAS unsigned char*)lds;
    F.MISC = (volatile LAS unsigned*)(F.lds + MISC_OFF);
    F.tid = threadIdx.x; F.lane = F.tid & 63; F.wave = __builtin_amdgcn_readfirstlane(F.tid >> 6);
    F.G = gridDim.x;
#pragma unroll
    for (int i = 0; i < 17; ++i) F.in[i] = args.in[i];
    F.out = args.out; F.ws = args.ws;
    F.ctl = (gu32*)(args.ws + WS_CTL);
    for (int u = F.tid; u < (LDS_BYTES - LDSCTL_OFF) / 4; u += NWAVES * 64) ((LAS unsigned*)(F.lds + LDSCTL_OFF))[u] = 0u;
    __syncthreads();
    XcdBarrier bar; bar.bar = (unsigned*)(F.ctl + CW_BAR); bar.x = 0; bar.st = nullptr;
    if (N_LAUNCHES != PER_PHASE) bar = xcd_barrier_post((unsigned*)(F.ctl + CW_BAR), F.MISC + 8);
#define GRID_BAR(seam) do { if (N_LAUNCHES == PER_PHASE) { if (F.tid == 0) __hip_atomic_store(F.ctl + CW_TMO, 0xBADBA0u | (unsigned)(seam), RLX_AGENT); } else { xcd_barrier(bar); } } while (0)
    const int lo = args.ph_lo, hi = args.ph_hi;
#ifdef PROBE_PHASE
    unsigned long long ts_prev = __builtin_amdgcn_s_memrealtime(), ts_dt = 0ull; int ts_k = 0;
#define STAMP() do { const unsigned long long t_ = __builtin_amdgcn_s_memrealtime(); if (ts_k == PROBE_PHASE) ts_dt = t_ - ts_prev; ts_prev = t_; ++ts_k; } while (0)
#else
#define STAMP() do {} while (0)
#endif
#define IN(k) (lo <= (k) && (k) < hi)
#define BOTH(k) (IN(k) && IN((k) + 1))
    bf16* const XB = (bf16*)(F.ws + WS_XB); bf16* const HID = (bf16*)(F.ws + WS_HID); bf16* const MIXp = (bf16*)(F.ws + WS_MIX);
    float* const RS1 = (float*)(F.ws + WS_RS1); float* const RS2 = (float*)(F.ws + WS_RS2);
    const LAS float* const SCL = (const LAS float*)(F.lds + RING_OFF + RING_BYTES);

    if (IN(0)) { unsigned long long p0_probe = 0ull; p0_prologue(F, p0_probe);
#if defined(PROBE_PHASE) && (PROBE_PHASE == 13 || PROBE_PHASE == 14)
        ts_dt = p0_probe;
#endif
        if (BOTH(0)) GRID_BAR(0); STAMP(); }
    if (IN(1)) {
        pg8::Gemm g{XB, (const bf16*)(F.ws + WS_WGU1), M, 2 * FF, D}; pg8::StaticOrder S; S.init(M, 2 * FF, F.G, (int)blockIdx.x, WGM_GU);
        pg8::EpiSwiGLU E{HID, nullptr, SCL, FF};
        pg8::gemm_phase<pg8::EpiSwiGLU, pg8::StaticOrder, true, true>(F.lds + RING_OFF, g, S, E);
        if (BOTH(1)) GRID_BAR(1); STAMP();
    }
    if (IN(2)) {
        pg8::Gemm g{HID, (const bf16*)(F.ws + WS_WD1), M, D, FF}; pg8::StaticOrder S; S.init(M, D, F.G, (int)blockIdx.x, WGM_DOWN);
        pg8::EpiRes<0> E{F.in[0], nullptr, XB, RS1, 0.5f};
        pg8::gemm_phase<pg8::EpiRes<0>, pg8::StaticOrder, true, true>(F.lds + RING_OFF, g, S, E);
        if (BOTH(2)) GRID_BAR(2); STAMP();
    }
    if (IN(3)) {
        { pg8::Gemm g{XB, (const bf16*)(F.ws + WS_WIN), M, 2560, D}; pg8::StaticOrder S; S.init(M, 2560, F.G, (int)blockIdx.x, WGM_IN);
          pg8::EpiWin E{(bf16*)(F.ws + WS_Q), (bf16*)(F.ws + WS_K), (bf16*)(F.ws + WS_QT), (bf16*)(F.ws + WS_KT), (bf16*)(F.ws + WS_G), (float*)(F.ws + WS_DM), (float*)(F.ws + WS_DE), RS1, F.in[7], F.in[8], (const float*)(F.ws + WS_LB), SCL};
          pg8::gemm_phase<pg8::EpiWin, pg8::StaticOrder, true, true>(F.lds + RING_OFF, g, S, E); }
        { pg8::Gemm g{(const bf16*)(F.ws + WS_WINT), XB, 1024, M, D}; pg8::StaticOrder S; S.init(1024, M, F.G, (int)blockIdx.x, WGM_INT);
          pg8::EpiVT E{(bf16*)(F.ws + WS_VT), (bf16*)(F.ws + WS_VHT), RS1, SCL};
          pg8::gemm_phase<pg8::EpiVT, pg8::StaticOrder, true, true>(F.lds + RING_OFF, g, S, E); }
        if (BOTH(3)) GRID_BAR(3); STAMP();
    }
    if (IN(4)) {
#ifdef PROBE_PHASE
        const unsigned long long th00_ = __builtin_amdgcn_s_memrealtime();
#endif
#ifdef PROBE_PHASE
        const unsigned long long th0_ = __builtin_amdgcn_s_memrealtime();
        if (PROBE_PHASE == 9) ts_dt = th0_ - th00_;
#endif
        unsigned long long hg_wait_acc = 0ull;
        if (blockIdx.x < 64) hgrn_phase(F, (int)blockIdx.x, hg_wait_acc);
#ifdef PROBE_PHASE
        if (PROBE_PHASE == 11 || PROBE_PHASE == 12) ts_dt = hg_wait_acc;
#endif
#ifdef PROBE_PHASE
        if (PROBE_PHASE == 8) ts_dt = __builtin_amdgcn_s_memrealtime() - th0_;
#endif
#ifdef PROBE_PHASE
        const unsigned long long ta0_ = __builtin_amdgcn_s_memrealtime();
#endif
        attn_phase(F);
#ifdef PROBE_PHASE
        if (PROBE_PHASE == 10) ts_dt = __builtin_amdgcn_s_memrealtime() - ta0_;
#endif
        if (BOTH(4)) GRID_BAR(4); STAMP();
    }
    if (IN(5)) {
        pg8::Gemm g{MIXp, (const bf16*)(F.ws + WS_WOUT), M, D, D}; pg8::StaticOrder S; S.init(M, D, F.G, (int)blockIdx.x, WGM_OUT);
        pg8::EpiRes<1> E{nullptr, nullptr, XB, RS2, 1.0f};
        pg8::gemm_phase<pg8::EpiRes<1>, pg8::StaticOrder, true, true>(F.lds + RING_OFF, g, S, E);
        if (BOTH(5)) GRID_BAR(5); STAMP();
    }
    if (IN(6)) {
        pg8::Gemm g{XB, (const bf16*)(F.ws + WS_WGU2), M, 2 * FF, D}; pg8::StaticOrder S; S.init(M, 2 * FF, F.G, (int)blockIdx.x, WGM_GU);
        pg8::EpiSwiGLU E{HID, RS2, SCL, FF};
        pg8::gemm_phase<pg8::EpiSwiGLU, pg8::StaticOrder, true, true>(F.lds + RING_OFF, g, S, E);
        if (BOTH(6)) GRID_BAR(6); STAMP();
    }
    if (IN(7)) {
        pg8::Gemm g{HID, (const bf16*)(F.ws + WS_WD2), M, D, FF}; pg8::StaticOrder S; S.init(M, D, F.G, (int)blockIdx.x, WGM_DOWN);
        pg8::EpiRes<2> E{nullptr, F.out, XB, nullptr, 0.5f};
        pg8::gemm_phase<pg8::EpiRes<2>, pg8::StaticOrder, true, true>(F.lds + RING_OFF, g, S, E);
    }
#ifdef PROBE_PHASE
    __syncthreads(); STAMP();
    if (blockIdx.x == (PROBE_PHASE == 10 ? 255 : 0) && F.tid == 0) { const unsigned long long t0_ = __builtin_amdgcn_s_memrealtime(); while (__builtin_amdgcn_s_memrealtime() - t0_ < 4ull * ts_dt) __builtin_amdgcn_s_sleep(8); }
#endif
#undef IN
#undef BOTH
}

extern "C" void kernel_launch(void* const* d_in, const int* in_sizes, int n_in, void* d_out, int out_size, void* d_ws, size_t ws_size, hipStream_t stream) {
    static int grid = 0;
    if (grid == 0) {
        if (n_in != 17 || in_sizes[0] != M * D || out_size != M * D || ws_size < WS_END) { fprintf(stderr, "kernel_launch: unexpected shapes (n_in %d, in0 %d, out %d, ws %zu); nothing launched\n", n_in, n_in > 0 ? in_sizes[0] : -1, out_size, ws_size); grid = -1; return; }
        int dev = 0, cus = 0, per_cu = 0;
        if (hipGetDevice(&dev) != hipSuccess || hipDeviceGetAttribute(&cus, hipDeviceAttributeMultiprocessorCount, dev) != hipSuccess) { grid = -1; return; }
        if (hipFuncSetAttribute((const void*)mega_fwd, hipFuncAttributeMaxDynamicSharedMemorySize, LDS_BYTES) != hipSuccess) { fprintf(stderr, "kernel_launch: hipFuncSetAttribute failed\n"); grid = -1; return; }
        if (hipOccupancyMaxActiveBlocksPerMultiprocessor(&per_cu, (const void*)mega_fwd, NWAVES * 64, LDS_BYTES) != hipSuccess || per_cu < 1) fprintf(stderr, "kernel_launch: note: occupancy query reports %d workgroups per CU\n", per_cu);
        (void)hipGetLastError();
        grid = cus;
    }
    if (grid < 0) return;
    if (hipMemsetAsync((char*)d_ws + WS_CTL, 0, CTL_ZERO_BYTES, stream) != hipSuccess) { fprintf(stderr, "kernel_launch: hipMemsetAsync failed\n"); return; }
    Args a{};
    for (int i = 0; i < 17; ++i) a.in[i] = (const float*)d_in[i];
    a.out = (float*)d_out; a.ws = (unsigned char*)d_ws;
    for (int li = 0; li < N_LAUNCHES; ++li) {
        a.ph_lo = (N_LAUNCHES == PER_PHASE) ? li : 0; a.ph_hi = (N_LAUNCHES == PER_PHASE) ? li + 1 : PER_PHASE; a.li = li;
        hipLaunchKernelGGL(mega_fwd, dim3(grid), dim3(NWAVES * 64), LDS_BYTES, stream, a);
        const hipError_t le = hipPeekAtLastError();
        if (le != hipSuccess) { fprintf(stderr, "kernel_launch: launch %d failed: %s\n", li, hipGetErrorName(le)); break; }
    }
}
```

```cpp
#include <hip/hip_runtime.h>
#include <cstdio>
#include <cstdint>
namespace pg8 {
#define PG8_LAS __attribute__((address_space(3)))
typedef unsigned short bf16_t;
typedef short bf16x8 __attribute__((ext_vector_type(8)));
typedef float f32x4 __attribute__((ext_vector_type(4)));
typedef unsigned u32x4 __attribute__((ext_vector_type(4)));
constexpr int BM = 256, BK = 64, HALF = 128, HTB = HALF * BK * 2  , STAGE_BYTES = 8 * HTB, NXCD = 8, WGM = 4;

__host__ __device__ __forceinline__ int lds_byte(int r, int c) { const int st = (r >> 4) * 2 + (c >> 5), rr = r & 15, cc = c & 31, ob = rr * 64 + cc * 2; return st * 1024 + (ob ^ (((ob >> 9) & 1) << 5)); }
__host__ __device__ __forceinline__ void stage_rc(int b, int& R, int& C) { const int st = b / 1024, sb = b % 1024, swz = sb ^ (((sb >> 9) & 1) << 5); R = (st >> 1) * 16 + swz / 64; C = (st & 1) * 32 + (swz % 64) / 2; }
__host__ __device__ __forceinline__ int perm32(int rho) { const int n = rho >> 4, i = rho & 15; return 8 * (i >> 2) + 4 * n + (i & 3); }

struct Unit { int pm, pn, par; };
struct Gemm { const bf16_t* A; const bf16_t* Bt; int M, N, K; };

struct StaticOrder {
    int nM, nN, nwg, G, c, wgm;
    __host__ __device__ void init(int M, int N, int G_, int c_, int wgm_ = WGM) { nM = M / BM; nN = N / BM; nwg = nM * nN; G = G_; c = c_; wgm = wgm_; }
    __host__ __device__ bool next(int i, Unit& u) const {
        const long L = (long)i * G + c; if (L >= nwg) return false;
        int wgid = (int)L; { const int q = nwg / NXCD, r = nwg % NXCD, xcd = wgid % NXCD, off = wgid / NXCD; wgid = (xcd < r ? xcd * (q + 1) : r * (q + 1) + (xcd - r) * q) + off; }
        const int nig = wgm * nN, gid = wgid / nig, fm = gid * wgm, gsz = (nM - fm) < wgm ? (nM - fm) : wgm;
        u.pm = fm + ((wgid % nig) % gsz); u.pn = (wgid % nig) / gsz; return true;
    }
    __device__ __forceinline__ void a_ready(const Unit&) const {}
    __device__ __forceinline__ void done(const Unit&) const {}
};


typedef unsigned u32x2 __attribute__((ext_vector_type(2)));
constexpr float RMS_EPS = 1e-6f, LOG2E = 1.4426950408889634f, QSCALE = 0.125f * 1.4426950408889634f;
__device__ __forceinline__ unsigned cvt_pk_bf16(float lo, float hi) { unsigned r; asm volatile("v_cvt_pk_bf16_f32 %0, %1, %2" : "=v"(r) : "v"(lo), "v"(hi)); return r; }
__device__ __forceinline__ float fsigmoid(float x) { return __builtin_amdgcn_rcpf(1.0f + __builtin_amdgcn_exp2f(-x * LOG2E)); }
__device__ __forceinline__ float fsilu(float x) { return x * fsigmoid(x); }
__device__ __forceinline__ f32x4 silu4(f32x4 v) { return (f32x4){fsilu(v[0]), fsilu(v[1]), fsilu(v[2]), fsilu(v[3])}; }
__device__ __forceinline__ u32x4 pack8(f32x4 a, f32x4 b) { u32x4 w; w.x = cvt_pk_bf16(a[0], a[1]); w.y = cvt_pk_bf16(a[2], a[3]); w.z = cvt_pk_bf16(b[0], b[1]); w.w = cvt_pk_bf16(b[2], b[3]); return w; }
__device__ __forceinline__ float rowscale(const float* rowsq, const PG8_LAS float* slot, int rl) { return rowsq ? __builtin_amdgcn_rsqf(slot[rl] * (1.0f / 1024.0f) + RMS_EPS) : 1.0f; }
template <int CTRL> __device__ __forceinline__ float dpp_mov0(float x) { return __builtin_bit_cast(float, __builtin_amdgcn_update_dpp(0, __builtin_bit_cast(int, x), CTRL, 0xf, 0xf, true)); }
__device__ __forceinline__ float row_scan16(float x) { x += dpp_mov0<0x111>(x); x += dpp_mov0<0x112>(x); x += dpp_mov0<0x114>(x); x += dpp_mov0<0x118>(x); return x; }

struct EpiSwiGLU {
    static constexpr bool PERM = false, AFTER_DRAIN = false; static constexpr int SCALE = 1;
    bf16_t* H; const float* rowsq; const PG8_LAS float* scl; int ldh;
    __device__ __forceinline__ void operator()(f32x4 (&acc)[2][2][4][2], const Unit& u, int wr, int wc, int fr, int fq) const {
        const int row0 = u.pm * BM + wr * 64 + fr, col0 = u.pn * HALF + wc * 32 + 8 * fq; const PG8_LAS float* slot = scl + u.par * 256 + wr * 64 + fr;
#pragma unroll
        for (int ai = 0; ai < 2; ++ai)
#pragma unroll
            for (int m = 0; m < 4; ++m) { const int row = row0 + ai * HALF + m * 16; const float r = rowscale(rowsq, slot, ai * HALF + m * 16);
                f32x4 hh[2];
#pragma unroll
                for (int n = 0; n < 2; ++n) { const f32x4 g = acc[ai][0][m][n] * r, gu = g * (acc[ai][1][m][n] * r);
#pragma unroll
                    for (int c = 0; c < 4; ++c) hh[n][c] = gu[c] * __builtin_amdgcn_rcpf(1.0f + __builtin_amdgcn_exp2f(-g[c])); }
                *(u32x4*)(H + (unsigned)(row * ldh + col0)) = pack8(hh[0], hh[1]); }
    }
};
template <int MODE> struct EpiRes {
    static constexpr bool PERM = false, AFTER_DRAIN = false; static constexpr int SCALE = 0;
    const float* base; float* out; bf16_t* xb; float* rowsq; float scale;
    __device__ __forceinline__ void operator()(f32x4 (&acc)[2][2][4][2], const Unit& u, int wr, int wc, int fr, int fq) const {
        const int row0 = u.pm * BM + wr * 64 + fr, col0 = u.pn * BM + wc * 32 + 4 * fq;
#pragma unroll
        for (int ai = 0; ai < 2; ++ai)
#pragma unroll
            for (int m = 0; m < 4; ++m) { const int row = row0 + ai * HALF + m * 16; const unsigned off = (unsigned)(row * 1024 + col0); float ss = 0.f;
#pragma unroll
                for (int bj = 0; bj < 2; ++bj)
#pragma unroll
                    for (int n = 0; n < 2; ++n) { const unsigned o = off + bj * HALF + n * 16; f32x4 v;
                        if (MODE == 0) v = *(const f32x4*)(base + o);
                        else { const u32x2 w = *(const u32x2*)(xb + o); v = (f32x4){__builtin_bit_cast(float, w.x << 16), __builtin_bit_cast(float, w.x & 0xffff0000u), __builtin_bit_cast(float, w.y << 16), __builtin_bit_cast(float, w.y & 0xffff0000u)}; }
                        v = v + acc[ai][bj][m][n] * scale;
                        if (MODE == 2) *(f32x4*)(out + o) = v;
                        else { u32x2 w; w.x = cvt_pk_bf16(v[0], v[1]); w.y = cvt_pk_bf16(v[2], v[3]); *(u32x2*)(xb + o) = w; ss += (v[0] * v[0] + v[1] * v[1]) + (v[2] * v[2] + v[3] * v[3]); } }
                if (MODE != 2) { ss += __shfl_xor(ss, 16); ss += __shfl_xor(ss, 32); if (fq == 0) __hip_atomic_fetch_add(rowsq + row, ss, __ATOMIC_RELAXED, __HIP_MEMORY_SCOPE_AGENT); }
                asm volatile("" ::: "memory"); }
    }
};
struct EpiWin {
    static constexpr bool PERM = false, AFTER_DRAIN = false; static constexpr int SCALE = 1;
    bf16_t *Q, *K, *QT, *KT, *G; float *DM, *DE; const float *rowsq, *gq, *gk, *lb; const PG8_LAS float* scl;
    __device__ __forceinline__ void operator()(f32x4 (&acc)[2][2][4][2], const Unit& u, int wr, int wc, int fr, int fq) const {
        const int row0 = u.pm * BM + wr * 64 + fr, t = u.pn; const PG8_LAS float* slot = scl + u.par * 256 + wr * 64 + fr;
        if (t < 4) {
            const bool isq = t < 2; const int head = 4 * (t & 1) + wc; const float* gp = isq ? gq : gk; const float gs = isq ? QSCALE : 1.0f;
            f32x4 gv[2][2];
#pragma unroll
            for (int bj = 0; bj < 2; ++bj)
#pragma unroll
                for (int n = 0; n < 2; ++n) gv[bj][n] = *(const f32x4*)(gp + 32 * bj + 8 * fq + 4 * n) * gs;
            bf16_t* dst = (isq ? Q : K) + (head * 32 * 8) * 512 + (fq >> 1) * 512 + (fq & 1) * 256;
#pragma unroll
            for (int ai = 0; ai < 2; ++ai)
#pragma unroll
                for (int m = 0; m < 4; ++m) { const int row = row0 + ai * HALF + m * 16; const float r = rowscale(rowsq, slot, ai * HALF + m * 16); float ss = 0.f;
#pragma unroll
                    for (int bj = 0; bj < 2; ++bj)
#pragma unroll
                        for (int n = 0; n < 2; ++n) { const f32x4 v = acc[ai][bj][m][n] * r; acc[ai][bj][m][n] = v; ss += (v[0] * v[0] + v[1] * v[1]) + (v[2] * v[2] + v[3] * v[3]); }
                    ss += __shfl_xor(ss, 16); ss += __shfl_xor(ss, 32);
                    const float inv = __builtin_amdgcn_rsqf(ss * (1.0f / 64.0f) + RMS_EPS);
                    const int tk = row & 2047, t5 = tk & 31, r32 = isq ? t5 : ((t5 & 0x13) | ((t5 & 4) << 1) | ((t5 & 8) >> 1));
                    const unsigned o = (unsigned)((((row >> 11) * 8 * 32 + (tk >> 6)) * 2 + ((tk >> 5) & 1)) * 4 * 512 + r32 * 8);
#pragma unroll
                    for (int bj = 0; bj < 2; ++bj) *(u32x4*)(dst + o + (unsigned)(2 * bj * 512)) = pack8(acc[ai][bj][m][0] * inv * gv[bj][0], acc[ai][bj][m][1] * inv * gv[bj][1]); }
        } else if (t < 8) {
            const int hh = t - 4, kbase = hh * 128 + wc * 32 + 8 * fq;
            float lbv[8]; { const f32x4 l0 = *(const f32x4*)(lb + kbase), l1 = *(const f32x4*)(lb + kbase + 4);
#pragma unroll
                for (int c = 0; c < 4; ++c) { lbv[c] = l0[c]; lbv[4 + c] = l1[c]; } }
            const int lane = fq * 16 + fr;
#pragma unroll
            for (int ai = 0; ai < 2; ++ai)
#pragma unroll
                for (int n = 0; n < 2; ++n) {
                    float omf[4][4], carry[4], bmid[4];
#pragma unroll
                    for (int m = 0; m < 4; ++m) { const float r = rowscale(rowsq, slot, ai * HALF + m * 16);
#pragma unroll
                        for (int c = 0; c < 4; ++c) { const int e = 4 * n + c; const float a = acc[ai][0][m][n][c] * r, b = acc[ai][1][m][n][c] * r;
                            const float sg = fsigmoid(b), f = lbv[e] + (1.0f - lbv[e]) * sg; omf[m][c] = (1.0f - lbv[e]) * (1.0f - sg);
                            acc[ai][1][m][n][c] = __builtin_amdgcn_logf(f);
                            acc[ai][0][m][n][c] = fsilu(a); } }
#pragma unroll
                    for (int c = 0; c < 4; ++c) { carry[c] = 0.f; bmid[c] = 0.f; }
#pragma unroll
                    for (int m = 0; m < 4; ++m)
#pragma unroll
                        for (int c = 0; c < 4; ++c) { float x = row_scan16(acc[ai][1][m][n][c]) + carry[c]; acc[ai][1][m][n][c] = x;
                            carry[c] = __shfl(x, lane | 15); if (m == 1) bmid[c] = carry[c]; }
#pragma unroll
                    for (int m = 0; m < 4; ++m) { const int row = row0 + ai * HALF + m * 16; f32x4 qv, kv;
#pragma unroll
                        for (int c = 0; c < 4; ++c) { const float d = acc[ai][1][m][n][c] - bmid[c];
                            qv[c] = acc[ai][0][m][n][c] * __builtin_amdgcn_exp2f(d); kv[c] = omf[m][c] * __builtin_amdgcn_exp2f(-d); }
                        const unsigned o = (unsigned)(row * 512 + kbase + 4 * n);
                        u32x2 w; w.x = cvt_pk_bf16(qv[0], qv[1]); w.y = cvt_pk_bf16(qv[2], qv[3]); *(u32x2*)(QT + o) = w;
                        w.x = cvt_pk_bf16(kv[0], kv[1]); w.y = cvt_pk_bf16(kv[2], kv[3]); *(u32x2*)(KT + o) = w; }
                    if (fr == 0) { const int chunk = (u.pm * BM + ai * HALF + wr * 64) >> 6; f32x4 a0, e0;
#pragma unroll
                        for (int c = 0; c < 4; ++c) { a0[c] = __builtin_amdgcn_exp2f(bmid[c]); e0[c] = __builtin_amdgcn_exp2f(carry[c] - bmid[c]); }
                        *(f32x4*)(DM + (unsigned)(chunk * 512 + kbase + 4 * n)) = a0; *(f32x4*)(DE + (unsigned)(chunk * 512 + kbase + 4 * n)) = e0; }
                    asm volatile("" ::: "memory");
                }
        } else {
            bf16_t* dst = G + (t - 8) * 256 + wc * 32 + 8 * fq;
#pragma unroll
            for (int ai = 0; ai < 2; ++ai)
#pragma unroll
                for (int m = 0; m < 4; ++m) { const int row = row0 + ai * HALF + m * 16; const float r = rowscale(rowsq, slot, ai * HALF + m * 16);
#pragma unroll
                    for (int bj = 0; bj < 2; ++bj) *(u32x4*)(dst + (unsigned)(row * 512 + bj * HALF)) = pack8(silu4(acc[ai][bj][m][0] * r), silu4(acc[ai][bj][m][1] * r)); }
        }
    }
};
struct EpiVT {
    static constexpr bool PERM = true, AFTER_DRAIN = false; static constexpr int SCALE = 2;
    bf16_t *VT, *VHT; const float* rowsq; const PG8_LAS float* scl;
    __device__ __forceinline__ void operator()(f32x4 (&acc)[2][2][4][2], const Unit& u, int wr, int wc, int fr, int fq) const {
        const int ch0 = (u.pm & 1) * BM + wr * 64 + fr, tok0 = u.pn * BM + wc * 32 + 8 * fq, b = tok0 >> 11, s0 = tok0 & 2047;
        f32x4 rs[2][2];
#pragma unroll
        for (int bj = 0; bj < 2; ++bj)
#pragma unroll
            for (int n = 0; n < 2; ++n) { const f32x4 q = *(const PG8_LAS f32x4*)(scl + u.par * 256 + wc * 32 + 8 * fq + bj * HALF + 4 * n);
#pragma unroll
                for (int c = 0; c < 4; ++c) rs[bj][n][c] = __builtin_amdgcn_rsqf(q[c] * (1.0f / 1024.0f) + RMS_EPS); }
        if (u.pm < 2) {
#pragma unroll
            for (int ai = 0; ai < 2; ++ai)
#pragma unroll
                for (int m = 0; m < 4; ++m) { const int ch = ch0 + ai * HALF + m * 16;
#pragma unroll
                    for (int bj = 0; bj < 2; ++bj) { const int sk = s0 + bj * HALF;
                        const unsigned o = (unsigned)((((((b * 8 + (ch >> 6)) * 32 + (sk >> 6)) * 2 + ((ch >> 5) & 1)) * 4 + ((sk >> 4) & 3)) * 64 + ((sk >> 3) & 1) * 32 + (ch & 31)) * 8);
                        *(u32x4*)(VT + o) = pack8(acc[ai][bj][m][0] * rs[bj][0], acc[ai][bj][m][1] * rs[bj][1]); } }
        } else {
            bf16_t* dst = VHT + (size_t)b * 512 * 2048 + s0;
#pragma unroll
            for (int ai = 0; ai < 2; ++ai)
#pragma unroll
                for (int m = 0; m < 4; ++m) { const int ch = ch0 + ai * HALF + m * 16;
#pragma unroll
                    for (int bj = 0; bj < 2; ++bj) *(u32x4*)(dst + (unsigned)(ch * 2048 + bj * HALF)) = pack8(acc[ai][bj][m][0] * rs[bj][0], acc[ai][bj][m][1] * rs[bj][1]); }
        }
    }
};

template <class Epi, class Sched, bool ALIGN_EPI = false, bool SP2 = false>
__device__ __forceinline__ void gemm_phase(PG8_LAS unsigned char* lds, const Gemm g, const Sched& S, const Epi& E) {
    const int tid = threadIdx.x, wid = __builtin_amdgcn_readfirstlane(tid >> 6), lane = tid & 63, wr = wid >> 2, wc = wid & 3, fr = lane & 15, fq = lane >> 4;
    const int K = g.K, nt = K / BK;
    unsigned voffA[2], voffB[2];
#pragma unroll
    for (int i = 0; i < 2; ++i) { int R, C; stage_rc(tid * 16 + i * 8192, R, C); const int Rb = Epi::PERM ? ((R & ~31) + perm32(R & 31)) : R;
        voffA[i] = (unsigned)(R * K + C) * 2u; voffB[i] = (unsigned)(Rb * K + C) * 2u; }
    const size_t kstep = (size_t)(BK * 2);
    const size_t hstep = (size_t)HALF * K * 2;
    const size_t tstep = 2 * hstep;
    const unsigned ldsw = (unsigned)wid * 1024u;
    const int aoff = lds_byte(wr * 64 + fr, fq * 8), boff = lds_byte(wc * 32 + fr, fq * 8);
#define PG8_SA(b, h) (((b) * 2 + (h)) * HTB)
#define PG8_SB(b, h) ((4 + (b) * 2 + (h)) * HTB)
#define PG8_STAGE(bufoff, gbase, voff) do { _Pragma("unroll") for (int _i = 0; _i < 2; ++_i) \
        __builtin_amdgcn_global_load_lds((const unsigned*)((const char*)(gbase) + (voff)[_i]), (PG8_LAS unsigned*)(lds + (bufoff) + ldsw + _i * 8192), 16, 0, 0); } while (0)
#define PG8_LDA(dst, b, h) do { _Pragma("unroll") for (int m = 0; m < 4; ++m) _Pragma("unroll") for (int k = 0; k < 2; ++k) dst[m][k] = *(const PG8_LAS bf16x8*)(lds + PG8_SA(b, h) + aoff + m * 2048 + k * 1024); } while (0)
#define PG8_LDB(dst, b, h) do { _Pragma("unroll") for (int n = 0; n < 2; ++n) _Pragma("unroll") for (int k = 0; k < 2; ++k) dst[n][k] = *(const PG8_LAS bf16x8*)(lds + PG8_SB(b, h) + boff + n * 2048 + k * 1024); } while (0)
#define PG8_MMA(ai, bj, At, Bt) do { __builtin_amdgcn_s_setprio(1); _Pragma("unroll") for (int m = 0; m < 4; ++m) _Pragma("unroll") for (int n = 0; n < 2; ++n) _Pragma("unroll") for (int k = 0; k < 2; ++k) \
        acc[ai][bj][m][n] = __builtin_amdgcn_mfma_f32_16x16x32_bf16(Bt[n][k], At[m][k], acc[ai][bj][m][n], 0, 0, 0); __builtin_amdgcn_s_setprio(0); } while (0)
#define PG8_WAIT_V(n) asm volatile("s_waitcnt vmcnt(" #n ")" ::: "memory")
#define PG8_WAIT_L(n) asm volatile("s_waitcnt lgkmcnt(" #n ")" ::: "memory")
#define PG8_BAR __builtin_amdgcn_s_barrier()
#define PG8_SCHED __builtin_amdgcn_sched_barrier(0)
    Unit cur, nxt; int ui = 0;
    if (!S.next(0, cur)) return;
    cur.par = 0;
#define PG8_SCALE_DMA(u_) do { if (Epi::SCALE != 0 && wid == 0 && E.rowsq != nullptr) \
        __builtin_amdgcn_global_load_lds((const unsigned*)(E.rowsq + ((Epi::SCALE == 1 ? (u_).pm : (u_).pn) * BM + lane * 4)), (PG8_LAS unsigned*)(lds + STAGE_BYTES + (u_).par * 1024), 16, 0, 0); } while (0)
    PG8_SCALE_DMA(cur);
    f32x4 acc[2][2][4][2];
#pragma unroll
    for (int a = 0; a < 2; ++a)
#pragma unroll
        for (int b = 0; b < 2; ++b)
#pragma unroll
            for (int m = 0; m < 4; ++m)
#pragma unroll
                for (int n = 0; n < 2; ++n) acc[a][b][m][n] = (f32x4){0.f, 0.f, 0.f, 0.f};
    bf16x8 At[4][2], B0[2][2], B1[2][2];
    const char* cA = (const char*)g.A + (size_t)cur.pm * tstep; const char* cB = (const char*)g.Bt + (size_t)cur.pn * tstep;
    S.a_ready(cur);
    if constexpr (SP2) {
        PG8_STAGE(PG8_SB(0, 0), cB, voffB); PG8_STAGE(PG8_SB(0, 1), cB + hstep, voffB); PG8_STAGE(PG8_SA(0, 0), cA, voffA); PG8_STAGE(PG8_SA(0, 1), cA + hstep, voffA);
        if (wr == 1) PG8_BAR;
        PG8_WAIT_V(2); PG8_BAR;
        PG8_STAGE(PG8_SB(1, 0), cB + kstep, voffB); PG8_STAGE(PG8_SA(1, 0), cA + kstep, voffA); PG8_STAGE(PG8_SB(1, 1), cB + hstep + kstep, voffB);
        PG8_WAIT_V(6); PG8_BAR;
    } else {
        PG8_STAGE(PG8_SB(0, 0), cB, voffB); PG8_STAGE(PG8_SA(0, 0), cA, voffA); PG8_STAGE(PG8_SB(0, 1), cB + hstep, voffB); PG8_STAGE(PG8_SA(0, 1), cA + hstep, voffA);
        if (wr == 1) PG8_BAR;
        PG8_WAIT_V(4); PG8_BAR;
        PG8_STAGE(PG8_SB(1, 0), cB + kstep, voffB); PG8_STAGE(PG8_SA(1, 0), cA + kstep, voffA); PG8_STAGE(PG8_SB(1, 1), cB + hstep + kstep, voffB);
        PG8_WAIT_V(6); PG8_BAR;
    }
    for (;;) {
        const bool has_next = S.next(ui + 1, nxt); nxt.par = (ui + 1) & 1;
        const char* nA = has_next ? (const char*)g.A + (size_t)nxt.pm * tstep : cA; const char* nB = has_next ? (const char*)g.Bt + (size_t)nxt.pn * tstep : cB;
        for (int t = 0; t < nt; t += 2) {
            const bool last = (t == nt - 2);
            const char* a1 = cA + (size_t)(t + 1) * kstep;
            const char* a2 = last ? nA : cA + (size_t)(t + 2) * kstep; const char* b2 = last ? nB : cB + (size_t)(t + 2) * kstep;
            const char* a3 = a2 + kstep; const char* b3 = b2 + kstep;
            if (last && has_next) { S.a_ready(nxt); PG8_SCALE_DMA(nxt); }
            if constexpr (SP2) {
            PG8_LDB(B0, 0, 0); PG8_LDB(B1, 0, 1); PG8_SCHED; PG8_LDA(At, 0, 0); PG8_STAGE(PG8_SA(1, 1), a1 + hstep, voffA);
            PG8_WAIT_V(8); PG8_WAIT_L(0); PG8_BAR; PG8_MMA(0, 0, At, B0); PG8_MMA(0, 1, At, B1); PG8_BAR; PG8_SCHED;
            PG8_LDA(At, 0, 1); PG8_STAGE(PG8_SB(0, 0), b2, voffB); PG8_STAGE(PG8_SB(0, 1), b2 + hstep, voffB); PG8_STAGE(PG8_SA(0, 0), a2, voffA);
            PG8_WAIT_V(8); PG8_WAIT_L(0); PG8_BAR; PG8_MMA(1, 0, At, B0); PG8_MMA(1, 1, At, B1); PG8_BAR; PG8_SCHED;
            PG8_LDB(B0, 1, 0); PG8_LDB(B1, 1, 1); PG8_SCHED; PG8_LDA(At, 1, 0); PG8_STAGE(PG8_SA(0, 1), a2 + hstep, voffA);
            PG8_WAIT_V(8); PG8_WAIT_L(0); PG8_BAR; PG8_MMA(0, 0, At, B0); PG8_MMA(0, 1, At, B1); PG8_BAR; PG8_SCHED;
            PG8_LDA(At, 1, 1); PG8_STAGE(PG8_SB(1, 0), b3, voffB); PG8_STAGE(PG8_SB(1, 1), b3 + hstep, voffB); PG8_STAGE(PG8_SA(1, 0), a3, voffA);
            PG8_WAIT_V(8); PG8_WAIT_L(0); PG8_BAR; PG8_MMA(1, 0, At, B0); PG8_MMA(1, 1, At, B1); PG8_BAR; PG8_SCHED;
            } else {
            PG8_LDB(B0, 0, 0); PG8_SCHED; PG8_LDA(At, 0, 0); PG8_STAGE(PG8_SA(1, 1), a1 + hstep, voffA);
            PG8_WAIT_L(8); PG8_BAR; PG8_WAIT_L(0); PG8_MMA(0, 0, At, B0); PG8_BAR; PG8_SCHED;
            PG8_LDB(B1, 0, 1); PG8_STAGE(PG8_SB(0, 0), b2, voffB);
            PG8_BAR; PG8_WAIT_L(0); PG8_MMA(0, 1, At, B1); PG8_BAR;
            PG8_LDA(At, 0, 1); PG8_STAGE(PG8_SA(0, 0), a2, voffA);
            PG8_BAR; PG8_WAIT_L(0); PG8_MMA(1, 0, At, B0); PG8_BAR; PG8_SCHED;
            PG8_STAGE(PG8_SB(0, 1), b2 + hstep, voffB);
            PG8_WAIT_V(6); PG8_BAR; PG8_MMA(1, 1, At, B1); PG8_BAR;
            PG8_LDB(B0, 1, 0); PG8_SCHED; PG8_LDA(At, 1, 0); PG8_STAGE(PG8_SA(0, 1), a2 + hstep, voffA);
            PG8_WAIT_L(8); PG8_BAR; PG8_WAIT_L(0); PG8_MMA(0, 0, At, B0); PG8_BAR; PG8_SCHED;
            PG8_LDB(B1, 1, 1); PG8_STAGE(PG8_SB(1, 0), b3, voffB);
            PG8_BAR; PG8_WAIT_L(0); PG8_MMA(0, 1, At, B1); PG8_BAR;
            PG8_LDA(At, 1, 1); PG8_STAGE(PG8_SA(1, 0), a3, voffA);
            PG8_BAR; PG8_WAIT_L(0); PG8_MMA(1, 0, At, B0); PG8_BAR; PG8_SCHED;
            PG8_STAGE(PG8_SB(1, 1), b3 + hstep, voffB);
            PG8_WAIT_V(6); PG8_BAR; PG8_MMA(1, 1, At, B1); PG8_BAR;
            }
        }
        if constexpr (ALIGN_EPI) { if (wr == 0) PG8_BAR; }
        if constexpr (!Epi::AFTER_DRAIN) { E(acc, cur, wr, wc, fr, fq); S.done(cur); }
        if (!has_next) break;
#pragma unroll
        for (int a = 0; a < 2; ++a)
#pragma unroll
            for (int b = 0; b < 2; ++b)
#pragma unroll
                for (int m = 0; m < 4; ++m)
#pragma unroll
                    for (int n = 0; n < 2; ++n) acc[a][b][m][n] = (f32x4){0.f, 0.f, 0.f, 0.f};
        cur = nxt; cA = nA; cB = nB; ++ui;
        if constexpr (ALIGN_EPI) { if (wr == 1) PG8_BAR; }
    }
    PG8_WAIT_V(0);
    if constexpr (!ALIGN_EPI) { if (wr == 0) PG8_BAR; }
    PG8_BAR;
    if constexpr (Epi::AFTER_DRAIN) { E.fused(acc, cur, wr, wc, fr, fq, lds, wid, lane); S.done(cur); }
#undef PG8_SCALE_DMA
#undef PG8_SA
#undef PG8_SB
#undef PG8_STAGE
#undef PG8_LDA
#undef PG8_LDB
#undef PG8_MMA
#undef PG8_WAIT_V
#undef PG8_WAIT_L
#undef PG8_BAR
#undef PG8_SCHED
}
}

constexpr int NWAVES = 8;
#ifndef MK_N_LAUNCHES
#define MK_N_LAUNCHES 1
#endif
constexpr int PER_PHASE = 8;
constexpr int N_LAUNCHES = MK_N_LAUNCHES;
constexpr int BATCH = 16, SEQ = 2048, D = 1024, M = BATCH * SEQ, FF = 2816, NPROJ = 3584;
constexpr int AW = 512, HW = 512, NCHUNK = SEQ / 64;
constexpr float RMS_EPS = 1e-6f, LOG2E = 1.4426950408889634f;
#ifndef WGM_GU
#define WGM_GU 4
#endif
#ifndef WGM_DOWN
#define WGM_DOWN 4
#endif
#ifndef WGM_OUT
#define WGM_OUT 4
#endif
#ifndef WGM_IN
#define WGM_IN 4
#endif
#ifndef WGM_INT
#define WGM_INT 4
#endif

constexpr size_t MiB = 1u << 20;
constexpr size_t WS_CTL = 0, CTL_ZERO_BYTES = 1 * MiB;
constexpr size_t WS_RS1 = 256 * 1024, WS_RS2 = 384 * 1024;
constexpr size_t WS_LB = 1 * MiB, WS_DM = 2 * MiB, WS_DE = 3 * MiB;
constexpr size_t WS_WGU1 = 4 * MiB, WS_WD1 = 15 * MiB, WS_WIN = 21 * MiB, WS_WINT = 26 * MiB, WS_WOUT = 28 * MiB, WS_WGU2 = 30 * MiB, WS_WD2 = 41 * MiB;
constexpr size_t WS_XB = 48 * MiB;
constexpr size_t WS_MIX = 112 * MiB;
constexpr size_t WS_HID = 176 * MiB;
constexpr size_t WS_Q = 176 * MiB, WS_K = 208 * MiB, WS_VT = 240 * MiB, WS_QT = 272 * MiB, WS_KT = 304 * MiB, WS_VHT = 336 * MiB, WS_G = 368 * MiB, WS_END = 400 * MiB;
static_assert(WS_WGU1 + (size_t)2 * FF * D * 2 <= WS_WD1 && WS_WD1 + (size_t)D * FF * 2 <= WS_WIN && WS_WIN + (size_t)2560 * D * 2 <= WS_WINT && WS_WGU2 + (size_t)2 * FF * D * 2 <= WS_WD2 && WS_WD2 + (size_t)D * FF * 2 <= WS_XB, "weight map");
static_assert(WS_HID + (size_t)M * FF * 2 <= WS_END && WS_XB + (size_t)M * D * 2 <= WS_MIX && WS_MIX + (size_t)M * D * 2 <= WS_HID, "activation map");
constexpr int CW_TMO = 0, CW_CODE = 1;
constexpr int CW_BAR = 4096;
constexpr int CW_WQ = 16384;

constexpr int RING_OFF = 0, RING_BYTES = 131072;
constexpr int LDS_BYTES = 163840;
constexpr int LDSCTL_OFF = LDS_BYTES - 1024, MISC_OFF = LDSCTL_OFF + 320;
static_assert(MISC_OFF + 128 <= LDS_BYTES, "LDS map");

#define GAS __attribute__((address_space(1)))
#define LAS __attribute__((address_space(3)))
typedef unsigned short bf16;
typedef unsigned v4u __attribute__((ext_vector_type(4)));
typedef float f32x4 __attribute__((ext_vector_type(4)));
typedef short bf16x8 __attribute__((ext_vector_type(8)));
typedef GAS unsigned gu32;
#define RLX_AGENT __ATOMIC_RELAXED, __HIP_MEMORY_SCOPE_AGENT
#define LDS_WAIT() asm volatile("s_waitcnt lgkmcnt(0)" ::: "memory")
#define VM_WAIT() asm volatile("s_waitcnt vmcnt(0)" ::: "memory")
__device__ __forceinline__ unsigned f2bf(float f) { unsigned u = __builtin_bit_cast(unsigned, f); return (u + 0x7fffu + ((u >> 16) & 1u)) >> 16; }
__device__ __forceinline__ unsigned pk2(float lo, float hi) { return f2bf(lo) | (f2bf(hi) << 16); }
__device__ __forceinline__ float bf2f(unsigned short h) { return __builtin_bit_cast(float, (unsigned)h << 16); }
__device__ __forceinline__ float bflo(unsigned w) { return __builtin_bit_cast(float, w << 16); }
__device__ __forceinline__ float bfhi(unsigned w) { return __builtin_bit_cast(float, w & 0xffff0000u); }

#define XB_TMO      128
#define XB_XCNT(j)  (256  + 64 * (j))
#define XB_XSUB(j)  (1280 + 64 * (j))
#define XB_XGEN(j)  (2304 + 64 * (j))
#define XB_TOP      3328
#define XB_TOPGEN   3392
#define XCD_BAR_WORDS 3456
#define XB_SPIN_CAP (1u << 18)

__device__ __forceinline__ unsigned xb_ld(unsigned* p)              { return __hip_atomic_load(p, __ATOMIC_RELAXED, __HIP_MEMORY_SCOPE_AGENT); }
__device__ __forceinline__ unsigned xb_add(unsigned* p, unsigned v) { return __hip_atomic_fetch_add(p, v, __ATOMIC_RELAXED, __HIP_MEMORY_SCOPE_AGENT); }
__device__ __forceinline__ unsigned xb_xcc_id() { return (unsigned)__builtin_amdgcn_s_getreg((3 << 11) | 20) & 0xFu; }
#define XB_SPIN(cond, bar) do { unsigned _sp = 0; while (cond) { __builtin_amdgcn_s_sleep(1); \
    if ((++_sp & 255u) == 0u) { if (xb_ld(&(bar)[XB_TMO])) break; if (_sp > XB_SPIN_CAP) { atomicAdd(&(bar)[XB_TMO], 1u); break; } } } } while (0)

struct XcdBarrier {
    unsigned* bar; unsigned x;
    volatile LAS unsigned* st;
};

__device__ __forceinline__ XcdBarrier xcd_barrier_post(unsigned* bar, volatile LAS unsigned* st) {
    XcdBarrier b; b.bar = bar; b.x = xb_xcc_id(); b.st = st;
    if (threadIdx.x == 0) (void)xb_add(&bar[XB_XCNT(b.x)], 1u);
    return b;
}
__device__ __forceinline__ void xcd_barrier_complete(unsigned* bar, unsigned x, unsigned& nloc, unsigned& nx) {
    const unsigned G = gridDim.x * gridDim.y * gridDim.z;
    unsigned sum, cnt, mine, sp = 0u;
    for (;;) {
        sum = 0u; cnt = 0u; mine = 0u;
#pragma unroll
        for (unsigned j = 0; j < 16; ++j) { const unsigned c = xb_ld(&bar[XB_XCNT(j)]); sum += c; cnt += (c > 0u) ? 1u : 0u; mine = (j == x) ? c : mine; }
        if (sum == G) break;
        __builtin_amdgcn_s_sleep(1);
        if ((++sp & 255u) == 0u) { if (xb_ld(&bar[XB_TMO])) break; if (sp > XB_SPIN_CAP) { atomicAdd(&bar[XB_TMO], 1u); break; } }
    }
    nloc = mine > 0u ? mine : 1u; nx = cnt > 0u ? cnt : 1u;
}

__device__ __forceinline__ void xcd_barrier(const XcdBarrier& b) {
    asm volatile("s_waitcnt vmcnt(0)" ::: "memory");
    __syncthreads();
    if (threadIdx.x == 0) {
        unsigned* bar = b.bar;
        __builtin_amdgcn_s_waitcnt(0);
        unsigned nloc = b.st[0], nx = b.st[1];
        if (nloc == 0u) { xcd_barrier_complete(bar, b.x, nloc, nx); b.st[0] = nloc; b.st[1] = nx; }
        const unsigned old = xb_add(&bar[XB_XSUB(b.x)], 1u);
        const unsigned gen = old / nloc;
        if (old + 1u == (gen + 1u) * nloc) {
            __builtin_amdgcn_fence(__ATOMIC_RELEASE, "agent");
            asm volatile("s_waitcnt vmcnt(0)" ::: "memory");
            const unsigned og = xb_add(&bar[XB_TOP], 1u);
            const unsigned tg = og / nx;
            if (og + 1u == (tg + 1u) * nx) xb_add(&bar[XB_TOPGEN], 1u);
            else XB_SPIN(xb_ld(&bar[XB_TOPGEN]) == tg, bar);
            __builtin_amdgcn_fence(__ATOMIC_ACQUIRE, "agent");
            xb_add(&bar[XB_XGEN(b.x)], 1u);
            asm volatile("s_waitcnt vmcnt(0)" ::: "memory");
        } else {
            XB_SPIN(xb_ld(&bar[XB_XGEN(b.x)]) == gen, bar);
            __builtin_amdgcn_fence(__ATOMIC_ACQUIRE, "agent");
            asm volatile("s_waitcnt vmcnt(0)" ::: "memory");
        }
    }
    __syncthreads();
}

struct Frame {
    LAS unsigned char* lds;
    volatile LAS unsigned* MISC;
    gu32* ctl;
    int tid, lane, wave, G;
    const float* in[17]; float* out; unsigned char* ws;
};
__device__ __forceinline__ float wave_sum(float v) {
#pragma unroll
    for (int o = 1; o < 64; o <<= 1) v += __shfl_xor(v, o);
    return v;
}
__device__ __forceinline__ int srccol(int kind, int R, int& sel) {
    sel = 0;
    if (kind == 0) return R;
    const int t = R >> 8, p = R & 255, bj = p >> 7, q = p & 127, wc = q >> 5, pr = pg8::perm32(q & 31);
    if (kind == 1) { sel = bj; return 128 * t + 32 * wc + pr; }
    if (kind == 2) {
        if (t < 2) return 64 * (4 * t + wc) + 32 * bj + pr;
        if (t < 4) return 512 + 64 * (4 * (t - 2) + wc) + 32 * bj + pr;
        if (t < 8) return (bj ? 2048 : 1536) + 128 * (t - 4) + 32 * wc + pr;
        return 3072 + 256 * (t - 8) + 128 * bj + 32 * wc + pr;
    }
    return R < 512 ? 1024 + R : 2560 + (R - 512);
}
struct P0Blk { f32x4 v[8]; };
__device__ __forceinline__ void p0_load(P0Blk& t, const float* W0, const float* W1, int N, int kind, int item, int nblk, int lane) {
    const int kb = item / nblk, nb = item % nblk, k0 = 64 * kb + 8 * (lane >> 3), R = 32 * nb + 4 * (lane & 7);
    int sel; const int c = srccol(kind, R, sel);
    const float* W = (sel ? W1 : W0) + (size_t)k0 * N + c;
#pragma unroll
    for (int i = 0; i < 8; ++i) t.v[i] = *(const f32x4*)(W + (size_t)i * N);
}
__device__ __forceinline__ void p0_store(const P0Blk& t, int K, bf16* WT, const float* gain, int kind, int item, int nblk, int lane) {
    const int kb = item / nblk, nb = item % nblk, k0 = 64 * kb + 8 * (lane >> 3), R = 32 * nb + 4 * (lane & 7);
    float gk[8];
    const float ws = kind == 1 ? (((R >> 7) & 1) ? 1.0f / LOG2E : LOG2E) : 1.0f;
#pragma unroll
    for (int i = 0; i < 8; ++i) gk[i] = ws;
    if (gain) { const f32x4 g0 = *(const f32x4*)(gain + k0), g1 = *(const f32x4*)(gain + k0 + 4);
#pragma unroll
        for (int i = 0; i < 4; ++i) { gk[i] = g0[i] * ws; gk[4 + i] = g1[i] * ws; } }
#pragma unroll
    for (int j = 0; j < 4; ++j) { v4u o; o.x = pk2(t.v[0][j] * gk[0], t.v[1][j] * gk[1]); o.y = pk2(t.v[2][j] * gk[2], t.v[3][j] * gk[3]); o.z = pk2(t.v[4][j] * gk[4], t.v[5][j] * gk[5]); o.w = pk2(t.v[6][j] * gk[6], t.v[7][j] * gk[7]);
        *(GAS v4u*)(WT + (size_t)(R + j) * K + k0) = o; }
}
struct P0Job { const float* W0; const float* W1; const float* gain; bf16* WT; int K, N, kind, nblk, item; };
constexpr int P0_I_GU = (D / 64) * (2 * FF / 32), P0_I_D = (FF / 64) * (D / 32), P0_I_IN = (D / 64) * (2560 / 32), P0_I_INT = (D / 64) * (1024 / 32), P0_I_O = (D / 64) * (D / 32);
constexpr int P0_N0 = P0_I_GU + P0_I_D + P0_I_IN + P0_I_INT, P0_N1 = P0_I_GU + P0_I_D + P0_I_O;
__device__ __forceinline__ P0Job p0_job(Frame& F, int set, int it) {
    int r = it;
    if (set == 0) {
        if (r < P0_I_GU) return P0Job{F.in[2], F.in[3], nullptr, (bf16*)(F.ws + WS_WGU1), D, FF, 1, 2 * FF / 32, r}; r -= P0_I_GU;
        if (r < P0_I_D) return P0Job{F.in[4], F.in[4], nullptr, (bf16*)(F.ws + WS_WD1), FF, D, 0, D / 32, r}; r -= P0_I_D;
        if (r < P0_I_IN) return P0Job{F.in[6], F.in[6], F.in[5], (bf16*)(F.ws + WS_WIN), D, NPROJ, 2, 2560 / 32, r}; r -= P0_I_IN;
        return P0Job{F.in[6], F.in[6], F.in[5], (bf16*)(F.ws + WS_WINT), D, NPROJ, 3, 1024 / 32, r};
    }
    if (r < P0_I_GU) return P0Job{F.in[14], F.in[15], F.in[13], (bf16*)(F.ws + WS_WGU2), D, FF, 1, 2 * FF / 32, r}; r -= P0_I_GU;
    if (r < P0_I_D) return P0Job{F.in[16], F.in[16], nullptr, (bf16*)(F.ws + WS_WD2), FF, D, 0, D / 32, r}; r -= P0_I_D;
    return P0Job{F.in[12], F.in[12], nullptr, (bf16*)(F.ws + WS_WOUT), D, D, 0, D / 32, r};
}
__device__ __forceinline__ void p0_weights(Frame& F, int set, int gw, int NGW) {
    const int NIT = set == 0 ? P0_N0 : P0_N1;
    int it = gw;
    if (it < NIT) {
        P0Job j0 = p0_job(F, set, it); P0Blk t0; p0_load(t0, j0.W0, j0.W1, j0.N, j0.kind, j0.item, j0.nblk, F.lane);
        for (;;) {
            const int it1 = it + NGW; const bool more = it1 < NIT;
            P0Job j1 = j0; P0Blk t1;
            if (more) { j1 = p0_job(F, set, it1); p0_load(t1, j1.W0, j1.W1, j1.N, j1.kind, j1.item, j1.nblk, F.lane); }
            p0_store(t0, j0.K, j0.WT, j0.gain, j0.kind, j0.item, j0.nblk, F.lane);
            if (!more) break;
            it = it1; j0 = j1;
#pragma unroll
            for (int i = 0; i < 8; ++i) t0.v[i] = t1.v[i];
        }
    }
}
__device__ __forceinline__ void rms_rows4_to_bf16(const float* x, const float* g, bf16* o, int lane) {
    f32x4 v[4][4]; float s[4];
#pragma unroll
    for (int r = 0; r < 4; ++r)
#pragma unroll
        for (int j = 0; j < 4; ++j) v[r][j] = *((const GAS f32x4*)(x + (size_t)r * D) + lane + 64 * j);
#pragma unroll
    for (int r = 0; r < 4; ++r) { s[r] = 0.f;
#pragma unroll
        for (int j = 0; j < 4; ++j) s[r] += (v[r][j].x * v[r][j].x + v[r][j].y * v[r][j].y) + (v[r][j].z * v[r][j].z + v[r][j].w * v[r][j].w); }
#pragma unroll
    for (int of = 1; of < 64; of <<= 1) {
#pragma unroll
        for (int r = 0; r < 4; ++r) s[r] += __shfl_xor(s[r], of); }
    f32x4 gg[4];
#pragma unroll
    for (int j = 0; j < 4; ++j) gg[j] = *((const GAS f32x4*)g + lane + 64 * j);
#pragma unroll
    for (int r = 0; r < 4; ++r) { const float rr = __builtin_amdgcn_rsqf(s[r] * (1.f / D) + RMS_EPS);
        GAS unsigned long long* o8 = (GAS unsigned long long*)(o + (size_t)r * D) + lane;
#pragma unroll
        for (int j = 0; j < 4; ++j) o8[64 * j] = (unsigned long long)pk2(v[r][j].x * rr * gg[j].x, v[r][j].y * rr * gg[j].y) | ((unsigned long long)pk2(v[r][j].z * rr * gg[j].z, v[r][j].w * rr * gg[j].w) << 32); }
}
__device__ __forceinline__ void p0_prologue(Frame& F, unsigned long long& p0_probe) {
    const int gw = (int)blockIdx.x * NWAVES + F.wave, NGW = F.G * NWAVES;
#if defined(PROBE_PHASE) && (PROBE_PHASE == 13 || PROBE_PHASE == 14)
    const unsigned long long p0_t0 = __builtin_amdgcn_s_memrealtime();
#endif
    p0_weights(F, 0, gw, NGW);
#if defined(PROBE_PHASE) && (PROBE_PHASE == 13 || PROBE_PHASE == 14)
    const unsigned long long tp1_ = __builtin_amdgcn_s_memrealtime();
    if (PROBE_PHASE == 13) p0_probe = tp1_ - p0_t0;
#endif
    for (int m = 4 * gw; m < M; m += 4 * NGW) rms_rows4_to_bf16(F.in[0] + (size_t)m * D, F.in[1], (bf16*)(F.ws + WS_XB) + (size_t)m * D, F.lane);
#if defined(PROBE_PHASE) && (PROBE_PHASE == 13 || PROBE_PHASE == 14)
    if (PROBE_PHASE == 14) p0_probe = __builtin_amdgcn_s_memrealtime() - tp1_;
#endif
    if (blockIdx.x == 0) {
        const float l0 = F.in[10][F.tid], l1 = F.in[10][512 + F.tid], mx = fmaxf(l0, l1), e0 = __expf(l0 - mx), e1 = __expf(l1 - mx);
        ((float*)(F.ws + WS_LB))[F.tid] = e0 / (e0 + e1);
    }
}

typedef float f32x16 __attribute__((ext_vector_type(16)));
typedef float f32x2_t __attribute__((ext_vector_type(2))); typedef __bf16 bf16x2_t __attribute__((ext_vector_type(2)));
__device__ __forceinline__ unsigned cvtpk_s(float lo, float hi) { f32x2_t v = {lo, hi}; bf16x2_t b = __builtin_convertvector(v, bf16x2_t); return __builtin_bit_cast(unsigned, b); }
__device__ __forceinline__ bf16x8 pack_step(const f32x16& x, int s) { v4u p; p.x = cvtpk_s(x[8 * s], x[8 * s + 1]); p.y = cvtpk_s(x[8 * s + 2], x[8 * s + 3]); p.z = cvtpk_s(x[8 * s + 4], x[8 * s + 5]); p.w = cvtpk_s(x[8 * s + 6], x[8 * s + 7]); return __builtin_bit_cast(bf16x8, p); }
__device__ __forceinline__ float swapmax(float m) { auto rr = __builtin_amdgcn_permlane32_swap(__float_as_uint(m), __float_as_uint(m), false, false); return fmaxf(__uint_as_float(rr[0]), __uint_as_float(rr[1])); }
__device__ __forceinline__ float swapsum(float m) { auto rr = __builtin_amdgcn_permlane32_swap(__float_as_uint(m), __float_as_uint(m), false, false); return __uint_as_float(rr[0]) + __uint_as_float(rr[1]); }
__device__ __forceinline__ int pi32(int x) { return (x & 0x13) | ((x & 4) << 1) | ((x & 8) >> 1); }
#define MFMA32(a, b, c) __builtin_amdgcn_mfma_f32_32x32x16_bf16((a), (b), (c), 0, 0, 0)
constexpr int ATT_ETAB_OFF = 0;
__device__ __forceinline__ void attn_item(Frame& F, int b, int c, int h, const LAS float* etab) {
    const bf16* Q = (const bf16*)(F.ws + WS_Q); const bf16* Kp = (const bf16*)(F.ws + WS_K); const bf16* VT = (const bf16*)(F.ws + WS_VT); bf16* MIX = (bf16*)(F.ws + WS_MIX);
    const int lane = F.lane, r32 = lane & 31, hi = lane >> 5;
    const float cfar = F.in[9][h * 257 + 256] * LOG2E;
    bf16x8 qf[2][4];
#pragma unroll
    for (int qb = 0; qb < 2; ++qb)
#pragma unroll
        for (int d0 = 0; d0 < 4; ++d0) qf[qb][d0] = *(const bf16x8*)(Q + (unsigned)((((((b * 8 + h) * 32 + c) * 2 + qb) * 4 + d0) * 64 + lane) * 8));
    f32x16 o[2][2];
#pragma unroll
    for (int db = 0; db < 2; ++db)
#pragma unroll
        for (int qb = 0; qb < 2; ++qb)
#pragma unroll
            for (int r = 0; r < 16; ++r) o[db][qb][r] = 0.f;
    float mrun[2] = {-INFINITY, -INFINITY}, lrun[2] = {0.f, 0.f};
    const int kt0 = c >= 8 ? c - 8 : 0;
    const unsigned fbase = (unsigned)(((b * 8 + h) * 32 * 8 * 64 + lane) * 8);
    const LAS float* et = etab + h * 256;
    bf16x8 kf[2][4], vf[2][4];
#define AT_LOADK(kt_) do { _Pragma("unroll") for (int kb = 0; kb < 2; ++kb) _Pragma("unroll") for (int d0 = 0; d0 < 4; ++d0) kf[kb][d0] = *(const bf16x8*)(Kp + fbase + (unsigned)((((kt_) * 2 + kb) * 4 + d0) * 512)); } while (0)
#define AT_LOADV(kt_) do { _Pragma("unroll") for (int db = 0; db < 2; ++db) _Pragma("unroll") for (int ks = 0; ks < 4; ++ks) vf[db][ks] = *(const bf16x8*)(VT + fbase + (unsigned)((((kt_) * 2 + db) * 4 + ks) * 512)); } while (0)
    AT_LOADK(kt0); AT_LOADV(kt0);
    for (int kt = kt0; kt <= c; ++kt) {
        const int j = c - kt, ktn = kt < c ? kt + 1 : c;
#pragma unroll
        for (int qb = 0; qb < 2; ++qb) {
            f32x16 s[2]; bf16x8 pk[2][2];
            const float c0 = j >= 3 ? cfar : 0.f;
#pragma unroll
            for (int r = 0; r < 16; ++r) { s[0][r] = c0; s[1][r] = c0; }
#pragma unroll
            for (int d0 = 0; d0 < 4; ++d0) { s[0] = MFMA32(kf[0][d0], qf[qb][d0], s[0]); s[1] = MFMA32(kf[1][d0], qf[qb][d0], s[1]); }
            if (qb == 1) { __builtin_amdgcn_sched_barrier(0); AT_LOADK(ktn); __builtin_amdgcn_sched_barrier(0); }
            if (j < 3) {
                const int ib = 64 * j + 32 * qb + r32 - 8 * hi + 63;
#pragma unroll
                for (int kb = 0; kb < 2; ++kb)
#pragma unroll
                    for (int r = 0; r < 16; ++r) s[kb][r] += et[ib - 32 * kb - 16 * (r >> 3) - (r & 7)];
            }
            float tm = fmaxf(s[0][0], s[1][0]);
#pragma unroll
            for (int r = 1; r < 16; ++r) tm = fmaxf(tm, fmaxf(s[0][r], s[1][r]));
            tm = swapmax(tm);
            const float mn = fmaxf(mrun[qb], tm), alpha = __builtin_amdgcn_exp2f(mrun[qb] - mn); mrun[qb] = mn;
            float ls = 0.f;
#pragma unroll
            for (int kb = 0; kb < 2; ++kb)
#pragma unroll
                for (int r = 0; r < 16; ++r) { const float p = __builtin_amdgcn_exp2f(s[kb][r] - mn); s[kb][r] = p; ls += p; }
            lrun[qb] = lrun[qb] * alpha + ls;
#pragma unroll
            for (int db = 0; db < 2; ++db)
#pragma unroll
                for (int r = 0; r < 16; ++r) o[db][qb][r] *= alpha;
#pragma unroll
            for (int kb = 0; kb < 2; ++kb) { pk[kb][0] = pack_step(s[kb], 0); pk[kb][1] = pack_step(s[kb], 1); }
#pragma unroll
            for (int db = 0; db < 2; ++db)
#pragma unroll
                for (int kb = 0; kb < 2; ++kb)
#pragma unroll
                    for (int sp = 0; sp < 2; ++sp) o[db][qb] = MFMA32(vf[db][2 * kb + sp], pk[kb][sp], o[db][qb]);
        }
        __builtin_amdgcn_sched_barrier(0); AT_LOADV(ktn); __builtin_amdgcn_sched_barrier(0);
    }
#undef AT_LOADK
#undef AT_LOADV
#pragma unroll
    for (int qb = 0; qb < 2; ++qb) {
        const float inv = 1.0f / swapsum(lrun[qb]);
        bf16* orow = MIX + (unsigned)((b * SEQ + 64 * c + 32 * qb + r32) * 1024 + h * 64 + 16 * hi);
#pragma unroll
        for (int db = 0; db < 2; ++db) {
            unsigned wx[4], wy[4];
#pragma unroll
            for (int g = 0; g < 4; ++g) { wx[g] = cvtpk_s(o[db][qb][4 * g] * inv, o[db][qb][4 * g + 1] * inv); wy[g] = cvtpk_s(o[db][qb][4 * g + 2] * inv, o[db][qb][4 * g + 3] * inv); }
#pragma unroll
            for (int p = 0; p < 2; ++p) {
                auto ax = __builtin_amdgcn_permlane32_swap(wx[p], wx[p + 2], false, false); auto ay = __builtin_amdgcn_permlane32_swap(wy[p], wy[p + 2], false, false);
                *(v4u*)(orow + 32 * db + 8 * p) = (v4u){ax[0], ay[0], ax[1], ay[1]}; }
        }
    }
}
__device__ __forceinline__ void attn_phase(Frame& F) {
    LAS float* etab = (LAS float*)(F.lds + RING_OFF + ATT_ETAB_OFF);
    for (int i = F.tid; i < 8 * 256; i += NWAVES * 64) { const int h = i >> 8; int rel = (i & 255) - 63; rel = rel > 128 ? 128 : rel; etab[i] = F.in[9][h * 257 + rel + 128] * LOG2E; }
    __syncthreads();
    for (int k = 0; k < 8; ++k) {
        const int shard = ((int)blockIdx.x + k) & 7;
        gu32* head = F.ctl + CW_WQ + 64 * shard;
        for (;;) {
            unsigned n = 0; if (F.lane == 0) n = __hip_atomic_fetch_add(head, 1u, RLX_AGENT);
            n = (unsigned)__builtin_amdgcn_readfirstlane((int)n);
            if (n >= 512u) break;
            const int bh = 8 * (int)(n >> 5) + shard, c = 31 - (int)(n & 31);
            attn_item(F, bh >> 3, c, bh & 7, etab);
        }
    }
    __syncthreads();
}

__device__ __forceinline__ unsigned off_b(unsigned row, unsigned ch) { return 256u * row + 16u * (ch ^ (((row & 3) << 2) | ((row >> 2) & 3))); }
__device__ __forceinline__ unsigned tr_read_addr_b(unsigned lane, unsigned c, unsigned ks, unsigned t) {
    const unsigned h = lane >> 5, blk = (lane >> 4) & 1, q = (lane & 15) >> 2, p = lane & 3;
    return off_b(16 * ks + 8 * h + 4 * t + q, 4 * c + 2 * blk + (p >> 1)) + 8 * (p & 1);
}
typedef short v4i16_t __attribute__((ext_vector_type(4)));
__device__ __forceinline__ v4i16_t lds_tr(const LAS unsigned char* p) { return __builtin_amdgcn_ds_read_tr16_b64_v4i16((LAS v4i16_t*)p); }
__device__ __forceinline__ bf16x8 krow_frag(bf16x8 nat) {
    const v4u d = __builtin_bit_cast(v4u, nat);
    auto a = __builtin_amdgcn_permlane32_swap(d.x, d.z, false, false); auto b = __builtin_amdgcn_permlane32_swap(d.y, d.w, false, false);
    v4u r; r.x = a[0]; r.y = b[0]; r.z = a[1]; r.w = b[1]; return __builtin_bit_cast(bf16x8, r);
}
constexpr int HG_PS_OFF = 8192, HG_DD_OFF = 10240, HG_GN_OFF = 12288, HG_BUF_OFF = 16384;
constexpr int HG_QT_OFF = 16384, HG_VT_OFF = 32768, HG_BUF_BYTES = 49152;
constexpr int HG_OX_OFF = HG_BUF_OFF + 2 * HG_BUF_BYTES, HG_OX_BYTES = 64 * 264;
constexpr int HG_XS_OFF = HG_OX_OFF + 2 * HG_OX_BYTES;
static_assert(HG_XS_OFF + 3 * 2048 <= LDSCTL_OFF && HG_OX_OFF % 16 == 0 && HG_XS_OFF % 16 == 0, "HGRN LDS map");
__device__ __forceinline__ void dma16(const void* g, LAS unsigned char* l) { __builtin_amdgcn_global_load_lds((const unsigned*)g, (LAS unsigned*)l, 16, 0, 0); }
__device__ __forceinline__ void hgrn_finalize(Frame& F, const v4u (&gw)[4], int b, int hh, int c) {
    bf16* MIX = (bf16*)(F.ws + WS_MIX);
    const int ht = F.tid - 256, tok = ht >> 2, pc = ht & 3;
    const LAS float* ps = (const LAS float*)(F.lds + RING_OFF + HG_PS_OFF) + ((c & 1) * 2 + (tok >> 5)) * 128 + (tok & 31);
    const float tot = (ps[0] + ps[32]) + (ps[64] + ps[96]);
    const float rs = __builtin_amdgcn_rsqf(tot * (1.0f / 128.0f) + RMS_EPS);
    const LAS unsigned char* ox = F.lds + RING_OFF + HG_OX_OFF + (c & 1) * HG_OX_BYTES + tok * 264 + 64 * pc;
    const LAS f32x4* gn = (const LAS f32x4*)(F.lds + RING_OFF + HG_GN_OFF) + 8 * pc;
    bf16* dst = MIX + (unsigned)((b * SEQ + 64 * c + tok) * 1024 + 512 + hh * 128 + 32 * pc);
#pragma unroll
    for (int q = 0; q < 4; ++q) { unsigned ow[4]; const unsigned g4w[4] = {gw[q].x, gw[q].y, gw[q].z, gw[q].w};
#pragma unroll
        for (int i = 0; i < 2; ++i) { const pg8::u32x2 o2 = *(const LAS pg8::u32x2*)(ox + 16 * q + 8 * i); const f32x4 g4 = gn[2 * q + i];
            ow[2 * i] = cvtpk_s(bflo(o2.x) * rs * g4[0] * bflo(g4w[2 * i]), bfhi(o2.x) * rs * g4[1] * bfhi(g4w[2 * i]));
            ow[2 * i + 1] = cvtpk_s(bflo(o2.y) * rs * g4[2] * bflo(g4w[2 * i + 1]), bfhi(o2.y) * rs * g4[3] * bfhi(g4w[2 * i + 1])); }
        *(v4u*)(dst + 8 * q) = (v4u){ow[0], ow[1], ow[2], ow[3]}; }
}
__device__ __forceinline__ void hgrn_phase(Frame& F, int bh, unsigned long long& hg_wait_acc) {
    (void)hg_wait_acc;
    const unsigned char* QT = F.ws + WS_QT; const unsigned char* KT = F.ws + WS_KT; const unsigned char* VHT = F.ws + WS_VHT; const bf16* Gt = (const bf16*)(F.ws + WS_G);
    const unsigned char* DM = F.ws + WS_DM; const unsigned char* DE = F.ws + WS_DE;
    const int b = bh >> 2, hh = bh & 3, lane = F.lane, r32 = lane & 31, hi = lane >> 5, w = F.wave, tid = F.tid;
    LAS unsigned char* const bufs = F.lds + RING_OFF + HG_BUF_OFF;
    LAS float* const psw = (LAS float*)(F.lds + RING_OFF + HG_PS_OFF);
    LAS float* const ddw = (LAS float*)(F.lds + RING_OFF + HG_DD_OFF);
    if (tid < 128) ((LAS float*)(F.lds + RING_OFF + HG_GN_OFF))[tid] = F.in[11][tid];
    if (w >= 4) {
        const int hw = w - 4;
        unsigned so_k[4], so_v[4];
#pragma unroll
        for (int j = 0; j < 4; ++j) { const unsigned ii = (unsigned)(hw + 4 * j), sl = ii * 64 + lane;
            { const unsigned img = sl >> 9, s9 = sl & 511, row = s9 >> 4, ch = (s9 & 15) ^ (((row & 3) << 2) | ((row >> 2) & 3)); so_k[j] = ((32 * img + row) * 512 + hh * 128) * 2 + ch * 16; }
            { const unsigned row = sl >> 3, ch = (sl & 7) ^ (row & 7); so_v[j] = ((hh * 128 + row) * SEQ) * 2 + ch * 16; } }
        const unsigned so_d = (unsigned)((hh * 128) * 4 + (lane & 31) * 16);
        const unsigned char* const ddsrc = (lane < 32 ? DM : DE) + (size_t)(b * NCHUNK) * 2048 + so_d;
        const unsigned char* const ktb = KT + (size_t)(b * SEQ) * 1024; const unsigned char* const qtb = QT + (size_t)(b * SEQ) * 1024; const unsigned char* const vtb = VHT + (size_t)(b * 512) * SEQ * 2;
#define HG_DMA(c_) do { LAS unsigned char* nb_ = bufs + ((c_) & 1) * HG_BUF_BYTES + hw * 1024; const size_t ck_ = (size_t)(c_) * 65536, cv_ = (size_t)(c_) * 128; \
        _Pragma("unroll") for (int j_ = 0; j_ < 4; ++j_) { dma16(ktb + ck_ + so_k[j_], nb_ + j_ * 4096); dma16(qtb + ck_ + so_k[j_], nb_ + HG_QT_OFF + j_ * 4096); dma16(vtb + cv_ + so_v[j_], nb_ + HG_VT_OFF + j_ * 4096); } \
        if (hw == 0) dma16(ddsrc + (size_t)(c_) * 2048, (LAS unsigned char*)(ddw + ((c_) & 1) * 256)); } while (0)
        const unsigned src_g = (unsigned)((b * SEQ + ((tid - 256) >> 2)) * 512 + hh * 128 + 32 * (tid & 3));
        const unsigned rk_ = (unsigned)pi32(r32), sk_ = ((rk_ & 3) << 2) | ((rk_ >> 2) & 3), sq_ = (((unsigned)r32 & 3) << 2) | (((unsigned)r32 >> 2) & 3);
        const unsigned kt_base = 256u * rk_ + 16u * ((unsigned)hi ^ (sk_ & 1)), kt_e = sk_ >> 1, qt_base = (unsigned)HG_QT_OFF + 256u * (unsigned)r32 + 16u * ((unsigned)hi ^ (sq_ & 1)), qt_e = sq_ >> 1;
        HG_DMA(0);
        asm volatile("s_waitcnt vmcnt(0) lgkmcnt(0)" ::: "memory"); __builtin_amdgcn_s_barrier(); asm volatile("" ::: "memory");
        for (int c = 0; c <= NCHUNK; ++c) {
            if (c + 1 < NCHUNK) HG_DMA(c + 1);
            if (hw < 3 && c < NCHUNK) {
                const LAS unsigned char* buf = bufs + (c & 1) * HG_BUF_BYTES;
                const int sbx = hw >> 1, tbx = (hw + 1) >> 1;
                unsigned ek = kt_e, eq = qt_e; asm volatile("" : "+v"(ek), "+v"(eq));
                f32x16 X;
#pragma unroll
                for (int r = 0; r < 16; ++r) X[r] = 0.f;
#pragma unroll
                for (int ks = 0; ks < 8; ++ks) { const bf16x8 kf = *(const LAS bf16x8*)(buf + sbx * 8192 + kt_base + (((unsigned)ks ^ ek) << 5)), qf = *(const LAS bf16x8*)(buf + tbx * 8192 + qt_base + (((unsigned)ks ^ eq) << 5)); X = MFMA32(kf, qf, X); }
                if (sbx == tbx) {
                    int thr = r32 - 8 * hi; asm volatile("" : "+v"(thr));
#pragma unroll
                    for (int r = 0; r < 16; ++r) X[r] = thr >= 16 * (r >> 3) + (r & 7) ? X[r] : 0.f;
                }
                LAS unsigned char* xw = F.lds + RING_OFF + HG_XS_OFF + hw * 2048 + lane * 16;
                *(LAS bf16x8*)xw = pack_step(X, 0); *(LAS bf16x8*)(xw + 1024) = pack_step(X, 1);
            }
            if (c > 0) { const bf16* gcp = Gt + (size_t)((c - 1) * 64 * 512); v4u gc[4];
#pragma unroll
                for (int q = 0; q < 4; ++q) gc[q] = *(const v4u*)(gcp + src_g + 8 * q);
                hgrn_finalize(F, gc, b, hh, c - 1); }
            asm volatile("s_waitcnt lgkmcnt(0)" ::: "memory"); __builtin_amdgcn_s_barrier(); asm volatile("" ::: "memory");
            asm volatile("s_waitcnt vmcnt(0) lgkmcnt(0)" ::: "memory"); __builtin_amdgcn_s_barrier(); asm volatile("" ::: "memory");
        }
#undef HG_DMA
    } else {
        const int vb = w;
        f32x16 S[4];
#pragma unroll
        for (int kb = 0; kb < 4; ++kb)
#pragma unroll
            for (int r = 0; r < 16; ++r) S[kb][r] = 0.f;
        const unsigned rk_ = (unsigned)pi32(r32), sk_ = ((rk_ & 3) << 2) | ((rk_ >> 2) & 3), sq_ = (((unsigned)r32 & 3) << 2) | (((unsigned)r32 >> 2) & 3);
        const unsigned kt_base = 256u * rk_ + 16u * ((unsigned)hi ^ (sk_ & 1)), kt_e = sk_ >> 1, qt_base = (unsigned)HG_QT_OFF + 256u * (unsigned)r32 + 16u * ((unsigned)hi ^ (sq_ & 1)), qt_e = sq_ >> 1;
        unsigned rd_tr[4][2], rd_vt[4];
#pragma unroll
        for (int kb = 0; kb < 4; ++kb) { rd_tr[kb][0] = tr_read_addr_b((unsigned)lane, (unsigned)kb, 0u, 0u); rd_tr[kb][1] = tr_read_addr_b((unsigned)lane, (unsigned)kb, 0u, 1u); }
#pragma unroll
        for (int k4 = 0; k4 < 4; ++k4) rd_vt[k4] = (unsigned)(HG_VT_OFF + (32 * vb + r32) * 128 + (((2 * k4 + hi) ^ (r32 & 7)) << 4));
        const unsigned wr_ox = (unsigned)(HG_OX_OFF + r32 * 264 + (32 * vb + 4 * hi) * 2);
        asm volatile("s_waitcnt vmcnt(0) lgkmcnt(0)" ::: "memory"); __builtin_amdgcn_s_barrier(); asm volatile("" ::: "memory");
        for (int c = 0; c <= NCHUNK; ++c) {
            const LAS unsigned char* buf = bufs + (c & 1) * HG_BUF_BYTES;
            f32x16 o[2]; bf16x8 vfr[4];
            if (c < NCHUNK) {
            const LAS float* dd = ddw + (c & 1) * 256 + 4 * hi;
#pragma unroll
            for (int kb = 0; kb < 4; ++kb)
#pragma unroll
                for (int g = 0; g < 4; ++g) { const f32x4 a = *(const LAS f32x4*)(dd + 32 * kb + 8 * g);
#pragma unroll
                    for (int i = 0; i < 4; ++i) S[kb][4 * g + i] *= a[i]; }
            unsigned ek = kt_e, eq = qt_e; asm volatile("" : "+v"(ek), "+v"(eq));
#define HG_RDKT(ks_) (kt_base + (((unsigned)(ks_) ^ ek) << 5))
#define HG_RDQT(ks_) (qt_base + (((unsigned)(ks_) ^ eq) << 5))
            __builtin_amdgcn_sched_barrier(0);
#pragma unroll
            for (int k4 = 0; k4 < 4; ++k4) vfr[k4] = *(const LAS bf16x8*)(buf + rd_vt[k4]);
#pragma unroll
            for (int r = 0; r < 16; ++r) { o[0][r] = 0.f; o[1][r] = 0.f; }
#pragma unroll
            for (int kb = 0; kb < 4; ++kb)
#pragma unroll
                for (int sp = 0; sp < 2; ++sp) { const bf16x8 sf = pack_step(S[kb], sp);
                    const bf16x8 q0 = *(const LAS bf16x8*)(buf + HG_RDQT(2 * kb + sp)), q1 = *(const LAS bf16x8*)(buf + 8192 + HG_RDQT(2 * kb + sp));
                    o[0] = MFMA32(sf, krow_frag(q0), o[0]); o[1] = MFMA32(sf, krow_frag(q1), o[1]); }
            __builtin_amdgcn_sched_barrier(0);
#pragma unroll
            for (int kb = 0; kb < 4; ++kb) {
#pragma unroll
                for (int k4 = 0; k4 < 4; ++k4) {
                    const LAS unsigned char* ip = buf + (k4 >> 1) * 8192 + (k4 & 1) * 4096;
                    const v4i16_t lo = lds_tr(ip + rd_tr[kb][0]), hi4 = lds_tr(ip + rd_tr[kb][1]);
                    const bf16x8 af = __builtin_shufflevector(lo, hi4, 0, 1, 2, 3, 4, 5, 6, 7);
                    S[kb] = MFMA32(af, vfr[k4], S[kb]);
                }
#pragma unroll
                for (int g = 0; g < 4; ++g) { const f32x4 a = *(const LAS f32x4*)(dd + 128 + 32 * kb + 8 * g);
#pragma unroll
                    for (int i = 0; i < 4; ++i) S[kb][4 * g + i] *= a[i]; }
            }
            }
            asm volatile("s_waitcnt lgkmcnt(0)" ::: "memory"); __builtin_amdgcn_s_barrier(); asm volatile("" ::: "memory");
            if (c < NCHUNK) {
            { const LAS unsigned char* xr = F.lds + RING_OFF + HG_XS_OFF + lane * 16;
              o[0] = MFMA32(vfr[0], *(const LAS bf16x8*)(xr), o[0]); o[0] = MFMA32(vfr[1], *(const LAS bf16x8*)(xr + 1024), o[0]);
              o[1] = MFMA32(vfr[0], *(const LAS bf16x8*)(xr + 2048), o[1]); o[1] = MFMA32(vfr[1], *(const LAS bf16x8*)(xr + 3072), o[1]);
              o[1] = MFMA32(vfr[2], *(const LAS bf16x8*)(xr + 4096), o[1]); o[1] = MFMA32(vfr[3], *(const LAS bf16x8*)(xr + 5120), o[1]); }
#pragma unroll
            for (int tbi = 0; tbi < 2; ++tbi) { float q = 0.f;
#pragma unroll
              for (int r = 0; r < 16; ++r) q += o[tbi][r] * o[tbi][r];
              q = swapsum(q);
              if (hi == 0) psw[((c & 1) * 2 + tbi) * 128 + vb * 32 + r32] = q;
              LAS unsigned char* oxw = F.lds + RING_OFF + (c & 1) * HG_OX_BYTES + wr_ox + tbi * 32 * 264;
#pragma unroll
              for (int g = 0; g < 4; ++g) *(LAS pg8::u32x2*)(oxw + 16 * g) = (pg8::u32x2){cvtpk_s(o[tbi][4 * g], o[tbi][4 * g + 1]), cvtpk_s(o[tbi][4 * g + 2], o[tbi][4 * g + 3])}; }
            }
            asm volatile("s_waitcnt vmcnt(0) lgkmcnt(0)" ::: "memory"); __builtin_amdgcn_s_barrier(); asm volatile("" ::: "memory");
        }
#undef HG_RDKT
#undef HG_RDQT
    }
    __syncthreads();
}

struct Args { const float* in[17]; float* out; unsigned char* ws; int ph_lo, ph_hi, li, pad; };
__global__ void __launch_bounds__(NWAVES * 64, 2) mega_fwd(Args args) {
    extern __shared__ __attribute__((aligned(16))) unsigned char lds[];
    Frame F;
    F.lds = (LAS unsigned char*)lds;
    F.MISC = (volatile LAS unsigned*)(F.lds + MISC_OFF);
    F.tid = threadIdx.x; F.lane = F.tid & 63; F.wave = __builtin_amdgcn_readfirstlane(F.tid >> 6);
    F.G = gridDim.x;
#pragma unroll
    for (int i = 0; i < 17; ++i) F.in[i] = args.in[i];
    F.out = args.out; F.ws = args.ws;
    F.ctl = (gu32*)(args.ws + WS_CTL);
    for (int u = F.tid; u < (LDS_BYTES - LDSCTL_OFF) / 4; u += NWAVES * 64) ((LAS unsigned*)(F.lds + LDSCTL_OFF))[u] = 0u;
    __syncthreads();
    XcdBarrier bar; bar.bar = (unsigned*)(F.ctl + CW_BAR); bar.x = 0; bar.st = nullptr;
    if (N_LAUNCHES != PER_PHASE) bar = xcd_barrier_post((unsigned*)(F.ctl + CW_BAR), F.MISC + 8);
#define GRID_BAR(seam) do { if (N_LAUNCHES == PER_PHASE) { if (F.tid == 0) __hip_atomic_store(F.ctl + CW_TMO, 0xBADBA0u | (unsigned)(seam), RLX_AGENT); } else { xcd_barrier(bar); } } while (0)
    const int lo = args.ph_lo, hi = args.ph_hi;
#ifdef PROBE_PHASE
    unsigned long long ts_prev = __builtin_amdgcn_s_memrealtime(), ts_dt = 0ull; int ts_k = 0;
#define STAMP() do { const unsigned long long t_ = __builtin_amdgcn_s_memrealtime(); if (ts_k == PROBE_PHASE) ts_dt = t_ - ts_prev; ts_prev = t_; ++ts_k; } while (0)
#else
#define STAMP() do {} while (0)
#endif
#define IN(k) (lo <= (k) && (k) < hi)
#define BOTH(k) (IN(k) && IN((k) + 1))
    bf16* const XB = (bf16*)(F.ws + WS_XB); bf16* const HID = (bf16*)(F.ws + WS_HID); bf16* const MIXp = (bf16*)(F.ws + WS_MIX);
    float* const RS1 = (float*)(F.ws + WS_RS1); float* const RS2 = (float*)(F.ws + WS_RS2);
    const LAS float* const SCL = (const LAS float*)(F.lds + RING_OFF + RING_BYTES);

    if (IN(0)) { unsigned long long p0_probe = 0ull; p0_prologue(F, p0_probe);
#if defined(PROBE_PHASE) && (PROBE_PHASE == 13 || PROBE_PHASE == 14)
        ts_dt = p0_probe;
#endif
        if (BOTH(0)) GRID_BAR(0); STAMP(); }
    if (IN(1)) {
        pg8::Gemm g{XB, (const bf16*)(F.ws + WS_WGU1), M, 2 * FF, D}; pg8::StaticOrder S; S.init(M, 2 * FF, F.G, (int)blockIdx.x, WGM_GU);
        pg8::EpiSwiGLU E{HID, nullptr, SCL, FF};
        pg8::gemm_phase<pg8::EpiSwiGLU, pg8::StaticOrder, true, true>(F.lds + RING_OFF, g, S, E);
        if (BOTH(1)) GRID_BAR(1); STAMP();
    }
    if (IN(2)) {
        pg8::Gemm g{HID, (const bf16*)(F.ws + WS_WD1), M, D, FF}; pg8::StaticOrder S; S.init(M, D, F.G, (int)blockIdx.x, WGM_DOWN);
        pg8::EpiRes<0> E{F.in[0], nullptr, XB, RS1, 0.5f};
        pg8::gemm_phase<pg8::EpiRes<0>, pg8::StaticOrder, true, true>(F.lds + RING_OFF, g, S, E);
        if (BOTH(2)) GRID_BAR(2); STAMP();
    }
    if (IN(3)) {
        { pg8::Gemm g{XB, (const bf16*)(F.ws + WS_WIN), M, 2560, D}; pg8::StaticOrder S; S.init(M, 2560, F.G, (int)blockIdx.x, WGM_IN);
          pg8::EpiWin E{(bf16*)(F.ws + WS_Q), (bf16*)(F.ws + WS_K), (bf16*)(F.ws + WS_QT), (bf16*)(F.ws + WS_KT), (bf16*)(F.ws + WS_G), (float*)(F.ws + WS_DM), (float*)(F.ws + WS_DE), RS1, F.in[7], F.in[8], (const float*)(F.ws + WS_LB), SCL};
          pg8::gemm_phase<pg8::EpiWin, pg8::StaticOrder, true, true>(F.lds + RING_OFF, g, S, E); }
        { pg8::Gemm g{(const bf16*)(F.ws + WS_WINT), XB, 1024, M, D}; pg8::StaticOrder S; S.init(1024, M, F.G, (int)blockIdx.x, WGM_INT);
          pg8::EpiVT E{(bf16*)(F.ws + WS_VT), (bf16*)(F.ws + WS_VHT), RS1, SCL};
          pg8::gemm_phase<pg8::EpiVT, pg8::StaticOrder, true, true>(F.lds + RING_OFF, g, S, E); }
        if (BOTH(3)) GRID_BAR(3); STAMP();
    }
    if (IN(4)) {
#ifdef PROBE_PHASE
        const unsigned long long th00_ = __builtin_amdgcn_s_memrealtime();
#endif
#ifdef PROBE_PHASE
        const unsigned long long th0_ = __builtin_amdgcn_s_memrealtime();
        if (PROBE_PHASE == 9) ts_dt = th0_ - th00_;
#endif
        unsigned long long hg_wait_acc = 0ull;
        if (blockIdx.x < 64) hgrn_phase(F, (int)blockIdx.x, hg_wait_acc);
#ifdef PROBE_PHASE
        if (PROBE_PHASE == 11 || PROBE_PHASE == 12) ts_dt = hg_wait_acc;
#endif
#ifdef PROBE_PHASE
        if (PROBE_PHASE == 8) ts_dt = __builtin_amdgcn_s_memrealtime() - th0_;
#endif
#ifdef PROBE_PHASE
        const unsigned long long ta0_ = __builtin_amdgcn_s_memrealtime();
#endif
        attn_phase(F);
        if (blockIdx.x >= 64) p0_weights(F, 1, ((int)blockIdx.x - 64) * NWAVES + F.wave, (F.G - 64) * NWAVES);
#ifdef PROBE_PHASE
        if (PROBE_PHASE == 10) ts_dt = __builtin_amdgcn_s_memrealtime() - ta0_;
#endif
        if (BOTH(4)) GRID_BAR(4); STAMP();
    }
    if (IN(5)) {
        pg8::Gemm g{MIXp, (const bf16*)(F.ws + WS_WOUT), M, D, D}; pg8::StaticOrder S; S.init(M, D, F.G, (int)blockIdx.x, WGM_OUT);
        pg8::EpiRes<1> E{nullptr, nullptr, XB, RS2, 1.0f};
        pg8::gemm_phase<pg8::EpiRes<1>, pg8::StaticOrder, true, true>(F.lds + RING_OFF, g, S, E);
        if (BOTH(5)) GRID_BAR(5); STAMP();
    }
    if (IN(6)) {
        pg8::Gemm g{XB, (const bf16*)(F.ws + WS_WGU2), M, 2 * FF, D}; pg8::StaticOrder S; S.init(M, 2 * FF, F.G, (int)blockIdx.x, WGM_GU);
        pg8::EpiSwiGLU E{HID, RS2, SCL, FF};
        pg8::gemm_phase<pg8::EpiSwiGLU, pg8::StaticOrder, true, true>(F.lds + RING_OFF, g, S, E);
        if (BOTH(6)) GRID_BAR(6); STAMP();
    }
    if (IN(7)) {
        pg8::Gemm g{HID, (const bf16*)(F.ws + WS_WD2), M, D, FF}; pg8::StaticOrder S; S.init(M, D, F.G, (int)blockIdx.x, WGM_DOWN);
        pg8::EpiRes<2> E{nullptr, F.out, XB, nullptr, 0.5f};
        pg8::gemm_phase<pg8::EpiRes<2>, pg8::StaticOrder, true, true>(F.lds + RING_OFF, g, S, E);
    }
#ifdef PROBE_PHASE
    __syncthreads(); STAMP();
    if (blockIdx.x == (PROBE_PHASE == 10 ? 255 : 0) && F.tid == 0) { const unsigned long long t0_ = __builtin_amdgcn_s_memrealtime(); while (__builtin_amdgcn_s_memrealtime() - t0_ < 4ull * ts_dt) __builtin_amdgcn_s_sleep(8); }
#endif
#undef IN
#undef BOTH
}

extern "C" void kernel_launch(void* const* d_in, const int* in_sizes, int n_in, void* d_out, int out_size, void* d_ws, size_t ws_size, hipStream_t stream) {
    static int grid = 0;
    if (grid == 0) {
        if (n_in != 17 || in_sizes[0] != M * D || out_size != M * D || ws_size < WS_END) { fprintf(stderr, "kernel_launch: unexpected shapes (n_in %d, in0 %d, out %d, ws %zu); nothing launched\n", n_in, n_in > 0 ? in_sizes[0] : -1, out_size, ws_size); grid = -1; return; }
        int dev = 0, cus = 0, per_cu = 0;
        if (hipGetDevice(&dev) != hipSuccess || hipDeviceGetAttribute(&cus, hipDeviceAttributeMultiprocessorCount, dev) != hipSuccess) { grid = -1; return; }
        if (hipFuncSetAttribute((const void*)mega_fwd, hipFuncAttributeMaxDynamicSharedMemorySize, LDS_BYTES) != hipSuccess) { fprintf(stderr, "kernel_launch: hipFuncSetAttribute failed\n"); grid = -1; return; }
        if (hipOccupancyMaxActiveBlocksPerMultiprocessor(&per_cu, (const void*)mega_fwd, NWAVES * 64, LDS_BYTES) != hipSuccess || per_cu < 1) fprintf(stderr, "kernel_launch: note: occupancy query reports %d workgroups per CU\n", per_cu);
        (void)hipGetLastError();
        grid = cus;
    }
    if (grid < 0) return;
    if (hipMemsetAsync((char*)d_ws + WS_CTL, 0, CTL_ZERO_BYTES, stream) != hipSuccess) { fprintf(stderr, "kernel_launch: hipMemsetAsync failed\n"); return; }
    Args a{};
    for (int i = 0; i < 17; ++i) a.in[i] = (const float*)d_in[i];
    a.out = (float*)d_out; a.ws = (unsigned char*)d_ws;
    for (int li = 0; li < N_LAUNCHES; ++li) {
        a.ph_lo = (N_LAUNCHES == PER_PHASE) ? li : 0; a.ph_hi = (N_LAUNCHES == PER_PHASE) ? li + 1 : PER_PHASE; a.li = li;
        hipLaunchKernelGGL(mega_fwd, dim3(grid), dim3(NWAVES * 64), LDS_BYTES, stream, a);
        const hipError_t le = hipPeekAtLastError();
        if (le != hipSuccess) { fprintf(stderr, "kernel_launch: launch %d failed: %s\n", li, hipGetErrorName(le)); break; }
    }
}
```

```cpp
#include <hip/hip_runtime.h>
#include <cstdio>
#include <cstdint>
namespace pg8 {
#define PG8_LAS __attribute__((address_space(3)))
typedef unsigned short bf16_t;
typedef short bf16x8 __attribute__((ext_vector_type(8)));
typedef float f32x4 __attribute__((ext_vector_type(4)));
typedef unsigned u32x4 __attribute__((ext_vector_type(4)));
constexpr int BM = 256, BK = 64, HALF = 128, HTB = HALF * BK * 2  , STAGE_BYTES = 8 * HTB, NXCD = 8, WGM = 4;

__host__ __device__ __forceinline__ int lds_byte(int r, int c) { const int st = (r >> 4) * 2 + (c >> 5), rr = r & 15, cc = c & 31, ob = rr * 64 + cc * 2; return st * 1024 + (ob ^ (((ob >> 9) & 1) << 5)); }
__host__ __device__ __forceinline__ void stage_rc(int b, int& R, int& C) { const int st = b / 1024, sb = b % 1024, swz = sb ^ (((sb >> 9) & 1) << 5); R = (st >> 1) * 16 + swz / 64; C = (st & 1) * 32 + (swz % 64) / 2; }
__host__ __device__ __forceinline__ int perm32(int rho) { const int n = rho >> 4, i = rho & 15; return 8 * (i >> 2) + 4 * n + (i & 3); }

struct Unit { int pm, pn, par; };
struct Gemm { const bf16_t* A; const bf16_t* Bt; int M, N, K; };

struct StaticOrder {
    int nM, nN, nwg, G, c, wgm;
    __host__ __device__ void init(int M, int N, int G_, int c_, int wgm_ = WGM) { nM = M / BM; nN = N / BM; nwg = nM * nN; G = G_; c = c_; wgm = wgm_; }
    __host__ __device__ bool next(int i, Unit& u) const {
        const long L = (long)i * G + c; if (L >= nwg) return false;
        int wgid = (int)L; { const int q = nwg / NXCD, r = nwg % NXCD, xcd = wgid % NXCD, off = wgid / NXCD; wgid = (xcd < r ? xcd * (q + 1) : r * (q + 1) + (xcd - r) * q) + off; }
        const int nig = wgm * nN, gid = wgid / nig, fm = gid * wgm, gsz = (nM - fm) < wgm ? (nM - fm) : wgm;
        u.pm = fm + ((wgid % nig) % gsz); u.pn = (wgid % nig) / gsz; return true;
    }
    __device__ __forceinline__ void a_ready(const Unit&) const {}
    __device__ __forceinline__ void done(const Unit&) const {}
};


typedef unsigned u32x2 __attribute__((ext_vector_type(2)));
constexpr float RMS_EPS = 1e-6f, LOG2E = 1.4426950408889634f, QSCALE = 0.125f * 1.4426950408889634f;
__device__ __forceinline__ unsigned cvt_pk_bf16(float lo, float hi) { unsigned r; asm volatile("v_cvt_pk_bf16_f32 %0, %1, %2" : "=v"(r) : "v"(lo), "v"(hi)); return r; }
__device__ __forceinline__ float fsigmoid(float x) { return __builtin_amdgcn_rcpf(1.0f + __builtin_amdgcn_exp2f(-x * LOG2E)); }
__device__ __forceinline__ float fsilu(float x) { return x * fsigmoid(x); }
__device__ __forceinline__ f32x4 silu4(f32x4 v) { return (f32x4){fsilu(v[0]), fsilu(v[1]), fsilu(v[2]), fsilu(v[3])}; }
__device__ __forceinline__ u32x4 pack8(f32x4 a, f32x4 b) { u32x4 w; w.x = cvt_pk_bf16(a[0], a[1]); w.y = cvt_pk_bf16(a[2], a[3]); w.z = cvt_pk_bf16(b[0], b[1]); w.w = cvt_pk_bf16(b[2], b[3]); return w; }
__device__ __forceinline__ float rowscale(const float* rowsq, const PG8_LAS float* slot, int rl) { return rowsq ? __builtin_amdgcn_rsqf(slot[rl] * (1.0f / 1024.0f) + RMS_EPS) : 1.0f; }
template <int CTRL> __device__ __forceinline__ float dpp_mov0(float x) { return __builtin_bit_cast(float, __builtin_amdgcn_update_dpp(0, __builtin_bit_cast(int, x), CTRL, 0xf, 0xf, true)); }
__device__ __forceinline__ float row_scan16(float x) { x += dpp_mov0<0x111>(x); x += dpp_mov0<0x112>(x); x += dpp_mov0<0x114>(x); x += dpp_mov0<0x118>(x); return x; }

struct EpiSwiGLU {
    static constexpr bool PERM = false, AFTER_DRAIN = false; static constexpr int SCALE = 1;
    bf16_t* H; const float* rowsq; const PG8_LAS float* scl; int ldh;
    __device__ __forceinline__ void operator()(f32x4 (&acc)[2][2][4][2], const Unit& u, int wr, int wc, int fr, int fq) const {
        const int row0 = u.pm * BM + wr * 64 + fr, col0 = u.pn * HALF + wc * 32 + 8 * fq; const PG8_LAS float* slot = scl + u.par * 256 + wr * 64 + fr;
#pragma unroll
        for (int ai = 0; ai < 2; ++ai)
#pragma unroll
            for (int m = 0; m < 4; ++m) { const int row = row0 + ai * HALF + m * 16; const float r = rowscale(rowsq, slot, ai * HALF + m * 16);
                f32x4 hh[2];
#pragma unroll
                for (int n = 0; n < 2; ++n) { const f32x4 g = acc[ai][0][m][n] * r, gu = g * (acc[ai][1][m][n] * r);
#pragma unroll
                    for (int c = 0; c < 4; ++c) hh[n][c] = gu[c] * __builtin_amdgcn_rcpf(1.0f + __builtin_amdgcn_exp2f(-g[c])); }
                *(u32x4*)(H + (unsigned)(row * ldh + col0)) = pack8(hh[0], hh[1]); }
    }
};
template <int MODE> struct EpiRes {
    static constexpr bool PERM = false, AFTER_DRAIN = false; static constexpr int SCALE = 0;
    const float* base; float* out; bf16_t* xb; float* rowsq; float scale;
    __device__ __forceinline__ void operator()(f32x4 (&acc)[2][2][4][2], const Unit& u, int wr, int wc, int fr, int fq) const {
        const int row0 = u.pm * BM + wr * 64 + fr, col0 = u.pn * BM + wc * 32 + 4 * fq;
        const unsigned off0 = (unsigned)(row0 * 1024 + col0);
#define EPR_AT(p, g, j) ((p) + ((((g) >> 2) * HALF + ((g) & 3) * 16) * 1024 + ((j) >> 1) * HALF + ((j) & 1) * 16))[off0]
        if constexpr (MODE == 0) {
            f32x4 rb[4][4];
#pragma unroll
            for (int g = 0; g < 4; ++g)
#pragma unroll
                for (int j = 0; j < 4; ++j) rb[g][j] = *(const f32x4*)&EPR_AT(base, g, j);
            __builtin_amdgcn_sched_barrier(0);
#pragma unroll
            for (int g = 0; g < 8; ++g) { const int ai = g >> 2, m = g & 3; float ss = 0.f; f32x4 v[4];
#pragma unroll
                for (int j = 0; j < 4; ++j) v[j] = rb[g & 3][j] + acc[ai][j >> 1][m][j & 1] * scale;
                if (g + 4 < 8) {
#pragma unroll
                    for (int j = 0; j < 4; ++j) rb[g & 3][j] = *(const f32x4*)&EPR_AT(base, g + 4, j); }
#pragma unroll
                for (int j = 0; j < 4; ++j) { u32x2 w; w.x = cvt_pk_bf16(v[j][0], v[j][1]); w.y = cvt_pk_bf16(v[j][2], v[j][3]); *(u32x2*)&EPR_AT(xb, g, j) = w; ss += (v[j][0] * v[j][0] + v[j][1] * v[j][1]) + (v[j][2] * v[j][2] + v[j][3] * v[j][3]); }
                ss += __shfl_xor(ss, 16); ss += __shfl_xor(ss, 32); if (fq == 0) __hip_atomic_fetch_add(rowsq + row0 + ai * HALF + m * 16, ss, __ATOMIC_RELAXED, __HIP_MEMORY_SCOPE_AGENT);
                __builtin_amdgcn_sched_barrier(0); }
        } else {
            u32x2 rb[8][4];
#pragma unroll
            for (int g = 0; g < 8; ++g)
#pragma unroll
                for (int j = 0; j < 4; ++j) rb[g][j] = *(const u32x2*)&EPR_AT(xb, g, j);
            __builtin_amdgcn_sched_barrier(0);
#pragma unroll
            for (int g = 0; g < 8; ++g) { const int ai = g >> 2, m = g & 3; float ss = 0.f;
#pragma unroll
                for (int j = 0; j < 4; ++j) { const u32x2 w0 = rb[g][j];
                    f32x4 v = (f32x4){__builtin_bit_cast(float, w0.x << 16), __builtin_bit_cast(float, w0.x & 0xffff0000u), __builtin_bit_cast(float, w0.y << 16), __builtin_bit_cast(float, w0.y & 0xffff0000u)};
                    v = v + acc[ai][j >> 1][m][j & 1] * scale;
                    if (MODE == 2) *(f32x4*)&EPR_AT(out, g, j) = v;
                    else { u32x2 w; w.x = cvt_pk_bf16(v[0], v[1]); w.y = cvt_pk_bf16(v[2], v[3]); *(u32x2*)&EPR_AT(xb, g, j) = w; ss += (v[0] * v[0] + v[1] * v[1]) + (v[2] * v[2] + v[3] * v[3]); } }
                if (MODE != 2) { ss += __shfl_xor(ss, 16); ss += __shfl_xor(ss, 32); if (fq == 0) __hip_atomic_fetch_add(rowsq + row0 + ai * HALF + m * 16, ss, __ATOMIC_RELAXED, __HIP_MEMORY_SCOPE_AGENT); }
                __builtin_amdgcn_sched_barrier(0); }
        }
#undef EPR_AT
    }
};
struct EpiWin {
    static constexpr bool PERM = false, AFTER_DRAIN = false; static constexpr int SCALE = 1;
    bf16_t *Q, *K, *QT, *KT, *G; float *DM, *DE; const float *rowsq, *gq, *gk, *lb; const PG8_LAS float* scl;
    __device__ __forceinline__ void operator()(f32x4 (&acc)[2][2][4][2], const Unit& u, int wr, int wc, int fr, int fq) const {
        const int row0 = u.pm * BM + wr * 64 + fr, t = u.pn; const PG8_LAS float* slot = scl + u.par * 256 + wr * 64 + fr;
        if (t < 4) {
            const bool isq = t < 2; const int head = 4 * (t & 1) + wc; const float* gp = isq ? gq : gk; const float gs = isq ? QSCALE : 1.0f;
            f32x4 gv[2][2];
#pragma unroll
            for (int bj = 0; bj < 2; ++bj)
#pragma unroll
                for (int n = 0; n < 2; ++n) gv[bj][n] = *(const f32x4*)(gp + 32 * bj + 8 * fq + 4 * n) * gs;
            bf16_t* dst = (isq ? Q : K) + (head * 32 * 8) * 512 + (fq >> 1) * 512 + (fq & 1) * 256;
#pragma unroll
            for (int ai = 0; ai < 2; ++ai)
#pragma unroll
                for (int m = 0; m < 4; ++m) { const int row = row0 + ai * HALF + m * 16; const float r = rowscale(rowsq, slot, ai * HALF + m * 16); float ss = 0.f;
#pragma unroll
                    for (int bj = 0; bj < 2; ++bj)
#pragma unroll
                        for (int n = 0; n < 2; ++n) { const f32x4 v = acc[ai][bj][m][n] * r; acc[ai][bj][m][n] = v; ss += (v[0] * v[0] + v[1] * v[1]) + (v[2] * v[2] + v[3] * v[3]); }
                    ss += __shfl_xor(ss, 16); ss += __shfl_xor(ss, 32);
                    const float inv = __builtin_amdgcn_rsqf(ss * (1.0f / 64.0f) + RMS_EPS);
                    const int tk = row & 2047, t5 = tk & 31, r32 = isq ? t5 : ((t5 & 0x13) | ((t5 & 4) << 1) | ((t5 & 8) >> 1));
                    const unsigned o = (unsigned)((((row >> 11) * 8 * 32 + (tk >> 6)) * 2 + ((tk >> 5) & 1)) * 4 * 512 + r32 * 8);
#pragma unroll
                    for (int bj = 0; bj < 2; ++bj) *(u32x4*)(dst + o + (unsigned)(2 * bj * 512)) = pack8(acc[ai][bj][m][0] * inv * gv[bj][0], acc[ai][bj][m][1] * inv * gv[bj][1]); }
        } else if (t < 8) {
            const int hh = t - 4, kbase = hh * 128 + wc * 32 + 8 * fq;
            float lbv[8]; { const f32x4 l0 = *(const f32x4*)(lb + kbase), l1 = *(const f32x4*)(lb + kbase + 4);
#pragma unroll
                for (int c = 0; c < 4; ++c) { lbv[c] = l0[c]; lbv[4 + c] = l1[c]; } }
            const int lane = fq * 16 + fr;
#pragma unroll
            for (int ai = 0; ai < 2; ++ai)
#pragma unroll
                for (int n = 0; n < 2; ++n) {
                    float omf[4][4], carry[4], bmid[4];
#pragma unroll
                    for (int m = 0; m < 4; ++m) { const float r = rowscale(rowsq, slot, ai * HALF + m * 16);
#pragma unroll
                        for (int c = 0; c < 4; ++c) { const int e = 4 * n + c; const float a = acc[ai][0][m][n][c] * r, b = acc[ai][1][m][n][c] * r;
                            const float sg = fsigmoid(b), f = lbv[e] + (1.0f - lbv[e]) * sg; omf[m][c] = (1.0f - lbv[e]) * (1.0f - sg);
                            acc[ai][1][m][n][c] = __builtin_amdgcn_logf(f);
                            acc[ai][0][m][n][c] = fsilu(a); } }
#pragma unroll
                    for (int c = 0; c < 4; ++c) { carry[c] = 0.f; bmid[c] = 0.f; }
#pragma unroll
                    for (int m = 0; m < 4; ++m)
#pragma unroll
                        for (int c = 0; c < 4; ++c) { float x = row_scan16(acc[ai][1][m][n][c]) + carry[c]; acc[ai][1][m][n][c] = x;
                            carry[c] = __shfl(x, lane | 15); if (m == 1) bmid[c] = carry[c]; }
#pragma unroll
                    for (int m = 0; m < 4; ++m) { const int row = row0 + ai * HALF + m * 16; f32x4 qv, kv;
#pragma unroll
                        for (int c = 0; c < 4; ++c) { const float d = acc[ai][1][m][n][c] - bmid[c];
                            qv[c] = acc[ai][0][m][n][c] * __builtin_amdgcn_exp2f(d); kv[c] = omf[m][c] * __builtin_amdgcn_exp2f(-d); }
                        const unsigned o = (unsigned)(row * 512 + kbase + 4 * n);
                        u32x2 w; w.x = cvt_pk_bf16(qv[0], qv[1]); w.y = cvt_pk_bf16(qv[2], qv[3]); *(u32x2*)(QT + o) = w;
                        w.x = cvt_pk_bf16(kv[0], kv[1]); w.y = cvt_pk_bf16(kv[2], kv[3]); *(u32x2*)(KT + o) = w; }
                    if (fr == 0) { const int chunk = (u.pm * BM + ai * HALF + wr * 64) >> 6; f32x4 a0, e0;
#pragma unroll
                        for (int c = 0; c < 4; ++c) { a0[c] = __builtin_amdgcn_exp2f(bmid[c]); e0[c] = __builtin_amdgcn_exp2f(carry[c] - bmid[c]); }
                        *(f32x4*)(DM + (unsigned)(chunk * 512 + kbase + 4 * n)) = a0; *(f32x4*)(DE + (unsigned)(chunk * 512 + kbase + 4 * n)) = e0; }
                    asm volatile("" ::: "memory");
                }
        } else {
            bf16_t* dst = G + (t - 8) * 256 + wc * 32 + 8 * fq;
#pragma unroll
            for (int ai = 0; ai < 2; ++ai)
#pragma unroll
                for (int m = 0; m < 4; ++m) { const int row = row0 + ai * HALF + m * 16; const float r = rowscale(rowsq, slot, ai * HALF + m * 16);
#pragma unroll
                    for (int bj = 0; bj < 2; ++bj) *(u32x4*)(dst + (unsigned)(row * 512 + bj * HALF)) = pack8(silu4(acc[ai][bj][m][0] * r), silu4(acc[ai][bj][m][1] * r)); }
        }
    }
};
struct EpiVT {
    static constexpr bool PERM = true, AFTER_DRAIN = false; static constexpr int SCALE = 2;
    bf16_t *VT, *VHT; const float* rowsq; const PG8_LAS float* scl;
    __device__ __forceinline__ void operator()(f32x4 (&acc)[2][2][4][2], const Unit& u, int wr, int wc, int fr, int fq) const {
        const int ch0 = (u.pm & 1) * BM + wr * 64 + fr, tok0 = u.pn * BM + wc * 32 + 8 * fq, b = tok0 >> 11, s0 = tok0 & 2047;
        f32x4 rs[2][2];
#pragma unroll
        for (int bj = 0; bj < 2; ++bj)
#pragma unroll
            for (int n = 0; n < 2; ++n) { const f32x4 q = *(const PG8_LAS f32x4*)(scl + u.par * 256 + wc * 32 + 8 * fq + bj * HALF + 4 * n);
#pragma unroll
                for (int c = 0; c < 4; ++c) rs[bj][n][c] = __builtin_amdgcn_rsqf(q[c] * (1.0f / 1024.0f) + RMS_EPS); }
        if (u.pm < 2) {
#pragma unroll
            for (int ai = 0; ai < 2; ++ai)
#pragma unroll
                for (int m = 0; m < 4; ++m) { const int ch = ch0 + ai * HALF + m * 16;
#pragma unroll
                    for (int bj = 0; bj < 2; ++bj) { const int sk = s0 + bj * HALF;
                        const unsigned o = (unsigned)((((((b * 8 + (ch >> 6)) * 32 + (sk >> 6)) * 2 + ((ch >> 5) & 1)) * 4 + ((sk >> 4) & 3)) * 64 + ((sk >> 3) & 1) * 32 + (ch & 31)) * 8);
                        *(u32x4*)(VT + o) = pack8(acc[ai][bj][m][0] * rs[bj][0], acc[ai][bj][m][1] * rs[bj][1]); } }
        } else {
            bf16_t* dst = VHT + (size_t)b * 512 * 2048 + s0;
#pragma unroll
            for (int ai = 0; ai < 2; ++ai)
#pragma unroll
                for (int m = 0; m < 4; ++m) { const int ch = ch0 + ai * HALF + m * 16;
#pragma unroll
                    for (int bj = 0; bj < 2; ++bj) *(u32x4*)(dst + (unsigned)(ch * 2048 + bj * HALF)) = pack8(acc[ai][bj][m][0] * rs[bj][0], acc[ai][bj][m][1] * rs[bj][1]); }
        }
    }
};

template <class Epi, class Sched, bool ALIGN_EPI = false, bool SP2 = false>
__device__ __forceinline__ void gemm_phase(PG8_LAS unsigned char* lds, const Gemm g, const Sched& S, const Epi& E) {
    const int tid = threadIdx.x, wid = __builtin_amdgcn_readfirstlane(tid >> 6), lane = tid & 63, wr = wid >> 2, wc = wid & 3, fr = lane & 15, fq = lane >> 4;
    const int K = g.K, nt = K / BK;
    unsigned voffA[2], voffB[2];
#pragma unroll
    for (int i = 0; i < 2; ++i) { int R, C; stage_rc(tid * 16 + i * 8192, R, C); const int Rb = Epi::PERM ? ((R & ~31) + perm32(R & 31)) : R;
        voffA[i] = (unsigned)(R * K + C) * 2u; voffB[i] = (unsigned)(Rb * K + C) * 2u; }
    const size_t kstep = (size_t)(BK * 2);
    const size_t hstep = (size_t)HALF * K * 2;
    const size_t tstep = 2 * hstep;
    const unsigned ldsw = (unsigned)wid * 1024u;
    const int aoff = lds_byte(wr * 64 + fr, fq * 8), boff = lds_byte(wc * 32 + fr, fq * 8);
#define PG8_SA(b, h) (((b) * 2 + (h)) * HTB)
#define PG8_SB(b, h) ((4 + (b) * 2 + (h)) * HTB)
#define PG8_STAGE(bufoff, gbase, voff) do { _Pragma("unroll") for (int _i = 0; _i < 2; ++_i) \
        __builtin_amdgcn_global_load_lds((const unsigned*)((const char*)(gbase) + (voff)[_i]), (PG8_LAS unsigned*)(lds + (bufoff) + ldsw + _i * 8192), 16, 0, 0); } while (0)
#define PG8_LDA(dst, b, h) do { _Pragma("unroll") for (int m = 0; m < 4; ++m) _Pragma("unroll") for (int k = 0; k < 2; ++k) dst[m][k] = *(const PG8_LAS bf16x8*)(lds + PG8_SA(b, h) + aoff + m * 2048 + k * 1024); } while (0)
#define PG8_LDB(dst, b, h) do { _Pragma("unroll") for (int n = 0; n < 2; ++n) _Pragma("unroll") for (int k = 0; k < 2; ++k) dst[n][k] = *(const PG8_LAS bf16x8*)(lds + PG8_SB(b, h) + boff + n * 2048 + k * 1024); } while (0)
#define PG8_MMA(ai, bj, At, Bt) do { __builtin_amdgcn_s_setprio(1); _Pragma("unroll") for (int m = 0; m < 4; ++m) _Pragma("unroll") for (int n = 0; n < 2; ++n) _Pragma("unroll") for (int k = 0; k < 2; ++k) \
        acc[ai][bj][m][n] = __builtin_amdgcn_mfma_f32_16x16x32_bf16(Bt[n][k], At[m][k], acc[ai][bj][m][n], 0, 0, 0); __builtin_amdgcn_s_setprio(0); } while (0)
#define PG8_WAIT_V(n) asm volatile("s_waitcnt vmcnt(" #n ")" ::: "memory")
#define PG8_WAIT_L(n) asm volatile("s_waitcnt lgkmcnt(" #n ")" ::: "memory")
#define PG8_BAR __builtin_amdgcn_s_barrier()
#define PG8_SCHED __builtin_amdgcn_sched_barrier(0)
    Unit cur, nxt; int ui = 0;
    if (!S.next(0, cur)) return;
    cur.par = 0;
#define PG8_SCALE_DMA(u_) do { if (Epi::SCALE != 0 && wid == 0 && E.rowsq != nullptr) \
        __builtin_amdgcn_global_load_lds((const unsigned*)(E.rowsq + ((Epi::SCALE == 1 ? (u_).pm : (u_).pn) * BM + lane * 4)), (PG8_LAS unsigned*)(lds + STAGE_BYTES + (u_).par * 1024), 16, 0, 0); } while (0)
    PG8_SCALE_DMA(cur);
    f32x4 acc[2][2][4][2];
#pragma unroll
    for (int a = 0; a < 2; ++a)
#pragma unroll
        for (int b = 0; b < 2; ++b)
#pragma unroll
            for (int m = 0; m < 4; ++m)
#pragma unroll
                for (int n = 0; n < 2; ++n) acc[a][b][m][n] = (f32x4){0.f, 0.f, 0.f, 0.f};
    bf16x8 At[4][2], B0[2][2], B1[2][2];
    const char* cA = (const char*)g.A + (size_t)cur.pm * tstep; const char* cB = (const char*)g.Bt + (size_t)cur.pn * tstep;
    S.a_ready(cur);
    if constexpr (SP2) {
        PG8_STAGE(PG8_SB(0, 0), cB, voffB); PG8_STAGE(PG8_SB(0, 1), cB + hstep, voffB); PG8_STAGE(PG8_SA(0, 0), cA, voffA); PG8_STAGE(PG8_SA(0, 1), cA + hstep, voffA);
        if (wr == 1) PG8_BAR;
        PG8_WAIT_V(2); PG8_BAR;
        PG8_STAGE(PG8_SB(1, 0), cB + kstep, voffB); PG8_STAGE(PG8_SA(1, 0), cA + kstep, voffA); PG8_STAGE(PG8_SB(1, 1), cB + hstep + kstep, voffB);
        PG8_WAIT_V(6); PG8_BAR;
    } else {
        PG8_STAGE(PG8_SB(0, 0), cB, voffB); PG8_STAGE(PG8_SA(0, 0), cA, voffA); PG8_STAGE(PG8_SB(0, 1), cB + hstep, voffB); PG8_STAGE(PG8_SA(0, 1), cA + hstep, voffA);
        if (wr == 1) PG8_BAR;
        PG8_WAIT_V(4); PG8_BAR;
        PG8_STAGE(PG8_SB(1, 0), cB + kstep, voffB); PG8_STAGE(PG8_SA(1, 0), cA + kstep, voffA); PG8_STAGE(PG8_SB(1, 1), cB + hstep + kstep, voffB);
        PG8_WAIT_V(6); PG8_BAR;
    }
    for (;;) {
        const bool has_next = S.next(ui + 1, nxt); nxt.par = (ui + 1) & 1;
        const char* nA = has_next ? (const char*)g.A + (size_t)nxt.pm * tstep : cA; const char* nB = has_next ? (const char*)g.Bt + (size_t)nxt.pn * tstep : cB;
        for (int t = 0; t < nt; t += 2) {
            const bool last = (t == nt - 2);
            const char* a1 = cA + (size_t)(t + 1) * kstep;
            const char* a2 = last ? nA : cA + (size_t)(t + 2) * kstep; const char* b2 = last ? nB : cB + (size_t)(t + 2) * kstep;
            const char* a3 = a2 + kstep; const char* b3 = b2 + kstep;
            if (last && has_next) { S.a_ready(nxt); PG8_SCALE_DMA(nxt); }
            if constexpr (SP2) {
            PG8_LDB(B0, 0, 0); PG8_LDB(B1, 0, 1); PG8_SCHED; PG8_LDA(At, 0, 0); PG8_STAGE(PG8_SA(1, 1), a1 + hstep, voffA);
            PG8_WAIT_V(8); PG8_WAIT_L(0); PG8_BAR; PG8_MMA(0, 0, At, B0); PG8_MMA(0, 1, At, B1); PG8_BAR; PG8_SCHED;
            PG8_LDA(At, 0, 1); PG8_STAGE(PG8_SB(0, 0), b2, voffB); PG8_STAGE(PG8_SB(0, 1), b2 + hstep, voffB); PG8_STAGE(PG8_SA(0, 0), a2, voffA);
            PG8_WAIT_V(8); PG8_WAIT_L(0); PG8_BAR; PG8_MMA(1, 0, At, B0); PG8_MMA(1, 1, At, B1); PG8_BAR; PG8_SCHED;
            PG8_LDB(B0, 1, 0); PG8_LDB(B1, 1, 1); PG8_SCHED; PG8_LDA(At, 1, 0); PG8_STAGE(PG8_SA(0, 1), a2 + hstep, voffA);
            PG8_WAIT_V(8); PG8_WAIT_L(0); PG8_BAR; PG8_MMA(0, 0, At, B0); PG8_MMA(0, 1, At, B1); PG8_BAR; PG8_SCHED;
            PG8_LDA(At, 1, 1); PG8_STAGE(PG8_SB(1, 0), b3, voffB); PG8_STAGE(PG8_SB(1, 1), b3 + hstep, voffB); PG8_STAGE(PG8_SA(1, 0), a3, voffA);
            PG8_WAIT_V(8); PG8_WAIT_L(0); PG8_BAR; PG8_MMA(1, 0, At, B0); PG8_MMA(1, 1, At, B1); PG8_BAR; PG8_SCHED;
            } else {
            PG8_LDB(B0, 0, 0); PG8_SCHED; PG8_LDA(At, 0, 0); PG8_STAGE(PG8_SA(1, 1), a1 + hstep, voffA);
            PG8_WAIT_L(8); PG8_BAR; PG8_WAIT_L(0); PG8_MMA(0, 0, At, B0); PG8_BAR; PG8_SCHED;
            PG8_LDB(B1, 0, 1); PG8_STAGE(PG8_SB(0, 0), b2, voffB);
            PG8_BAR; PG8_WAIT_L(0); PG8_MMA(0, 1, At, B1); PG8_BAR;
            PG8_LDA(At, 0, 1); PG8_STAGE(PG8_SA(0, 0), a2, voffA);
            PG8_BAR; PG8_WAIT_L(0); PG8_MMA(1, 0, At, B0); PG8_BAR; PG8_SCHED;
            PG8_STAGE(PG8_SB(0, 1), b2 + hstep, voffB);
            PG8_WAIT_V(6); PG8_BAR; PG8_MMA(1, 1, At, B1); PG8_BAR;
            PG8_LDB(B0, 1, 0); PG8_SCHED; PG8_LDA(At, 1, 0); PG8_STAGE(PG8_SA(0, 1), a2 + hstep, voffA);
            PG8_WAIT_L(8); PG8_BAR; PG8_WAIT_L(0); PG8_MMA(0, 0, At, B0); PG8_BAR; PG8_SCHED;
            PG8_LDB(B1, 1, 1); PG8_STAGE(PG8_SB(1, 0), b3, voffB);
            PG8_BAR; PG8_WAIT_L(0); PG8_MMA(0, 1, At, B1); PG8_BAR;
            PG8_LDA(At, 1, 1); PG8_STAGE(PG8_SA(1, 0), a3, voffA);
            PG8_BAR; PG8_WAIT_L(0); PG8_MMA(1, 0, At, B0); PG8_BAR; PG8_SCHED;
            PG8_STAGE(PG8_SB(1, 1), b3 + hstep, voffB);
            PG8_WAIT_V(6); PG8_BAR; PG8_MMA(1, 1, At, B1); PG8_BAR;
            }
        }
        if constexpr (ALIGN_EPI) { if (wr == 0) PG8_BAR; }
        if constexpr (!Epi::AFTER_DRAIN) { E(acc, cur, wr, wc, fr, fq); S.done(cur); }
        if (!has_next) break;
#pragma unroll
        for (int a = 0; a < 2; ++a)
#pragma unroll
            for (int b = 0; b < 2; ++b)
#pragma unroll
                for (int m = 0; m < 4; ++m)
#pragma unroll
                    for (int n = 0; n < 2; ++n) acc[a][b][m][n] = (f32x4){0.f, 0.f, 0.f, 0.f};
        cur = nxt; cA = nA; cB = nB; ++ui;
        if constexpr (ALIGN_EPI) { if (wr == 1) PG8_BAR; }
    }
    PG8_WAIT_V(0);
    if constexpr (!ALIGN_EPI) { if (wr == 0) PG8_BAR; }
    PG8_BAR;
    if constexpr (Epi::AFTER_DRAIN) { E.fused(acc, cur, wr, wc, fr, fq, lds, wid, lane); S.done(cur); }
#undef PG8_SCALE_DMA
#undef PG8_SA
#undef PG8_SB
#undef PG8_STAGE
#undef PG8_LDA
#undef PG8_LDB
#undef PG8_MMA
#undef PG8_WAIT_V
#undef PG8_WAIT_L
#undef PG8_BAR
#undef PG8_SCHED
}
}

constexpr int NWAVES = 8;
#ifndef MK_N_LAUNCHES
#define MK_N_LAUNCHES 1
#endif
constexpr int PER_PHASE = 8;
constexpr int N_LAUNCHES = MK_N_LAUNCHES;
constexpr int BATCH = 16, SEQ = 2048, D = 1024, M = BATCH * SEQ, FF = 2816, NPROJ = 3584;
constexpr int AW = 512, HW = 512, NCHUNK = SEQ / 64;
constexpr float RMS_EPS = 1e-6f, LOG2E = 1.4426950408889634f;
#ifndef WGM_GU
#define WGM_GU 4
#endif
#ifndef WGM_DOWN
#define WGM_DOWN 4
#endif
#ifndef WGM_OUT
#define WGM_OUT 4
#endif
#ifndef WGM_IN
#define WGM_IN 4
#endif
#ifndef WGM_INT
#define WGM_INT 4
#endif

constexpr size_t MiB = 1u << 20;
constexpr size_t WS_CTL = 0, CTL_ZERO_BYTES = 1 * MiB;
constexpr size_t WS_RS1 = 256 * 1024, WS_RS2 = 384 * 1024;
constexpr size_t WS_LB = 1 * MiB, WS_DM = 2 * MiB, WS_DE = 3 * MiB;
constexpr size_t WS_WGU1 = 4 * MiB, WS_WD1 = 15 * MiB, WS_WIN = 21 * MiB, WS_WINT = 26 * MiB, WS_WOUT = 28 * MiB, WS_WGU2 = 30 * MiB, WS_WD2 = 41 * MiB;
constexpr size_t WS_XB = 48 * MiB;
constexpr size_t WS_MIX = 112 * MiB;
constexpr size_t WS_HID = 176 * MiB;
constexpr size_t WS_Q = 176 * MiB, WS_K = 208 * MiB, WS_VT = 240 * MiB, WS_QT = 272 * MiB, WS_KT = 304 * MiB, WS_VHT = 336 * MiB, WS_G = 368 * MiB, WS_END = 400 * MiB;
static_assert(WS_WGU1 + (size_t)2 * FF * D * 2 <= WS_WD1 && WS_WD1 + (size_t)D * FF * 2 <= WS_WIN && WS_WIN + (size_t)2560 * D * 2 <= WS_WINT && WS_WGU2 + (size_t)2 * FF * D * 2 <= WS_WD2 && WS_WD2 + (size_t)D * FF * 2 <= WS_XB, "weight map");
static_assert(WS_HID + (size_t)M * FF * 2 <= WS_END && WS_XB + (size_t)M * D * 2 <= WS_MIX && WS_MIX + (size_t)M * D * 2 <= WS_HID, "activation map");
constexpr int CW_TMO = 0, CW_CODE = 1;
constexpr int CW_BAR = 4096;
constexpr int CW_WQ = 16384;

constexpr int RING_OFF = 0, RING_BYTES = 131072;
constexpr int LDS_BYTES = 163840;
constexpr int LDSCTL_OFF = LDS_BYTES - 1024, MISC_OFF = LDSCTL_OFF + 320;
static_assert(MISC_OFF + 128 <= LDS_BYTES, "LDS map");

#define GAS __attribute__((address_space(1)))
#define LAS __attribute__((address_space(3)))
typedef unsigned short bf16;
typedef unsigned v4u __attribute__((ext_vector_type(4)));
typedef float f32x4 __attribute__((ext_vector_type(4)));
typedef short bf16x8 __attribute__((ext_vector_type(8)));
typedef GAS unsigned gu32;
#define RLX_AGENT __ATOMIC_RELAXED, __HIP_MEMORY_SCOPE_AGENT
#define LDS_WAIT() asm volatile("s_waitcnt lgkmcnt(0)" ::: "memory")
#define VM_WAIT() asm volatile("s_waitcnt vmcnt(0)" ::: "memory")
__device__ __forceinline__ unsigned f2bf(float f) { unsigned u = __builtin_bit_cast(unsigned, f); return (u + 0x7fffu + ((u >> 16) & 1u)) >> 16; }
__device__ __forceinline__ unsigned pk2(float lo, float hi) { return f2bf(lo) | (f2bf(hi) << 16); }
__device__ __forceinline__ float bf2f(unsigned short h) { return __builtin_bit_cast(float, (unsigned)h << 16); }
__device__ __forceinline__ float bflo(unsigned w) { return __builtin_bit_cast(float, w << 16); }
__device__ __forceinline__ float bfhi(unsigned w) { return __builtin_bit_cast(float, w & 0xffff0000u); }

#define XB_TMO      128
#define XB_XCNT(j)  (256  + 64 * (j))
#define XB_XSUB(j)  (1280 + 64 * (j))
#define XB_XGEN(j)  (2304 + 64 * (j))
#define XB_TOP      3328
#define XB_TOPGEN   3392
#define XCD_BAR_WORDS 3456
#define XB_SPIN_CAP (1u << 18)

__device__ __forceinline__ unsigned xb_ld(unsigned* p)              { return __hip_atomic_load(p, __ATOMIC_RELAXED, __HIP_MEMORY_SCOPE_AGENT); }
__device__ __forceinline__ unsigned xb_add(unsigned* p, unsigned v) { return __hip_atomic_fetch_add(p, v, __ATOMIC_RELAXED, __HIP_MEMORY_SCOPE_AGENT); }
__device__ __forceinline__ unsigned xb_xcc_id() { return (unsigned)__builtin_amdgcn_s_getreg((3 << 11) | 20) & 0xFu; }
#define XB_SPIN(cond, bar) do { unsigned _sp = 0; while (cond) { __builtin_amdgcn_s_sleep(1); \
    if ((++_sp & 255u) == 0u) { if (xb_ld(&(bar)[XB_TMO])) break; if (_sp > XB_SPIN_CAP) { atomicAdd(&(bar)[XB_TMO], 1u); break; } } } } while (0)

struct XcdBarrier {
    unsigned* bar; unsigned x;
    volatile LAS unsigned* st;
};

__device__ __forceinline__ XcdBarrier xcd_barrier_post(unsigned* bar, volatile LAS unsigned* st) {
    XcdBarrier b; b.bar = bar; b.x = xb_xcc_id(); b.st = st;
    if (threadIdx.x == 0) (void)xb_add(&bar[XB_XCNT(b.x)], 1u);
    return b;
}
__device__ __forceinline__ void xcd_barrier_complete(unsigned* bar, unsigned x, unsigned& nloc, unsigned& nx) {
    const unsigned G = gridDim.x * gridDim.y * gridDim.z;
    unsigned sum, cnt, mine, sp = 0u;
    for (;;) {
        sum = 0u; cnt = 0u; mine = 0u;
#pragma unroll
        for (unsigned j = 0; j < 16; ++j) { const unsigned c = xb_ld(&bar[XB_XCNT(j)]); sum += c; cnt += (c > 0u) ? 1u : 0u; mine = (j == x) ? c : mine; }
        if (sum == G) break;
        __builtin_amdgcn_s_sleep(1);
        if ((++sp & 255u) == 0u) { if (xb_ld(&bar[XB_TMO])) break; if (sp > XB_SPIN_CAP) { atomicAdd(&bar[XB_TMO], 1u); break; } }
    }
    nloc = mine > 0u ? mine : 1u; nx = cnt > 0u ? cnt : 1u;
}

__device__ __forceinline__ void xcd_barrier(const XcdBarrier& b) {
    asm volatile("s_waitcnt vmcnt(0)" ::: "memory");
    __syncthreads();
    if (threadIdx.x == 0) {
        unsigned* bar = b.bar;
        __builtin_amdgcn_s_waitcnt(0);
        unsigned nloc = b.st[0], nx = b.st[1];
        if (nloc == 0u) { xcd_barrier_complete(bar, b.x, nloc, nx); b.st[0] = nloc; b.st[1] = nx; }
        const unsigned old = xb_add(&bar[XB_XSUB(b.x)], 1u);
        const unsigned gen = old / nloc;
        if (old + 1u == (gen + 1u) * nloc) {
            __builtin_amdgcn_fence(__ATOMIC_RELEASE, "agent");
            asm volatile("s_waitcnt vmcnt(0)" ::: "memory");
            const unsigned og = xb_add(&bar[XB_TOP], 1u);
            const unsigned tg = og / nx;
            if (og + 1u == (tg + 1u) * nx) xb_add(&bar[XB_TOPGEN], 1u);
            else XB_SPIN(xb_ld(&bar[XB_TOPGEN]) == tg, bar);
            __builtin_amdgcn_fence(__ATOMIC_ACQUIRE, "agent");
            xb_add(&bar[XB_XGEN(b.x)], 1u);
            asm volatile("s_waitcnt vmcnt(0)" ::: "memory");
        } else {
            XB_SPIN(xb_ld(&bar[XB_XGEN(b.x)]) == gen, bar);
            __builtin_amdgcn_fence(__ATOMIC_ACQUIRE, "agent");
            asm volatile("s_waitcnt vmcnt(0)" ::: "memory");
        }
    }
    __syncthreads();
}

struct Frame {
    LAS unsigned char* lds;
    volatile LAS unsigned* MISC;
    gu32* ctl;
    int tid, lane, wave, G;
    const float* in[17]; float* out; unsigned char* ws;
};
__device__ __forceinline__ float wave_sum(float v) {
#pragma unroll
    for (int o = 1; o < 64; o <<= 1) v += __shfl_xor(v, o);
    return v;
}
__device__ __forceinline__ int srccol(int kind, int R, int& sel) {
    sel = 0;
    if (kind == 0) return R;
    const int t = R >> 8, p = R & 255, bj = p >> 7, q = p & 127, wc = q >> 5, pr = pg8::perm32(q & 31);
    if (kind == 1) { sel = bj; return 128 * t + 32 * wc + pr; }
    if (kind == 2) {
        if (t < 2) return 64 * (4 * t + wc) + 32 * bj + pr;
        if (t < 4) return 512 + 64 * (4 * (t - 2) + wc) + 32 * bj + pr;
        if (t < 8) return (bj ? 2048 : 1536) + 128 * (t - 4) + 32 * wc + pr;
        return 3072 + 256 * (t - 8) + 128 * bj + 32 * wc + pr;
    }
    return R < 512 ? 1024 + R : 2560 + (R - 512);
}
struct P0Blk { f32x4 v[8]; };
__device__ __forceinline__ void p0_load(P0Blk& t, const float* W0, const float* W1, int N, int kind, int item, int nblk, int lane) {
    const int kb = item / nblk, nb = item % nblk, k0 = 64 * kb + 8 * (lane >> 3), R = 32 * nb + 4 * (lane & 7);
    int sel; const int c = srccol(kind, R, sel);
    const float* W = (sel ? W1 : W0) + (size_t)k0 * N + c;
#pragma unroll
    for (int i = 0; i < 8; ++i) t.v[i] = *(const f32x4*)(W + (size_t)i * N);
}
__device__ __forceinline__ void p0_store(const P0Blk& t, int K, bf16* WT, const float* gain, int kind, int item, int nblk, int lane) {
    const int kb = item / nblk, nb = item % nblk, k0 = 64 * kb + 8 * (lane >> 3), R = 32 * nb + 4 * (lane & 7);
    float gk[8];
    const float ws = kind == 1 ? (((R >> 7) & 1) ? 1.0f / LOG2E : LOG2E) : 1.0f;
#pragma unroll
    for (int i = 0; i < 8; ++i) gk[i] = ws;
    if (gain) { const f32x4 g0 = *(const f32x4*)(gain + k0), g1 = *(const f32x4*)(gain + k0 + 4);
#pragma unroll
        for (int i = 0; i < 4; ++i) { gk[i] = g0[i] * ws; gk[4 + i] = g1[i] * ws; } }
#pragma unroll
    for (int j = 0; j < 4; ++j) { v4u o; o.x = pk2(t.v[0][j] * gk[0], t.v[1][j] * gk[1]); o.y = pk2(t.v[2][j] * gk[2], t.v[3][j] * gk[3]); o.z = pk2(t.v[4][j] * gk[4], t.v[5][j] * gk[5]); o.w = pk2(t.v[6][j] * gk[6], t.v[7][j] * gk[7]);
        *(GAS v4u*)(WT + (size_t)(R + j) * K + k0) = o; }
}
struct P0Job { const float* W0; const float* W1; const float* gain; bf16* WT; int K, N, kind, nblk, item; };
constexpr int P0_I_GU = (D / 64) * (2 * FF / 32), P0_I_D = (FF / 64) * (D / 32), P0_I_IN = (D / 64) * (2560 / 32), P0_I_INT = (D / 64) * (1024 / 32), P0_I_O = (D / 64) * (D / 32);
constexpr int P0_N0 = P0_I_GU + P0_I_D + P0_I_IN + P0_I_INT, P0_N1 = P0_I_GU + P0_I_D + P0_I_O;
__device__ __forceinline__ P0Job p0_job(Frame& F, int set, int it) {
    int r = it;
    if (set == 0) {
        if (r < P0_I_GU) return P0Job{F.in[2], F.in[3], nullptr, (bf16*)(F.ws + WS_WGU1), D, FF, 1, 2 * FF / 32, r}; r -= P0_I_GU;
        if (r < P0_I_D) return P0Job{F.in[4], F.in[4], nullptr, (bf16*)(F.ws + WS_WD1), FF, D, 0, D / 32, r}; r -= P0_I_D;
        if (r < P0_I_IN) return P0Job{F.in[6], F.in[6], F.in[5], (bf16*)(F.ws + WS_WIN), D, NPROJ, 2, 2560 / 32, r}; r -= P0_I_IN;
        return P0Job{F.in[6], F.in[6], F.in[5], (bf16*)(F.ws + WS_WINT), D, NPROJ, 3, 1024 / 32, r};
    }
    if (r < P0_I_GU) return P0Job{F.in[14], F.in[15], F.in[13], (bf16*)(F.ws + WS_WGU2), D, FF, 1, 2 * FF / 32, r}; r -= P0_I_GU;
    if (r < P0_I_D) return P0Job{F.in[16], F.in[16], nullptr, (bf16*)(F.ws + WS_WD2), FF, D, 0, D / 32, r}; r -= P0_I_D;
    return P0Job{F.in[12], F.in[12], nullptr, (bf16*)(F.ws + WS_WOUT), D, D, 0, D / 32, r};
}
__device__ __forceinline__ void p0_weights(Frame& F, int set, int gw, int NGW) {
    const int NIT = set == 0 ? P0_N0 : P0_N1;
    int it = gw;
    if (it < NIT) {
        P0Job j0 = p0_job(F, set, it); P0Blk t0; p0_load(t0, j0.W0, j0.W1, j0.N, j0.kind, j0.item, j0.nblk, F.lane);
        for (;;) {
            const int it1 = it + NGW; const bool more = it1 < NIT;
            P0Job j1 = j0; P0Blk t1;
            if (more) { j1 = p0_job(F, set, it1); p0_load(t1, j1.W0, j1.W1, j1.N, j1.kind, j1.item, j1.nblk, F.lane); }
            p0_store(t0, j0.K, j0.WT, j0.gain, j0.kind, j0.item, j0.nblk, F.lane);
            if (!more) break;
            it = it1; j0 = j1;
#pragma unroll
            for (int i = 0; i < 8; ++i) t0.v[i] = t1.v[i];
        }
    }
}
__device__ __forceinline__ void rms_rows4_to_bf16(const float* x, const float* g, bf16* o, int lane) {
    f32x4 v[4][4]; float s[4];
#pragma unroll
    for (int r = 0; r < 4; ++r)
#pragma unroll
        for (int j = 0; j < 4; ++j) v[r][j] = *((const GAS f32x4*)(x + (size_t)r * D) + lane + 64 * j);
#pragma unroll
    for (int r = 0; r < 4; ++r) { s[r] = 0.f;
#pragma unroll
        for (int j = 0; j < 4; ++j) s[r] += (v[r][j].x * v[r][j].x + v[r][j].y * v[r][j].y) + (v[r][j].z * v[r][j].z + v[r][j].w * v[r][j].w); }
#pragma unroll
    for (int of = 1; of < 64; of <<= 1) {
#pragma unroll
        for (int r = 0; r < 4; ++r) s[r] += __shfl_xor(s[r], of); }
    f32x4 gg[4];
#pragma unroll
    for (int j = 0; j < 4; ++j) gg[j] = *((const GAS f32x4*)g + lane + 64 * j);
#pragma unroll
    for (int r = 0; r < 4; ++r) { const float rr = __builtin_amdgcn_rsqf(s[r] * (1.f / D) + RMS_EPS);
        GAS unsigned long long* o8 = (GAS unsigned long long*)(o + (size_t)r * D) + lane;
#pragma unroll
        for (int j = 0; j < 4; ++j) o8[64 * j] = (unsigned long long)pk2(v[r][j].x * rr * gg[j].x, v[r][j].y * rr * gg[j].y) | ((unsigned long long)pk2(v[r][j].z * rr * gg[j].z, v[r][j].w * rr * gg[j].w) << 32); }
}
__device__ __forceinline__ void p0_prologue(Frame& F, unsigned long long& p0_probe) {
    const int gw = (int)blockIdx.x * NWAVES + F.wave, NGW = F.G * NWAVES;
#if defined(PROBE_PHASE) && (PROBE_PHASE == 13 || PROBE_PHASE == 14)
    const unsigned long long p0_t0 = __builtin_amdgcn_s_memrealtime();
#endif
    p0_weights(F, 0, gw, NGW);
#if defined(PROBE_PHASE) && (PROBE_PHASE == 13 || PROBE_PHASE == 14)
    const unsigned long long tp1_ = __builtin_amdgcn_s_memrealtime();
    if (PROBE_PHASE == 13) p0_probe = tp1_ - p0_t0;
#endif
    for (int m = 4 * gw; m < M; m += 4 * NGW) rms_rows4_to_bf16(F.in[0] + (size_t)m * D, F.in[1], (bf16*)(F.ws + WS_XB) + (size_t)m * D, F.lane);
#if defined(PROBE_PHASE) && (PROBE_PHASE == 13 || PROBE_PHASE == 14)
    if (PROBE_PHASE == 14) p0_probe = __builtin_amdgcn_s_memrealtime() - tp1_;
#endif
    if (blockIdx.x == 0) {
        const float l0 = F.in[10][F.tid], l1 = F.in[10][512 + F.tid], mx = fmaxf(l0, l1), e0 = __expf(l0 - mx), e1 = __expf(l1 - mx);
        ((float*)(F.ws + WS_LB))[F.tid] = e0 / (e0 + e1);
    }
}

typedef float f32x16 __attribute__((ext_vector_type(16)));
typedef float f32x2_t __attribute__((ext_vector_type(2))); typedef __bf16 bf16x2_t __attribute__((ext_vector_type(2)));
__device__ __forceinline__ unsigned cvtpk_s(float lo, float hi) { f32x2_t v = {lo, hi}; bf16x2_t b = __builtin_convertvector(v, bf16x2_t); return __builtin_bit_cast(unsigned, b); }
__device__ __forceinline__ bf16x8 pack_step(const f32x16& x, int s) { v4u p; p.x = cvtpk_s(x[8 * s], x[8 * s + 1]); p.y = cvtpk_s(x[8 * s + 2], x[8 * s + 3]); p.z = cvtpk_s(x[8 * s + 4], x[8 * s + 5]); p.w = cvtpk_s(x[8 * s + 6], x[8 * s + 7]); return __builtin_bit_cast(bf16x8, p); }
__device__ __forceinline__ float swapmax(float m) { auto rr = __builtin_amdgcn_permlane32_swap(__float_as_uint(m), __float_as_uint(m), false, false); return fmaxf(__uint_as_float(rr[0]), __uint_as_float(rr[1])); }
__device__ __forceinline__ float swapsum(float m) { auto rr = __builtin_amdgcn_permlane32_swap(__float_as_uint(m), __float_as_uint(m), false, false); return __uint_as_float(rr[0]) + __uint_as_float(rr[1]); }
__device__ __forceinline__ int pi32(int x) { return (x & 0x13) | ((x & 4) << 1) | ((x & 8) >> 1); }
#define MFMA32(a, b, c) __builtin_amdgcn_mfma_f32_32x32x16_bf16((a), (b), (c), 0, 0, 0)
constexpr int ATT_ETAB_OFF = 0;
__device__ __forceinline__ void attn_item(Frame& F, int b, int c, int h, const LAS float* etab) {
    const bf16* Q = (const bf16*)(F.ws + WS_Q); const bf16* Kp = (const bf16*)(F.ws + WS_K); const bf16* VT = (const bf16*)(F.ws + WS_VT); bf16* MIX = (bf16*)(F.ws + WS_MIX);
    const int lane = F.lane, r32 = lane & 31, hi = lane >> 5;
    const float cfar = F.in[9][h * 257 + 256] * LOG2E;
    bf16x8 qf[2][4];
#pragma unroll
    for (int qb = 0; qb < 2; ++qb)
#pragma unroll
        for (int d0 = 0; d0 < 4; ++d0) qf[qb][d0] = *(const bf16x8*)(Q + (unsigned)((((((b * 8 + h) * 32 + c) * 2 + qb) * 4 + d0) * 64 + lane) * 8));
    f32x16 o[2][2];
#pragma unroll
    for (int db = 0; db < 2; ++db)
#pragma unroll
        for (int qb = 0; qb < 2; ++qb)
#pragma unroll
            for (int r = 0; r < 16; ++r) o[db][qb][r] = 0.f;
    float mrun[2] = {-INFINITY, -INFINITY}, lrun[2] = {0.f, 0.f};
    const int kt0 = c >= 8 ? c - 8 : 0;
    const unsigned fbase = (unsigned)(((b * 8 + h) * 32 * 8 * 64 + lane) * 8);
    const LAS float* et = etab + h * 256;
    bf16x8 kf[2][4], vf[2][4];
#define AT_LOADK(kt_) do { _Pragma("unroll") for (int kb = 0; kb < 2; ++kb) _Pragma("unroll") for (int d0 = 0; d0 < 4; ++d0) kf[kb][d0] = *(const bf16x8*)(Kp + fbase + (unsigned)((((kt_) * 2 + kb) * 4 + d0) * 512)); } while (0)
#define AT_LOADV(kt_) do { _Pragma("unroll") for (int db = 0; db < 2; ++db) _Pragma("unroll") for (int ks = 0; ks < 4; ++ks) vf[db][ks] = *(const bf16x8*)(VT + fbase + (unsigned)((((kt_) * 2 + db) * 4 + ks) * 512)); } while (0)
    AT_LOADK(kt0); AT_LOADV(kt0);
    for (int kt = kt0; kt <= c; ++kt) {
        const int j = c - kt, ktn = kt < c ? kt + 1 : c;
#pragma unroll
        for (int qb = 0; qb < 2; ++qb) {
            f32x16 s[2]; bf16x8 pk[2][2];
            const float c0 = j >= 3 ? cfar : 0.f;
#pragma unroll
            for (int r = 0; r < 16; ++r) { s[0][r] = c0; s[1][r] = c0; }
#pragma unroll
            for (int d0 = 0; d0 < 4; ++d0) { s[0] = MFMA32(kf[0][d0], qf[qb][d0], s[0]); s[1] = MFMA32(kf[1][d0], qf[qb][d0], s[1]); }
            if (qb == 1) { __builtin_amdgcn_sched_barrier(0); AT_LOADK(ktn); __builtin_amdgcn_sched_barrier(0); }
            if (j < 3) {
                const int ib = 64 * j + 32 * qb + r32 - 8 * hi + 63;
#pragma unroll
                for (int kb = 0; kb < 2; ++kb)
#pragma unroll
                    for (int r = 0; r < 16; ++r) s[kb][r] += et[ib - 32 * kb - 16 * (r >> 3) - (r & 7)];
            }
            float tm = fmaxf(s[0][0], s[1][0]);
#pragma unroll
            for (int r = 1; r < 16; ++r) tm = fmaxf(tm, fmaxf(s[0][r], s[1][r]));
            tm = swapmax(tm);
            const float mn = fmaxf(mrun[qb], tm), alpha = __builtin_amdgcn_exp2f(mrun[qb] - mn); mrun[qb] = mn;
            float ls = 0.f;
#pragma unroll
            for (int kb = 0; kb < 2; ++kb)
#pragma unroll
                for (int r = 0; r < 16; ++r) { const float p = __builtin_amdgcn_exp2f(s[kb][r] - mn); s[kb][r] = p; ls += p; }
            lrun[qb] = lrun[qb] * alpha + ls;
#pragma unroll
            for (int db = 0; db < 2; ++db)
#pragma unroll
                for (int r = 0; r < 16; ++r) o[db][qb][r] *= alpha;
#pragma unroll
            for (int kb = 0; kb < 2; ++kb) { pk[kb][0] = pack_step(s[kb], 0); pk[kb][1] = pack_step(s[kb], 1); }
#pragma unroll
            for (int db = 0; db < 2; ++db)
#pragma unroll
                for (int kb = 0; kb < 2; ++kb)
#pragma unroll
                    for (int sp = 0; sp < 2; ++sp) o[db][qb] = MFMA32(vf[db][2 * kb + sp], pk[kb][sp], o[db][qb]);
        }
        __builtin_amdgcn_sched_barrier(0); AT_LOADV(ktn); __builtin_amdgcn_sched_barrier(0);
    }
#undef AT_LOADK
#undef AT_LOADV
#pragma unroll
    for (int qb = 0; qb < 2; ++qb) {
        const float inv = 1.0f / swapsum(lrun[qb]);
        bf16* orow = MIX + (unsigned)((b * SEQ + 64 * c + 32 * qb + r32) * 1024 + h * 64 + 16 * hi);
#pragma unroll
        for (int db = 0; db < 2; ++db) {
            unsigned wx[4], wy[4];
#pragma unroll
            for (int g = 0; g < 4; ++g) { wx[g] = cvtpk_s(o[db][qb][4 * g] * inv, o[db][qb][4 * g + 1] * inv); wy[g] = cvtpk_s(o[db][qb][4 * g + 2] * inv, o[db][qb][4 * g + 3] * inv); }
#pragma unroll
            for (int p = 0; p < 2; ++p) {
                auto ax = __builtin_amdgcn_permlane32_swap(wx[p], wx[p + 2], false, false); auto ay = __builtin_amdgcn_permlane32_swap(wy[p], wy[p + 2], false, false);
                *(v4u*)(orow + 32 * db + 8 * p) = (v4u){ax[0], ay[0], ax[1], ay[1]}; }
        }
    }
}
__device__ __forceinline__ void attn_phase(Frame& F) {
    LAS float* etab = (LAS float*)(F.lds + RING_OFF + ATT_ETAB_OFF);
    for (int i = F.tid; i < 8 * 256; i += NWAVES * 64) { const int h = i >> 8; int rel = (i & 255) - 63; rel = rel > 128 ? 128 : rel; etab[i] = F.in[9][h * 257 + rel + 128] * LOG2E; }
    __syncthreads();
    for (int k = 0; k < 8; ++k) {
        const int shard = ((int)blockIdx.x + k) & 7;
        gu32* head = F.ctl + CW_WQ + 64 * shard;
        for (;;) {
            unsigned n = 0; if (F.lane == 0) n = __hip_atomic_fetch_add(head, 1u, RLX_AGENT);
            n = (unsigned)__builtin_amdgcn_readfirstlane((int)n);
            if (n >= 512u) break;
            const int bh = 8 * (int)(n >> 5) + shard, c = 31 - (int)(n & 31);
            attn_item(F, bh >> 3, c, bh & 7, etab);
        }
    }
    __syncthreads();
}

__device__ __forceinline__ unsigned off_b(unsigned row, unsigned ch) { return 256u * row + 16u * (ch ^ (((row & 3) << 2) | ((row >> 2) & 3))); }
__device__ __forceinline__ unsigned tr_read_addr_b(unsigned lane, unsigned c, unsigned ks, unsigned t) {
    const unsigned h = lane >> 5, blk = (lane >> 4) & 1, q = (lane & 15) >> 2, p = lane & 3;
    return off_b(16 * ks + 8 * h + 4 * t + q, 4 * c + 2 * blk + (p >> 1)) + 8 * (p & 1);
}
typedef short v4i16_t __attribute__((ext_vector_type(4)));
__device__ __forceinline__ v4i16_t lds_tr(const LAS unsigned char* p) { return __builtin_amdgcn_ds_read_tr16_b64_v4i16((LAS v4i16_t*)p); }
__device__ __forceinline__ bf16x8 krow_frag(bf16x8 nat) {
    const v4u d = __builtin_bit_cast(v4u, nat);
    auto a = __builtin_amdgcn_permlane32_swap(d.x, d.z, false, false); auto b = __builtin_amdgcn_permlane32_swap(d.y, d.w, false, false);
    v4u r; r.x = a[0]; r.y = b[0]; r.z = a[1]; r.w = b[1]; return __builtin_bit_cast(bf16x8, r);
}
constexpr int HG_PS_OFF = 8192, HG_DD_OFF = 10240, HG_GN_OFF = 12288, HG_BUF_OFF = 16384;
constexpr int HG_QT_OFF = 16384, HG_VT_OFF = 32768, HG_BUF_BYTES = 49152;
constexpr int HG_OX_OFF = HG_BUF_OFF + 2 * HG_BUF_BYTES, HG_OX_BYTES = 64 * 264;
constexpr int HG_XS_OFF = HG_OX_OFF + 2 * HG_OX_BYTES;
static_assert(HG_XS_OFF + 3 * 2048 <= LDSCTL_OFF && HG_OX_OFF % 16 == 0 && HG_XS_OFF % 16 == 0, "HGRN LDS map");
__device__ __forceinline__ void dma16(const void* g, LAS unsigned char* l) { __builtin_amdgcn_global_load_lds((const unsigned*)g, (LAS unsigned*)l, 16, 0, 0); }
__device__ __forceinline__ void hgrn_finalize(Frame& F, const v4u (&gw)[4], int b, int hh, int c) {
    bf16* MIX = (bf16*)(F.ws + WS_MIX);
    const int ht = F.tid - 256, tok = ht >> 2, pc = ht & 3;
    const LAS float* ps = (const LAS float*)(F.lds + RING_OFF + HG_PS_OFF) + ((c & 1) * 2 + (tok >> 5)) * 128 + (tok & 31);
    const float tot = (ps[0] + ps[32]) + (ps[64] + ps[96]);
    const float rs = __builtin_amdgcn_rsqf(tot * (1.0f / 128.0f) + RMS_EPS);
    const LAS unsigned char* ox = F.lds + RING_OFF + HG_OX_OFF + (c & 1) * HG_OX_BYTES + tok * 264 + 64 * pc;
    const LAS f32x4* gn = (const LAS f32x4*)(F.lds + RING_OFF + HG_GN_OFF) + 8 * pc;
    bf16* dst = MIX + (unsigned)((b * SEQ + 64 * c + tok) * 1024 + 512 + hh * 128 + 32 * pc);
#pragma unroll
    for (int q = 0; q < 4; ++q) { unsigned ow[4]; const unsigned g4w[4] = {gw[q].x, gw[q].y, gw[q].z, gw[q].w};
#pragma unroll
        for (int i = 0; i < 2; ++i) { const pg8::u32x2 o2 = *(const LAS pg8::u32x2*)(ox + 16 * q + 8 * i); const f32x4 g4 = gn[2 * q + i];
            ow[2 * i] = cvtpk_s(bflo(o2.x) * rs * g4[0] * bflo(g4w[2 * i]), bfhi(o2.x) * rs * g4[1] * bfhi(g4w[2 * i]));
            ow[2 * i + 1] = cvtpk_s(bflo(o2.y) * rs * g4[2] * bflo(g4w[2 * i + 1]), bfhi(o2.y) * rs * g4[3] * bfhi(g4w[2 * i + 1])); }
        *(v4u*)(dst + 8 * q) = (v4u){ow[0], ow[1], ow[2], ow[3]}; }
}
__device__ __forceinline__ void hgrn_phase(Frame& F, int bh, unsigned long long& hg_wait_acc) {
    (void)hg_wait_acc;
    const unsigned char* QT = F.ws + WS_QT; const unsigned char* KT = F.ws + WS_KT; const unsigned char* VHT = F.ws + WS_VHT; const bf16* Gt = (const bf16*)(F.ws + WS_G);
    const unsigned char* DM = F.ws + WS_DM; const unsigned char* DE = F.ws + WS_DE;
    const int b = bh >> 2, hh = bh & 3, lane = F.lane, r32 = lane & 31, hi = lane >> 5, w = F.wave, tid = F.tid;
    LAS unsigned char* const bufs = F.lds + RING_OFF + HG_BUF_OFF;
    LAS float* const psw = (LAS float*)(F.lds + RING_OFF + HG_PS_OFF);
    LAS float* const ddw = (LAS float*)(F.lds + RING_OFF + HG_DD_OFF);
    if (tid < 128) ((LAS float*)(F.lds + RING_OFF + HG_GN_OFF))[tid] = F.in[11][tid];
    if (w >= 4) {
        const int hw = w - 4;
        unsigned so_k[4], so_v[4];
#pragma unroll
        for (int j = 0; j < 4; ++j) { const unsigned ii = (unsigned)(hw + 4 * j), sl = ii * 64 + lane;
            { const unsigned img = sl >> 9, s9 = sl & 511, row = s9 >> 4, ch = (s9 & 15) ^ (((row & 3) << 2) | ((row >> 2) & 3)); so_k[j] = ((32 * img + row) * 512 + hh * 128) * 2 + ch * 16; }
            { const unsigned row = sl >> 3, ch = (sl & 7) ^ (row & 7); so_v[j] = ((hh * 128 + row) * SEQ) * 2 + ch * 16; } }
        const unsigned so_d = (unsigned)((hh * 128) * 4 + (lane & 31) * 16);
        const unsigned char* const ddsrc = (lane < 32 ? DM : DE) + (size_t)(b * NCHUNK) * 2048 + so_d;
        const unsigned char* const ktb = KT + (size_t)(b * SEQ) * 1024; const unsigned char* const qtb = QT + (size_t)(b * SEQ) * 1024; const unsigned char* const vtb = VHT + (size_t)(b * 512) * SEQ * 2;
#define HG_DMA(c_) do { LAS unsigned char* nb_ = bufs + ((c_) & 1) * HG_BUF_BYTES + hw * 1024; const size_t ck_ = (size_t)(c_) * 65536, cv_ = (size_t)(c_) * 128; \
        _Pragma("unroll") for (int j_ = 0; j_ < 4; ++j_) { dma16(ktb + ck_ + so_k[j_], nb_ + j_ * 4096); dma16(qtb + ck_ + so_k[j_], nb_ + HG_QT_OFF + j_ * 4096); dma16(vtb + cv_ + so_v[j_], nb_ + HG_VT_OFF + j_ * 4096); } \
        if (hw == 0) dma16(ddsrc + (size_t)(c_) * 2048, (LAS unsigned char*)(ddw + ((c_) & 1) * 256)); } while (0)
        const unsigned src_g = (unsigned)((b * SEQ + ((tid - 256) >> 2)) * 512 + hh * 128 + 32 * (tid & 3));
        const unsigned rk_ = (unsigned)pi32(r32), sk_ = ((rk_ & 3) << 2) | ((rk_ >> 2) & 3), sq_ = (((unsigned)r32 & 3) << 2) | (((unsigned)r32 >> 2) & 3);
        const unsigned kt_base = 256u * rk_ + 16u * ((unsigned)hi ^ (sk_ & 1)), kt_e = sk_ >> 1, qt_base = (unsigned)HG_QT_OFF + 256u * (unsigned)r32 + 16u * ((unsigned)hi ^ (sq_ & 1)), qt_e = sq_ >> 1;
        HG_DMA(0);
        asm volatile("s_waitcnt vmcnt(0) lgkmcnt(0)" ::: "memory"); __builtin_amdgcn_s_barrier(); asm volatile("" ::: "memory");
        for (int c = 0; c <= NCHUNK; ++c) {
            if (c + 1 < NCHUNK) HG_DMA(c + 1);
            if (hw < 3 && c < NCHUNK) {
                const LAS unsigned char* buf = bufs + (c & 1) * HG_BUF_BYTES;
                const int sbx = hw >> 1, tbx = (hw + 1) >> 1;
                unsigned ek = kt_e, eq = qt_e; asm volatile("" : "+v"(ek), "+v"(eq));
                f32x16 X;
#pragma unroll
                for (int r = 0; r < 16; ++r) X[r] = 0.f;
#pragma unroll
                for (int ks = 0; ks < 8; ++ks) { const bf16x8 kf = *(const LAS bf16x8*)(buf + sbx * 8192 + kt_base + (((unsigned)ks ^ ek) << 5)), qf = *(const LAS bf16x8*)(buf + tbx * 8192 + qt_base + (((unsigned)ks ^ eq) << 5)); X = MFMA32(kf, qf, X); }
                if (sbx == tbx) {
                    int thr = r32 - 8 * hi; asm volatile("" : "+v"(thr));
#pragma unroll
                    for (int r = 0; r < 16; ++r) X[r] = thr >= 16 * (r >> 3) + (r & 7) ? X[r] : 0.f;
                }
                LAS unsigned char* xw = F.lds + RING_OFF + HG_XS_OFF + hw * 2048 + lane * 16;
                *(LAS bf16x8*)xw = pack_step(X, 0); *(LAS bf16x8*)(xw + 1024) = pack_step(X, 1);
            }
            if (c > 0) { const bf16* gcp = Gt + (size_t)((c - 1) * 64 * 512); v4u gc[4];
#pragma unroll
                for (int q = 0; q < 4; ++q) gc[q] = *(const v4u*)(gcp + src_g + 8 * q);
                hgrn_finalize(F, gc, b, hh, c - 1); }
            asm volatile("s_waitcnt lgkmcnt(0)" ::: "memory"); __builtin_amdgcn_s_barrier(); asm volatile("" ::: "memory");
            asm volatile("s_waitcnt vmcnt(0) lgkmcnt(0)" ::: "memory"); __builtin_amdgcn_s_barrier(); asm volatile("" ::: "memory");
        }
#undef HG_DMA
    } else {
        const int vb = w;
        f32x16 S[4];
#pragma unroll
        for (int kb = 0; kb < 4; ++kb)
#pragma unroll
            for (int r = 0; r < 16; ++r) S[kb][r] = 0.f;
        const unsigned rk_ = (unsigned)pi32(r32), sk_ = ((rk_ & 3) << 2) | ((rk_ >> 2) & 3), sq_ = (((unsigned)r32 & 3) << 2) | (((unsigned)r32 >> 2) & 3);
        const unsigned kt_base = 256u * rk_ + 16u * ((unsigned)hi ^ (sk_ & 1)), kt_e = sk_ >> 1, qt_base = (unsigned)HG_QT_OFF + 256u * (unsigned)r32 + 16u * ((unsigned)hi ^ (sq_ & 1)), qt_e = sq_ >> 1;
        unsigned rd_tr[4][2], rd_vt[4];
#pragma unroll
        for (int kb = 0; kb < 4; ++kb) { rd_tr[kb][0] = tr_read_addr_b((unsigned)lane, (unsigned)kb, 0u, 0u); rd_tr[kb][1] = tr_read_addr_b((unsigned)lane, (unsigned)kb, 0u, 1u); }
#pragma unroll
        for (int k4 = 0; k4 < 4; ++k4) rd_vt[k4] = (unsigned)(HG_VT_OFF + (32 * vb + r32) * 128 + (((2 * k4 + hi) ^ (r32 & 7)) << 4));
        const unsigned wr_ox = (unsigned)(HG_OX_OFF + r32 * 264 + (32 * vb + 4 * hi) * 2);
        asm volatile("s_waitcnt vmcnt(0) lgkmcnt(0)" ::: "memory"); __builtin_amdgcn_s_barrier(); asm volatile("" ::: "memory");
        for (int c = 0; c <= NCHUNK; ++c) {
            const LAS unsigned char* buf = bufs + (c & 1) * HG_BUF_BYTES;
            f32x16 o[2]; bf16x8 vfr[4];
            if (c < NCHUNK) {
            const LAS float* dd = ddw + (c & 1) * 256 + 4 * hi;
#pragma unroll
            for (int kb = 0; kb < 4; ++kb)
#pragma unroll
                for (int g = 0; g < 4; ++g) { const f32x4 a = *(const LAS f32x4*)(dd + 32 * kb + 8 * g);
#pragma unroll
                    for (int i = 0; i < 4; ++i) S[kb][4 * g + i] *= a[i]; }
            unsigned ek = kt_e, eq = qt_e; asm volatile("" : "+v"(ek), "+v"(eq));
#define HG_RDKT(ks_) (kt_base + (((unsigned)(ks_) ^ ek) << 5))
#define HG_RDQT(ks_) (qt_base + (((unsigned)(ks_) ^ eq) << 5))
            __builtin_amdgcn_sched_barrier(0);
#pragma unroll
            for (int k4 = 0; k4 < 4; ++k4) vfr[k4] = *(const LAS bf16x8*)(buf + rd_vt[k4]);
#pragma unroll
            for (int r = 0; r < 16; ++r) { o[0][r] = 0.f; o[1][r] = 0.f; }
#pragma unroll
            for (int kb = 0; kb < 4; ++kb)
#pragma unroll
                for (int sp = 0; sp < 2; ++sp) { const bf16x8 sf = pack_step(S[kb], sp);
                    const bf16x8 q0 = *(const LAS bf16x8*)(buf + HG_RDQT(2 * kb + sp)), q1 = *(const LAS bf16x8*)(buf + 8192 + HG_RDQT(2 * kb + sp));
                    o[0] = MFMA32(sf, krow_frag(q0), o[0]); o[1] = MFMA32(sf, krow_frag(q1), o[1]); }
            __builtin_amdgcn_sched_barrier(0);
#pragma unroll
            for (int kb = 0; kb < 4; ++kb) {
#pragma unroll
                for (int k4 = 0; k4 < 4; ++k4) {
                    const LAS unsigned char* ip = buf + (k4 >> 1) * 8192 + (k4 & 1) * 4096;
                    const v4i16_t lo = lds_tr(ip + rd_tr[kb][0]), hi4 = lds_tr(ip + rd_tr[kb][1]);
                    const bf16x8 af = __builtin_shufflevector(lo, hi4, 0, 1, 2, 3, 4, 5, 6, 7);
                    S[kb] = MFMA32(af, vfr[k4], S[kb]);
                }
#pragma unroll
                for (int g = 0; g < 4; ++g) { const f32x4 a = *(const LAS f32x4*)(dd + 128 + 32 * kb + 8 * g);
#pragma unroll
                    for (int i = 0; i < 4; ++i) S[kb][4 * g + i] *= a[i]; }
            }
            }
            asm volatile("s_waitcnt lgkmcnt(0)" ::: "memory"); __builtin_amdgcn_s_barrier(); asm volatile("" ::: "memory");
            if (c < NCHUNK) {
            { const LAS unsigned char* xr = F.lds + RING_OFF + HG_XS_OFF + lane * 16;
              o[0] = MFMA32(vfr[0], *(const LAS bf16x8*)(xr), o[0]); o[0] = MFMA32(vfr[1], *(const LAS bf16x8*)(xr + 1024), o[0]);
              o[1] = MFMA32(vfr[0], *(const LAS bf16x8*)(xr + 2048), o[1]); o[1] = MFMA32(vfr[1], *(const LAS bf16x8*)(xr + 3072), o[1]);
              o[1] = MFMA32(vfr[2], *(const LAS bf16x8*)(xr + 4096), o[1]); o[1] = MFMA32(vfr[3], *(const LAS bf16x8*)(xr + 5120), o[1]); }
#pragma unroll
            for (int tbi = 0; tbi < 2; ++tbi) { float q = 0.f;
#pragma unroll
              for (int r = 0; r < 16; ++r) q += o[tbi][r] * o[tbi][r];
              q = swapsum(q);
              if (hi == 0) psw[((c & 1) * 2 + tbi) * 128 + vb * 32 + r32] = q;
              LAS unsigned char* oxw = F.lds + RING_OFF + (c & 1) * HG_OX_BYTES + wr_ox + tbi * 32 * 264;
#pragma unroll
              for (int g = 0; g < 4; ++g) *(LAS pg8::u32x2*)(oxw + 16 * g) = (pg8::u32x2){cvtpk_s(o[tbi][4 * g], o[tbi][4 * g + 1]), cvtpk_s(o[tbi][4 * g + 2], o[tbi][4 * g + 3])}; }
            }
            asm volatile("s_waitcnt vmcnt(0) lgkmcnt(0)" ::: "memory"); __builtin_amdgcn_s_barrier(); asm volatile("" ::: "memory");
        }
#undef HG_RDKT
#undef HG_RDQT
    }
    __syncthreads();
}

struct Args { const float* in[17]; float* out; unsigned char* ws; int ph_lo, ph_hi, li, pad; };
__global__ void __launch_bounds__(NWAVES * 64, 2) mega_fwd(Args args) {
    extern __shared__ __attribute__((aligned(16))) unsigned char lds[];
    Frame F;
    F.lds = (LAS unsigned char*)lds;
    F.MISC = (volatile LAS unsigned*)(F.lds + MISC_OFF);
    F.tid = threadIdx.x; F.lane = F.tid & 63; F.wave = __builtin_amdgcn_readfirstlane(F.tid >> 6);
    F.G = gridDim.x;
#pragma unroll
    for (int i = 0; i < 17; ++i) F.in[i] = args.in[i];
    F.out = args.out; F.ws = args.ws;
    F.ctl = (gu32*)(args.ws + WS_CTL);
    for (int u = F.tid; u < (LDS_BYTES - LDSCTL_OFF) / 4; u += NWAVES * 64) ((LAS unsigned*)(F.lds + LDSCTL_OFF))[u] = 0u;
    __syncthreads();
    XcdBarrier bar; bar.bar = (unsigned*)(F.ctl + CW_BAR); bar.x = 0; bar.st = nullptr;
    if (N_LAUNCHES != PER_PHASE) bar = xcd_barrier_post((unsigned*)(F.ctl + CW_BAR), F.MISC + 8);
#define GRID_BAR(seam) do { if (N_LAUNCHES == PER_PHASE) { if (F.tid == 0) __hip_atomic_store(F.ctl + CW_TMO, 0xBADBA0u | (unsigned)(seam), RLX_AGENT); } else { xcd_barrier(bar); } } while (0)
    const int lo = args.ph_lo, hi = args.ph_hi;
#ifdef PROBE_PHASE
    unsigned long long ts_prev = __builtin_amdgcn_s_memrealtime(), ts_dt = 0ull; int ts_k = 0;
#define STAMP() do { const unsigned long long t_ = __builtin_amdgcn_s_memrealtime(); if (ts_k == PROBE_PHASE) ts_dt = t_ - ts_prev; ts_prev = t_; ++ts_k; } while (0)
#else
#define STAMP() do {} while (0)
#endif
#define IN(k) (lo <= (k) && (k) < hi)
#define BOTH(k) (IN(k) && IN((k) + 1))
    bf16* const XB = (bf16*)(F.ws + WS_XB); bf16* const HID = (bf16*)(F.ws + WS_HID); bf16* const MIXp = (bf16*)(F.ws + WS_MIX);
    float* const RS1 = (float*)(F.ws + WS_RS1); float* const RS2 = (float*)(F.ws + WS_RS2);
    const LAS float* const SCL = (const LAS float*)(F.lds + RING_OFF + RING_BYTES);

    if (IN(0)) { unsigned long long p0_probe = 0ull; p0_prologue(F, p0_probe);
#if defined(PROBE_PHASE) && (PROBE_PHASE == 13 || PROBE_PHASE == 14)
        ts_dt = p0_probe;
#endif
        if (BOTH(0)) GRID_BAR(0); STAMP(); }
    if (IN(1)) {
        pg8::Gemm g{XB, (const bf16*)(F.ws + WS_WGU1), M, 2 * FF, D}; pg8::StaticOrder S; S.init(M, 2 * FF, F.G, (int)blockIdx.x, WGM_GU);
        pg8::EpiSwiGLU E{HID, nullptr, SCL, FF};
        pg8::gemm_phase<pg8::EpiSwiGLU, pg8::StaticOrder, true, true>(F.lds + RING_OFF, g, S, E);
        if (BOTH(1)) GRID_BAR(1); STAMP();
    }
    if (IN(2)) {
        pg8::Gemm g{HID, (const bf16*)(F.ws + WS_WD1), M, D, FF}; pg8::StaticOrder S; S.init(M, D, F.G, (int)blockIdx.x, WGM_DOWN);
        pg8::EpiRes<0> E{F.in[0], nullptr, XB, RS1, 0.5f};
        pg8::gemm_phase<pg8::EpiRes<0>, pg8::StaticOrder, true, true>(F.lds + RING_OFF, g, S, E);
        if (BOTH(2)) GRID_BAR(2); STAMP();
    }
    if (IN(3)) {
        { pg8::Gemm g{XB, (const bf16*)(F.ws + WS_WIN), M, 2560, D}; pg8::StaticOrder S; S.init(M, 2560, F.G, (int)blockIdx.x, WGM_IN);
          pg8::EpiWin E{(bf16*)(F.ws + WS_Q), (bf16*)(F.ws + WS_K), (bf16*)(F.ws + WS_QT), (bf16*)(F.ws + WS_KT), (bf16*)(F.ws + WS_G), (float*)(F.ws + WS_DM), (float*)(F.ws + WS_DE), RS1, F.in[7], F.in[8], (const float*)(F.ws + WS_LB), SCL};
          pg8::gemm_phase<pg8::EpiWin, pg8::StaticOrder, true, true>(F.lds + RING_OFF, g, S, E); }
        { pg8::Gemm g{(const bf16*)(F.ws + WS_WINT), XB, 1024, M, D}; pg8::StaticOrder S; S.init(1024, M, F.G, (int)blockIdx.x, WGM_INT);
          pg8::EpiVT E{(bf16*)(F.ws + WS_VT), (bf16*)(F.ws + WS_VHT), RS1, SCL};
          pg8::gemm_phase<pg8::EpiVT, pg8::StaticOrder, true, true>(F.lds + RING_OFF, g, S, E); }
        if (BOTH(3)) GRID_BAR(3); STAMP();
    }
    if (IN(4)) {
#ifdef PROBE_PHASE
        const unsigned long long th00_ = __builtin_amdgcn_s_memrealtime();
#endif
#ifdef PROBE_PHASE
        const unsigned long long th0_ = __builtin_amdgcn_s_memrealtime();
        if (PROBE_PHASE == 9) ts_dt = th0_ - th00_;
#endif
        unsigned long long hg_wait_acc = 0ull;
        if (blockIdx.x < 64) hgrn_phase(F, (int)blockIdx.x, hg_wait_acc);
#ifdef PROBE_PHASE
        if (PROBE_PHASE == 11 || PROBE_PHASE == 12) ts_dt = hg_wait_acc;
#endif
#ifdef PROBE_PHASE
        if (PROBE_PHASE == 8) ts_dt = __builtin_amdgcn_s_memrealtime() - th0_;
#endif
#ifdef PROBE_PHASE
        const unsigned long long ta0_ = __builtin_amdgcn_s_memrealtime();
#endif
        attn_phase(F);
        if (blockIdx.x >= 64) p0_weights(F, 1, ((int)blockIdx.x - 64) * NWAVES + F.wave, (F.G - 64) * NWAVES);
#ifdef PROBE_PHASE
        if (PROBE_PHASE == 10) ts_dt = __builtin_amdgcn_s_memrealtime() - ta0_;
#endif
        if (BOTH(4)) GRID_BAR(4); STAMP();
    }
    if (IN(5)) {
        pg8::Gemm g{MIXp, (const bf16*)(F.ws + WS_WOUT), M, D, D}; pg8::StaticOrder S; S.init(M, D, F.G, (int)blockIdx.x, WGM_OUT);
        pg8::EpiRes<1> E{nullptr, nullptr, XB, RS2, 1.0f};
        pg8::gemm_phase<pg8::EpiRes<1>, pg8::StaticOrder, true, true>(F.lds + RING_OFF, g, S, E);
        if (BOTH(5)) GRID_BAR(5); STAMP();
    }
    if (IN(6)) {
        pg8::Gemm g{XB, (const bf16*)(F.ws + WS_WGU2), M, 2 * FF, D}; pg8::StaticOrder S; S.init(M, 2 * FF, F.G, (int)blockIdx.x, WGM_GU);
        pg8::EpiSwiGLU E{HID, RS2, SCL, FF};
        pg8::gemm_phase<pg8::EpiSwiGLU, pg8::StaticOrder, true, true>(F.lds + RING_OFF, g, S, E);
        if (BOTH(6)) GRID_BAR(6); STAMP();
    }
    if (IN(7)) {
        pg8::Gemm g{HID, (const bf16*)(F.ws + WS_WD2), M, D, FF}; pg8::StaticOrder S; S.init(M, D, F.G, (int)blockIdx.x, WGM_DOWN);
        pg8::EpiRes<2> E{nullptr, F.out, XB, nullptr, 0.5f};
        pg8::gemm_phase<pg8::EpiRes<2>, pg8::StaticOrder, true, true>(F.lds + RING_OFF, g, S, E);
    }
#ifdef PROBE_PHASE
    __syncthreads(); STAMP();
    if (blockIdx.x == (PROBE_PHASE == 10 ? 255 : 0) && F.tid == 0) { const unsigned long long t0_ = __builtin_amdgcn_s_memrealtime(); while (__builtin_amdgcn_s_memrealtime() - t0_ < 4ull * ts_dt) __builtin_amdgcn_s_sleep(8); }
#endif
#undef IN
#undef BOTH
}

extern "C" void kernel_launch(void* const* d_in, const int* in_sizes, int n_in, void* d_out, int out_size, void* d_ws, size_t ws_size, hipStream_t stream) {
    static int grid = 0;
    if (grid == 0) {
        if (n_in != 17 || in_sizes[0] != M * D || out_size != M * D || ws_size < WS_END) { fprintf(stderr, "kernel_launch: unexpected shapes (n_in %d, in0 %d, out %d, ws %zu); nothing launched\n", n_in, n_in > 0 ? in_sizes[0] : -1, out_size, ws_size); grid = -1; return; }
        int dev = 0, cus = 0, per_cu = 0;
        if (hipGetDevice(&dev) != hipSuccess || hipDeviceGetAttribute(&cus, hipDeviceAttributeMultiprocessorCount, dev) != hipSuccess) { grid = -1; return; }
        if (hipFuncSetAttribute((const void*)mega_fwd, hipFuncAttributeMaxDynamicSharedMemorySize, LDS_BYTES) != hipSuccess) { fprintf(stderr, "kernel_launch: hipFuncSetAttribute failed\n"); grid = -1; return; }
        if (hipOccupancyMaxActiveBlocksPerMultiprocessor(&per_cu, (const void*)mega_fwd, NWAVES * 64, LDS_BYTES) != hipSuccess || per_cu < 1) fprintf(stderr, "kernel_launch: note: occupancy query reports %d workgroups per CU\n", per_cu);
        (void)hipGetLastError();
        grid = cus;
    }
    if (grid < 0) return;
    if (hipMemsetAsync((char*)d_ws + WS_CTL, 0, CTL_ZERO_BYTES, stream) != hipSuccess) { fprintf(stderr, "kernel_launch: hipMemsetAsync failed\n"); return; }
    Args a{};
    for (int i = 0; i < 17; ++i) a.in[i] = (const float*)d_in[i];
    a.out = (float*)d_out; a.ws = (unsigned char*)d_ws;
    for (int li = 0; li < N_LAUNCHES; ++li) {
        a.ph_lo = (N_LAUNCHES == PER_PHASE) ? li : 0; a.ph_hi = (N_LAUNCHES == PER_PHASE) ? li + 1 : PER_PHASE; a.li = li;
        hipLaunchKernelGGL(mega_fwd, dim3(grid), dim3(NWAVES * 64), LDS_BYTES, stream, a);
        const hipError_t le = hipPeekAtLastError();
        if (le != hipSuccess) { fprintf(stderr, "kernel_launch: launch %d failed: %s\n", li, hipGetErrorName(le)); break; }
    }
}
```

```cpp
#include <hip/hip_runtime.h>
#include <cstdio>
#include <cstdint>
namespace pg8 {
#define PG8_LAS __attribute__((address_space(3)))
typedef unsigned short bf16_t;
typedef short bf16x8 __attribute__((ext_vector_type(8)));
typedef float f32x4 __attribute__((ext_vector_type(4)));
typedef unsigned u32x4 __attribute__((ext_vector_type(4)));
constexpr int BM = 256, BK = 64, HALF = 128, HTB = HALF * BK * 2  , STAGE_BYTES = 8 * HTB, NXCD = 8, WGM = 4;

__host__ __device__ __forceinline__ int lds_byte(int r, int c) { const int st = (r >> 4) * 2 + (c >> 5), rr = r & 15, cc = c & 31, ob = rr * 64 + cc * 2; return st * 1024 + (ob ^ (((ob >> 9) & 1) << 5)); }
__host__ __device__ __forceinline__ void stage_rc(int b, int& R, int& C) { const int st = b / 1024, sb = b % 1024, swz = sb ^ (((sb >> 9) & 1) << 5); R = (st >> 1) * 16 + swz / 64; C = (st & 1) * 32 + (swz % 64) / 2; }
__host__ __device__ __forceinline__ int perm32(int rho) { const int n = rho >> 4, i = rho & 15; return 8 * (i >> 2) + 4 * n + (i & 3); }

struct Unit { int pm, pn, par; };
struct Gemm { const bf16_t* A; const bf16_t* Bt; int M, N, K; };

struct StaticOrder {
    int nM, nN, nwg, G, c, wgm;
    __host__ __device__ void init(int M, int N, int G_, int c_, int wgm_ = WGM) { nM = M / BM; nN = N / BM; nwg = nM * nN; G = G_; c = c_; wgm = wgm_; }
    __host__ __device__ bool next(int i, Unit& u) const {
        const long L = (long)i * G + c; if (L >= nwg) return false;
        int wgid = (int)L; { const int q = nwg / NXCD, r = nwg % NXCD, xcd = wgid % NXCD, off = wgid / NXCD; wgid = (xcd < r ? xcd * (q + 1) : r * (q + 1) + (xcd - r) * q) + off; }
        const int nig = wgm * nN, gid = wgid / nig, fm = gid * wgm, gsz = (nM - fm) < wgm ? (nM - fm) : wgm;
        u.pm = fm + ((wgid % nig) % gsz); u.pn = (wgid % nig) / gsz; return true;
    }
    __device__ __forceinline__ void a_ready(const Unit&) const {}
    __device__ __forceinline__ void done(const Unit&) const {}
};


typedef unsigned u32x2 __attribute__((ext_vector_type(2)));
constexpr float RMS_EPS = 1e-6f, LOG2E = 1.4426950408889634f, QSCALE = 0.125f * 1.4426950408889634f;
__device__ __forceinline__ unsigned cvt_pk_bf16(float lo, float hi) { unsigned r; asm volatile("v_cvt_pk_bf16_f32 %0, %1, %2" : "=v"(r) : "v"(lo), "v"(hi)); return r; }
__device__ __forceinline__ float fsigmoid(float x) { return __builtin_amdgcn_rcpf(1.0f + __builtin_amdgcn_exp2f(-x * LOG2E)); }
__device__ __forceinline__ float fsilu(float x) { return x * fsigmoid(x); }
__device__ __forceinline__ f32x4 silu4(f32x4 v) { return (f32x4){fsilu(v[0]), fsilu(v[1]), fsilu(v[2]), fsilu(v[3])}; }
__device__ __forceinline__ u32x4 pack8(f32x4 a, f32x4 b) { u32x4 w; w.x = cvt_pk_bf16(a[0], a[1]); w.y = cvt_pk_bf16(a[2], a[3]); w.z = cvt_pk_bf16(b[0], b[1]); w.w = cvt_pk_bf16(b[2], b[3]); return w; }
__device__ __forceinline__ float rowscale(const float* rowsq, const PG8_LAS float* slot, int rl) { return rowsq ? __builtin_amdgcn_rsqf(slot[rl] * (1.0f / 1024.0f) + RMS_EPS) : 1.0f; }
template <int CTRL> __device__ __forceinline__ float dpp_mov0(float x) { return __builtin_bit_cast(float, __builtin_amdgcn_update_dpp(0, __builtin_bit_cast(int, x), CTRL, 0xf, 0xf, true)); }
__device__ __forceinline__ float row_scan16(float x) { x += dpp_mov0<0x111>(x); x += dpp_mov0<0x112>(x); x += dpp_mov0<0x114>(x); x += dpp_mov0<0x118>(x); return x; }

struct EpiSwiGLU {
    static constexpr bool PERM = false, AFTER_DRAIN = false; static constexpr int SCALE = 1;
    bf16_t* H; const float* rowsq; const PG8_LAS float* scl; int ldh;
    __device__ __forceinline__ void operator()(f32x4 (&acc)[2][2][4][2], const Unit& u, int wr, int wc, int fr, int fq) const {
        const int row0 = u.pm * BM + wr * 64 + fr, col0 = u.pn * HALF + wc * 32 + 8 * fq; const PG8_LAS float* slot = scl + u.par * 256 + wr * 64 + fr;
#pragma unroll
        for (int ai = 0; ai < 2; ++ai)
#pragma unroll
            for (int m = 0; m < 4; ++m) { const int row = row0 + ai * HALF + m * 16; const float r = rowscale(rowsq, slot, ai * HALF + m * 16);
                f32x4 hh[2];
#pragma unroll
                for (int n = 0; n < 2; ++n) { const f32x4 g = acc[ai][0][m][n] * r, gu = g * (acc[ai][1][m][n] * r);
#pragma unroll
                    for (int c = 0; c < 4; ++c) hh[n][c] = gu[c] * __builtin_amdgcn_rcpf(1.0f + __builtin_amdgcn_exp2f(-g[c])); }
                *(u32x4*)(H + (unsigned)(row * ldh + col0)) = pack8(hh[0], hh[1]); }
    }
};
template <int MODE> struct EpiRes {
    static constexpr bool PERM = true, AFTER_DRAIN = false; static constexpr int SCALE = 0;
    const float* base; float* out; bf16_t* xb; float* rowsq; float scale;
    __device__ __forceinline__ void operator()(f32x4 (&acc)[2][2][4][2], const Unit& u, int wr, int wc, int fr, int fq) const {
        const int row0 = u.pm * BM + wr * 64 + fr, col0 = u.pn * BM + wc * 32 + 8 * fq;
        const unsigned off0 = (unsigned)(row0 * 1024 + col0);
#define EPR_AT(p, g, bj, n) ((p) + ((((g) >> 2) * HALF + ((g) & 3) * 16) * 1024 + (bj) * HALF + (n) * 4))[off0]
        if constexpr (MODE == 0) {
            f32x4 rb[4][4];
#pragma unroll
            for (int g = 0; g < 4; ++g)
#pragma unroll
                for (int j = 0; j < 4; ++j) rb[g][j] = *(const f32x4*)&EPR_AT(base, g, j >> 1, j & 1);
            __builtin_amdgcn_sched_barrier(0);
#pragma unroll
            for (int g = 0; g < 8; ++g) { const int ai = g >> 2, m = g & 3; float ss = 0.f; f32x4 v[4];
#pragma unroll
                for (int j = 0; j < 4; ++j) v[j] = rb[g & 3][j] + acc[ai][j >> 1][m][j & 1] * scale;
                if (g + 4 < 8) {
#pragma unroll
                    for (int j = 0; j < 4; ++j) rb[g & 3][j] = *(const f32x4*)&EPR_AT(base, g + 4, j >> 1, j & 1); }
#pragma unroll
                for (int bj = 0; bj < 2; ++bj) { *(u32x4*)&EPR_AT(xb, g, bj, 0) = pack8(v[2 * bj], v[2 * bj + 1]);
#pragma unroll
                    for (int n = 0; n < 2; ++n) { const f32x4 t = v[2 * bj + n]; ss += (t[0] * t[0] + t[1] * t[1]) + (t[2] * t[2] + t[3] * t[3]); } }
                ss += __shfl_xor(ss, 16); ss += __shfl_xor(ss, 32); if (fq == 0) __hip_atomic_fetch_add(rowsq + row0 + ai * HALF + m * 16, ss, __ATOMIC_RELAXED, __HIP_MEMORY_SCOPE_AGENT);
                __builtin_amdgcn_sched_barrier(0); }
        } else {
            u32x4 rb[8][2];
#pragma unroll
            for (int g = 0; g < 8; ++g)
#pragma unroll
                for (int bj = 0; bj < 2; ++bj) rb[g][bj] = *(const u32x4*)&EPR_AT(xb, g, bj, 0);
            __builtin_amdgcn_sched_barrier(0);
#pragma unroll
            for (int g = 0; g < 8; ++g) { const int ai = g >> 2, m = g & 3; float ss = 0.f;
#pragma unroll
                for (int bj = 0; bj < 2; ++bj) { const u32x4 w0 = rb[g][bj];
                    const f32x4 v0 = (f32x4){__builtin_bit_cast(float, w0.x << 16), __builtin_bit_cast(float, w0.x & 0xffff0000u), __builtin_bit_cast(float, w0.y << 16), __builtin_bit_cast(float, w0.y & 0xffff0000u)} + acc[ai][bj][m][0] * scale;
                    const f32x4 v1 = (f32x4){__builtin_bit_cast(float, w0.z << 16), __builtin_bit_cast(float, w0.z & 0xffff0000u), __builtin_bit_cast(float, w0.w << 16), __builtin_bit_cast(float, w0.w & 0xffff0000u)} + acc[ai][bj][m][1] * scale;
                    if (MODE == 2) { *(f32x4*)&EPR_AT(out, g, bj, 0) = v0; *(f32x4*)&EPR_AT(out, g, bj, 1) = v1; }
                    else { *(u32x4*)&EPR_AT(xb, g, bj, 0) = pack8(v0, v1);
                        ss += ((v0[0] * v0[0] + v0[1] * v0[1]) + (v0[2] * v0[2] + v0[3] * v0[3])) + ((v1[0] * v1[0] + v1[1] * v1[1]) + (v1[2] * v1[2] + v1[3] * v1[3])); } }
                if (MODE != 2) { ss += __shfl_xor(ss, 16); ss += __shfl_xor(ss, 32); if (fq == 0) __hip_atomic_fetch_add(rowsq + row0 + ai * HALF + m * 16, ss, __ATOMIC_RELAXED, __HIP_MEMORY_SCOPE_AGENT); }
                __builtin_amdgcn_sched_barrier(0); }
        }
#undef EPR_AT
    }
};
struct EpiWin {
    static constexpr bool PERM = false, AFTER_DRAIN = false; static constexpr int SCALE = 1;
    bf16_t *Q, *K, *QT, *KT, *G; float *DM, *DE; const float *rowsq, *gq, *gk, *lb; const PG8_LAS float* scl;
    __device__ __forceinline__ void operator()(f32x4 (&acc)[2][2][4][2], const Unit& u, int wr, int wc, int fr, int fq) const {
        const int row0 = u.pm * BM + wr * 64 + fr, t = u.pn; const PG8_LAS float* slot = scl + u.par * 256 + wr * 64 + fr;
        if (t < 4) {
            const bool isq = t < 2; const int head = 4 * (t & 1) + wc; const float* gp = isq ? gq : gk; const float gs = isq ? QSCALE : 1.0f;
            f32x4 gv[2][2];
#pragma unroll
            for (int bj = 0; bj < 2; ++bj)
#pragma unroll
                for (int n = 0; n < 2; ++n) gv[bj][n] = *(const f32x4*)(gp + 32 * bj + 8 * fq + 4 * n) * gs;
            bf16_t* dst = (isq ? Q : K) + (head * 32 * 8) * 512 + (fq >> 1) * 512 + (fq & 1) * 256;
#pragma unroll
            for (int ai = 0; ai < 2; ++ai)
#pragma unroll
                for (int m = 0; m < 4; ++m) { const int row = row0 + ai * HALF + m * 16; const float r = rowscale(rowsq, slot, ai * HALF + m * 16); float ss = 0.f;
#pragma unroll
                    for (int bj = 0; bj < 2; ++bj)
#pragma unroll
                        for (int n = 0; n < 2; ++n) { const f32x4 v = acc[ai][bj][m][n] * r; acc[ai][bj][m][n] = v; ss += (v[0] * v[0] + v[1] * v[1]) + (v[2] * v[2] + v[3] * v[3]); }
                    ss += __shfl_xor(ss, 16); ss += __shfl_xor(ss, 32);
                    const float inv = __builtin_amdgcn_rsqf(ss * (1.0f / 64.0f) + RMS_EPS);
                    const int tk = row & 2047, t5 = tk & 31, r32 = isq ? t5 : ((t5 & 0x13) | ((t5 & 4) << 1) | ((t5 & 8) >> 1));
                    const unsigned o = (unsigned)((((row >> 11) * 8 * 32 + (tk >> 6)) * 2 + ((tk >> 5) & 1)) * 4 * 512 + r32 * 8);
#pragma unroll
                    for (int bj = 0; bj < 2; ++bj) *(u32x4*)(dst + o + (unsigned)(2 * bj * 512)) = pack8(acc[ai][bj][m][0] * inv * gv[bj][0], acc[ai][bj][m][1] * inv * gv[bj][1]); }
        } else if (t < 8) {
            const int hh = t - 4, kbase = hh * 128 + wc * 32 + 8 * fq;
            float lbv[8]; { const f32x4 l0 = *(const f32x4*)(lb + kbase), l1 = *(const f32x4*)(lb + kbase + 4);
#pragma unroll
                for (int c = 0; c < 4; ++c) { lbv[c] = l0[c]; lbv[4 + c] = l1[c]; } }
            const int lane = fq * 16 + fr;
#pragma unroll
            for (int ai = 0; ai < 2; ++ai)
#pragma unroll
                for (int n = 0; n < 2; ++n) {
                    float omf[4][4], carry[4], bmid[4];
#pragma unroll
                    for (int m = 0; m < 4; ++m) { const float r = rowscale(rowsq, slot, ai * HALF + m * 16);
#pragma unroll
                        for (int c = 0; c < 4; ++c) { const int e = 4 * n + c; const float a = acc[ai][0][m][n][c] * r, b = acc[ai][1][m][n][c] * r;
                            const float sg = fsigmoid(b), f = lbv[e] + (1.0f - lbv[e]) * sg; omf[m][c] = (1.0f - lbv[e]) * (1.0f - sg);
                            acc[ai][1][m][n][c] = __builtin_amdgcn_logf(f);
                            acc[ai][0][m][n][c] = fsilu(a); } }
#pragma unroll
                    for (int c = 0; c < 4; ++c) { carry[c] = 0.f; bmid[c] = 0.f; }
#pragma unroll
                    for (int m = 0; m < 4; ++m)
#pragma unroll
                        for (int c = 0; c < 4; ++c) { float x = row_scan16(acc[ai][1][m][n][c]) + carry[c]; acc[ai][1][m][n][c] = x;
                            carry[c] = __shfl(x, lane | 15); if (m == 1) bmid[c] = carry[c]; }
#pragma unroll
                    for (int m = 0; m < 4; ++m) { const int row = row0 + ai * HALF + m * 16; f32x4 qv, kv;
#pragma unroll
                        for (int c = 0; c < 4; ++c) { const float d = acc[ai][1][m][n][c] - bmid[c];
                            qv[c] = acc[ai][0][m][n][c] * __builtin_amdgcn_exp2f(d); kv[c] = omf[m][c] * __builtin_amdgcn_exp2f(-d); }
                        const unsigned o = (unsigned)(row * 512 + kbase + 4 * n);
                        u32x2 w; w.x = cvt_pk_bf16(qv[0], qv[1]); w.y = cvt_pk_bf16(qv[2], qv[3]); *(u32x2*)(QT + o) = w;
                        w.x = cvt_pk_bf16(kv[0], kv[1]); w.y = cvt_pk_bf16(kv[2], kv[3]); *(u32x2*)(KT + o) = w; }
                    if (fr == 0) { const int chunk = (u.pm * BM + ai * HALF + wr * 64) >> 6; f32x4 a0, e0;
#pragma unroll
                        for (int c = 0; c < 4; ++c) { a0[c] = __builtin_amdgcn_exp2f(bmid[c]); e0[c] = __builtin_amdgcn_exp2f(carry[c] - bmid[c]); }
                        *(f32x4*)(DM + (unsigned)(chunk * 512 + kbase + 4 * n)) = a0; *(f32x4*)(DE + (unsigned)(chunk * 512 + kbase + 4 * n)) = e0; }
                    asm volatile("" ::: "memory");
                }
        } else {
            bf16_t* dst = G + (t - 8) * 256 + wc * 32 + 8 * fq;
#pragma unroll
            for (int ai = 0; ai < 2; ++ai)
#pragma unroll
                for (int m = 0; m < 4; ++m) { const int row = row0 + ai * HALF + m * 16; const float r = rowscale(rowsq, slot, ai * HALF + m * 16);
#pragma unroll
                    for (int bj = 0; bj < 2; ++bj) *(u32x4*)(dst + (unsigned)(row * 512 + bj * HALF)) = pack8(silu4(acc[ai][bj][m][0] * r), silu4(acc[ai][bj][m][1] * r)); }
        }
    }
};
struct EpiVT {
    static constexpr bool PERM = true, AFTER_DRAIN = false; static constexpr int SCALE = 2;
    bf16_t *VT, *VHT; const float* rowsq; const PG8_LAS float* scl;
    __device__ __forceinline__ void operator()(f32x4 (&acc)[2][2][4][2], const Unit& u, int wr, int wc, int fr, int fq) const {
        const int ch0 = (u.pm & 1) * BM + wr * 64 + fr, tok0 = u.pn * BM + wc * 32 + 8 * fq, b = tok0 >> 11, s0 = tok0 & 2047;
        f32x4 rs[2][2];
#pragma unroll
        for (int bj = 0; bj < 2; ++bj)
#pragma unroll
            for (int n = 0; n < 2; ++n) { const f32x4 q = *(const PG8_LAS f32x4*)(scl + u.par * 256 + wc * 32 + 8 * fq + bj * HALF + 4 * n);
#pragma unroll
                for (int c = 0; c < 4; ++c) rs[bj][n][c] = __builtin_amdgcn_rsqf(q[c] * (1.0f / 1024.0f) + RMS_EPS); }
        if (u.pm < 2) {
#pragma unroll
            for (int ai = 0; ai < 2; ++ai)
#pragma unroll
                for (int m = 0; m < 4; ++m) { const int ch = ch0 + ai * HALF + m * 16;
#pragma unroll
                    for (int bj = 0; bj < 2; ++bj) { const int sk = s0 + bj * HALF;
                        const unsigned o = (unsigned)((((((b * 8 + (ch >> 6)) * 32 + (sk >> 6)) * 2 + ((ch >> 5) & 1)) * 4 + ((sk >> 4) & 3)) * 64 + ((sk >> 3) & 1) * 32 + (ch & 31)) * 8);
                        *(u32x4*)(VT + o) = pack8(acc[ai][bj][m][0] * rs[bj][0], acc[ai][bj][m][1] * rs[bj][1]); } }
        } else {
            bf16_t* dst = VHT + (size_t)b * 512 * 2048 + s0;
#pragma unroll
            for (int ai = 0; ai < 2; ++ai)
#pragma unroll
                for (int m = 0; m < 4; ++m) { const int ch = ch0 + ai * HALF + m * 16;
#pragma unroll
                    for (int bj = 0; bj < 2; ++bj) *(u32x4*)(dst + (unsigned)(ch * 2048 + bj * HALF)) = pack8(acc[ai][bj][m][0] * rs[bj][0], acc[ai][bj][m][1] * rs[bj][1]); }
        }
    }
};

template <class Epi, class Sched, bool ALIGN_EPI = false, bool SP2 = false>
__device__ __forceinline__ void gemm_phase(PG8_LAS unsigned char* lds, const Gemm g, const Sched& S, const Epi& E) {
    const int tid = threadIdx.x, wid = __builtin_amdgcn_readfirstlane(tid >> 6), lane = tid & 63, wr = wid >> 2, wc = wid & 3, fr = lane & 15, fq = lane >> 4;
    const int K = g.K, nt = K / BK;
    unsigned voffA[2], voffB[2];
#pragma unroll
    for (int i = 0; i < 2; ++i) { int R, C; stage_rc(tid * 16 + i * 8192, R, C); const int Rb = Epi::PERM ? ((R & ~31) + perm32(R & 31)) : R;
        voffA[i] = (unsigned)(R * K + C) * 2u; voffB[i] = (unsigned)(Rb * K + C) * 2u; }
    const size_t kstep = (size_t)(BK * 2);
    const size_t hstep = (size_t)HALF * K * 2;
    const size_t tstep = 2 * hstep;
    const unsigned ldsw = (unsigned)wid * 1024u;
    const int aoff = lds_byte(wr * 64 + fr, fq * 8), boff = lds_byte(wc * 32 + fr, fq * 8);
#define PG8_SA(b, h) (((b) * 2 + (h)) * HTB)
#define PG8_SB(b, h) ((4 + (b) * 2 + (h)) * HTB)
#define PG8_STAGE(bufoff, gbase, voff) do { _Pragma("unroll") for (int _i = 0; _i < 2; ++_i) \
        __builtin_amdgcn_global_load_lds((const unsigned*)((const char*)(gbase) + (voff)[_i]), (PG8_LAS unsigned*)(lds + (bufoff) + ldsw + _i * 8192), 16, 0, 0); } while (0)
#define PG8_LDA(dst, b, h) do { _Pragma("unroll") for (int m = 0; m < 4; ++m) _Pragma("unroll") for (int k = 0; k < 2; ++k) dst[m][k] = *(const PG8_LAS bf16x8*)(lds + PG8_SA(b, h) + aoff + m * 2048 + k * 1024); } while (0)
#define PG8_LDB(dst, b, h) do { _Pragma("unroll") for (int n = 0; n < 2; ++n) _Pragma("unroll") for (int k = 0; k < 2; ++k) dst[n][k] = *(const PG8_LAS bf16x8*)(lds + PG8_SB(b, h) + boff + n * 2048 + k * 1024); } while (0)
#define PG8_MMA(ai, bj, At, Bt) do { __builtin_amdgcn_s_setprio(1); _Pragma("unroll") for (int m = 0; m < 4; ++m) _Pragma("unroll") for (int n = 0; n < 2; ++n) _Pragma("unroll") for (int k = 0; k < 2; ++k) \
        acc[ai][bj][m][n] = __builtin_amdgcn_mfma_f32_16x16x32_bf16(Bt[n][k], At[m][k], acc[ai][bj][m][n], 0, 0, 0); __builtin_amdgcn_s_setprio(0); } while (0)
#define PG8_WAIT_V(n) asm volatile("s_waitcnt vmcnt(" #n ")" ::: "memory")
#define PG8_WAIT_L(n) asm volatile("s_waitcnt lgkmcnt(" #n ")" ::: "memory")
#define PG8_BAR __builtin_amdgcn_s_barrier()
#define PG8_SCHED __builtin_amdgcn_sched_barrier(0)
    Unit cur, nxt; int ui = 0;
    if (!S.next(0, cur)) return;
    cur.par = 0;
#define PG8_SCALE_DMA(u_) do { if (Epi::SCALE != 0 && wid == 0 && E.rowsq != nullptr) \
        __builtin_amdgcn_global_load_lds((const unsigned*)(E.rowsq + ((Epi::SCALE == 1 ? (u_).pm : (u_).pn) * BM + lane * 4)), (PG8_LAS unsigned*)(lds + STAGE_BYTES + (u_).par * 1024), 16, 0, 0); } while (0)
    PG8_SCALE_DMA(cur);
    f32x4 acc[2][2][4][2];
#pragma unroll
    for (int a = 0; a < 2; ++a)
#pragma unroll
        for (int b = 0; b < 2; ++b)
#pragma unroll
            for (int m = 0; m < 4; ++m)
#pragma unroll
                for (int n = 0; n < 2; ++n) acc[a][b][m][n] = (f32x4){0.f, 0.f, 0.f, 0.f};
    bf16x8 At[4][2], B0[2][2], B1[2][2];
    const char* cA = (const char*)g.A + (size_t)cur.pm * tstep; const char* cB = (const char*)g.Bt + (size_t)cur.pn * tstep;
    S.a_ready(cur);
    if constexpr (SP2) {
        PG8_STAGE(PG8_SB(0, 0), cB, voffB); PG8_STAGE(PG8_SB(0, 1), cB + hstep, voffB); PG8_STAGE(PG8_SA(0, 0), cA, voffA); PG8_STAGE(PG8_SA(0, 1), cA + hstep, voffA);
        if (wr == 1) PG8_BAR;
        PG8_WAIT_V(2); PG8_BAR;
        PG8_STAGE(PG8_SB(1, 0), cB + kstep, voffB); PG8_STAGE(PG8_SA(1, 0), cA + kstep, voffA); PG8_STAGE(PG8_SB(1, 1), cB + hstep + kstep, voffB);
        PG8_WAIT_V(6); PG8_BAR;
    } else {
        PG8_STAGE(PG8_SB(0, 0), cB, voffB); PG8_STAGE(PG8_SA(0, 0), cA, voffA); PG8_STAGE(PG8_SB(0, 1), cB + hstep, voffB); PG8_STAGE(PG8_SA(0, 1), cA + hstep, voffA);
        if (wr == 1) PG8_BAR;
        PG8_WAIT_V(4); PG8_BAR;
        PG8_STAGE(PG8_SB(1, 0), cB + kstep, voffB); PG8_STAGE(PG8_SA(1, 0), cA + kstep, voffA); PG8_STAGE(PG8_SB(1, 1), cB + hstep + kstep, voffB);
        PG8_WAIT_V(6); PG8_BAR;
    }
    for (;;) {
        const bool has_next = S.next(ui + 1, nxt); nxt.par = (ui + 1) & 1;
        const char* nA = has_next ? (const char*)g.A + (size_t)nxt.pm * tstep : cA; const char* nB = has_next ? (const char*)g.Bt + (size_t)nxt.pn * tstep : cB;
        for (int t = 0; t < nt; t += 2) {
            const bool last = (t == nt - 2);
            const char* a1 = cA + (size_t)(t + 1) * kstep;
            const char* a2 = last ? nA : cA + (size_t)(t + 2) * kstep; const char* b2 = last ? nB : cB + (size_t)(t + 2) * kstep;
            const char* a3 = a2 + kstep; const char* b3 = b2 + kstep;
            if (last && has_next) { S.a_ready(nxt); PG8_SCALE_DMA(nxt); }
            if constexpr (SP2) {
            PG8_LDB(B0, 0, 0); PG8_LDB(B1, 0, 1); PG8_SCHED; PG8_LDA(At, 0, 0); PG8_STAGE(PG8_SA(1, 1), a1 + hstep, voffA);
            PG8_WAIT_V(8); PG8_WAIT_L(0); PG8_BAR; PG8_MMA(0, 0, At, B0); PG8_MMA(0, 1, At, B1); PG8_BAR; PG8_SCHED;
            PG8_LDA(At, 0, 1); PG8_STAGE(PG8_SB(0, 0), b2, voffB); PG8_STAGE(PG8_SB(0, 1), b2 + hstep, voffB); PG8_STAGE(PG8_SA(0, 0), a2, voffA);
            PG8_WAIT_V(8); PG8_WAIT_L(0); PG8_BAR; PG8_MMA(1, 0, At, B0); PG8_MMA(1, 1, At, B1); PG8_BAR; PG8_SCHED;
            PG8_LDB(B0, 1, 0); PG8_LDB(B1, 1, 1); PG8_SCHED; PG8_LDA(At, 1, 0); PG8_STAGE(PG8_SA(0, 1), a2 + hstep, voffA);
            PG8_WAIT_V(8); PG8_WAIT_L(0); PG8_BAR; PG8_MMA(0, 0, At, B0); PG8_MMA(0, 1, At, B1); PG8_BAR; PG8_SCHED;
            PG8_LDA(At, 1, 1); PG8_STAGE(PG8_SB(1, 0), b3, voffB); PG8_STAGE(PG8_SB(1, 1), b3 + hstep, voffB); PG8_STAGE(PG8_SA(1, 0), a3, voffA);
            PG8_WAIT_V(8); PG8_WAIT_L(0); PG8_BAR; PG8_MMA(1, 0, At, B0); PG8_MMA(1, 1, At, B1); PG8_BAR; PG8_SCHED;
            } else {
            PG8_LDB(B0, 0, 0); PG8_SCHED; PG8_LDA(At, 0, 0); PG8_STAGE(PG8_SA(1, 1), a1 + hstep, voffA);
            PG8_WAIT_L(8); PG8_BAR; PG8_WAIT_L(0); PG8_MMA(0, 0, At, B0); PG8_BAR; PG8_SCHED;
            PG8_LDB(B1, 0, 1); PG8_STAGE(PG8_SB(0, 0), b2, voffB);
            PG8_BAR; PG8_WAIT_L(0); PG8_MMA(0, 1, At, B1); PG8_BAR;
            PG8_LDA(At, 0, 1); PG8_STAGE(PG8_SA(0, 0), a2, voffA);
            PG8_BAR; PG8_WAIT_L(0); PG8_MMA(1, 0, At, B0); PG8_BAR; PG8_SCHED;
            PG8_STAGE(PG8_SB(0, 1), b2 + hstep, voffB);
            PG8_WAIT_V(6); PG8_BAR; PG8_MMA(1, 1, At, B1); PG8_BAR;
            PG8_LDB(B0, 1, 0); PG8_SCHED; PG8_LDA(At, 1, 0); PG8_STAGE(PG8_SA(0, 1), a2 + hstep, voffA);
            PG8_WAIT_L(8); PG8_BAR; PG8_WAIT_L(0); PG8_MMA(0, 0, At, B0); PG8_BAR; PG8_SCHED;
            PG8_LDB(B1, 1, 1); PG8_STAGE(PG8_SB(1, 0), b3, voffB);
            PG8_BAR; PG8_WAIT_L(0); PG8_MMA(0, 1, At, B1); PG8_BAR;
            PG8_LDA(At, 1, 1); PG8_STAGE(PG8_SA(1, 0), a3, voffA);
            PG8_BAR; PG8_WAIT_L(0); PG8_MMA(1, 0, At, B0); PG8_BAR; PG8_SCHED;
            PG8_STAGE(PG8_SB(1, 1), b3 + hstep, voffB);
            PG8_WAIT_V(6); PG8_BAR; PG8_MMA(1, 1, At, B1); PG8_BAR;
            }
        }
        if constexpr (ALIGN_EPI) { if (wr == 0) PG8_BAR; }
        if constexpr (!Epi::AFTER_DRAIN) { E(acc, cur, wr, wc, fr, fq); S.done(cur); }
        if (!has_next) break;
#pragma unroll
        for (int a = 0; a < 2; ++a)
#pragma unroll
            for (int b = 0; b < 2; ++b)
#pragma unroll
                for (int m = 0; m < 4; ++m)
#pragma unroll
                    for (int n = 0; n < 2; ++n) acc[a][b][m][n] = (f32x4){0.f, 0.f, 0.f, 0.f};
        cur = nxt; cA = nA; cB = nB; ++ui;
        if constexpr (ALIGN_EPI) { if (wr == 1) PG8_BAR; }
    }
    PG8_WAIT_V(0);
    if constexpr (!ALIGN_EPI) { if (wr == 0) PG8_BAR; }
    PG8_BAR;
    if constexpr (Epi::AFTER_DRAIN) { E.fused(acc, cur, wr, wc, fr, fq, lds, wid, lane); S.done(cur); }
#undef PG8_SCALE_DMA
#undef PG8_SA
#undef PG8_SB
#undef PG8_STAGE
#undef PG8_LDA
#undef PG8_LDB
#undef PG8_MMA
#undef PG8_WAIT_V
#undef PG8_WAIT_L
#undef PG8_BAR
#undef PG8_SCHED
}
}

constexpr int NWAVES = 8;
#ifndef MK_N_LAUNCHES
#define MK_N_LAUNCHES 1
#endif
constexpr int PER_PHASE = 8;
constexpr int N_LAUNCHES = MK_N_LAUNCHES;
constexpr int BATCH = 16, SEQ = 2048, D = 1024, M = BATCH * SEQ, FF = 2816, NPROJ = 3584;
constexpr int AW = 512, HW = 512, NCHUNK = SEQ / 64;
constexpr float RMS_EPS = 1e-6f, LOG2E = 1.4426950408889634f;
#ifndef WGM_GU
#define WGM_GU 4
#endif
#ifndef WGM_DOWN
#define WGM_DOWN 4
#endif
#ifndef WGM_OUT
#define WGM_OUT 4
#endif
#ifndef WGM_IN
#define WGM_IN 4
#endif
#ifndef WGM_INT
#define WGM_INT 4
#endif

constexpr size_t MiB = 1u << 20;
constexpr size_t WS_CTL = 0, CTL_ZERO_BYTES = 1 * MiB;
constexpr size_t WS_RS1 = 256 * 1024, WS_RS2 = 384 * 1024;
constexpr size_t WS_LB = 1 * MiB, WS_DM = 2 * MiB, WS_DE = 3 * MiB;
constexpr size_t WS_WGU1 = 4 * MiB, WS_WD1 = 15 * MiB, WS_WIN = 21 * MiB, WS_WINT = 26 * MiB, WS_WOUT = 28 * MiB, WS_WGU2 = 30 * MiB, WS_WD2 = 41 * MiB;
constexpr size_t WS_XB = 48 * MiB;
constexpr size_t WS_MIX = 112 * MiB;
constexpr size_t WS_HID = 176 * MiB;
constexpr size_t WS_Q = 176 * MiB, WS_K = 208 * MiB, WS_VT = 240 * MiB, WS_QT = 272 * MiB, WS_KT = 304 * MiB, WS_VHT = 336 * MiB, WS_G = 368 * MiB, WS_END = 400 * MiB;
static_assert(WS_WGU1 + (size_t)2 * FF * D * 2 <= WS_WD1 && WS_WD1 + (size_t)D * FF * 2 <= WS_WIN && WS_WIN + (size_t)2560 * D * 2 <= WS_WINT && WS_WGU2 + (size_t)2 * FF * D * 2 <= WS_WD2 && WS_WD2 + (size_t)D * FF * 2 <= WS_XB, "weight map");
static_assert(WS_HID + (size_t)M * FF * 2 <= WS_END && WS_XB + (size_t)M * D * 2 <= WS_MIX && WS_MIX + (size_t)M * D * 2 <= WS_HID, "activation map");
constexpr int CW_TMO = 0, CW_CODE = 1;
constexpr int CW_BAR = 4096;
constexpr int CW_WQ = 16384;

constexpr int RING_OFF = 0, RING_BYTES = 131072;
constexpr int LDS_BYTES = 163840;
constexpr int LDSCTL_OFF = LDS_BYTES - 1024, MISC_OFF = LDSCTL_OFF + 320;
static_assert(MISC_OFF + 128 <= LDS_BYTES, "LDS map");

#define GAS __attribute__((address_space(1)))
#define LAS __attribute__((address_space(3)))
typedef unsigned short bf16;
typedef unsigned v4u __attribute__((ext_vector_type(4)));
typedef float f32x4 __attribute__((ext_vector_type(4)));
typedef short bf16x8 __attribute__((ext_vector_type(8)));
typedef GAS unsigned gu32;
#define RLX_AGENT __ATOMIC_RELAXED, __HIP_MEMORY_SCOPE_AGENT
#define LDS_WAIT() asm volatile("s_waitcnt lgkmcnt(0)" ::: "memory")
#define VM_WAIT() asm volatile("s_waitcnt vmcnt(0)" ::: "memory")
__device__ __forceinline__ unsigned f2bf(float f) { unsigned u = __builtin_bit_cast(unsigned, f); return (u + 0x7fffu + ((u >> 16) & 1u)) >> 16; }
__device__ __forceinline__ unsigned pk2(float lo, float hi) { return f2bf(lo) | (f2bf(hi) << 16); }
__device__ __forceinline__ float bf2f(unsigned short h) { return __builtin_bit_cast(float, (unsigned)h << 16); }
__device__ __forceinline__ float bflo(unsigned w) { return __builtin_bit_cast(float, w << 16); }
__device__ __forceinline__ float bfhi(unsigned w) { return __builtin_bit_cast(float, w & 0xffff0000u); }

#define XB_TMO      128
#define XB_XCNT(j)  (256  + 64 * (j))
#define XB_XSUB(j)  (1280 + 64 * (j))
#define XB_XGEN(j)  (2304 + 64 * (j))
#define XB_TOP      3328
#define XB_TOPGEN   3392
#define XCD_BAR_WORDS 3456
#define XB_SPIN_CAP (1u << 18)

__device__ __forceinline__ unsigned xb_ld(unsigned* p)              { return __hip_atomic_load(p, __ATOMIC_RELAXED, __HIP_MEMORY_SCOPE_AGENT); }
__device__ __forceinline__ unsigned xb_add(unsigned* p, unsigned v) { return __hip_atomic_fetch_add(p, v, __ATOMIC_RELAXED, __HIP_MEMORY_SCOPE_AGENT); }
__device__ __forceinline__ unsigned xb_xcc_id() { return (unsigned)__builtin_amdgcn_s_getreg((3 << 11) | 20) & 0xFu; }
#define XB_SPIN(cond, bar) do { unsigned _sp = 0; while (cond) { __builtin_amdgcn_s_sleep(1); \
    if ((++_sp & 255u) == 0u) { if (xb_ld(&(bar)[XB_TMO])) break; if (_sp > XB_SPIN_CAP) { atomicAdd(&(bar)[XB_TMO], 1u); break; } } } } while (0)

struct XcdBarrier {
    unsigned* bar; unsigned x;
    volatile LAS unsigned* st;
};

__device__ __forceinline__ XcdBarrier xcd_barrier_post(unsigned* bar, volatile LAS unsigned* st) {
    XcdBarrier b; b.bar = bar; b.x = xb_xcc_id(); b.st = st;
    if (threadIdx.x == 0) (void)xb_add(&bar[XB_XCNT(b.x)], 1u);
    return b;
}
__device__ __forceinline__ void xcd_barrier_complete(unsigned* bar, unsigned x, unsigned& nloc, unsigned& nx) {
    const unsigned G = gridDim.x * gridDim.y * gridDim.z;
    unsigned sum, cnt, mine, sp = 0u;
    for (;;) {
        sum = 0u; cnt = 0u; mine = 0u;
#pragma unroll
        for (unsigned j = 0; j < 16; ++j) { const unsigned c = xb_ld(&bar[XB_XCNT(j)]); sum += c; cnt += (c > 0u) ? 1u : 0u; mine = (j == x) ? c : mine; }
        if (sum == G) break;
        __builtin_amdgcn_s_sleep(1);
        if ((++sp & 255u) == 0u) { if (xb_ld(&bar[XB_TMO])) break; if (sp > XB_SPIN_CAP) { atomicAdd(&bar[XB_TMO], 1u); break; } }
    }
    nloc = mine > 0u ? mine : 1u; nx = cnt > 0u ? cnt : 1u;
}

__device__ __forceinline__ void xcd_barrier(const XcdBarrier& b) {
    asm volatile("s_waitcnt vmcnt(0)" ::: "memory");
    __syncthreads();
    if (threadIdx.x == 0) {
        unsigned* bar = b.bar;
        __builtin_amdgcn_s_waitcnt(0);
        unsigned nloc = b.st[0], nx = b.st[1];
        if (nloc == 0u) { xcd_barrier_complete(bar, b.x, nloc, nx); b.st[0] = nloc; b.st[1] = nx; }
        const unsigned old = xb_add(&bar[XB_XSUB(b.x)], 1u);
        const unsigned gen = old / nloc;
        if (old + 1u == (gen + 1u) * nloc) {
            __builtin_amdgcn_fence(__ATOMIC_RELEASE, "agent");
            asm volatile("s_waitcnt vmcnt(0)" ::: "memory");
            const unsigned og = xb_add(&bar[XB_TOP], 1u);
            const unsigned tg = og / nx;
            if (og + 1u == (tg + 1u) * nx) xb_add(&bar[XB_TOPGEN], 1u);
            else XB_SPIN(xb_ld(&bar[XB_TOPGEN]) == tg, bar);
            __builtin_amdgcn_fence(__ATOMIC_ACQUIRE, "agent");
            xb_add(&bar[XB_XGEN(b.x)], 1u);
            asm volatile("s_waitcnt vmcnt(0)" ::: "memory");
        } else {
            XB_SPIN(xb_ld(&bar[XB_XGEN(b.x)]) == gen, bar);
            __builtin_amdgcn_fence(__ATOMIC_ACQUIRE, "agent");
            asm volatile("s_waitcnt vmcnt(0)" ::: "memory");
        }
    }
    __syncthreads();
}

struct Frame {
    LAS unsigned char* lds;
    volatile LAS unsigned* MISC;
    gu32* ctl;
    int tid, lane, wave, G;
    const float* in[17]; float* out; unsigned char* ws;
};
__device__ __forceinline__ float wave_sum(float v) {
#pragma unroll
    for (int o = 1; o < 64; o <<= 1) v += __shfl_xor(v, o);
    return v;
}
__device__ __forceinline__ int srccol(int kind, int R, int& sel) {
    sel = 0;
    if (kind == 0) return R;
    const int t = R >> 8, p = R & 255, bj = p >> 7, q = p & 127, wc = q >> 5, pr = pg8::perm32(q & 31);
    if (kind == 1) { sel = bj; return 128 * t + 32 * wc + pr; }
    if (kind == 2) {
        if (t < 2) return 64 * (4 * t + wc) + 32 * bj + pr;
        if (t < 4) return 512 + 64 * (4 * (t - 2) + wc) + 32 * bj + pr;
        if (t < 8) return (bj ? 2048 : 1536) + 128 * (t - 4) + 32 * wc + pr;
        return 3072 + 256 * (t - 8) + 128 * bj + 32 * wc + pr;
    }
    return R < 512 ? 1024 + R : 2560 + (R - 512);
}
struct P0Blk { f32x4 v[8]; };
__device__ __forceinline__ void p0_load(P0Blk& t, const float* W0, const float* W1, int N, int kind, int item, int nblk, int lane) {
    const int kb = item / nblk, nb = item % nblk, k0 = 64 * kb + 8 * (lane >> 3), R = 32 * nb + 4 * (lane & 7);
    int sel; const int c = srccol(kind, R, sel);
    const float* W = (sel ? W1 : W0) + (size_t)k0 * N + c;
#pragma unroll
    for (int i = 0; i < 8; ++i) t.v[i] = *(const f32x4*)(W + (size_t)i * N);
}
__device__ __forceinline__ void p0_store(const P0Blk& t, int K, bf16* WT, const float* gain, int kind, int item, int nblk, int lane) {
    const int kb = item / nblk, nb = item % nblk, k0 = 64 * kb + 8 * (lane >> 3), R = 32 * nb + 4 * (lane & 7);
    float gk[8];
    const float ws = kind == 1 ? (((R >> 7) & 1) ? 1.0f / LOG2E : LOG2E) : 1.0f;
#pragma unroll
    for (int i = 0; i < 8; ++i) gk[i] = ws;
    if (gain) { const f32x4 g0 = *(const f32x4*)(gain + k0), g1 = *(const f32x4*)(gain + k0 + 4);
#pragma unroll
        for (int i = 0; i < 4; ++i) { gk[i] = g0[i] * ws; gk[4 + i] = g1[i] * ws; } }
#pragma unroll
    for (int j = 0; j < 4; ++j) { v4u o; o.x = pk2(t.v[0][j] * gk[0], t.v[1][j] * gk[1]); o.y = pk2(t.v[2][j] * gk[2], t.v[3][j] * gk[3]); o.z = pk2(t.v[4][j] * gk[4], t.v[5][j] * gk[5]); o.w = pk2(t.v[6][j] * gk[6], t.v[7][j] * gk[7]);
        *(GAS v4u*)(WT + (size_t)(R + j) * K + k0) = o; }
}
struct P0Job { const float* W0; const float* W1; const float* gain; bf16* WT; int K, N, kind, nblk, item; };
constexpr int P0_I_GU = (D / 64) * (2 * FF / 32), P0_I_D = (FF / 64) * (D / 32), P0_I_IN = (D / 64) * (2560 / 32), P0_I_INT = (D / 64) * (1024 / 32), P0_I_O = (D / 64) * (D / 32);
constexpr int P0_N0 = P0_I_GU + P0_I_D + P0_I_IN + P0_I_INT, P0_N1 = P0_I_GU + P0_I_D + P0_I_O;
__device__ __forceinline__ P0Job p0_job(Frame& F, int set, int it) {
    int r = it;
    if (set == 0) {
        if (r < P0_I_GU) return P0Job{F.in[2], F.in[3], nullptr, (bf16*)(F.ws + WS_WGU1), D, FF, 1, 2 * FF / 32, r}; r -= P0_I_GU;
        if (r < P0_I_D) return P0Job{F.in[4], F.in[4], nullptr, (bf16*)(F.ws + WS_WD1), FF, D, 0, D / 32, r}; r -= P0_I_D;
        if (r < P0_I_IN) return P0Job{F.in[6], F.in[6], F.in[5], (bf16*)(F.ws + WS_WIN), D, NPROJ, 2, 2560 / 32, r}; r -= P0_I_IN;
        return P0Job{F.in[6], F.in[6], F.in[5], (bf16*)(F.ws + WS_WINT), D, NPROJ, 3, 1024 / 32, r};
    }
    if (r < P0_I_GU) return P0Job{F.in[14], F.in[15], F.in[13], (bf16*)(F.ws + WS_WGU2), D, FF, 1, 2 * FF / 32, r}; r -= P0_I_GU;
    if (r < P0_I_D) return P0Job{F.in[16], F.in[16], nullptr, (bf16*)(F.ws + WS_WD2), FF, D, 0, D / 32, r}; r -= P0_I_D;
    return P0Job{F.in[12], F.in[12], nullptr, (bf16*)(F.ws + WS_WOUT), D, D, 0, D / 32, r};
}
__device__ __forceinline__ void p0_weights(Frame& F, int set, int gw, int NGW) {
    const int NIT = set == 0 ? P0_N0 : P0_N1;
    int it = gw;
    if (it < NIT) {
        P0Job j0 = p0_job(F, set, it); P0Blk t0; p0_load(t0, j0.W0, j0.W1, j0.N, j0.kind, j0.item, j0.nblk, F.lane);
        for (;;) {
            const int it1 = it + NGW; const bool more = it1 < NIT;
            P0Job j1 = j0; P0Blk t1;
            if (more) { j1 = p0_job(F, set, it1); p0_load(t1, j1.W0, j1.W1, j1.N, j1.kind, j1.item, j1.nblk, F.lane); }
            p0_store(t0, j0.K, j0.WT, j0.gain, j0.kind, j0.item, j0.nblk, F.lane);
            if (!more) break;
            it = it1; j0 = j1;
#pragma unroll
            for (int i = 0; i < 8; ++i) t0.v[i] = t1.v[i];
        }
    }
}
__device__ __forceinline__ void rms_rows4_to_bf16(const float* x, const float* g, bf16* o, int lane) {
    f32x4 v[4][4]; float s[4];
#pragma unroll
    for (int r = 0; r < 4; ++r)
#pragma unroll
        for (int j = 0; j < 4; ++j) v[r][j] = *((const GAS f32x4*)(x + (size_t)r * D) + lane + 64 * j);
#pragma unroll
    for (int r = 0; r < 4; ++r) { s[r] = 0.f;
#pragma unroll
        for (int j = 0; j < 4; ++j) s[r] += (v[r][j].x * v[r][j].x + v[r][j].y * v[r][j].y) + (v[r][j].z * v[r][j].z + v[r][j].w * v[r][j].w); }
#pragma unroll
    for (int of = 1; of < 64; of <<= 1) {
#pragma unroll
        for (int r = 0; r < 4; ++r) s[r] += __shfl_xor(s[r], of); }
    f32x4 gg[4];
#pragma unroll
    for (int j = 0; j < 4; ++j) gg[j] = *((const GAS f32x4*)g + lane + 64 * j);
#pragma unroll
    for (int r = 0; r < 4; ++r) { const float rr = __builtin_amdgcn_rsqf(s[r] * (1.f / D) + RMS_EPS);
        GAS unsigned long long* o8 = (GAS unsigned long long*)(o + (size_t)r * D) + lane;
#pragma unroll
        for (int j = 0; j < 4; ++j) o8[64 * j] = (unsigned long long)pk2(v[r][j].x * rr * gg[j].x, v[r][j].y * rr * gg[j].y) | ((unsigned long long)pk2(v[r][j].z * rr * gg[j].z, v[r][j].w * rr * gg[j].w) << 32); }
}
__device__ __forceinline__ void p0_prologue(Frame& F, unsigned long long& p0_probe) {
    const int gw = (int)blockIdx.x * NWAVES + F.wave, NGW = F.G * NWAVES;
#if defined(PROBE_PHASE) && (PROBE_PHASE == 13 || PROBE_PHASE == 14)
    const unsigned long long p0_t0 = __builtin_amdgcn_s_memrealtime();
#endif
    p0_weights(F, 0, gw, NGW);
#if defined(PROBE_PHASE) && (PROBE_PHASE == 13 || PROBE_PHASE == 14)
    const unsigned long long tp1_ = __builtin_amdgcn_s_memrealtime();
    if (PROBE_PHASE == 13) p0_probe = tp1_ - p0_t0;
#endif
    for (int m = 4 * gw; m < M; m += 4 * NGW) rms_rows4_to_bf16(F.in[0] + (size_t)m * D, F.in[1], (bf16*)(F.ws + WS_XB) + (size_t)m * D, F.lane);
#if defined(PROBE_PHASE) && (PROBE_PHASE == 13 || PROBE_PHASE == 14)
    if (PROBE_PHASE == 14) p0_probe = __builtin_amdgcn_s_memrealtime() - tp1_;
#endif
    if (blockIdx.x == 0) {
        const float l0 = F.in[10][F.tid], l1 = F.in[10][512 + F.tid], mx = fmaxf(l0, l1), e0 = __expf(l0 - mx), e1 = __expf(l1 - mx);
        ((float*)(F.ws + WS_LB))[F.tid] = e0 / (e0 + e1);
    }
}

typedef float f32x16 __attribute__((ext_vector_type(16)));
typedef float f32x2_t __attribute__((ext_vector_type(2))); typedef __bf16 bf16x2_t __attribute__((ext_vector_type(2)));
__device__ __forceinline__ unsigned cvtpk_s(float lo, float hi) { f32x2_t v = {lo, hi}; bf16x2_t b = __builtin_convertvector(v, bf16x2_t); return __builtin_bit_cast(unsigned, b); }
__device__ __forceinline__ bf16x8 pack_step(const f32x16& x, int s) { v4u p; p.x = cvtpk_s(x[8 * s], x[8 * s + 1]); p.y = cvtpk_s(x[8 * s + 2], x[8 * s + 3]); p.z = cvtpk_s(x[8 * s + 4], x[8 * s + 5]); p.w = cvtpk_s(x[8 * s + 6], x[8 * s + 7]); return __builtin_bit_cast(bf16x8, p); }
__device__ __forceinline__ float swapmax(float m) { auto rr = __builtin_amdgcn_permlane32_swap(__float_as_uint(m), __float_as_uint(m), false, false); return fmaxf(__uint_as_float(rr[0]), __uint_as_float(rr[1])); }
__device__ __forceinline__ float swapsum(float m) { auto rr = __builtin_amdgcn_permlane32_swap(__float_as_uint(m), __float_as_uint(m), false, false); return __uint_as_float(rr[0]) + __uint_as_float(rr[1]); }
__device__ __forceinline__ int pi32(int x) { return (x & 0x13) | ((x & 4) << 1) | ((x & 8) >> 1); }
#define MFMA32(a, b, c) __builtin_amdgcn_mfma_f32_32x32x16_bf16((a), (b), (c), 0, 0, 0)
constexpr int ATT_ETAB_OFF = 0;
__device__ __forceinline__ void attn_item(Frame& F, int b, int c, int h, const LAS float* etab) {
    const bf16* Q = (const bf16*)(F.ws + WS_Q); const bf16* Kp = (const bf16*)(F.ws + WS_K); const bf16* VT = (const bf16*)(F.ws + WS_VT); bf16* MIX = (bf16*)(F.ws + WS_MIX);
    const int lane = F.lane, r32 = lane & 31, hi = lane >> 5;
    const float cfar = F.in[9][h * 257 + 256] * LOG2E;
    bf16x8 qf[2][4];
#pragma unroll
    for (int qb = 0; qb < 2; ++qb)
#pragma unroll
        for (int d0 = 0; d0 < 4; ++d0) qf[qb][d0] = *(const bf16x8*)(Q + (unsigned)((((((b * 8 + h) * 32 + c) * 2 + qb) * 4 + d0) * 64 + lane) * 8));
    f32x16 o[2][2];
#pragma unroll
    for (int db = 0; db < 2; ++db)
#pragma unroll
        for (int qb = 0; qb < 2; ++qb)
#pragma unroll
            for (int r = 0; r < 16; ++r) o[db][qb][r] = 0.f;
    float mrun[2] = {-INFINITY, -INFINITY}, lrun[2] = {0.f, 0.f};
    const int kt0 = c >= 8 ? c - 8 : 0;
    const unsigned fbase = (unsigned)(((b * 8 + h) * 32 * 8 * 64 + lane) * 8);
    const LAS float* et = etab + h * 256;
    bf16x8 kf[2][4], vf[2][4];
#define AT_LOADK(kt_) do { _Pragma("unroll") for (int kb = 0; kb < 2; ++kb) _Pragma("unroll") for (int d0 = 0; d0 < 4; ++d0) kf[kb][d0] = *(const bf16x8*)(Kp + fbase + (unsigned)((((kt_) * 2 + kb) * 4 + d0) * 512)); } while (0)
#define AT_LOADV(kt_) do { _Pragma("unroll") for (int db = 0; db < 2; ++db) _Pragma("unroll") for (int ks = 0; ks < 4; ++ks) vf[db][ks] = *(const bf16x8*)(VT + fbase + (unsigned)((((kt_) * 2 + db) * 4 + ks) * 512)); } while (0)
    AT_LOADK(kt0); AT_LOADV(kt0);
    for (int kt = kt0; kt <= c; ++kt) {
        const int j = c - kt, ktn = kt < c ? kt + 1 : c;
#pragma unroll
        for (int qb = 0; qb < 2; ++qb) {
            f32x16 s[2]; bf16x8 pk[2][2];
            const float c0 = j >= 3 ? cfar : 0.f;
#pragma unroll
            for (int r = 0; r < 16; ++r) { s[0][r] = c0; s[1][r] = c0; }
#pragma unroll
            for (int d0 = 0; d0 < 4; ++d0) { s[0] = MFMA32(kf[0][d0], qf[qb][d0], s[0]); s[1] = MFMA32(kf[1][d0], qf[qb][d0], s[1]); }
            if (qb == 1) { __builtin_amdgcn_sched_barrier(0); AT_LOADK(ktn); __builtin_amdgcn_sched_barrier(0); }
            if (j < 3) {
                const int ib = 64 * j + 32 * qb + r32 - 8 * hi + 63;
#pragma unroll
                for (int kb = 0; kb < 2; ++kb)
#pragma unroll
                    for (int r = 0; r < 16; ++r) s[kb][r] += et[ib - 32 * kb - 16 * (r >> 3) - (r & 7)];
            }
            float tm = fmaxf(s[0][0], s[1][0]);
#pragma unroll
            for (int r = 1; r < 16; ++r) tm = fmaxf(tm, fmaxf(s[0][r], s[1][r]));
            tm = swapmax(tm);
            const float mn = fmaxf(mrun[qb], tm), alpha = __builtin_amdgcn_exp2f(mrun[qb] - mn); mrun[qb] = mn;
            float ls = 0.f;
#pragma unroll
            for (int kb = 0; kb < 2; ++kb)
#pragma unroll
                for (int r = 0; r < 16; ++r) { const float p = __builtin_amdgcn_exp2f(s[kb][r] - mn); s[kb][r] = p; ls += p; }
            lrun[qb] = lrun[qb] * alpha + ls;
#pragma unroll
            for (int db = 0; db < 2; ++db)
#pragma unroll
                for (int r = 0; r < 16; ++r) o[db][qb][r] *= alpha;
#pragma unroll
            for (int kb = 0; kb < 2; ++kb) { pk[kb][0] = pack_step(s[kb], 0); pk[kb][1] = pack_step(s[kb], 1); }
#pragma unroll
            for (int db = 0; db < 2; ++db)
#pragma unroll
                for (int kb = 0; kb < 2; ++kb)
#pragma unroll
                    for (int sp = 0; sp < 2; ++sp) o[db][qb] = MFMA32(vf[db][2 * kb + sp], pk[kb][sp], o[db][qb]);
        }
        __builtin_amdgcn_sched_barrier(0); AT_LOADV(ktn); __builtin_amdgcn_sched_barrier(0);
    }
#undef AT_LOADK
#undef AT_LOADV
#pragma unroll
    for (int qb = 0; qb < 2; ++qb) {
        const float inv = 1.0f / swapsum(lrun[qb]);
        bf16* orow = MIX + (unsigned)((b * SEQ + 64 * c + 32 * qb + r32) * 1024 + h * 64 + 16 * hi);
#pragma unroll
        for (int db = 0; db < 2; ++db) {
            unsigned wx[4], wy[4];
#pragma unroll
            for (int g = 0; g < 4; ++g) { wx[g] = cvtpk_s(o[db][qb][4 * g] * inv, o[db][qb][4 * g + 1] * inv); wy[g] = cvtpk_s(o[db][qb][4 * g + 2] * inv, o[db][qb][4 * g + 3] * inv); }
#pragma unroll
            for (int p = 0; p < 2; ++p) {
                auto ax = __builtin_amdgcn_permlane32_swap(wx[p], wx[p + 2], false, false); auto ay = __builtin_amdgcn_permlane32_swap(wy[p], wy[p + 2], false, false);
                *(v4u*)(orow + 32 * db + 8 * p) = (v4u){ax[0], ay[0], ax[1], ay[1]}; }
        }
    }
}
__device__ __forceinline__ void attn_phase(Frame& F) {
    LAS float* etab = (LAS float*)(F.lds + RING_OFF + ATT_ETAB_OFF);
    for (int i = F.tid; i < 8 * 256; i += NWAVES * 64) { const int h = i >> 8; int rel = (i & 255) - 63; rel = rel > 128 ? 128 : rel; etab[i] = F.in[9][h * 257 + rel + 128] * LOG2E; }
    __syncthreads();
    for (int k = 0; k < 8; ++k) {
        const int shard = ((int)blockIdx.x + k) & 7;
        gu32* head = F.ctl + CW_WQ + 64 * shard;
        for (;;) {
            unsigned n = 0; if (F.lane == 0) n = __hip_atomic_fetch_add(head, 1u, RLX_AGENT);
            n = (unsigned)__builtin_amdgcn_readfirstlane((int)n);
            if (n >= 512u) break;
            const int bh = 8 * (int)(n >> 5) + shard, c = 31 - (int)(n & 31);
            attn_item(F, bh >> 3, c, bh & 7, etab);
        }
    }
    __syncthreads();
}

__device__ __forceinline__ unsigned off_b(unsigned row, unsigned ch) { return 256u * row + 16u * (ch ^ (((row & 3) << 2) | ((row >> 2) & 3))); }
__device__ __forceinline__ unsigned tr_read_addr_b(unsigned lane, unsigned c, unsigned ks, unsigned t) {
    const unsigned h = lane >> 5, blk = (lane >> 4) & 1, q = (lane & 15) >> 2, p = lane & 3;
    return off_b(16 * ks + 8 * h + 4 * t + q, 4 * c + 2 * blk + (p >> 1)) + 8 * (p & 1);
}
typedef short v4i16_t __attribute__((ext_vector_type(4)));
__device__ __forceinline__ v4i16_t lds_tr(const LAS unsigned char* p) { return __builtin_amdgcn_ds_read_tr16_b64_v4i16((LAS v4i16_t*)p); }
__device__ __forceinline__ bf16x8 krow_frag(bf16x8 nat) {
    const v4u d = __builtin_bit_cast(v4u, nat);
    auto a = __builtin_amdgcn_permlane32_swap(d.x, d.z, false, false); auto b = __builtin_amdgcn_permlane32_swap(d.y, d.w, false, false);
    v4u r; r.x = a[0]; r.y = b[0]; r.z = a[1]; r.w = b[1]; return __builtin_bit_cast(bf16x8, r);
}
constexpr int HG_PS_OFF = 8192, HG_DD_OFF = 10240, HG_GN_OFF = 12288, HG_BUF_OFF = 16384;
constexpr int HG_QT_OFF = 16384, HG_VT_OFF = 32768, HG_BUF_BYTES = 49152;
constexpr int HG_OX_OFF = HG_BUF_OFF + 2 * HG_BUF_BYTES, HG_OX_BYTES = 64 * 264;
constexpr int HG_XS_OFF = HG_OX_OFF + 2 * HG_OX_BYTES;
static_assert(HG_XS_OFF + 3 * 2048 <= LDSCTL_OFF && HG_OX_OFF % 16 == 0 && HG_XS_OFF % 16 == 0, "HGRN LDS map");
__device__ __forceinline__ void dma16(const void* g, LAS unsigned char* l) { __builtin_amdgcn_global_load_lds((const unsigned*)g, (LAS unsigned*)l, 16, 0, 0); }
__device__ __forceinline__ void hgrn_finalize(Frame& F, const v4u (&gw)[4], int b, int hh, int c) {
    bf16* MIX = (bf16*)(F.ws + WS_MIX);
    const int ht = F.tid - 256, tok = ht >> 2, pc = ht & 3;
    const LAS float* ps = (const LAS float*)(F.lds + RING_OFF + HG_PS_OFF) + ((c & 1) * 2 + (tok >> 5)) * 128 + (tok & 31);
    const float tot = (ps[0] + ps[32]) + (ps[64] + ps[96]);
    const float rs = __builtin_amdgcn_rsqf(tot * (1.0f / 128.0f) + RMS_EPS);
    const LAS unsigned char* ox = F.lds + RING_OFF + HG_OX_OFF + (c & 1) * HG_OX_BYTES + tok * 264 + 64 * pc;
    const LAS f32x4* gn = (const LAS f32x4*)(F.lds + RING_OFF + HG_GN_OFF) + 8 * pc;
    bf16* dst = MIX + (unsigned)((b * SEQ + 64 * c + tok) * 1024 + 512 + hh * 128 + 32 * pc);
#pragma unroll
    for (int q = 0; q < 4; ++q) { unsigned ow[4]; const unsigned g4w[4] = {gw[q].x, gw[q].y, gw[q].z, gw[q].w};
#pragma unroll
        for (int i = 0; i < 2; ++i) { const pg8::u32x2 o2 = *(const LAS pg8::u32x2*)(ox + 16 * q + 8 * i); const f32x4 g4 = gn[2 * q + i];
            ow[2 * i] = cvtpk_s(bflo(o2.x) * rs * g4[0] * bflo(g4w[2 * i]), bfhi(o2.x) * rs * g4[1] * bfhi(g4w[2 * i]));
            ow[2 * i + 1] = cvtpk_s(bflo(o2.y) * rs * g4[2] * bflo(g4w[2 * i + 1]), bfhi(o2.y) * rs * g4[3] * bfhi(g4w[2 * i + 1])); }
        *(v4u*)(dst + 8 * q) = (v4u){ow[0], ow[1], ow[2], ow[3]}; }
}
__device__ __forceinline__ void hgrn_phase(Frame& F, int bh, unsigned long long& hg_wait_acc) {
    (void)hg_wait_acc;
    const unsigned char* QT = F.ws + WS_QT; const unsigned char* KT = F.ws + WS_KT; const unsigned char* VHT = F.ws + WS_VHT; const bf16* Gt = (const bf16*)(F.ws + WS_G);
    const unsigned char* DM = F.ws + WS_DM; const unsigned char* DE = F.ws + WS_DE;
    const int b = bh >> 2, hh = bh & 3, lane = F.lane, r32 = lane & 31, hi = lane >> 5, w = F.wave, tid = F.tid;
    LAS unsigned char* const bufs = F.lds + RING_OFF + HG_BUF_OFF;
    LAS float* const psw = (LAS float*)(F.lds + RING_OFF + HG_PS_OFF);
    LAS float* const ddw = (LAS float*)(F.lds + RING_OFF + HG_DD_OFF);
    if (tid < 128) ((LAS float*)(F.lds + RING_OFF + HG_GN_OFF))[tid] = F.in[11][tid];
    if (w >= 4) {
        const int hw = w - 4;
        unsigned so_k[4], so_v[4];
#pragma unroll
        for (int j = 0; j < 4; ++j) { const unsigned ii = (unsigned)(hw + 4 * j), sl = ii * 64 + lane;
            { const unsigned img = sl >> 9, s9 = sl & 511, row = s9 >> 4, ch = (s9 & 15) ^ (((row & 3) << 2) | ((row >> 2) & 3)); so_k[j] = ((32 * img + row) * 512 + hh * 128) * 2 + ch * 16; }
            { const unsigned row = sl >> 3, ch = (sl & 7) ^ (row & 7); so_v[j] = ((hh * 128 + row) * SEQ) * 2 + ch * 16; } }
        const unsigned so_d = (unsigned)((hh * 128) * 4 + (lane & 31) * 16);
        const unsigned char* const ddsrc = (lane < 32 ? DM : DE) + (size_t)(b * NCHUNK) * 2048 + so_d;
        const unsigned char* const ktb = KT + (size_t)(b * SEQ) * 1024; const unsigned char* const qtb = QT + (size_t)(b * SEQ) * 1024; const unsigned char* const vtb = VHT + (size_t)(b * 512) * SEQ * 2;
#define HG_DMA(c_) do { LAS unsigned char* nb_ = bufs + ((c_) & 1) * HG_BUF_BYTES + hw * 1024; const size_t ck_ = (size_t)(c_) * 65536, cv_ = (size_t)(c_) * 128; \
        _Pragma("unroll") for (int j_ = 0; j_ < 4; ++j_) { dma16(ktb + ck_ + so_k[j_], nb_ + j_ * 4096); dma16(qtb + ck_ + so_k[j_], nb_ + HG_QT_OFF + j_ * 4096); dma16(vtb + cv_ + so_v[j_], nb_ + HG_VT_OFF + j_ * 4096); } \
        if (hw == 0) dma16(ddsrc + (size_t)(c_) * 2048, (LAS unsigned char*)(ddw + ((c_) & 1) * 256)); } while (0)
        const unsigned src_g = (unsigned)((b * SEQ + ((tid - 256) >> 2)) * 512 + hh * 128 + 32 * (tid & 3));
        const unsigned rk_ = (unsigned)pi32(r32), sk_ = ((rk_ & 3) << 2) | ((rk_ >> 2) & 3), sq_ = (((unsigned)r32 & 3) << 2) | (((unsigned)r32 >> 2) & 3);
        const unsigned kt_base = 256u * rk_ + 16u * ((unsigned)hi ^ (sk_ & 1)), kt_e = sk_ >> 1, qt_base = (unsigned)HG_QT_OFF + 256u * (unsigned)r32 + 16u * ((unsigned)hi ^ (sq_ & 1)), qt_e = sq_ >> 1;
        HG_DMA(0);
        asm volatile("s_waitcnt vmcnt(0) lgkmcnt(0)" ::: "memory"); __builtin_amdgcn_s_barrier(); asm volatile("" ::: "memory");
        for (int c = 0; c <= NCHUNK; ++c) {
            if (c + 1 < NCHUNK) HG_DMA(c + 1);
            if (hw < 3 && c < NCHUNK) {
                const LAS unsigned char* buf = bufs + (c & 1) * HG_BUF_BYTES;
                const int sbx = hw >> 1, tbx = (hw + 1) >> 1;
                unsigned ek = kt_e, eq = qt_e; asm volatile("" : "+v"(ek), "+v"(eq));
                f32x16 X;
#pragma unroll
                for (int r = 0; r < 16; ++r) X[r] = 0.f;
#pragma unroll
                for (int ks = 0; ks < 8; ++ks) { const bf16x8 kf = *(const LAS bf16x8*)(buf + sbx * 8192 + kt_base + (((unsigned)ks ^ ek) << 5)), qf = *(const LAS bf16x8*)(buf + tbx * 8192 + qt_base + (((unsigned)ks ^ eq) << 5)); X = MFMA32(kf, qf, X); }
                if (sbx == tbx) {
                    int thr = r32 - 8 * hi; asm volatile("" : "+v"(thr));
#pragma unroll
                    for (int r = 0; r < 16; ++r) X[r] = thr >= 16 * (r >> 3) + (r & 7) ? X[r] : 0.f;
                }
                LAS unsigned char* xw = F.lds + RING_OFF + HG_XS_OFF + hw * 2048 + lane * 16;
                *(LAS bf16x8*)xw = pack_step(X, 0); *(LAS bf16x8*)(xw + 1024) = pack_step(X, 1);
            }
            if (c > 0) { const bf16* gcp = Gt + (size_t)((c - 1) * 64 * 512); v4u gc[4];
#pragma unroll
                for (int q = 0; q < 4; ++q) gc[q] = *(const v4u*)(gcp + src_g + 8 * q);
                hgrn_finalize(F, gc, b, hh, c - 1); }
            asm volatile("s_waitcnt lgkmcnt(0)" ::: "memory"); __builtin_amdgcn_s_barrier(); asm volatile("" ::: "memory");
            asm volatile("s_waitcnt vmcnt(0) lgkmcnt(0)" ::: "memory"); __builtin_amdgcn_s_barrier(); asm volatile("" ::: "memory");
        }
#undef HG_DMA
    } else {
        const int vb = w;
        f32x16 S[4];
#pragma unroll
        for (int kb = 0; kb < 4; ++kb)
#pragma unroll
            for (int r = 0; r < 16; ++r) S[kb][r] = 0.f;
        const unsigned rk_ = (unsigned)pi32(r32), sk_ = ((rk_ & 3) << 2) | ((rk_ >> 2) & 3), sq_ = (((unsigned)r32 & 3) << 2) | (((unsigned)r32 >> 2) & 3);
        const unsigned kt_base = 256u * rk_ + 16u * ((unsigned)hi ^ (sk_ & 1)), kt_e = sk_ >> 1, qt_base = (unsigned)HG_QT_OFF + 256u * (unsigned)r32 + 16u * ((unsigned)hi ^ (sq_ & 1)), qt_e = sq_ >> 1;
        unsigned rd_tr[4][2], rd_vt[4];
#pragma unroll
        for (int kb = 0; kb < 4; ++kb) { rd_tr[kb][0] = tr_read_addr_b((unsigned)lane, (unsigned)kb, 0u, 0u); rd_tr[kb][1] = tr_read_addr_b((unsigned)lane, (unsigned)kb, 0u, 1u); }
#pragma unroll
        for (int k4 = 0; k4 < 4; ++k4) rd_vt[k4] = (unsigned)(HG_VT_OFF + (32 * vb + r32) * 128 + (((2 * k4 + hi) ^ (r32 & 7)) << 4));
        const unsigned wr_ox = (unsigned)(HG_OX_OFF + r32 * 264 + (32 * vb + 4 * hi) * 2);
        asm volatile("s_waitcnt vmcnt(0) lgkmcnt(0)" ::: "memory"); __builtin_amdgcn_s_barrier(); asm volatile("" ::: "memory");
        for (int c = 0; c <= NCHUNK; ++c) {
            const LAS unsigned char* buf = bufs + (c & 1) * HG_BUF_BYTES;
            f32x16 o[2]; bf16x8 vfr[4];
            if (c < NCHUNK) {
            const LAS float* dd = ddw + (c & 1) * 256 + 4 * hi;
#pragma unroll
            for (int kb = 0; kb < 4; ++kb)
#pragma unroll
                for (int g = 0; g < 4; ++g) { const f32x4 a = *(const LAS f32x4*)(dd + 32 * kb + 8 * g);
#pragma unroll
                    for (int i = 0; i < 4; ++i) S[kb][4 * g + i] *= a[i]; }
            unsigned ek = kt_e, eq = qt_e; asm volatile("" : "+v"(ek), "+v"(eq));
#define HG_RDKT(ks_) (kt_base + (((unsigned)(ks_) ^ ek) << 5))
#define HG_RDQT(ks_) (qt_base + (((unsigned)(ks_) ^ eq) << 5))
            __builtin_amdgcn_sched_barrier(0);
#pragma unroll
            for (int k4 = 0; k4 < 4; ++k4) vfr[k4] = *(const LAS bf16x8*)(buf + rd_vt[k4]);
#pragma unroll
            for (int r = 0; r < 16; ++r) { o[0][r] = 0.f; o[1][r] = 0.f; }
#pragma unroll
            for (int kb = 0; kb < 4; ++kb)
#pragma unroll
                for (int sp = 0; sp < 2; ++sp) { const bf16x8 sf = pack_step(S[kb], sp);
                    const bf16x8 q0 = *(const LAS bf16x8*)(buf + HG_RDQT(2 * kb + sp)), q1 = *(const LAS bf16x8*)(buf + 8192 + HG_RDQT(2 * kb + sp));
                    o[0] = MFMA32(sf, krow_frag(q0), o[0]); o[1] = MFMA32(sf, krow_frag(q1), o[1]); }
            __builtin_amdgcn_sched_barrier(0);
#pragma unroll
            for (int kb = 0; kb < 4; ++kb) {
#pragma unroll
                for (int k4 = 0; k4 < 4; ++k4) {
                    const LAS unsigned char* ip = buf + (k4 >> 1) * 8192 + (k4 & 1) * 4096;
                    const v4i16_t lo = lds_tr(ip + rd_tr[kb][0]), hi4 = lds_tr(ip + rd_tr[kb][1]);
                    const bf16x8 af = __builtin_shufflevector(lo, hi4, 0, 1, 2, 3, 4, 5, 6, 7);
                    S[kb] = MFMA32(af, vfr[k4], S[kb]);
                }
#pragma unroll
                for (int g = 0; g < 4; ++g) { const f32x4 a = *(const LAS f32x4*)(dd + 128 + 32 * kb + 8 * g);
#pragma unroll
                    for (int i = 0; i < 4; ++i) S[kb][4 * g + i] *= a[i]; }
            }
            }
            asm volatile("s_waitcnt lgkmcnt(0)" ::: "memory"); __builtin_amdgcn_s_barrier(); asm volatile("" ::: "memory");
            if (c < NCHUNK) {
            { const LAS unsigned char* xr = F.lds + RING_OFF + HG_XS_OFF + lane * 16;
              o[0] = MFMA32(vfr[0], *(const LAS bf16x8*)(xr), o[0]); o[0] = MFMA32(vfr[1], *(const LAS bf16x8*)(xr + 1024), o[0]);
              o[1] = MFMA32(vfr[0], *(const LAS bf16x8*)(xr + 2048), o[1]); o[1] = MFMA32(vfr[1], *(const LAS bf16x8*)(xr + 3072), o[1]);
              o[1] = MFMA32(vfr[2], *(const LAS bf16x8*)(xr + 4096), o[1]); o[1] = MFMA32(vfr[3], *(const LAS bf16x8*)(xr + 5120), o[1]); }
#pragma unroll
            for (int tbi = 0; tbi < 2; ++tbi) { float q = 0.f;
#pragma unroll
              for (int r = 0; r < 16; ++r) q += o[tbi][r] * o[tbi][r];
              q = swapsum(q);
              if (hi == 0) psw[((c & 1) * 2 + tbi) * 128 + vb * 32 + r32] = q;
              LAS unsigned char* oxw = F.lds + RING_OFF + (c & 1) * HG_OX_BYTES + wr_ox + tbi * 32 * 264;
#pragma unroll
              for (int g = 0; g < 4; ++g) *(LAS pg8::u32x2*)(oxw + 16 * g) = (pg8::u32x2){cvtpk_s(o[tbi][4 * g], o[tbi][4 * g + 1]), cvtpk_s(o[tbi][4 * g + 2], o[tbi][4 * g + 3])}; }
            }
            asm volatile("s_waitcnt vmcnt(0) lgkmcnt(0)" ::: "memory"); __builtin_amdgcn_s_barrier(); asm volatile("" ::: "memory");
        }
#undef HG_RDKT
#undef HG_RDQT
    }
    __syncthreads();
}

struct Args { const float* in[17]; float* out; unsigned char* ws; int ph_lo, ph_hi, li, pad; };
__global__ void __launch_bounds__(NWAVES * 64, 2) mega_fwd(Args args) {
    extern __shared__ __attribute__((aligned(16))) unsigned char lds[];
    Frame F;
    F.lds = (LAS unsigned char*)lds;
    F.MISC = (volatile LAS unsigned*)(F.lds + MISC_OFF);
    F.tid = threadIdx.x; F.lane = F.tid & 63; F.wave = __builtin_amdgcn_readfirstlane(F.tid >> 6);
    F.G = gridDim.x;
#pragma unroll
    for (int i = 0; i < 17; ++i) F.in[i] = args.in[i];
    F.out = args.out; F.ws = args.ws;
    F.ctl = (gu32*)(args.ws + WS_CTL);
    for (int u = F.tid; u < (LDS_BYTES - LDSCTL_OFF) / 4; u += NWAVES * 64) ((LAS unsigned*)(F.lds + LDSCTL_OFF))[u] = 0u;
    __syncthreads();
    XcdBarrier bar; bar.bar = (unsigned*)(F.ctl + CW_BAR); bar.x = 0; bar.st = nullptr;
    if (N_LAUNCHES != PER_PHASE) bar = xcd_barrier_post((unsigned*)(F.ctl + CW_BAR), F.MISC + 8);
#define GRID_BAR(seam) do { if (N_LAUNCHES == PER_PHASE) { if (F.tid == 0) __hip_atomic_store(F.ctl + CW_TMO, 0xBADBA0u | (unsigned)(seam), RLX_AGENT); } else { xcd_barrier(bar); } } while (0)
    const int lo = args.ph_lo, hi = args.ph_hi;
#ifdef PROBE_PHASE
    unsigned long long ts_prev = __builtin_amdgcn_s_memrealtime(), ts_dt = 0ull; int ts_k = 0;
#define STAMP() do { const unsigned long long t_ = __builtin_amdgcn_s_memrealtime(); if (ts_k == PROBE_PHASE) ts_dt = t_ - ts_prev; ts_prev = t_; ++ts_k; } while (0)
#else
#define STAMP() do {} while (0)
#endif
#define IN(k) (lo <= (k) && (k) < hi)
#define BOTH(k) (IN(k) && IN((k) + 1))
    bf16* const XB = (bf16*)(F.ws + WS_XB); bf16* const HID = (bf16*)(F.ws + WS_HID); bf16* const MIXp = (bf16*)(F.ws + WS_MIX);
    float* const RS1 = (float*)(F.ws + WS_RS1); float* const RS2 = (float*)(F.ws + WS_RS2);
    const LAS float* const SCL = (const LAS float*)(F.lds + RING_OFF + RING_BYTES);

    if (IN(0)) { unsigned long long p0_probe = 0ull; p0_prologue(F, p0_probe);
#if defined(PROBE_PHASE) && (PROBE_PHASE == 13 || PROBE_PHASE == 14)
        ts_dt = p0_probe;
#endif
        if (BOTH(0)) GRID_BAR(0); STAMP(); }
    if (IN(1)) {
        pg8::Gemm g{XB, (const bf16*)(F.ws + WS_WGU1), M, 2 * FF, D}; pg8::StaticOrder S; S.init(M, 2 * FF, F.G, (int)blockIdx.x, WGM_GU);
        pg8::EpiSwiGLU E{HID, nullptr, SCL, FF};
        pg8::gemm_phase<pg8::EpiSwiGLU, pg8::StaticOrder, true, true>(F.lds + RING_OFF, g, S, E);
        if (BOTH(1)) GRID_BAR(1); STAMP();
    }
    if (IN(2)) {
        pg8::Gemm g{HID, (const bf16*)(F.ws + WS_WD1), M, D, FF}; pg8::StaticOrder S; S.init(M, D, F.G, (int)blockIdx.x, WGM_DOWN);
        pg8::EpiRes<0> E{F.in[0], nullptr, XB, RS1, 0.5f};
        pg8::gemm_phase<pg8::EpiRes<0>, pg8::StaticOrder, true, true>(F.lds + RING_OFF, g, S, E);
        if (BOTH(2)) GRID_BAR(2); STAMP();
    }
    if (IN(3)) {
        { pg8::Gemm g{XB, (const bf16*)(F.ws + WS_WIN), M, 2560, D}; pg8::StaticOrder S; S.init(M, 2560, F.G, (int)blockIdx.x, WGM_IN);
          pg8::EpiWin E{(bf16*)(F.ws + WS_Q), (bf16*)(F.ws + WS_K), (bf16*)(F.ws + WS_QT), (bf16*)(F.ws + WS_KT), (bf16*)(F.ws + WS_G), (float*)(F.ws + WS_DM), (float*)(F.ws + WS_DE), RS1, F.in[7], F.in[8], (const float*)(F.ws + WS_LB), SCL};
          pg8::gemm_phase<pg8::EpiWin, pg8::StaticOrder, true, true>(F.lds + RING_OFF, g, S, E); }
        { pg8::Gemm g{(const bf16*)(F.ws + WS_WINT), XB, 1024, M, D}; pg8::StaticOrder S; S.init(1024, M, F.G, (int)blockIdx.x, WGM_INT);
          pg8::EpiVT E{(bf16*)(F.ws + WS_VT), (bf16*)(F.ws + WS_VHT), RS1, SCL};
          pg8::gemm_phase<pg8::EpiVT, pg8::StaticOrder, true, true>(F.lds + RING_OFF, g, S, E); }
        if (BOTH(3)) GRID_BAR(3); STAMP();
    }
    if (IN(4)) {
#ifdef PROBE_PHASE
        const unsigned long long th00_ = __builtin_amdgcn_s_memrealtime();
#endif
#ifdef PROBE_PHASE
        const unsigned long long th0_ = __builtin_amdgcn_s_memrealtime();
        if (PROBE_PHASE == 9) ts_dt = th0_ - th00_;
#endif
        unsigned long long hg_wait_acc = 0ull;
        if (blockIdx.x < 64) hgrn_phase(F, (int)blockIdx.x, hg_wait_acc);
#ifdef PROBE_PHASE
        if (PROBE_PHASE == 11 || PROBE_PHASE == 12) ts_dt = hg_wait_acc;
#endif
#ifdef PROBE_PHASE
        if (PROBE_PHASE == 8) ts_dt = __builtin_amdgcn_s_memrealtime() - th0_;
#endif
#ifdef PROBE_PHASE
        const unsigned long long ta0_ = __builtin_amdgcn_s_memrealtime();
#endif
        attn_phase(F);
        if (blockIdx.x >= 64) p0_weights(F, 1, ((int)blockIdx.x - 64) * NWAVES + F.wave, (F.G - 64) * NWAVES);
#ifdef PROBE_PHASE
        if (PROBE_PHASE == 10) ts_dt = __builtin_amdgcn_s_memrealtime() - ta0_;
#endif
        if (BOTH(4)) GRID_BAR(4); STAMP();
    }
    if (IN(5)) {
        pg8::Gemm g{MIXp, (const bf16*)(F.ws + WS_WOUT), M, D, D}; pg8::StaticOrder S; S.init(M, D, F.G, (int)blockIdx.x, WGM_OUT);
        pg8::EpiRes<1> E{nullptr, nullptr, XB, RS2, 1.0f};
        pg8::gemm_phase<pg8::EpiRes<1>, pg8::StaticOrder, true, true>(F.lds + RING_OFF, g, S, E);
        if (BOTH(5)) GRID_BAR(5); STAMP();
    }
    if (IN(6)) {
        pg8::Gemm g{XB, (const bf16*)(F.ws + WS_WGU2), M, 2 * FF, D}; pg8::StaticOrder S; S.init(M, 2 * FF, F.G, (int)blockIdx.x, WGM_GU);
        pg8::EpiSwiGLU E{HID, RS2, SCL, FF};
        pg8::gemm_phase<pg8::EpiSwiGLU, pg8::StaticOrder, true, true>(F.lds + RING_OFF, g, S, E);
        if (BOTH(6)) GRID_BAR(6); STAMP();
    }
    if (IN(7)) {
        pg8::Gemm g{HID, (const bf16*)(F.ws + WS_WD2), M, D, FF}; pg8::StaticOrder S; S.init(M, D, F.G, (int)blockIdx.x, WGM_DOWN);
        pg8::EpiRes<2> E{nullptr, F.out, XB, nullptr, 0.5f};
        pg8::gemm_phase<pg8::EpiRes<2>, pg8::StaticOrder, true, true>(F.lds + RING_OFF, g, S, E);
    }
#ifdef PROBE_PHASE
    __syncthreads(); STAMP();
    if (blockIdx.x == (PROBE_PHASE == 10 ? 255 : 0) && F.tid == 0) { const unsigned long long t0_ = __builtin_amdgcn_s_memrealtime(); while (__builtin_amdgcn_s_memrealtime() - t0_ < 4ull * ts_dt) __builtin_amdgcn_s_sleep(8); }
#endif
#undef IN
#undef BOTH
}

extern "C" void kernel_launch(void* const* d_in, const int* in_sizes, int n_in, void* d_out, int out_size, void* d_ws, size_t ws_size, hipStream_t stream) {
    static int grid = 0;
    if (grid == 0) {
        if (n_in != 17 || in_sizes[0] != M * D || out_size != M * D || ws_size < WS_END) { fprintf(stderr, "kernel_launch: unexpected shapes (n_in %d, in0 %d, out %d, ws %zu); nothing launched\n", n_in, n_in > 0 ? in_sizes[0] : -1, out_size, ws_size); grid = -1; return; }
        int dev = 0, cus = 0, per_cu = 0;
        if (hipGetDevice(&dev) != hipSuccess || hipDeviceGetAttribute(&cus, hipDeviceAttributeMultiprocessorCount, dev) != hipSuccess) { grid = -1; return; }
        if (hipFuncSetAttribute((const void*)mega_fwd, hipFuncAttributeMaxDynamicSharedMemorySize, LDS_BYTES) != hipSuccess) { fprintf(stderr, "kernel_launch: hipFuncSetAttribute failed\n"); grid = -1; return; }
        if (hipOccupancyMaxActiveBlocksPerMultiprocessor(&per_cu, (const void*)mega_fwd, NWAVES * 64, LDS_BYTES) != hipSuccess || per_cu < 1) fprintf(stderr, "kernel_launch: note: occupancy query reports %d workgroups per CU\n", per_cu);
        (void)hipGetLastError();
        grid = cus;
    }
    if (grid < 0) return;
    if (hipMemsetAsync((char*)d_ws + WS_CTL, 0, CTL_ZERO_BYTES, stream) != hipSuccess) { fprintf(stderr, "kernel_launch: hipMemsetAsync failed\n"); return; }
    Args a{};
    for (int i = 0; i < 17; ++i) a.in[i] = (const float*)d_in[i];
    a.out = (float*)d_out; a.ws = (unsigned char*)d_ws;
    for (int li = 0; li < N_LAUNCHES; ++li) {
        a.ph_lo = (N_LAUNCHES == PER_PHASE) ? li : 0; a.ph_hi = (N_LAUNCHES == PER_PHASE) ? li + 1 : PER_PHASE; a.li = li;
        hipLaunchKernelGGL(mega_fwd, dim3(grid), dim3(NWAVES * 64), LDS_BYTES, stream, a);
        const hipError_t le = hipPeekAtLastError();
        if (le != hipSuccess) { fprintf(stderr, "kernel_launch: launch %d failed: %s\n", li, hipGetErrorName(le)); break; }
    }
}
```

```cpp
#include <hip/hip_runtime.h>
#include <cstdio>
#include <cstdint>
namespace pg8 {
#define PG8_LAS __attribute__((address_space(3)))
typedef unsigned short bf16_t;
typedef short bf16x8 __attribute__((ext_vector_type(8)));
typedef float f32x4 __attribute__((ext_vector_type(4)));
typedef unsigned u32x4 __attribute__((ext_vector_type(4)));
constexpr int BM = 256, BK = 64, HALF = 128, HTB = HALF * BK * 2  , STAGE_BYTES = 8 * HTB, NXCD = 8, WGM = 4;

__host__ __device__ __forceinline__ int lds_byte(int r, int c) { const int st = (r >> 4) * 2 + (c >> 5), rr = r & 15, cc = c & 31, ob = rr * 64 + cc * 2; return st * 1024 + (ob ^ (((ob >> 9) & 1) << 5)); }
__host__ __device__ __forceinline__ void stage_rc(int b, int& R, int& C) { const int st = b / 1024, sb = b % 1024, swz = sb ^ (((sb >> 9) & 1) << 5); R = (st >> 1) * 16 + swz / 64; C = (st & 1) * 32 + (swz % 64) / 2; }
__host__ __device__ __forceinline__ int perm32(int rho) { const int n = rho >> 4, i = rho & 15; return 8 * (i >> 2) + 4 * n + (i & 3); }

struct Unit { int pm, pn, par; };
struct Gemm { const bf16_t* A; const bf16_t* Bt; int M, N, K; };

struct StaticOrder {
    int nM, nN, nwg, G, c, wgm;
    __host__ __device__ void init(int M, int N, int G_, int c_, int wgm_ = WGM) { nM = M / BM; nN = N / BM; nwg = nM * nN; G = G_; c = c_; wgm = wgm_; }
    __host__ __device__ bool next(int i, Unit& u) const {
        const long L = (long)i * G + c; if (L >= nwg) return false;
        int wgid = (int)L; { const int q = nwg / NXCD, r = nwg % NXCD, xcd = wgid % NXCD, off = wgid / NXCD; wgid = (xcd < r ? xcd * (q + 1) : r * (q + 1) + (xcd - r) * q) + off; }
        const int nig = wgm * nN, gid = wgid / nig, fm = gid * wgm, gsz = (nM - fm) < wgm ? (nM - fm) : wgm;
        u.pm = fm + ((wgid % nig) % gsz); u.pn = (wgid % nig) / gsz; return true;
    }
    __device__ __forceinline__ void a_ready(const Unit&) const {}
    __device__ __forceinline__ void done(const Unit&) const {}
};


typedef unsigned u32x2 __attribute__((ext_vector_type(2)));
constexpr float RMS_EPS = 1e-6f, LOG2E = 1.4426950408889634f, QSCALE = 0.125f * 1.4426950408889634f;
__device__ __forceinline__ unsigned cvt_pk_bf16(float lo, float hi) { unsigned r; asm volatile("v_cvt_pk_bf16_f32 %0, %1, %2" : "=v"(r) : "v"(lo), "v"(hi)); return r; }
__device__ __forceinline__ float fsigmoid(float x) { return __builtin_amdgcn_rcpf(1.0f + __builtin_amdgcn_exp2f(-x * LOG2E)); }
__device__ __forceinline__ float fsilu(float x) { return x * fsigmoid(x); }
__device__ __forceinline__ f32x4 silu4(f32x4 v) { return (f32x4){fsilu(v[0]), fsilu(v[1]), fsilu(v[2]), fsilu(v[3])}; }
__device__ __forceinline__ u32x4 pack8(f32x4 a, f32x4 b) { u32x4 w; w.x = cvt_pk_bf16(a[0], a[1]); w.y = cvt_pk_bf16(a[2], a[3]); w.z = cvt_pk_bf16(b[0], b[1]); w.w = cvt_pk_bf16(b[2], b[3]); return w; }
__device__ __forceinline__ float rowscale(const float* rowsq, const PG8_LAS float* slot, int rl) { return rowsq ? __builtin_amdgcn_rsqf(slot[rl] * (1.0f / 1024.0f) + RMS_EPS) : 1.0f; }
template <int CTRL> __device__ __forceinline__ float dpp_mov0(float x) { return __builtin_bit_cast(float, __builtin_amdgcn_update_dpp(0, __builtin_bit_cast(int, x), CTRL, 0xf, 0xf, true)); }
__device__ __forceinline__ float row_scan16(float x) { x += dpp_mov0<0x111>(x); x += dpp_mov0<0x112>(x); x += dpp_mov0<0x114>(x); x += dpp_mov0<0x118>(x); return x; }

struct EpiSwiGLU {
    static constexpr bool PERM = false, AFTER_DRAIN = false; static constexpr int SCALE = 1;
    bf16_t* H; const float* rowsq; const PG8_LAS float* scl; int ldh;
    __device__ __forceinline__ void operator()(f32x4 (&acc)[2][2][4][2], const Unit& u, int wr, int wc, int fr, int fq) const {
        const int row0 = u.pm * BM + wr * 64 + fr, col0 = u.pn * HALF + wc * 32 + 8 * fq; const PG8_LAS float* slot = scl + u.par * 256 + wr * 64 + fr;
#pragma unroll
        for (int ai = 0; ai < 2; ++ai)
#pragma unroll
            for (int m = 0; m < 4; ++m) { const int row = row0 + ai * HALF + m * 16; const float r = rowscale(rowsq, slot, ai * HALF + m * 16);
                f32x4 hh[2];
#pragma unroll
                for (int n = 0; n < 2; ++n) { const f32x4 g = acc[ai][0][m][n] * r, gu = g * (acc[ai][1][m][n] * r);
#pragma unroll
                    for (int c = 0; c < 4; ++c) hh[n][c] = gu[c] * __builtin_amdgcn_rcpf(1.0f + __builtin_amdgcn_exp2f(-g[c])); }
                *(u32x4*)(H + (unsigned)(row * ldh + col0)) = pack8(hh[0], hh[1]); }
    }
};
template <int MODE> struct EpiRes {
    static constexpr int PERM = 2; static constexpr bool AFTER_DRAIN = false; static constexpr int SCALE = 0;
    const float* base; float* out; bf16_t* xb; float* rowsq; float scale;
    __device__ __forceinline__ void operator()(f32x4 (&acc)[2][2][4][2], const Unit& u, int wr, int wc, int fr, int fq) const {
        const int row0 = u.pm * BM + wr * 64 + fr, col0 = u.pn * BM + wc * 64 + 8 * fq;
        const unsigned off0 = (unsigned)(row0 * 1024 + col0);
#define EPR_AT(p, g, bj, n) ((p) + ((((g) >> 2) * HALF + ((g) & 3) * 16) * 1024 + (bj) * 32 + (n) * 4))[off0]
        if constexpr (MODE == 0) {
            f32x4 rb[4][4];
#pragma unroll
            for (int g = 0; g < 4; ++g)
#pragma unroll
                for (int j = 0; j < 4; ++j) rb[g][j] = *(const f32x4*)&EPR_AT(base, g, j >> 1, j & 1);
            __builtin_amdgcn_sched_barrier(0);
#pragma unroll
            for (int g = 0; g < 8; ++g) { const int ai = g >> 2, m = g & 3; float ss = 0.f; f32x4 v[4];
#pragma unroll
                for (int j = 0; j < 4; ++j) v[j] = rb[g & 3][j] + acc[ai][j >> 1][m][j & 1] * scale;
                if (g + 4 < 8) {
#pragma unroll
                    for (int j = 0; j < 4; ++j) rb[g & 3][j] = *(const f32x4*)&EPR_AT(base, g + 4, j >> 1, j & 1); }
#pragma unroll
                for (int bj = 0; bj < 2; ++bj) { *(u32x4*)&EPR_AT(xb, g, bj, 0) = pack8(v[2 * bj], v[2 * bj + 1]);
#pragma unroll
                    for (int n = 0; n < 2; ++n) { const f32x4 t = v[2 * bj + n]; ss += (t[0] * t[0] + t[1] * t[1]) + (t[2] * t[2] + t[3] * t[3]); } }
                ss += __shfl_xor(ss, 16); ss += __shfl_xor(ss, 32); if (fq == 0) __hip_atomic_fetch_add(rowsq + row0 + ai * HALF + m * 16, ss, __ATOMIC_RELAXED, __HIP_MEMORY_SCOPE_AGENT);
                __builtin_amdgcn_sched_barrier(0); }
        } else {
            u32x4 rb[8][2];
#pragma unroll
            for (int g = 0; g < 8; ++g)
#pragma unroll
                for (int bj = 0; bj < 2; ++bj) rb[g][bj] = *(const u32x4*)&EPR_AT(xb, g, bj, 0);
            __builtin_amdgcn_sched_barrier(0);
#pragma unroll
            for (int g = 0; g < 8; ++g) { const int ai = g >> 2, m = g & 3; float ss = 0.f;
#pragma unroll
                for (int bj = 0; bj < 2; ++bj) { const u32x4 w0 = rb[g][bj];
                    const f32x4 v0 = (f32x4){__builtin_bit_cast(float, w0.x << 16), __builtin_bit_cast(float, w0.x & 0xffff0000u), __builtin_bit_cast(float, w0.y << 16), __builtin_bit_cast(float, w0.y & 0xffff0000u)} + acc[ai][bj][m][0] * scale;
                    const f32x4 v1 = (f32x4){__builtin_bit_cast(float, w0.z << 16), __builtin_bit_cast(float, w0.z & 0xffff0000u), __builtin_bit_cast(float, w0.w << 16), __builtin_bit_cast(float, w0.w & 0xffff0000u)} + acc[ai][bj][m][1] * scale;
                    if (MODE == 2) { *(f32x4*)&EPR_AT(out, g, bj, 0) = v0; *(f32x4*)&EPR_AT(out, g, bj, 1) = v1; }
                    else { *(u32x4*)&EPR_AT(xb, g, bj, 0) = pack8(v0, v1);
                        ss += ((v0[0] * v0[0] + v0[1] * v0[1]) + (v0[2] * v0[2] + v0[3] * v0[3])) + ((v1[0] * v1[0] + v1[1] * v1[1]) + (v1[2] * v1[2] + v1[3] * v1[3])); } }
                if (MODE != 2) { ss += __shfl_xor(ss, 16); ss += __shfl_xor(ss, 32); if (fq == 0) __hip_atomic_fetch_add(rowsq + row0 + ai * HALF + m * 16, ss, __ATOMIC_RELAXED, __HIP_MEMORY_SCOPE_AGENT); }
                __builtin_amdgcn_sched_barrier(0); }
        }
#undef EPR_AT
    }
};
struct EpiWin {
    static constexpr bool PERM = false, AFTER_DRAIN = false; static constexpr int SCALE = 1;
    bf16_t *Q, *K, *QT, *KT, *G; float *DM, *DE; const float *rowsq, *gq, *gk, *lb; const PG8_LAS float* scl;
    __device__ __forceinline__ void operator()(f32x4 (&acc)[2][2][4][2], const Unit& u, int wr, int wc, int fr, int fq) const {
        const int row0 = u.pm * BM + wr * 64 + fr, t = u.pn; const PG8_LAS float* slot = scl + u.par * 256 + wr * 64 + fr;
        if (t < 4) {
            const bool isq = t < 2; const int head = 4 * (t & 1) + wc; const float* gp = isq ? gq : gk; const float gs = isq ? QSCALE : 1.0f;
            f32x4 gv[2][2];
#pragma unroll
            for (int bj = 0; bj < 2; ++bj)
#pragma unroll
                for (int n = 0; n < 2; ++n) gv[bj][n] = *(const f32x4*)(gp + 32 * bj + 8 * fq + 4 * n) * gs;
            bf16_t* dst = (isq ? Q : K) + (head * 32 * 8) * 512 + (fq >> 1) * 512 + (fq & 1) * 256;
#pragma unroll
            for (int ai = 0; ai < 2; ++ai)
#pragma unroll
                for (int m = 0; m < 4; ++m) { const int row = row0 + ai * HALF + m * 16; const float r = rowscale(rowsq, slot, ai * HALF + m * 16); float ss = 0.f;
#pragma unroll
                    for (int bj = 0; bj < 2; ++bj)
#pragma unroll
                        for (int n = 0; n < 2; ++n) { const f32x4 v = acc[ai][bj][m][n] * r; acc[ai][bj][m][n] = v; ss += (v[0] * v[0] + v[1] * v[1]) + (v[2] * v[2] + v[3] * v[3]); }
                    ss += __shfl_xor(ss, 16); ss += __shfl_xor(ss, 32);
                    const float inv = __builtin_amdgcn_rsqf(ss * (1.0f / 64.0f) + RMS_EPS);
                    const int tk = row & 2047, t5 = tk & 31, r32 = isq ? t5 : ((t5 & 0x13) | ((t5 & 4) << 1) | ((t5 & 8) >> 1));
                    const unsigned o = (unsigned)((((row >> 11) * 8 * 32 + (tk >> 6)) * 2 + ((tk >> 5) & 1)) * 4 * 512 + r32 * 8);
#pragma unroll
                    for (int bj = 0; bj < 2; ++bj) *(u32x4*)(dst + o + (unsigned)(2 * bj * 512)) = pack8(acc[ai][bj][m][0] * inv * gv[bj][0], acc[ai][bj][m][1] * inv * gv[bj][1]); }
        } else if (t < 8) {
            const int hh = t - 4, kbase = hh * 128 + wc * 32 + 8 * fq;
            float lbv[8]; { const f32x4 l0 = *(const f32x4*)(lb + kbase), l1 = *(const f32x4*)(lb + kbase + 4);
#pragma unroll
                for (int c = 0; c < 4; ++c) { lbv[c] = l0[c]; lbv[4 + c] = l1[c]; } }
            const int lane = fq * 16 + fr;
#pragma unroll
            for (int ai = 0; ai < 2; ++ai)
#pragma unroll
                for (int n = 0; n < 2; ++n) {
                    float omf[4][4], carry[4], bmid[4];
#pragma unroll
                    for (int m = 0; m < 4; ++m) { const float r = rowscale(rowsq, slot, ai * HALF + m * 16);
#pragma unroll
                        for (int c = 0; c < 4; ++c) { const int e = 4 * n + c; const float a = acc[ai][0][m][n][c] * r, b = acc[ai][1][m][n][c] * r;
                            const float sg = fsigmoid(b), f = lbv[e] + (1.0f - lbv[e]) * sg; omf[m][c] = (1.0f - lbv[e]) * (1.0f - sg);
                            acc[ai][1][m][n][c] = __builtin_amdgcn_logf(f);
                            acc[ai][0][m][n][c] = fsilu(a); } }
#pragma unroll
                    for (int c = 0; c < 4; ++c) { carry[c] = 0.f; bmid[c] = 0.f; }
#pragma unroll
                    for (int m = 0; m < 4; ++m)
#pragma unroll
                        for (int c = 0; c < 4; ++c) { float x = row_scan16(acc[ai][1][m][n][c]) + carry[c]; acc[ai][1][m][n][c] = x;
                            carry[c] = __shfl(x, lane | 15); if (m == 1) bmid[c] = carry[c]; }
#pragma unroll
                    for (int m = 0; m < 4; ++m) { const int row = row0 + ai * HALF + m * 16; f32x4 qv, kv;
#pragma unroll
                        for (int c = 0; c < 4; ++c) { const float d = acc[ai][1][m][n][c] - bmid[c];
                            qv[c] = acc[ai][0][m][n][c] * __builtin_amdgcn_exp2f(d); kv[c] = omf[m][c] * __builtin_amdgcn_exp2f(-d); }
                        const unsigned o = (unsigned)(row * 512 + kbase + 4 * n);
                        u32x2 w; w.x = cvt_pk_bf16(qv[0], qv[1]); w.y = cvt_pk_bf16(qv[2], qv[3]); *(u32x2*)(QT + o) = w;
                        w.x = cvt_pk_bf16(kv[0], kv[1]); w.y = cvt_pk_bf16(kv[2], kv[3]); *(u32x2*)(KT + o) = w; }
                    if (fr == 0) { const int chunk = (u.pm * BM + ai * HALF + wr * 64) >> 6; f32x4 a0, e0;
#pragma unroll
                        for (int c = 0; c < 4; ++c) { a0[c] = __builtin_amdgcn_exp2f(bmid[c]); e0[c] = __builtin_amdgcn_exp2f(carry[c] - bmid[c]); }
                        *(f32x4*)(DM + (unsigned)(chunk * 512 + kbase + 4 * n)) = a0; *(f32x4*)(DE + (unsigned)(chunk * 512 + kbase + 4 * n)) = e0; }
                    asm volatile("" ::: "memory");
                }
        } else {
            bf16_t* dst = G + (t - 8) * 256 + wc * 32 + 8 * fq;
#pragma unroll
            for (int ai = 0; ai < 2; ++ai)
#pragma unroll
                for (int m = 0; m < 4; ++m) { const int row = row0 + ai * HALF + m * 16; const float r = rowscale(rowsq, slot, ai * HALF + m * 16);
#pragma unroll
                    for (int bj = 0; bj < 2; ++bj) *(u32x4*)(dst + (unsigned)(row * 512 + bj * HALF)) = pack8(silu4(acc[ai][bj][m][0] * r), silu4(acc[ai][bj][m][1] * r)); }
        }
    }
};
struct EpiVT {
    static constexpr bool PERM = true, AFTER_DRAIN = false; static constexpr int SCALE = 2;
    bf16_t *VT, *VHT; const float* rowsq; const PG8_LAS float* scl;
    __device__ __forceinline__ void operator()(f32x4 (&acc)[2][2][4][2], const Unit& u, int wr, int wc, int fr, int fq) const {
        const int ch0 = (u.pm & 1) * BM + wr * 64 + fr, tok0 = u.pn * BM + wc * 32 + 8 * fq, b = tok0 >> 11, s0 = tok0 & 2047;
        f32x4 rs[2][2];
#pragma unroll
        for (int bj = 0; bj < 2; ++bj)
#pragma unroll
            for (int n = 0; n < 2; ++n) { const f32x4 q = *(const PG8_LAS f32x4*)(scl + u.par * 256 + wc * 32 + 8 * fq + bj * HALF + 4 * n);
#pragma unroll
                for (int c = 0; c < 4; ++c) rs[bj][n][c] = __builtin_amdgcn_rsqf(q[c] * (1.0f / 1024.0f) + RMS_EPS); }
        if (u.pm < 2) {
#pragma unroll
            for (int ai = 0; ai < 2; ++ai)
#pragma unroll
                for (int m = 0; m < 4; ++m) { const int ch = ch0 + ai * HALF + m * 16;
#pragma unroll
                    for (int bj = 0; bj < 2; ++bj) { const int sk = s0 + bj * HALF;
                        const unsigned o = (unsigned)((((((b * 8 + (ch >> 6)) * 32 + (sk >> 6)) * 2 + ((ch >> 5) & 1)) * 4 + ((sk >> 4) & 3)) * 64 + ((sk >> 3) & 1) * 32 + (ch & 31)) * 8);
                        *(u32x4*)(VT + o) = pack8(acc[ai][bj][m][0] * rs[bj][0], acc[ai][bj][m][1] * rs[bj][1]); } }
        } else {
            bf16_t* dst = VHT + (size_t)b * 512 * 2048 + s0;
#pragma unroll
            for (int ai = 0; ai < 2; ++ai)
#pragma unroll
                for (int m = 0; m < 4; ++m) { const int ch = ch0 + ai * HALF + m * 16;
#pragma unroll
                    for (int bj = 0; bj < 2; ++bj) *(u32x4*)(dst + (unsigned)(ch * 2048 + bj * HALF)) = pack8(acc[ai][bj][m][0] * rs[bj][0], acc[ai][bj][m][1] * rs[bj][1]); }
        }
    }
};

template <class Epi, class Sched, bool ALIGN_EPI = false, bool SP2 = false>
__device__ __forceinline__ void gemm_phase(PG8_LAS unsigned char* lds, const Gemm g, const Sched& S, const Epi& E) {
    const int tid = threadIdx.x, wid = __builtin_amdgcn_readfirstlane(tid >> 6), lane = tid & 63, wr = wid >> 2, wc = wid & 3, fr = lane & 15, fq = lane >> 4;
    const int K = g.K, nt = K / BK;
    unsigned voffA[2], voffB[2];
#pragma unroll
    for (int i = 0; i < 2; ++i) { int R, C; stage_rc(tid * 16 + i * 8192, R, C); const int Rb = (int)Epi::PERM == 2 ? ((R >> 5) * 64 + perm32(R & 31)) : Epi::PERM ? ((R & ~31) + perm32(R & 31)) : R;
        voffA[i] = (unsigned)(R * K + C) * 2u; voffB[i] = (unsigned)(Rb * K + C) * 2u; }
    const size_t kstep = (size_t)(BK * 2);
    const size_t hstep = (size_t)HALF * K * 2;
    const size_t hstepB = (int)Epi::PERM == 2 ? (size_t)32 * K * 2 : hstep;
    const size_t tstep = 2 * hstep;
    const unsigned ldsw = (unsigned)wid * 1024u;
    const int aoff = lds_byte(wr * 64 + fr, fq * 8), boff = lds_byte(wc * 32 + fr, fq * 8);
#define PG8_SA(b, h) (((b) * 2 + (h)) * HTB)
#define PG8_SB(b, h) ((4 + (b) * 2 + (h)) * HTB)
#define PG8_STAGE(bufoff, gbase, voff) do { _Pragma("unroll") for (int _i = 0; _i < 2; ++_i) \
        __builtin_amdgcn_global_load_lds((const unsigned*)((const char*)(gbase) + (voff)[_i]), (PG8_LAS unsigned*)(lds + (bufoff) + ldsw + _i * 8192), 16, 0, 0); } while (0)
#define PG8_LDA(dst, b, h) do { _Pragma("unroll") for (int m = 0; m < 4; ++m) _Pragma("unroll") for (int k = 0; k < 2; ++k) dst[m][k] = *(const PG8_LAS bf16x8*)(lds + PG8_SA(b, h) + aoff + m * 2048 + k * 1024); } while (0)
#define PG8_LDB(dst, b, h) do { _Pragma("unroll") for (int n = 0; n < 2; ++n) _Pragma("unroll") for (int k = 0; k < 2; ++k) dst[n][k] = *(const PG8_LAS bf16x8*)(lds + PG8_SB(b, h) + boff + n * 2048 + k * 1024); } while (0)
#define PG8_MMA(ai, bj, At, Bt) do { __builtin_amdgcn_s_setprio(1); _Pragma("unroll") for (int m = 0; m < 4; ++m) _Pragma("unroll") for (int n = 0; n < 2; ++n) _Pragma("unroll") for (int k = 0; k < 2; ++k) \
        acc[ai][bj][m][n] = __builtin_amdgcn_mfma_f32_16x16x32_bf16(Bt[n][k], At[m][k], acc[ai][bj][m][n], 0, 0, 0); __builtin_amdgcn_s_setprio(0); } while (0)
#define PG8_WAIT_V(n) asm volatile("s_waitcnt vmcnt(" #n ")" ::: "memory")
#define PG8_WAIT_L(n) asm volatile("s_waitcnt lgkmcnt(" #n ")" ::: "memory")
#define PG8_BAR __builtin_amdgcn_s_barrier()
#define PG8_SCHED __builtin_amdgcn_sched_barrier(0)
    Unit cur, nxt; int ui = 0;
    if (!S.next(0, cur)) return;
    cur.par = 0;
#define PG8_SCALE_DMA(u_) do { if (Epi::SCALE != 0 && wid == 0 && E.rowsq != nullptr) \
        __builtin_amdgcn_global_load_lds((const unsigned*)(E.rowsq + ((Epi::SCALE == 1 ? (u_).pm : (u_).pn) * BM + lane * 4)), (PG8_LAS unsigned*)(lds + STAGE_BYTES + (u_).par * 1024), 16, 0, 0); } while (0)
    PG8_SCALE_DMA(cur);
    f32x4 acc[2][2][4][2];
#pragma unroll
    for (int a = 0; a < 2; ++a)
#pragma unroll
        for (int b = 0; b < 2; ++b)
#pragma unroll
            for (int m = 0; m < 4; ++m)
#pragma unroll
                for (int n = 0; n < 2; ++n) acc[a][b][m][n] = (f32x4){0.f, 0.f, 0.f, 0.f};
    bf16x8 At[4][2], B0[2][2], B1[2][2];
    const char* cA = (const char*)g.A + (size_t)cur.pm * tstep; const char* cB = (const char*)g.Bt + (size_t)cur.pn * tstep;
    S.a_ready(cur);
    if constexpr (SP2) {
        PG8_STAGE(PG8_SB(0, 0), cB, voffB); PG8_STAGE(PG8_SB(0, 1), cB + hstepB, voffB); PG8_STAGE(PG8_SA(0, 0), cA, voffA); PG8_STAGE(PG8_SA(0, 1), cA + hstep, voffA);
        if (wr == 1) PG8_BAR;
        PG8_WAIT_V(2); PG8_BAR;
        PG8_STAGE(PG8_SB(1, 0), cB + kstep, voffB); PG8_STAGE(PG8_SA(1, 0), cA + kstep, voffA); PG8_STAGE(PG8_SB(1, 1), cB + hstepB + kstep, voffB);
        PG8_WAIT_V(6); PG8_BAR;
    } else {
        PG8_STAGE(PG8_SB(0, 0), cB, voffB); PG8_STAGE(PG8_SA(0, 0), cA, voffA); PG8_STAGE(PG8_SB(0, 1), cB + hstepB, voffB); PG8_STAGE(PG8_SA(0, 1), cA + hstep, voffA);
        if (wr == 1) PG8_BAR;
        PG8_WAIT_V(4); PG8_BAR;
        PG8_STAGE(PG8_SB(1, 0), cB + kstep, voffB); PG8_STAGE(PG8_SA(1, 0), cA + kstep, voffA); PG8_STAGE(PG8_SB(1, 1), cB + hstepB + kstep, voffB);
        PG8_WAIT_V(6); PG8_BAR;
    }
    for (;;) {
        const bool has_next = S.next(ui + 1, nxt); nxt.par = (ui + 1) & 1;
        const char* nA = has_next ? (const char*)g.A + (size_t)nxt.pm * tstep : cA; const char* nB = has_next ? (const char*)g.Bt + (size_t)nxt.pn * tstep : cB;
        for (int t = 0; t < nt; t += 2) {
            const bool last = (t == nt - 2);
            const char* a1 = cA + (size_t)(t + 1) * kstep;
            const char* a2 = last ? nA : cA + (size_t)(t + 2) * kstep; const char* b2 = last ? nB : cB + (size_t)(t + 2) * kstep;
            const char* a3 = a2 + kstep; const char* b3 = b2 + kstep;
            if (last && has_next) { S.a_ready(nxt); PG8_SCALE_DMA(nxt); }
            if constexpr (SP2) {
            PG8_LDB(B0, 0, 0); PG8_LDB(B1, 0, 1); PG8_SCHED; PG8_LDA(At, 0, 0); PG8_STAGE(PG8_SA(1, 1), a1 + hstep, voffA);
            PG8_WAIT_V(8); PG8_WAIT_L(0); PG8_BAR; PG8_MMA(0, 0, At, B0); PG8_MMA(0, 1, At, B1); PG8_BAR; PG8_SCHED;
            PG8_LDA(At, 0, 1); PG8_STAGE(PG8_SB(0, 0), b2, voffB); PG8_STAGE(PG8_SB(0, 1), b2 + hstepB, voffB); PG8_STAGE(PG8_SA(0, 0), a2, voffA);
            PG8_WAIT_V(8); PG8_WAIT_L(0); PG8_BAR; PG8_MMA(1, 0, At, B0); PG8_MMA(1, 1, At, B1); PG8_BAR; PG8_SCHED;
            PG8_LDB(B0, 1, 0); PG8_LDB(B1, 1, 1); PG8_SCHED; PG8_LDA(At, 1, 0); PG8_STAGE(PG8_SA(0, 1), a2 + hstep, voffA);
            PG8_WAIT_V(8); PG8_WAIT_L(0); PG8_BAR; PG8_MMA(0, 0, At, B0); PG8_MMA(0, 1, At, B1); PG8_BAR; PG8_SCHED;
            PG8_LDA(At, 1, 1); PG8_STAGE(PG8_SB(1, 0), b3, voffB); PG8_STAGE(PG8_SB(1, 1), b3 + hstepB, voffB); PG8_STAGE(PG8_SA(1, 0), a3, voffA);
            PG8_WAIT_V(8); PG8_WAIT_L(0); PG8_BAR; PG8_MMA(1, 0, At, B0); PG8_MMA(1, 1, At, B1); PG8_BAR; PG8_SCHED;
            } else {
            PG8_LDB(B0, 0, 0); PG8_SCHED; PG8_LDA(At, 0, 0); PG8_STAGE(PG8_SA(1, 1), a1 + hstep, voffA);
            PG8_WAIT_L(8); PG8_BAR; PG8_WAIT_L(0); PG8_MMA(0, 0, At, B0); PG8_BAR; PG8_SCHED;
            PG8_LDB(B1, 0, 1); PG8_STAGE(PG8_SB(0, 0), b2, voffB);
            PG8_BAR; PG8_WAIT_L(0); PG8_MMA(0, 1, At, B1); PG8_BAR;
            PG8_LDA(At, 0, 1); PG8_STAGE(PG8_SA(0, 0), a2, voffA);
            PG8_BAR; PG8_WAIT_L(0); PG8_MMA(1, 0, At, B0); PG8_BAR; PG8_SCHED;
            PG8_STAGE(PG8_SB(0, 1), b2 + hstepB, voffB);
            PG8_WAIT_V(6); PG8_BAR; PG8_MMA(1, 1, At, B1); PG8_BAR;
            PG8_LDB(B0, 1, 0); PG8_SCHED; PG8_LDA(At, 1, 0); PG8_STAGE(PG8_SA(0, 1), a2 + hstep, voffA);
            PG8_WAIT_L(8); PG8_BAR; PG8_WAIT_L(0); PG8_MMA(0, 0, At, B0); PG8_BAR; PG8_SCHED;
            PG8_LDB(B1, 1, 1); PG8_STAGE(PG8_SB(1, 0), b3, voffB);
            PG8_BAR; PG8_WAIT_L(0); PG8_MMA(0, 1, At, B1); PG8_BAR;
            PG8_LDA(At, 1, 1); PG8_STAGE(PG8_SA(1, 0), a3, voffA);
            PG8_BAR; PG8_WAIT_L(0); PG8_MMA(1, 0, At, B0); PG8_BAR; PG8_SCHED;
            PG8_STAGE(PG8_SB(1, 1), b3 + hstepB, voffB);
            PG8_WAIT_V(6); PG8_BAR; PG8_MMA(1, 1, At, B1); PG8_BAR;
            }
        }
        if constexpr (ALIGN_EPI) { if (wr == 0) PG8_BAR; }
        if constexpr (!Epi::AFTER_DRAIN) { E(acc, cur, wr, wc, fr, fq); S.done(cur); }
        if (!has_next) break;
#pragma unroll
        for (int a = 0; a < 2; ++a)
#pragma unroll
            for (int b = 0; b < 2; ++b)
#pragma unroll
                for (int m = 0; m < 4; ++m)
#pragma unroll
                    for (int n = 0; n < 2; ++n) acc[a][b][m][n] = (f32x4){0.f, 0.f, 0.f, 0.f};
        cur = nxt; cA = nA; cB = nB; ++ui;
        if constexpr (ALIGN_EPI) { if (wr == 1) PG8_BAR; }
    }
    PG8_WAIT_V(0);
    if constexpr (!ALIGN_EPI) { if (wr == 0) PG8_BAR; }
    PG8_BAR;
    if constexpr (Epi::AFTER_DRAIN) { E.fused(acc, cur, wr, wc, fr, fq, lds, wid, lane); S.done(cur); }
#undef PG8_SCALE_DMA
#undef PG8_SA
#undef PG8_SB
#undef PG8_STAGE
#undef PG8_LDA
#undef PG8_LDB
#undef PG8_MMA
#undef PG8_WAIT_V
#undef PG8_WAIT_L
#undef PG8_BAR
#undef PG8_SCHED
}
}

constexpr int NWAVES = 8;
#ifndef MK_N_LAUNCHES
#define MK_N_LAUNCHES 1
#endif
constexpr int PER_PHASE = 8;
constexpr int N_LAUNCHES = MK_N_LAUNCHES;
constexpr int BATCH = 16, SEQ = 2048, D = 1024, M = BATCH * SEQ, FF = 2816, NPROJ = 3584;
constexpr int AW = 512, HW = 512, NCHUNK = SEQ / 64;
constexpr float RMS_EPS = 1e-6f, LOG2E = 1.4426950408889634f;
#ifndef WGM_GU
#define WGM_GU 4
#endif
#ifndef WGM_DOWN
#define WGM_DOWN 4
#endif
#ifndef WGM_OUT
#define WGM_OUT 4
#endif
#ifndef WGM_IN
#define WGM_IN 4
#endif
#ifndef WGM_INT
#define WGM_INT 4
#endif

constexpr size_t MiB = 1u << 20;
constexpr size_t WS_CTL = 0, CTL_ZERO_BYTES = 1 * MiB;
constexpr size_t WS_RS1 = 256 * 1024, WS_RS2 = 384 * 1024;
constexpr size_t WS_LB = 1 * MiB, WS_DM = 2 * MiB, WS_DE = 3 * MiB;
constexpr size_t WS_WGU1 = 4 * MiB, WS_WD1 = 15 * MiB, WS_WIN = 21 * MiB, WS_WINT = 26 * MiB, WS_WOUT = 28 * MiB, WS_WGU2 = 30 * MiB, WS_WD2 = 41 * MiB;
constexpr size_t WS_XB = 48 * MiB;
constexpr size_t WS_MIX = 112 * MiB;
constexpr size_t WS_HID = 176 * MiB;
constexpr size_t WS_Q = 176 * MiB, WS_K = 208 * MiB, WS_VT = 240 * MiB, WS_QT = 272 * MiB, WS_KT = 304 * MiB, WS_VHT = 336 * MiB, WS_G = 368 * MiB, WS_END = 400 * MiB;
static_assert(WS_WGU1 + (size_t)2 * FF * D * 2 <= WS_WD1 && WS_WD1 + (size_t)D * FF * 2 <= WS_WIN && WS_WIN + (size_t)2560 * D * 2 <= WS_WINT && WS_WGU2 + (size_t)2 * FF * D * 2 <= WS_WD2 && WS_WD2 + (size_t)D * FF * 2 <= WS_XB, "weight map");
static_assert(WS_HID + (size_t)M * FF * 2 <= WS_END && WS_XB + (size_t)M * D * 2 <= WS_MIX && WS_MIX + (size_t)M * D * 2 <= WS_HID, "activation map");
constexpr int CW_TMO = 0, CW_CODE = 1;
constexpr int CW_BAR = 4096;
constexpr int CW_WQ = 16384;

constexpr int RING_OFF = 0, RING_BYTES = 131072;
constexpr int LDS_BYTES = 163840;
constexpr int LDSCTL_OFF = LDS_BYTES - 1024, MISC_OFF = LDSCTL_OFF + 320;
static_assert(MISC_OFF + 128 <= LDS_BYTES, "LDS map");

#define GAS __attribute__((address_space(1)))
#define LAS __attribute__((address_space(3)))
typedef unsigned short bf16;
typedef unsigned v4u __attribute__((ext_vector_type(4)));
typedef float f32x4 __attribute__((ext_vector_type(4)));
typedef short bf16x8 __attribute__((ext_vector_type(8)));
typedef GAS unsigned gu32;
#define RLX_AGENT __ATOMIC_RELAXED, __HIP_MEMORY_SCOPE_AGENT
#define LDS_WAIT() asm volatile("s_waitcnt lgkmcnt(0)" ::: "memory")
#define VM_WAIT() asm volatile("s_waitcnt vmcnt(0)" ::: "memory")
__device__ __forceinline__ unsigned f2bf(float f) { unsigned u = __builtin_bit_cast(unsigned, f); return (u + 0x7fffu + ((u >> 16) & 1u)) >> 16; }
__device__ __forceinline__ unsigned pk2(float lo, float hi) { return f2bf(lo) | (f2bf(hi) << 16); }
__device__ __forceinline__ float bf2f(unsigned short h) { return __builtin_bit_cast(float, (unsigned)h << 16); }
__device__ __forceinline__ float bflo(unsigned w) { return __builtin_bit_cast(float, w << 16); }
__device__ __forceinline__ float bfhi(unsigned w) { return __builtin_bit_cast(float, w & 0xffff0000u); }

#define XB_TMO      128
#define XB_XCNT(j)  (256  + 64 * (j))
#define XB_XSUB(j)  (1280 + 64 * (j))
#define XB_XGEN(j)  (2304 + 64 * (j))
#define XB_TOP      3328
#define XB_TOPGEN   3392
#define XCD_BAR_WORDS 3456
#define XB_SPIN_CAP (1u << 18)

__device__ __forceinline__ unsigned xb_ld(unsigned* p)              { return __hip_atomic_load(p, __ATOMIC_RELAXED, __HIP_MEMORY_SCOPE_AGENT); }
__device__ __forceinline__ unsigned xb_add(unsigned* p, unsigned v) { return __hip_atomic_fetch_add(p, v, __ATOMIC_RELAXED, __HIP_MEMORY_SCOPE_AGENT); }
__device__ __forceinline__ unsigned xb_xcc_id() { return (unsigned)__builtin_amdgcn_s_getreg((3 << 11) | 20) & 0xFu; }
#define XB_SPIN(cond, bar) do { unsigned _sp = 0; while (cond) { __builtin_amdgcn_s_sleep(1); \
    if ((++_sp & 255u) == 0u) { if (xb_ld(&(bar)[XB_TMO])) break; if (_sp > XB_SPIN_CAP) { atomicAdd(&(bar)[XB_TMO], 1u); break; } } } } while (0)

struct XcdBarrier {
    unsigned* bar; unsigned x;
    volatile LAS unsigned* st;
};

__device__ __forceinline__ XcdBarrier xcd_barrier_post(unsigned* bar, volatile LAS unsigned* st) {
    XcdBarrier b; b.bar = bar; b.x = xb_xcc_id(); b.st = st;
    if (threadIdx.x == 0) (void)xb_add(&bar[XB_XCNT(b.x)], 1u);
    return b;
}
__device__ __forceinline__ void xcd_barrier_complete(unsigned* bar, unsigned x, unsigned& nloc, unsigned& nx) {
    const unsigned G = gridDim.x * gridDim.y * gridDim.z;
    unsigned sum, cnt, mine, sp = 0u;
    for (;;) {
        sum = 0u; cnt = 0u; mine = 0u;
#pragma unroll
        for (unsigned j = 0; j < 16; ++j) { const unsigned c = xb_ld(&bar[XB_XCNT(j)]); sum += c; cnt += (c > 0u) ? 1u : 0u; mine = (j == x) ? c : mine; }
        if (sum == G) break;
        __builtin_amdgcn_s_sleep(1);
        if ((++sp & 255u) == 0u) { if (xb_ld(&bar[XB_TMO])) break; if (sp > XB_SPIN_CAP) { atomicAdd(&bar[XB_TMO], 1u); break; } }
    }
    nloc = mine > 0u ? mine : 1u; nx = cnt > 0u ? cnt : 1u;
}

__device__ __forceinline__ void xcd_barrier(const XcdBarrier& b) {
    asm volatile("s_waitcnt vmcnt(0)" ::: "memory");
    __syncthreads();
    if (threadIdx.x == 0) {
        unsigned* bar = b.bar;
        __builtin_amdgcn_s_waitcnt(0);
        unsigned nloc = b.st[0], nx = b.st[1];
        if (nloc == 0u) { xcd_barrier_complete(bar, b.x, nloc, nx); b.st[0] = nloc; b.st[1] = nx; }
        const unsigned old = xb_add(&bar[XB_XSUB(b.x)], 1u);
        const unsigned gen = old / nloc;
        if (old + 1u == (gen + 1u) * nloc) {
            __builtin_amdgcn_fence(__ATOMIC_RELEASE, "agent");
            asm volatile("s_waitcnt vmcnt(0)" ::: "memory");
            const unsigned og = xb_add(&bar[XB_TOP], 1u);
            const unsigned tg = og / nx;
            if (og + 1u == (tg + 1u) * nx) xb_add(&bar[XB_TOPGEN], 1u);
            else XB_SPIN(xb_ld(&bar[XB_TOPGEN]) == tg, bar);
            __builtin_amdgcn_fence(__ATOMIC_ACQUIRE, "agent");
            xb_add(&bar[XB_XGEN(b.x)], 1u);
            asm volatile("s_waitcnt vmcnt(0)" ::: "memory");
        } else {
            XB_SPIN(xb_ld(&bar[XB_XGEN(b.x)]) == gen, bar);
            __builtin_amdgcn_fence(__ATOMIC_ACQUIRE, "agent");
            asm volatile("s_waitcnt vmcnt(0)" ::: "memory");
        }
    }
    __syncthreads();
}

struct Frame {
    LAS unsigned char* lds;
    volatile LAS unsigned* MISC;
    gu32* ctl;
    int tid, lane, wave, G;
    const float* in[17]; float* out; unsigned char* ws;
};
__device__ __forceinline__ float wave_sum(float v) {
#pragma unroll
    for (int o = 1; o < 64; o <<= 1) v += __shfl_xor(v, o);
    return v;
}
__device__ __forceinline__ int srccol(int kind, int R, int& sel) {
    sel = 0;
    if (kind == 0) return R;
    const int t = R >> 8, p = R & 255, bj = p >> 7, q = p & 127, wc = q >> 5, pr = pg8::perm32(q & 31);
    if (kind == 1) { sel = bj; return 128 * t + 32 * wc + pr; }
    if (kind == 2) {
        if (t < 2) return 64 * (4 * t + wc) + 32 * bj + pr;
        if (t < 4) return 512 + 64 * (4 * (t - 2) + wc) + 32 * bj + pr;
        if (t < 8) return (bj ? 2048 : 1536) + 128 * (t - 4) + 32 * wc + pr;
        return 3072 + 256 * (t - 8) + 128 * bj + 32 * wc + pr;
    }
    return R < 512 ? 1024 + R : 2560 + (R - 512);
}
struct P0Blk { f32x4 v[8]; };
__device__ __forceinline__ void p0_load(P0Blk& t, const float* W0, const float* W1, int N, int kind, int item, int nblk, int lane) {
    const int kb = item / nblk, nb = item % nblk, k0 = 64 * kb + 8 * (lane >> 3), R = 32 * nb + 4 * (lane & 7);
    int sel; const int c = srccol(kind, R, sel);
    const float* W = (sel ? W1 : W0) + (size_t)k0 * N + c;
#pragma unroll
    for (int i = 0; i < 8; ++i) t.v[i] = *(const f32x4*)(W + (size_t)i * N);
}
__device__ __forceinline__ void p0_store(const P0Blk& t, int K, bf16* WT, const float* gain, int kind, int item, int nblk, int lane) {
    const int kb = item / nblk, nb = item % nblk, k0 = 64 * kb + 8 * (lane >> 3), R = 32 * nb + 4 * (lane & 7);
    float gk[8];
    const float ws = kind == 1 ? (((R >> 7) & 1) ? 1.0f / LOG2E : LOG2E) : 1.0f;
#pragma unroll
    for (int i = 0; i < 8; ++i) gk[i] = ws;
    if (gain) { const f32x4 g0 = *(const f32x4*)(gain + k0), g1 = *(const f32x4*)(gain + k0 + 4);
#pragma unroll
        for (int i = 0; i < 4; ++i) { gk[i] = g0[i] * ws; gk[4 + i] = g1[i] * ws; } }
#pragma unroll
    for (int j = 0; j < 4; ++j) { v4u o; o.x = pk2(t.v[0][j] * gk[0], t.v[1][j] * gk[1]); o.y = pk2(t.v[2][j] * gk[2], t.v[3][j] * gk[3]); o.z = pk2(t.v[4][j] * gk[4], t.v[5][j] * gk[5]); o.w = pk2(t.v[6][j] * gk[6], t.v[7][j] * gk[7]);
        *(GAS v4u*)(WT + (size_t)(R + j) * K + k0) = o; }
}
struct P0Job { const float* W0; const float* W1; const float* gain; bf16* WT; int K, N, kind, nblk, item; };
constexpr int P0_I_GU = (D / 64) * (2 * FF / 32), P0_I_D = (FF / 64) * (D / 32), P0_I_IN = (D / 64) * (2560 / 32), P0_I_INT = (D / 64) * (1024 / 32), P0_I_O = (D / 64) * (D / 32);
constexpr int P0_N0 = P0_I_GU + P0_I_D + P0_I_IN + P0_I_INT, P0_N1 = P0_I_GU + P0_I_D + P0_I_O;
__device__ __forceinline__ P0Job p0_job(Frame& F, int set, int it) {
    int r = it;
    if (set == 0) {
        if (r < P0_I_GU) return P0Job{F.in[2], F.in[3], nullptr, (bf16*)(F.ws + WS_WGU1), D, FF, 1, 2 * FF / 32, r}; r -= P0_I_GU;
        if (r < P0_I_D) return P0Job{F.in[4], F.in[4], nullptr, (bf16*)(F.ws + WS_WD1), FF, D, 0, D / 32, r}; r -= P0_I_D;
        if (r < P0_I_IN) return P0Job{F.in[6], F.in[6], F.in[5], (bf16*)(F.ws + WS_WIN), D, NPROJ, 2, 2560 / 32, r}; r -= P0_I_IN;
        return P0Job{F.in[6], F.in[6], F.in[5], (bf16*)(F.ws + WS_WINT), D, NPROJ, 3, 1024 / 32, r};
    }
    if (r < P0_I_GU) return P0Job{F.in[14], F.in[15], F.in[13], (bf16*)(F.ws + WS_WGU2), D, FF, 1, 2 * FF / 32, r}; r -= P0_I_GU;
    if (r < P0_I_D) return P0Job{F.in[16], F.in[16], nullptr, (bf16*)(F.ws + WS_WD2), FF, D, 0, D / 32, r}; r -= P0_I_D;
    return P0Job{F.in[12], F.in[12], nullptr, (bf16*)(F.ws + WS_WOUT), D, D, 0, D / 32, r};
}
__device__ __forceinline__ void p0_weights(Frame& F, int set, int gw, int NGW) {
    const int NIT = set == 0 ? P0_N0 : P0_N1;
    int it = gw;
    if (it < NIT) {
        P0Job j0 = p0_job(F, set, it); P0Blk t0; p0_load(t0, j0.W0, j0.W1, j0.N, j0.kind, j0.item, j0.nblk, F.lane);
        for (;;) {
            const int it1 = it + NGW; const bool more = it1 < NIT;
            P0Job j1 = j0; P0Blk t1;
            if (more) { j1 = p0_job(F, set, it1); p0_load(t1, j1.W0, j1.W1, j1.N, j1.kind, j1.item, j1.nblk, F.lane); }
            p0_store(t0, j0.K, j0.WT, j0.gain, j0.kind, j0.item, j0.nblk, F.lane);
            if (!more) break;
            it = it1; j0 = j1;
#pragma unroll
            for (int i = 0; i < 8; ++i) t0.v[i] = t1.v[i];
        }
    }
}
__device__ __forceinline__ void rms_rows4_to_bf16(const float* x, const float* g, bf16* o, int lane) {
    f32x4 v[4][4]; float s[4];
#pragma unroll
    for (int r = 0; r < 4; ++r)
#pragma unroll
        for (int j = 0; j < 4; ++j) v[r][j] = *((const GAS f32x4*)(x + (size_t)r * D) + lane + 64 * j);
#pragma unroll
    for (int r = 0; r < 4; ++r) { s[r] = 0.f;
#pragma unroll
        for (int j = 0; j < 4; ++j) s[r] += (v[r][j].x * v[r][j].x + v[r][j].y * v[r][j].y) + (v[r][j].z * v[r][j].z + v[r][j].w * v[r][j].w); }
#pragma unroll
    for (int of = 1; of < 64; of <<= 1) {
#pragma unroll
        for (int r = 0; r < 4; ++r) s[r] += __shfl_xor(s[r], of); }
    f32x4 gg[4];
#pragma unroll
    for (int j = 0; j < 4; ++j) gg[j] = *((const GAS f32x4*)g + lane + 64 * j);
#pragma unroll
    for (int r = 0; r < 4; ++r) { const float rr = __builtin_amdgcn_rsqf(s[r] * (1.f / D) + RMS_EPS);
        GAS unsigned long long* o8 = (GAS unsigned long long*)(o + (size_t)r * D) + lane;
#pragma unroll
        for (int j = 0; j < 4; ++j) o8[64 * j] = (unsigned long long)pk2(v[r][j].x * rr * gg[j].x, v[r][j].y * rr * gg[j].y) | ((unsigned long long)pk2(v[r][j].z * rr * gg[j].z, v[r][j].w * rr * gg[j].w) << 32); }
}
__device__ __forceinline__ void p0_prologue(Frame& F, unsigned long long& p0_probe) {
    const int gw = (int)blockIdx.x * NWAVES + F.wave, NGW = F.G * NWAVES;
#if defined(PROBE_PHASE) && (PROBE_PHASE == 13 || PROBE_PHASE == 14)
    const unsigned long long p0_t0 = __builtin_amdgcn_s_memrealtime();
#endif
    p0_weights(F, 0, gw, NGW);
#if defined(PROBE_PHASE) && (PROBE_PHASE == 13 || PROBE_PHASE == 14)
    const unsigned long long tp1_ = __builtin_amdgcn_s_memrealtime();
    if (PROBE_PHASE == 13) p0_probe = tp1_ - p0_t0;
#endif
    for (int m = 4 * gw; m < M; m += 4 * NGW) rms_rows4_to_bf16(F.in[0] + (size_t)m * D, F.in[1], (bf16*)(F.ws + WS_XB) + (size_t)m * D, F.lane);
#if defined(PROBE_PHASE) && (PROBE_PHASE == 13 || PROBE_PHASE == 14)
    if (PROBE_PHASE == 14) p0_probe = __builtin_amdgcn_s_memrealtime() - tp1_;
#endif
    if (blockIdx.x == 0) {
        const float l0 = F.in[10][F.tid], l1 = F.in[10][512 + F.tid], mx = fmaxf(l0, l1), e0 = __expf(l0 - mx), e1 = __expf(l1 - mx);
        ((float*)(F.ws + WS_LB))[F.tid] = e0 / (e0 + e1);
    }
}

typedef float f32x16 __attribute__((ext_vector_type(16)));
typedef float f32x2_t __attribute__((ext_vector_type(2))); typedef __bf16 bf16x2_t __attribute__((ext_vector_type(2)));
__device__ __forceinline__ unsigned cvtpk_s(float lo, float hi) { f32x2_t v = {lo, hi}; bf16x2_t b = __builtin_convertvector(v, bf16x2_t); return __builtin_bit_cast(unsigned, b); }
__device__ __forceinline__ bf16x8 pack_step(const f32x16& x, int s) { v4u p; p.x = cvtpk_s(x[8 * s], x[8 * s + 1]); p.y = cvtpk_s(x[8 * s + 2], x[8 * s + 3]); p.z = cvtpk_s(x[8 * s + 4], x[8 * s + 5]); p.w = cvtpk_s(x[8 * s + 6], x[8 * s + 7]); return __builtin_bit_cast(bf16x8, p); }
__device__ __forceinline__ float swapmax(float m) { auto rr = __builtin_amdgcn_permlane32_swap(__float_as_uint(m), __float_as_uint(m), false, false); return fmaxf(__uint_as_float(rr[0]), __uint_as_float(rr[1])); }
__device__ __forceinline__ float swapsum(float m) { auto rr = __builtin_amdgcn_permlane32_swap(__float_as_uint(m), __float_as_uint(m), false, false); return __uint_as_float(rr[0]) + __uint_as_float(rr[1]); }
__device__ __forceinline__ int pi32(int x) { return (x & 0x13) | ((x & 4) << 1) | ((x & 8) >> 1); }
#define MFMA32(a, b, c) __builtin_amdgcn_mfma_f32_32x32x16_bf16((a), (b), (c), 0, 0, 0)
constexpr int ATT_ETAB_OFF = 0;
__device__ __forceinline__ void attn_item(Frame& F, int b, int c, int h, const LAS float* etab) {
    const bf16* Q = (const bf16*)(F.ws + WS_Q); const bf16* Kp = (const bf16*)(F.ws + WS_K); const bf16* VT = (const bf16*)(F.ws + WS_VT); bf16* MIX = (bf16*)(F.ws + WS_MIX);
    const int lane = F.lane, r32 = lane & 31, hi = lane >> 5;
    const float cfar = F.in[9][h * 257 + 256] * LOG2E;
    bf16x8 qf[2][4];
#pragma unroll
    for (int qb = 0; qb < 2; ++qb)
#pragma unroll
        for (int d0 = 0; d0 < 4; ++d0) qf[qb][d0] = *(const bf16x8*)(Q + (unsigned)((((((b * 8 + h) * 32 + c) * 2 + qb) * 4 + d0) * 64 + lane) * 8));
    f32x16 o[2][2];
#pragma unroll
    for (int db = 0; db < 2; ++db)
#pragma unroll
        for (int qb = 0; qb < 2; ++qb)
#pragma unroll
            for (int r = 0; r < 16; ++r) o[db][qb][r] = 0.f;
    float mrun[2] = {-INFINITY, -INFINITY}, lrun[2] = {0.f, 0.f};
    const int kt0 = c >= 8 ? c - 8 : 0;
    const unsigned fbase = (unsigned)(((b * 8 + h) * 32 * 8 * 64 + lane) * 8);
    const LAS float* et = etab + h * 256;
    bf16x8 kf[2][4], vf[2][4];
#define AT_LOADK(kt_) do { _Pragma("unroll") for (int kb = 0; kb < 2; ++kb) _Pragma("unroll") for (int d0 = 0; d0 < 4; ++d0) kf[kb][d0] = *(const bf16x8*)(Kp + fbase + (unsigned)((((kt_) * 2 + kb) * 4 + d0) * 512)); } while (0)
#define AT_LOADV(kt_) do { _Pragma("unroll") for (int db = 0; db < 2; ++db) _Pragma("unroll") for (int ks = 0; ks < 4; ++ks) vf[db][ks] = *(const bf16x8*)(VT + fbase + (unsigned)((((kt_) * 2 + db) * 4 + ks) * 512)); } while (0)
    AT_LOADK(kt0); AT_LOADV(kt0);
    for (int kt = kt0; kt <= c; ++kt) {
        const int j = c - kt, ktn = kt < c ? kt + 1 : c;
#pragma unroll
        for (int qb = 0; qb < 2; ++qb) {
            f32x16 s[2]; bf16x8 pk[2][2];
            const float c0 = j >= 3 ? cfar : 0.f;
#pragma unroll
            for (int r = 0; r < 16; ++r) { s[0][r] = c0; s[1][r] = c0; }
#pragma unroll
            for (int d0 = 0; d0 < 4; ++d0) { s[0] = MFMA32(kf[0][d0], qf[qb][d0], s[0]); s[1] = MFMA32(kf[1][d0], qf[qb][d0], s[1]); }
            if (qb == 1) { __builtin_amdgcn_sched_barrier(0); AT_LOADK(ktn); __builtin_amdgcn_sched_barrier(0); }
            if (j < 3) {
                const int ib = 64 * j + 32 * qb + r32 - 8 * hi + 63;
#pragma unroll
                for (int kb = 0; kb < 2; ++kb)
#pragma unroll
                    for (int r = 0; r < 16; ++r) s[kb][r] += et[ib - 32 * kb - 16 * (r >> 3) - (r & 7)];
            }
            float tm = fmaxf(s[0][0], s[1][0]);
#pragma unroll
            for (int r = 1; r < 16; ++r) tm = fmaxf(tm, fmaxf(s[0][r], s[1][r]));
            tm = swapmax(tm);
            const float mn = fmaxf(mrun[qb], tm), alpha = __builtin_amdgcn_exp2f(mrun[qb] - mn); mrun[qb] = mn;
            float ls = 0.f;
#pragma unroll
            for (int kb = 0; kb < 2; ++kb)
#pragma unroll
                for (int r = 0; r < 16; ++r) { const float p = __builtin_amdgcn_exp2f(s[kb][r] - mn); s[kb][r] = p; ls += p; }
            lrun[qb] = lrun[qb] * alpha + ls;
#pragma unroll
            for (int db = 0; db < 2; ++db)
#pragma unroll
                for (int r = 0; r < 16; ++r) o[db][qb][r] *= alpha;
#pragma unroll
            for (int kb = 0; kb < 2; ++kb) { pk[kb][0] = pack_step(s[kb], 0); pk[kb][1] = pack_step(s[kb], 1); }
#pragma unroll
            for (int db = 0; db < 2; ++db)
#pragma unroll
                for (int kb = 0; kb < 2; ++kb)
#pragma unroll
                    for (int sp = 0; sp < 2; ++sp) o[db][qb] = MFMA32(vf[db][2 * kb + sp], pk[kb][sp], o[db][qb]);
        }
        __builtin_amdgcn_sched_barrier(0); AT_LOADV(ktn); __builtin_amdgcn_sched_barrier(0);
    }
#undef AT_LOADK
#undef AT_LOADV
#pragma unroll
    for (int qb = 0; qb < 2; ++qb) {
        const float inv = 1.0f / swapsum(lrun[qb]);
        bf16* orow = MIX + (unsigned)((b * SEQ + 64 * c + 32 * qb + r32) * 1024 + h * 64 + 16 * hi);
#pragma unroll
        for (int db = 0; db < 2; ++db) {
            unsigned wx[4], wy[4];
#pragma unroll
            for (int g = 0; g < 4; ++g) { wx[g] = cvtpk_s(o[db][qb][4 * g] * inv, o[db][qb][4 * g + 1] * inv); wy[g] = cvtpk_s(o[db][qb][4 * g + 2] * inv, o[db][qb][4 * g + 3] * inv); }
#pragma unroll
            for (int p = 0; p < 2; ++p) {
                auto ax = __builtin_amdgcn_permlane32_swap(wx[p], wx[p + 2], false, false); auto ay = __builtin_amdgcn_permlane32_swap(wy[p], wy[p + 2], false, false);
                *(v4u*)(orow + 32 * db + 8 * p) = (v4u){ax[0], ay[0], ax[1], ay[1]}; }
        }
    }
}
__device__ __forceinline__ void attn_phase(Frame& F) {
    LAS float* etab = (LAS float*)(F.lds + RING_OFF + ATT_ETAB_OFF);
    for (int i = F.tid; i < 8 * 256; i += NWAVES * 64) { const int h = i >> 8; int rel = (i & 255) - 63; rel = rel > 128 ? 128 : rel; etab[i] = F.in[9][h * 257 + rel + 128] * LOG2E; }
    __syncthreads();
    for (int k = 0; k < 8; ++k) {
        const int shard = ((int)blockIdx.x + k) & 7;
        gu32* head = F.ctl + CW_WQ + 64 * shard;
        for (;;) {
            unsigned n = 0; if (F.lane == 0) n = __hip_atomic_fetch_add(head, 1u, RLX_AGENT);
            n = (unsigned)__builtin_amdgcn_readfirstlane((int)n);
            if (n >= 512u) break;
            const int bh = 8 * (int)(n >> 5) + shard, c = 31 - (int)(n & 31);
            attn_item(F, bh >> 3, c, bh & 7, etab);
        }
    }
    __syncthreads();
}

__device__ __forceinline__ unsigned off_b(unsigned row, unsigned ch) { return 256u * row + 16u * (ch ^ (((row & 3) << 2) | ((row >> 2) & 3))); }
__device__ __forceinline__ unsigned tr_read_addr_b(unsigned lane, unsigned c, unsigned ks, unsigned t) {
    const unsigned h = lane >> 5, blk = (lane >> 4) & 1, q = (lane & 15) >> 2, p = lane & 3;
    return off_b(16 * ks + 8 * h + 4 * t + q, 4 * c + 2 * blk + (p >> 1)) + 8 * (p & 1);
}
typedef short v4i16_t __attribute__((ext_vector_type(4)));
__device__ __forceinline__ v4i16_t lds_tr(const LAS unsigned char* p) { return __builtin_amdgcn_ds_read_tr16_b64_v4i16((LAS v4i16_t*)p); }
__device__ __forceinline__ bf16x8 krow_frag(bf16x8 nat) {
    const v4u d = __builtin_bit_cast(v4u, nat);
    auto a = __builtin_amdgcn_permlane32_swap(d.x, d.z, false, false); auto b = __builtin_amdgcn_permlane32_swap(d.y, d.w, false, false);
    v4u r; r.x = a[0]; r.y = b[0]; r.z = a[1]; r.w = b[1]; return __builtin_bit_cast(bf16x8, r);
}
constexpr int HG_PS_OFF = 8192, HG_DD_OFF = 10240, HG_GN_OFF = 12288, HG_BUF_OFF = 16384;
constexpr int HG_QT_OFF = 16384, HG_VT_OFF = 32768, HG_BUF_BYTES = 49152;
constexpr int HG_OX_OFF = HG_BUF_OFF + 2 * HG_BUF_BYTES, HG_OX_BYTES = 64 * 264;
constexpr int HG_XS_OFF = HG_OX_OFF + 2 * HG_OX_BYTES;
static_assert(HG_XS_OFF + 3 * 2048 <= LDSCTL_OFF && HG_OX_OFF % 16 == 0 && HG_XS_OFF % 16 == 0, "HGRN LDS map");
__device__ __forceinline__ void dma16(const void* g, LAS unsigned char* l) { __builtin_amdgcn_global_load_lds((const unsigned*)g, (LAS unsigned*)l, 16, 0, 0); }
__device__ __forceinline__ void hgrn_finalize(Frame& F, const v4u (&gw)[4], int b, int hh, int c) {
    bf16* MIX = (bf16*)(F.ws + WS_MIX);
    const int ht = F.tid - 256, tok = ht >> 2, pc = ht & 3;
    const LAS float* ps = (const LAS float*)(F.lds + RING_OFF + HG_PS_OFF) + ((c & 1) * 2 + (tok >> 5)) * 128 + (tok & 31);
    const float tot = (ps[0] + ps[32]) + (ps[64] + ps[96]);
    const float rs = __builtin_amdgcn_rsqf(tot * (1.0f / 128.0f) + RMS_EPS);
    const LAS unsigned char* ox = F.lds + RING_OFF + HG_OX_OFF + (c & 1) * HG_OX_BYTES + tok * 264 + 64 * pc;
    const LAS f32x4* gn = (const LAS f32x4*)(F.lds + RING_OFF + HG_GN_OFF) + 8 * pc;
    bf16* dst = MIX + (unsigned)((b * SEQ + 64 * c + tok) * 1024 + 512 + hh * 128 + 32 * pc);
#pragma unroll
    for (int q = 0; q < 4; ++q) { unsigned ow[4]; const unsigned g4w[4] = {gw[q].x, gw[q].y, gw[q].z, gw[q].w};
#pragma unroll
        for (int i = 0; i < 2; ++i) { const pg8::u32x2 o2 = *(const LAS pg8::u32x2*)(ox + 16 * q + 8 * i); const f32x4 g4 = gn[2 * q + i];
            ow[2 * i] = cvtpk_s(bflo(o2.x) * rs * g4[0] * bflo(g4w[2 * i]), bfhi(o2.x) * rs * g4[1] * bfhi(g4w[2 * i]));
            ow[2 * i + 1] = cvtpk_s(bflo(o2.y) * rs * g4[2] * bflo(g4w[2 * i + 1]), bfhi(o2.y) * rs * g4[3] * bfhi(g4w[2 * i + 1])); }
        *(v4u*)(dst + 8 * q) = (v4u){ow[0], ow[1], ow[2], ow[3]}; }
}
__device__ __forceinline__ void hgrn_phase(Frame& F, int bh, unsigned long long& hg_wait_acc) {
    (void)hg_wait_acc;
    const unsigned char* QT = F.ws + WS_QT; const unsigned char* KT = F.ws + WS_KT; const unsigned char* VHT = F.ws + WS_VHT; const bf16* Gt = (const bf16*)(F.ws + WS_G);
    const unsigned char* DM = F.ws + WS_DM; const unsigned char* DE = F.ws + WS_DE;
    const int b = bh >> 2, hh = bh & 3, lane = F.lane, r32 = lane & 31, hi = lane >> 5, w = F.wave, tid = F.tid;
    LAS unsigned char* const bufs = F.lds + RING_OFF + HG_BUF_OFF;
    LAS float* const psw = (LAS float*)(F.lds + RING_OFF + HG_PS_OFF);
    LAS float* const ddw = (LAS float*)(F.lds + RING_OFF + HG_DD_OFF);
    if (tid < 128) ((LAS float*)(F.lds + RING_OFF + HG_GN_OFF))[tid] = F.in[11][tid];
    if (w >= 4) {
        const int hw = w - 4;
        unsigned so_k[4], so_v[4];
#pragma unroll
        for (int j = 0; j < 4; ++j) { const unsigned ii = (unsigned)(hw + 4 * j), sl = ii * 64 + lane;
            { const unsigned img = sl >> 9, s9 = sl & 511, row = s9 >> 4, ch = (s9 & 15) ^ (((row & 3) << 2) | ((row >> 2) & 3)); so_k[j] = ((32 * img + row) * 512 + hh * 128) * 2 + ch * 16; }
            { const unsigned row = sl >> 3, ch = (sl & 7) ^ (row & 7); so_v[j] = ((hh * 128 + row) * SEQ) * 2 + ch * 16; } }
        const unsigned so_d = (unsigned)((hh * 128) * 4 + (lane & 31) * 16);
        const unsigned char* const ddsrc = (lane < 32 ? DM : DE) + (size_t)(b * NCHUNK) * 2048 + so_d;
        const unsigned char* const ktb = KT + (size_t)(b * SEQ) * 1024; const unsigned char* const qtb = QT + (size_t)(b * SEQ) * 1024; const unsigned char* const vtb = VHT + (size_t)(b * 512) * SEQ * 2;
#define HG_DMA(c_) do { LAS unsigned char* nb_ = bufs + ((c_) & 1) * HG_BUF_BYTES + hw * 1024; const size_t ck_ = (size_t)(c_) * 65536, cv_ = (size_t)(c_) * 128; \
        _Pragma("unroll") for (int j_ = 0; j_ < 4; ++j_) { dma16(ktb + ck_ + so_k[j_], nb_ + j_ * 4096); dma16(qtb + ck_ + so_k[j_], nb_ + HG_QT_OFF + j_ * 4096); dma16(vtb + cv_ + so_v[j_], nb_ + HG_VT_OFF + j_ * 4096); } \
        if (hw == 0) dma16(ddsrc + (size_t)(c_) * 2048, (LAS unsigned char*)(ddw + ((c_) & 1) * 256)); } while (0)
        const unsigned src_g = (unsigned)((b * SEQ + ((tid - 256) >> 2)) * 512 + hh * 128 + 32 * (tid & 3));
        const unsigned rk_ = (unsigned)pi32(r32), sk_ = ((rk_ & 3) << 2) | ((rk_ >> 2) & 3), sq_ = (((unsigned)r32 & 3) << 2) | (((unsigned)r32 >> 2) & 3);
        const unsigned kt_base = 256u * rk_ + 16u * ((unsigned)hi ^ (sk_ & 1)), kt_e = sk_ >> 1, qt_base = (unsigned)HG_QT_OFF + 256u * (unsigned)r32 + 16u * ((unsigned)hi ^ (sq_ & 1)), qt_e = sq_ >> 1;
        HG_DMA(0);
        asm volatile("s_waitcnt vmcnt(0) lgkmcnt(0)" ::: "memory"); __builtin_amdgcn_s_barrier(); asm volatile("" ::: "memory");
        for (int c = 0; c <= NCHUNK; ++c) {
            if (c + 1 < NCHUNK) HG_DMA(c + 1);
            if (hw < 3 && c < NCHUNK) {
                const LAS unsigned char* buf = bufs + (c & 1) * HG_BUF_BYTES;
                const int sbx = hw >> 1, tbx = (hw + 1) >> 1;
                unsigned ek = kt_e, eq = qt_e; asm volatile("" : "+v"(ek), "+v"(eq));
                f32x16 X;
#pragma unroll
                for (int r = 0; r < 16; ++r) X[r] = 0.f;
#pragma unroll
                for (int ks = 0; ks < 8; ++ks) { const bf16x8 kf = *(const LAS bf16x8*)(buf + sbx * 8192 + kt_base + (((unsigned)ks ^ ek) << 5)), qf = *(const LAS bf16x8*)(buf + tbx * 8192 + qt_base + (((unsigned)ks ^ eq) << 5)); X = MFMA32(kf, qf, X); }
                if (sbx == tbx) {
                    int thr = r32 - 8 * hi; asm volatile("" : "+v"(thr));
#pragma unroll
                    for (int r = 0; r < 16; ++r) X[r] = thr >= 16 * (r >> 3) + (r & 7) ? X[r] : 0.f;
                }
                LAS unsigned char* xw = F.lds + RING_OFF + HG_XS_OFF + hw * 2048 + lane * 16;
                *(LAS bf16x8*)xw = pack_step(X, 0); *(LAS bf16x8*)(xw + 1024) = pack_step(X, 1);
            }
            if (c > 0) { const bf16* gcp = Gt + (size_t)((c - 1) * 64 * 512); v4u gc[4];
#pragma unroll
                for (int q = 0; q < 4; ++q) gc[q] = *(const v4u*)(gcp + src_g + 8 * q);
                hgrn_finalize(F, gc, b, hh, c - 1); }
            asm volatile("s_waitcnt lgkmcnt(0)" ::: "memory"); __builtin_amdgcn_s_barrier(); asm volatile("" ::: "memory");
            asm volatile("s_waitcnt vmcnt(0) lgkmcnt(0)" ::: "memory"); __builtin_amdgcn_s_barrier(); asm volatile("" ::: "memory");
        }
#undef HG_DMA
    } else {
        const int vb = w;
        f32x16 S[4];
#pragma unroll
        for (int kb = 0; kb < 4; ++kb)
#pragma unroll
            for (int r = 0; r < 16; ++r) S[kb][r] = 0.f;
        const unsigned rk_ = (unsigned)pi32(r32), sk_ = ((rk_ & 3) << 2) | ((rk_ >> 2) & 3), sq_ = (((unsigned)r32 & 3) << 2) | (((unsigned)r32 >> 2) & 3);
        const unsigned kt_base = 256u * rk_ + 16u * ((unsigned)hi ^ (sk_ & 1)), kt_e = sk_ >> 1, qt_base = (unsigned)HG_QT_OFF + 256u * (unsigned)r32 + 16u * ((unsigned)hi ^ (sq_ & 1)), qt_e = sq_ >> 1;
        unsigned rd_tr[4][2], rd_vt[4];
#pragma unroll
        for (int kb = 0; kb < 4; ++kb) { rd_tr[kb][0] = tr_read_addr_b((unsigned)lane, (unsigned)kb, 0u, 0u); rd_tr[kb][1] = tr_read_addr_b((unsigned)lane, (unsigned)kb, 0u, 1u); }
#pragma unroll
        for (int k4 = 0; k4 < 4; ++k4) rd_vt[k4] = (unsigned)(HG_VT_OFF + (32 * vb + r32) * 128 + (((2 * k4 + hi) ^ (r32 & 7)) << 4));
        const unsigned wr_ox = (unsigned)(HG_OX_OFF + r32 * 264 + (32 * vb + 4 * hi) * 2);
        asm volatile("s_waitcnt vmcnt(0) lgkmcnt(0)" ::: "memory"); __builtin_amdgcn_s_barrier(); asm volatile("" ::: "memory");
        for (int c = 0; c <= NCHUNK; ++c) {
            const LAS unsigned char* buf = bufs + (c & 1) * HG_BUF_BYTES;
            f32x16 o[2]; bf16x8 vfr[4];
            if (c < NCHUNK) {
            const LAS float* dd = ddw + (c & 1) * 256 + 4 * hi;
#pragma unroll
            for (int kb = 0; kb < 4; ++kb)
#pragma unroll
                for (int g = 0; g < 4; ++g) { const f32x4 a = *(const LAS f32x4*)(dd + 32 * kb + 8 * g);
#pragma unroll
                    for (int i = 0; i < 4; ++i) S[kb][4 * g + i] *= a[i]; }
            unsigned ek = kt_e, eq = qt_e; asm volatile("" : "+v"(ek), "+v"(eq));
#define HG_RDKT(ks_) (kt_base + (((unsigned)(ks_) ^ ek) << 5))
#define HG_RDQT(ks_) (qt_base + (((unsigned)(ks_) ^ eq) << 5))
            __builtin_amdgcn_sched_barrier(0);
#pragma unroll
            for (int k4 = 0; k4 < 4; ++k4) vfr[k4] = *(const LAS bf16x8*)(buf + rd_vt[k4]);
#pragma unroll
            for (int r = 0; r < 16; ++r) { o[0][r] = 0.f; o[1][r] = 0.f; }
#pragma unroll
            for (int kb = 0; kb < 4; ++kb)
#pragma unroll
                for (int sp = 0; sp < 2; ++sp) { const bf16x8 sf = pack_step(S[kb], sp);
                    const bf16x8 q0 = *(const LAS bf16x8*)(buf + HG_RDQT(2 * kb + sp)), q1 = *(const LAS bf16x8*)(buf + 8192 + HG_RDQT(2 * kb + sp));
                    o[0] = MFMA32(sf, krow_frag(q0), o[0]); o[1] = MFMA32(sf, krow_frag(q1), o[1]); }
            __builtin_amdgcn_sched_barrier(0);
#pragma unroll
            for (int kb = 0; kb < 4; ++kb) {
#pragma unroll
                for (int k4 = 0; k4 < 4; ++k4) {
                    const LAS unsigned char* ip = buf + (k4 >> 1) * 8192 + (k4 & 1) * 4096;
                    const v4i16_t lo = lds_tr(ip + rd_tr[kb][0]), hi4 = lds_tr(ip + rd_tr[kb][1]);
                    const bf16x8 af = __builtin_shufflevector(lo, hi4, 0, 1, 2, 3, 4, 5, 6, 7);
                    S[kb] = MFMA32(af, vfr[k4], S[kb]);
                }
#pragma unroll
                for (int g = 0; g < 4; ++g) { const f32x4 a = *(const LAS f32x4*)(dd + 128 + 32 * kb + 8 * g);
#pragma unroll
                    for (int i = 0; i < 4; ++i) S[kb][4 * g + i] *= a[i]; }
            }
            }
            asm volatile("s_waitcnt lgkmcnt(0)" ::: "memory"); __builtin_amdgcn_s_barrier(); asm volatile("" ::: "memory");
            if (c < NCHUNK) {
            { const LAS unsigned char* xr = F.lds + RING_OFF + HG_XS_OFF + lane * 16;
              o[0] = MFMA32(vfr[0], *(const LAS bf16x8*)(xr), o[0]); o[0] = MFMA32(vfr[1], *(const LAS bf16x8*)(xr + 1024), o[0]);
              o[1] = MFMA32(vfr[0], *(const LAS bf16x8*)(xr + 2048), o[1]); o[1] = MFMA32(vfr[1], *(const LAS bf16x8*)(xr + 3072), o[1]);
              o[1] = MFMA32(vfr[2], *(const LAS bf16x8*)(xr + 4096), o[1]); o[1] = MFMA32(vfr[3], *(const LAS bf16x8*)(xr + 5120), o[1]); }
#pragma unroll
            for (int tbi = 0; tbi < 2; ++tbi) { float q = 0.f;
#pragma unroll
              for (int r = 0; r < 16; ++r) q += o[tbi][r] * o[tbi][r];
              q = swapsum(q);
              if (hi == 0) psw[((c & 1) * 2 + tbi) * 128 + vb * 32 + r32] = q;
              LAS unsigned char* oxw = F.lds + RING_OFF + (c & 1) * HG_OX_BYTES + wr_ox + tbi * 32 * 264;
#pragma unroll
              for (int g = 0; g < 4; ++g) *(LAS pg8::u32x2*)(oxw + 16 * g) = (pg8::u32x2){cvtpk_s(o[tbi][4 * g], o[tbi][4 * g + 1]), cvtpk_s(o[tbi][4 * g + 2], o[tbi][4 * g + 3])}; }
            }
            asm volatile("s_waitcnt vmcnt(0) lgkmcnt(0)" ::: "memory"); __builtin_amdgcn_s_barrier(); asm volatile("" ::: "memory");
        }
#undef HG_RDKT
#undef HG_RDQT
    }
    __syncthreads();
}

struct Args { const float* in[17]; float* out; unsigned char* ws; int ph_lo, ph_hi, li, pad; };
__global__ void __launch_bounds__(NWAVES * 64, 2) mega_fwd(Args args) {
    extern __shared__ __attribute__((aligned(16))) unsigned char lds[];
    Frame F;
    F.lds = (LAS unsigned char*)lds;
    F.MISC = (volatile LAS unsigned*)(F.lds + MISC_OFF);
    F.tid = threadIdx.x; F.lane = F.tid & 63; F.wave = __builtin_amdgcn_readfirstlane(F.tid >> 6);
    F.G = gridDim.x;
#pragma unroll
    for (int i = 0; i < 17; ++i) F.in[i] = args.in[i];
    F.out = args.out; F.ws = args.ws;
    F.ctl = (gu32*)(args.ws + WS_CTL);
    for (int u = F.tid; u < (LDS_BYTES - LDSCTL_OFF) / 4; u += NWAVES * 64) ((LAS unsigned*)(F.lds + LDSCTL_OFF))[u] = 0u;
    __syncthreads();
    XcdBarrier bar; bar.bar = (unsigned*)(F.ctl + CW_BAR); bar.x = 0; bar.st = nullptr;
    if (N_LAUNCHES != PER_PHASE) bar = xcd_barrier_post((unsigned*)(F.ctl + CW_BAR), F.MISC + 8);
#define GRID_BAR(seam) do { if (N_LAUNCHES == PER_PHASE) { if (F.tid == 0) __hip_atomic_store(F.ctl + CW_TMO, 0xBADBA0u | (unsigned)(seam), RLX_AGENT); } else { xcd_barrier(bar); } } while (0)
    const int lo = args.ph_lo, hi = args.ph_hi;
#ifdef PROBE_PHASE
    unsigned long long ts_prev = __builtin_amdgcn_s_memrealtime(), ts_dt = 0ull; int ts_k = 0;
#define STAMP() do { const unsigned long long t_ = __builtin_amdgcn_s_memrealtime(); if (ts_k == PROBE_PHASE) ts_dt = t_ - ts_prev; ts_prev = t_; ++ts_k; } while (0)
#else
#define STAMP() do {} while (0)
#endif
#define IN(k) (lo <= (k) && (k) < hi)
#define BOTH(k) (IN(k) && IN((k) + 1))
    bf16* const XB = (bf16*)(F.ws + WS_XB); bf16* const HID = (bf16*)(F.ws + WS_HID); bf16* const MIXp = (bf16*)(F.ws + WS_MIX);
    float* const RS1 = (float*)(F.ws + WS_RS1); float* const RS2 = (float*)(F.ws + WS_RS2);
    const LAS float* const SCL = (const LAS float*)(F.lds + RING_OFF + RING_BYTES);

    if (IN(0)) { unsigned long long p0_probe = 0ull; p0_prologue(F, p0_probe);
#if defined(PROBE_PHASE) && (PROBE_PHASE == 13 || PROBE_PHASE == 14)
        ts_dt = p0_probe;
#endif
        if (BOTH(0)) GRID_BAR(0); STAMP(); }
    if (IN(1)) {
        pg8::Gemm g{XB, (const bf16*)(F.ws + WS_WGU1), M, 2 * FF, D}; pg8::StaticOrder S; S.init(M, 2 * FF, F.G, (int)blockIdx.x, WGM_GU);
        pg8::EpiSwiGLU E{HID, nullptr, SCL, FF};
        pg8::gemm_phase<pg8::EpiSwiGLU, pg8::StaticOrder, true, true>(F.lds + RING_OFF, g, S, E);
        if (BOTH(1)) GRID_BAR(1); STAMP();
    }
    if (IN(2)) {
        pg8::Gemm g{HID, (const bf16*)(F.ws + WS_WD1), M, D, FF}; pg8::StaticOrder S; S.init(M, D, F.G, (int)blockIdx.x, WGM_DOWN);
        pg8::EpiRes<0> E{F.in[0], nullptr, XB, RS1, 0.5f};
        pg8::gemm_phase<pg8::EpiRes<0>, pg8::StaticOrder, true, true>(F.lds + RING_OFF, g, S, E);
        if (BOTH(2)) GRID_BAR(2); STAMP();
    }
    if (IN(3)) {
        { pg8::Gemm g{XB, (const bf16*)(F.ws + WS_WIN), M, 2560, D}; pg8::StaticOrder S; S.init(M, 2560, F.G, (int)blockIdx.x, WGM_IN);
          pg8::EpiWin E{(bf16*)(F.ws + WS_Q), (bf16*)(F.ws + WS_K), (bf16*)(F.ws + WS_QT), (bf16*)(F.ws + WS_KT), (bf16*)(F.ws + WS_G), (float*)(F.ws + WS_DM), (float*)(F.ws + WS_DE), RS1, F.in[7], F.in[8], (const float*)(F.ws + WS_LB), SCL};
          pg8::gemm_phase<pg8::EpiWin, pg8::StaticOrder, true, true>(F.lds + RING_OFF, g, S, E); }
        { pg8::Gemm g{(const bf16*)(F.ws + WS_WINT), XB, 1024, M, D}; pg8::StaticOrder S; S.init(1024, M, F.G, (int)blockIdx.x, WGM_INT);
          pg8::EpiVT E{(bf16*)(F.ws + WS_VT), (bf16*)(F.ws + WS_VHT), RS1, SCL};
          pg8::gemm_phase<pg8::EpiVT, pg8::StaticOrder, true, true>(F.lds + RING_OFF, g, S, E); }
        if (BOTH(3)) GRID_BAR(3); STAMP();
    }
    if (IN(4)) {
#ifdef PROBE_PHASE
        const unsigned long long th00_ = __builtin_amdgcn_s_memrealtime();
#endif
#ifdef PROBE_PHASE
        const unsigned long long th0_ = __builtin_amdgcn_s_memrealtime();
        if (PROBE_PHASE == 9) ts_dt = th0_ - th00_;
#endif
        unsigned long long hg_wait_acc = 0ull;
        if (blockIdx.x < 64) hgrn_phase(F, (int)blockIdx.x, hg_wait_acc);
#ifdef PROBE_PHASE
        if (PROBE_PHASE == 11 || PROBE_PHASE == 12) ts_dt = hg_wait_acc;
#endif
#ifdef PROBE_PHASE
        if (PROBE_PHASE == 8) ts_dt = __builtin_amdgcn_s_memrealtime() - th0_;
#endif
#ifdef PROBE_PHASE
        const unsigned long long ta0_ = __builtin_amdgcn_s_memrealtime();
#endif
        attn_phase(F);
        if (blockIdx.x >= 64) p0_weights(F, 1, ((int)blockIdx.x - 64) * NWAVES + F.wave, (F.G - 64) * NWAVES);
#ifdef PROBE_PHASE
        if (PROBE_PHASE == 10) ts_dt = __builtin_amdgcn_s_memrealtime() - ta0_;
#endif
        if (BOTH(4)) GRID_BAR(4); STAMP();
    }
    if (IN(5)) {
        pg8::Gemm g{MIXp, (const bf16*)(F.ws + WS_WOUT), M, D, D}; pg8::StaticOrder S; S.init(M, D, F.G, (int)blockIdx.x, WGM_OUT);
        pg8::EpiRes<1> E{nullptr, nullptr, XB, RS2, 1.0f};
        pg8::gemm_phase<pg8::EpiRes<1>, pg8::StaticOrder, true, true>(F.lds + RING_OFF, g, S, E);
        if (BOTH(5)) GRID_BAR(5); STAMP();
    }
    if (IN(6)) {
        pg8::Gemm g{XB, (const bf16*)(F.ws + WS_WGU2), M, 2 * FF, D}; pg8::StaticOrder S; S.init(M, 2 * FF, F.G, (int)blockIdx.x, WGM_GU);
        pg8::EpiSwiGLU E{HID, RS2, SCL, FF};
        pg8::gemm_phase<pg8::EpiSwiGLU, pg8::StaticOrder, true, true>(F.lds + RING_OFF, g, S, E);
        if (BOTH(6)) GRID_BAR(6); STAMP();
    }
    if (IN(7)) {
        pg8::Gemm g{HID, (const bf16*)(F.ws + WS_WD2), M, D, FF}; pg8::StaticOrder S; S.init(M, D, F.G, (int)blockIdx.x, WGM_DOWN);
        pg8::EpiRes<2> E{nullptr, F.out, XB, nullptr, 0.5f};
        pg8::gemm_phase<pg8::EpiRes<2>, pg8::StaticOrder, true, true>(F.lds + RING_OFF, g, S, E);
    }
#ifdef PROBE_PHASE
    __syncthreads(); STAMP();
    if (blockIdx.x == (PROBE_PHASE == 10 ? 255 : 0) && F.tid == 0) { const unsigned long long t0_ = __builtin_amdgcn_s_memrealtime(); while (__builtin_amdgcn_s_memrealtime() - t0_ < 4ull * ts_dt) __builtin_amdgcn_s_sleep(8); }
#endif
#undef IN
#undef BOTH
}

extern "C" void kernel_launch(void* const* d_in, const int* in_sizes, int n_in, void* d_out, int out_size, void* d_ws, size_t ws_size, hipStream_t stream) {
    static int grid = 0;
    if (grid == 0) {
        if (n_in != 17 || in_sizes[0] != M * D || out_size != M * D || ws_size < WS_END) { fprintf(stderr, "kernel_launch: unexpected shapes (n_in %d, in0 %d, out %d, ws %zu); nothing launched\n", n_in, n_in > 0 ? in_sizes[0] : -1, out_size, ws_size); grid = -1; return; }
        int dev = 0, cus = 0, per_cu = 0;
        if (hipGetDevice(&dev) != hipSuccess || hipDeviceGetAttribute(&cus, hipDeviceAttributeMultiprocessorCount, dev) != hipSuccess) { grid = -1; return; }
        if (hipFuncSetAttribute((const void*)mega_fwd, hipFuncAttributeMaxDynamicSharedMemorySize, LDS_BYTES) != hipSuccess) { fprintf(stderr, "kernel_launch: hipFuncSetAttribute failed\n"); grid = -1; return; }
        if (hipOccupancyMaxActiveBlocksPerMultiprocessor(&per_cu, (const void*)mega_fwd, NWAVES * 64, LDS_BYTES) != hipSuccess || per_cu < 1) fprintf(stderr, "kernel_launch: note: occupancy query reports %d workgroups per CU\n", per_cu);
        (void)hipGetLastError();
        grid = cus;
    }
    if (grid < 0) return;
    if (hipMemsetAsync((char*)d_ws + WS_CTL, 0, CTL_ZERO_BYTES, stream) != hipSuccess) { fprintf(stderr, "kernel_launch: hipMemsetAsync failed\n"); return; }
    Args a{};
    for (int i = 0; i < 17; ++i) a.in[i] = (const float*)d_in[i];
    a.out = (float*)d_out; a.ws = (unsigned char*)d_ws;
    for (int li = 0; li < N_LAUNCHES; ++li) {
        a.ph_lo = (N_LAUNCHES == PER_PHASE) ? li : 0; a.ph_hi = (N_LAUNCHES == PER_PHASE) ? li + 1 : PER_PHASE; a.li = li;
        hipLaunchKernelGGL(mega_fwd, dim3(grid), dim3(NWAVES * 64), LDS_BYTES, stream, a);
        const hipError_t le = hipPeekAtLastError();
        if (le != hipSuccess) { fprintf(stderr, "kernel_launch: launch %d failed: %s\n", li, hipGetErrorName(le)); break; }
    }
}
```

```cpp
#include <hip/hip_runtime.h>
#include <cstdio>
#include <cstdint>
namespace pg8 {
#define PG8_LAS __attribute__((address_space(3)))
typedef unsigned short bf16_t;
typedef short bf16x8 __attribute__((ext_vector_type(8)));
typedef float f32x4 __attribute__((ext_vector_type(4)));
typedef unsigned u32x4 __attribute__((ext_vector_type(4)));
constexpr int BM = 256, BK = 64, HALF = 128, HTB = HALF * BK * 2  , STAGE_BYTES = 8 * HTB, NXCD = 8, WGM = 4;

__host__ __device__ __forceinline__ int lds_byte(int r, int c) { const int st = (r >> 4) * 2 + (c >> 5), rr = r & 15, cc = c & 31, ob = rr * 64 + cc * 2; return st * 1024 + (ob ^ (((ob >> 9) & 1) << 5)); }
__host__ __device__ __forceinline__ void stage_rc(int b, int& R, int& C) { const int st = b / 1024, sb = b % 1024, swz = sb ^ (((sb >> 9) & 1) << 5); R = (st >> 1) * 16 + swz / 64; C = (st & 1) * 32 + (swz % 64) / 2; }
__host__ __device__ __forceinline__ int perm32(int rho) { const int n = rho >> 4, i = rho & 15; return 8 * (i >> 2) + 4 * n + (i & 3); }

struct Unit { int pm, pn, par; };
struct Gemm { const bf16_t* A; const bf16_t* Bt; int M, N, K; };

struct StaticOrder {
    int nM, nN, nwg, G, c, wgm;
    __host__ __device__ void init(int M, int N, int G_, int c_, int wgm_ = WGM) { nM = M / BM; nN = N / BM; nwg = nM * nN; G = G_; c = c_; wgm = wgm_; }
    __host__ __device__ bool next(int i, Unit& u) const {
        const long L = (long)i * G + c; if (L >= nwg) return false;
        int wgid = (int)L; { const int q = nwg / NXCD, r = nwg % NXCD, xcd = wgid % NXCD, off = wgid / NXCD; wgid = (xcd < r ? xcd * (q + 1) : r * (q + 1) + (xcd - r) * q) + off; }
        const int nig = wgm * nN, gid = wgid / nig, fm = gid * wgm, gsz = (nM - fm) < wgm ? (nM - fm) : wgm;
        u.pm = fm + ((wgid % nig) % gsz); u.pn = (wgid % nig) / gsz; return true;
    }
    __device__ __forceinline__ void a_ready(const Unit&) const {}
    __device__ __forceinline__ void done(const Unit&) const {}
};


typedef unsigned u32x2 __attribute__((ext_vector_type(2)));
constexpr float RMS_EPS = 1e-6f, LOG2E = 1.4426950408889634f, QSCALE = 0.125f * 1.4426950408889634f;
__device__ __forceinline__ unsigned cvt_pk_bf16(float lo, float hi) { unsigned r; asm volatile("v_cvt_pk_bf16_f32 %0, %1, %2" : "=v"(r) : "v"(lo), "v"(hi)); return r; }
__device__ __forceinline__ float fsigmoid(float x) { return __builtin_amdgcn_rcpf(1.0f + __builtin_amdgcn_exp2f(-x * LOG2E)); }
__device__ __forceinline__ float fsilu(float x) { return x * fsigmoid(x); }
__device__ __forceinline__ f32x4 silu4(f32x4 v) { return (f32x4){fsilu(v[0]), fsilu(v[1]), fsilu(v[2]), fsilu(v[3])}; }
__device__ __forceinline__ u32x4 pack8(f32x4 a, f32x4 b) { u32x4 w; w.x = cvt_pk_bf16(a[0], a[1]); w.y = cvt_pk_bf16(a[2], a[3]); w.z = cvt_pk_bf16(b[0], b[1]); w.w = cvt_pk_bf16(b[2], b[3]); return w; }
__device__ __forceinline__ float rowscale(const float* rowsq, const PG8_LAS float* slot, int rl) { return rowsq ? __builtin_amdgcn_rsqf(slot[rl] * (1.0f / 1024.0f) + RMS_EPS) : 1.0f; }
template <int CTRL> __device__ __forceinline__ float dpp_mov0(float x) { return __builtin_bit_cast(float, __builtin_amdgcn_update_dpp(0, __builtin_bit_cast(int, x), CTRL, 0xf, 0xf, true)); }
__device__ __forceinline__ float row_scan16(float x) { x += dpp_mov0<0x111>(x); x += dpp_mov0<0x112>(x); x += dpp_mov0<0x114>(x); x += dpp_mov0<0x118>(x); return x; }

struct EpiSwiGLU {
    static constexpr bool PERM = false, AFTER_DRAIN = false; static constexpr int SCALE = 1;
    bf16_t* H; const float* rowsq; const PG8_LAS float* scl; int ldh;
    __device__ __forceinline__ void operator()(f32x4 (&acc)[2][2][4][2], const Unit& u, int wr, int wc, int fr, int fq) const {
        const int row0 = u.pm * BM + wr * 64 + fr, col0 = u.pn * HALF + wc * 32 + 8 * fq; const PG8_LAS float* slot = scl + u.par * 256 + wr * 64 + fr;
#pragma unroll
        for (int ai = 0; ai < 2; ++ai)
#pragma unroll
            for (int m = 0; m < 4; ++m) { const int row = row0 + ai * HALF + m * 16; const float r = rowscale(rowsq, slot, ai * HALF + m * 16);
                f32x4 hh[2];
#pragma unroll
                for (int n = 0; n < 2; ++n) { const f32x4 g = acc[ai][0][m][n] * r, gu = g * (acc[ai][1][m][n] * r);
#pragma unroll
                    for (int c = 0; c < 4; ++c) hh[n][c] = gu[c] * __builtin_amdgcn_rcpf(1.0f + __builtin_amdgcn_exp2f(-g[c])); }
                *(u32x4*)(H + (unsigned)(row * ldh + col0)) = pack8(hh[0], hh[1]); }
    }
};
__device__ __forceinline__ unsigned dpp_x8_hi(unsigned old, unsigned src) { return (unsigned)__builtin_amdgcn_update_dpp((int)old, (int)src, 0x128, 0xf, 0xc, false); }
__device__ __forceinline__ unsigned dpp_x8_lo(unsigned old, unsigned src) { return (unsigned)__builtin_amdgcn_update_dpp((int)old, (int)src, 0x128, 0xf, 0x3, false); }
__device__ __forceinline__ void xch8(u32x4& p, u32x4& q) { u32x4 a, b;
#pragma unroll
    for (int i = 0; i < 4; ++i) { a[i] = dpp_x8_hi(p[i], q[i]); b[i] = dpp_x8_lo(q[i], p[i]); }
    p = a; q = b; }
__device__ __forceinline__ void xch8(f32x4& p, f32x4& q) { u32x4 a = __builtin_bit_cast(u32x4, p), b = __builtin_bit_cast(u32x4, q); xch8(a, b); p = __builtin_bit_cast(f32x4, a); q = __builtin_bit_cast(f32x4, b); }
__device__ __forceinline__ f32x4 bf4lo(u32x4 w) { return (f32x4){__builtin_bit_cast(float, w.x << 16), __builtin_bit_cast(float, w.x & 0xffff0000u), __builtin_bit_cast(float, w.y << 16), __builtin_bit_cast(float, w.y & 0xffff0000u)}; }
__device__ __forceinline__ f32x4 bf4hi(u32x4 w) { return (f32x4){__builtin_bit_cast(float, w.z << 16), __builtin_bit_cast(float, w.z & 0xffff0000u), __builtin_bit_cast(float, w.w << 16), __builtin_bit_cast(float, w.w & 0xffff0000u)}; }
__device__ __forceinline__ float sq4(f32x4 t) { return (t[0] * t[0] + t[1] * t[1]) + (t[2] * t[2] + t[3] * t[3]); }
template <int MODE> struct EpiRes {
    static constexpr int PERM = 2; static constexpr bool AFTER_DRAIN = false; static constexpr int SCALE = 0;
    const float* base; float* out; bf16_t* xb; float* rowsq; float scale;
    __device__ __forceinline__ void operator()(f32x4 (&acc)[2][2][4][2], const Unit& u, int wr, int wc, int fr, int fq) const {
        const int row0 = u.pm * BM + wr * 64 + fr, rowl = u.pm * BM + wr * 64 + (fr & 7), colw = u.pn * BM + wc * 64 + 8 * fq;
        const unsigned offH = (unsigned)(rowl * 1024 + colw + 32 * (fr >> 3)), offF = (unsigned)(rowl * 1024 + colw + 4 * (fr >> 3));
#define EPR_ROWS(g, h) ((((g) >> 2) * HALF + ((g) & 3) * 16 + 8 * (h)) * 1024)
#define EPR_H(p, g, h) ((p) + EPR_ROWS(g, h))[offH]
#define EPR_F(p, g, bj, h) ((p) + (EPR_ROWS(g, h) + (bj) * 32))[offF]
        if constexpr (MODE == 0) {
            f32x4 rb[4][4];
#pragma unroll
            for (int g = 0; g < 4; ++g)
#pragma unroll
                for (int j = 0; j < 4; ++j) rb[g][j] = *(const f32x4*)&EPR_F(base, g, j >> 1, j & 1);
            __builtin_amdgcn_sched_barrier(0);
#pragma unroll
            for (int g = 0; g < 8; ++g) { const int ai = g >> 2, m = g & 3; f32x4 v[4];
#pragma unroll
                for (int j = 0; j < 4; ++j) v[j] = rb[g & 3][j];
                if (g + 4 < 8) {
#pragma unroll
                    for (int j = 0; j < 4; ++j) rb[g & 3][j] = *(const f32x4*)&EPR_F(base, g + 4, j >> 1, j & 1); }
                xch8(v[0], v[1]); xch8(v[2], v[3]);
#pragma unroll
                for (int j = 0; j < 4; ++j) v[j] = v[j] + acc[ai][j >> 1][m][j & 1] * scale;
                float ss = (sq4(v[0]) + sq4(v[1])) + (sq4(v[2]) + sq4(v[3]));
                u32x4 p0 = pack8(v[0], v[1]), p1 = pack8(v[2], v[3]); xch8(p0, p1);
                *(u32x4*)&EPR_H(xb, g, 0) = p0; *(u32x4*)&EPR_H(xb, g, 1) = p1;
                ss += __shfl_xor(ss, 16); ss += __shfl_xor(ss, 32); if (fq == 0) __hip_atomic_fetch_add(rowsq + row0 + ai * HALF + m * 16, ss, __ATOMIC_RELAXED, __HIP_MEMORY_SCOPE_AGENT);
                __builtin_amdgcn_sched_barrier(0); }
        } else {
            u32x4 rb[8][2];
#pragma unroll
            for (int g = 0; g < 8; ++g)
#pragma unroll
                for (int h = 0; h < 2; ++h) rb[g][h] = *(const u32x4*)&EPR_H(xb, g, h);
            __builtin_amdgcn_sched_barrier(0);
#pragma unroll
            for (int g = 0; g < 8; ++g) { const int ai = g >> 2, m = g & 3;
                u32x4 x0 = rb[g][0], x1 = rb[g][1]; xch8(x0, x1);
                f32x4 v[4] = {bf4lo(x0) + acc[ai][0][m][0] * scale, bf4hi(x0) + acc[ai][0][m][1] * scale, bf4lo(x1) + acc[ai][1][m][0] * scale, bf4hi(x1) + acc[ai][1][m][1] * scale};
                if (MODE == 2) { xch8(v[0], v[1]); xch8(v[2], v[3]);
#pragma unroll
                    for (int j = 0; j < 4; ++j) *(f32x4*)&EPR_F(out, g, j >> 1, j & 1) = v[j]; }
                else { float ss = (sq4(v[0]) + sq4(v[1])) + (sq4(v[2]) + sq4(v[3]));
                    u32x4 p0 = pack8(v[0], v[1]), p1 = pack8(v[2], v[3]); xch8(p0, p1);
                    *(u32x4*)&EPR_H(xb, g, 0) = p0; *(u32x4*)&EPR_H(xb, g, 1) = p1;
                    ss += __shfl_xor(ss, 16); ss += __shfl_xor(ss, 32); if (fq == 0) __hip_atomic_fetch_add(rowsq + row0 + ai * HALF + m * 16, ss, __ATOMIC_RELAXED, __HIP_MEMORY_SCOPE_AGENT); }
                __builtin_amdgcn_sched_barrier(0); }
        }
#undef EPR_ROWS
#undef EPR_H
#undef EPR_F
    }
};
struct EpiWin {
    static constexpr bool PERM = false, AFTER_DRAIN = false; static constexpr int SCALE = 1;
    bf16_t *Q, *K, *QT, *KT, *G; float *DM, *DE; const float *rowsq, *gq, *gk, *lb; const PG8_LAS float* scl;
    __device__ __forceinline__ void operator()(f32x4 (&acc)[2][2][4][2], const Unit& u, int wr, int wc, int fr, int fq) const {
        const int row0 = u.pm * BM + wr * 64 + fr, t = u.pn; const PG8_LAS float* slot = scl + u.par * 256 + wr * 64 + fr;
        if (t < 4) {
            const bool isq = t < 2; const int head = 4 * (t & 1) + wc; const float* gp = isq ? gq : gk; const float gs = isq ? QSCALE : 1.0f;
            f32x4 gv[2][2];
#pragma unroll
            for (int bj = 0; bj < 2; ++bj)
#pragma unroll
                for (int n = 0; n < 2; ++n) gv[bj][n] = *(const f32x4*)(gp + 32 * bj + 8 * fq + 4 * n) * gs;
            bf16_t* dst = (isq ? Q : K) + (head * 32 * 8) * 512 + (fq >> 1) * 512 + (fq & 1) * 256;
#pragma unroll
            for (int ai = 0; ai < 2; ++ai)
#pragma unroll
                for (int m = 0; m < 4; ++m) { const int row = row0 + ai * HALF + m * 16; const float r = rowscale(rowsq, slot, ai * HALF + m * 16); float ss = 0.f;
#pragma unroll
                    for (int bj = 0; bj < 2; ++bj)
#pragma unroll
                        for (int n = 0; n < 2; ++n) { const f32x4 v = acc[ai][bj][m][n] * r; acc[ai][bj][m][n] = v; ss += (v[0] * v[0] + v[1] * v[1]) + (v[2] * v[2] + v[3] * v[3]); }
                    ss += __shfl_xor(ss, 16); ss += __shfl_xor(ss, 32);
                    const float inv = __builtin_amdgcn_rsqf(ss * (1.0f / 64.0f) + RMS_EPS);
                    const int tk = row & 2047, t5 = tk & 31, r32 = isq ? t5 : ((t5 & 0x13) | ((t5 & 4) << 1) | ((t5 & 8) >> 1));
                    const unsigned o = (unsigned)((((row >> 11) * 8 * 32 + (tk >> 6)) * 2 + ((tk >> 5) & 1)) * 4 * 512 + r32 * 8);
#pragma unroll
                    for (int bj = 0; bj < 2; ++bj) *(u32x4*)(dst + o + (unsigned)(2 * bj * 512)) = pack8(acc[ai][bj][m][0] * inv * gv[bj][0], acc[ai][bj][m][1] * inv * gv[bj][1]); }
        } else if (t < 8) {
            const int hh = t - 4, kbase = hh * 128 + wc * 32 + 8 * fq;
            float lbv[8]; { const f32x4 l0 = *(const f32x4*)(lb + kbase), l1 = *(const f32x4*)(lb + kbase + 4);
#pragma unroll
                for (int c = 0; c < 4; ++c) { lbv[c] = l0[c]; lbv[4 + c] = l1[c]; } }
            const int lane = fq * 16 + fr;
#pragma unroll
            for (int ai = 0; ai < 2; ++ai)
#pragma unroll
                for (int n = 0; n < 2; ++n) {
                    float omf[4][4], carry[4], bmid[4];
#pragma unroll
                    for (int m = 0; m < 4; ++m) { const float r = rowscale(rowsq, slot, ai * HALF + m * 16);
#pragma unroll
                        for (int c = 0; c < 4; ++c) { const int e = 4 * n + c; const float a = acc[ai][0][m][n][c] * r, b = acc[ai][1][m][n][c] * r;
                            const float sg = fsigmoid(b), f = lbv[e] + (1.0f - lbv[e]) * sg; omf[m][c] = (1.0f - lbv[e]) * (1.0f - sg);
                            acc[ai][1][m][n][c] = __builtin_amdgcn_logf(f);
                            acc[ai][0][m][n][c] = fsilu(a); } }
#pragma unroll
                    for (int c = 0; c < 4; ++c) { carry[c] = 0.f; bmid[c] = 0.f; }
#pragma unroll
                    for (int m = 0; m < 4; ++m)
#pragma unroll
                        for (int c = 0; c < 4; ++c) { float x = row_scan16(acc[ai][1][m][n][c]) + carry[c]; acc[ai][1][m][n][c] = x;
                            carry[c] = __shfl(x, lane | 15); if (m == 1) bmid[c] = carry[c]; }
#pragma unroll
                    for (int m = 0; m < 4; ++m) { const int row = row0 + ai * HALF + m * 16; f32x4 qv, kv;
#pragma unroll
                        for (int c = 0; c < 4; ++c) { const float d = acc[ai][1][m][n][c] - bmid[c];
                            qv[c] = acc[ai][0][m][n][c] * __builtin_amdgcn_exp2f(d); kv[c] = omf[m][c] * __builtin_amdgcn_exp2f(-d); }
                        const unsigned o = (unsigned)(row * 512 + kbase + 4 * n);
                        u32x2 w; w.x = cvt_pk_bf16(qv[0], qv[1]); w.y = cvt_pk_bf16(qv[2], qv[3]); *(u32x2*)(QT + o) = w;
                        w.x = cvt_pk_bf16(kv[0], kv[1]); w.y = cvt_pk_bf16(kv[2], kv[3]); *(u32x2*)(KT + o) = w; }
                    if (fr == 0) { const int chunk = (u.pm * BM + ai * HALF + wr * 64) >> 6; f32x4 a0, e0;
#pragma unroll
                        for (int c = 0; c < 4; ++c) { a0[c] = __builtin_amdgcn_exp2f(bmid[c]); e0[c] = __builtin_amdgcn_exp2f(carry[c] - bmid[c]); }
                        *(f32x4*)(DM + (unsigned)(chunk * 512 + kbase + 4 * n)) = a0; *(f32x4*)(DE + (unsigned)(chunk * 512 + kbase + 4 * n)) = e0; }
                    asm volatile("" ::: "memory");
                }
        } else {
            bf16_t* dst = G + (t - 8) * 256 + wc * 32 + 8 * fq;
#pragma unroll
            for (int ai = 0; ai < 2; ++ai)
#pragma unroll
                for (int m = 0; m < 4; ++m) { const int row = row0 + ai * HALF + m * 16; const float r = rowscale(rowsq, slot, ai * HALF + m * 16);
#pragma unroll
                    for (int bj = 0; bj < 2; ++bj) *(u32x4*)(dst + (unsigned)(row * 512 + bj * HALF)) = pack8(silu4(acc[ai][bj][m][0] * r), silu4(acc[ai][bj][m][1] * r)); }
        }
    }
};
struct EpiVT {
    static constexpr bool PERM = true, AFTER_DRAIN = false; static constexpr int SCALE = 2;
    bf16_t *VT, *VHT; const float* rowsq; const PG8_LAS float* scl;
    __device__ __forceinline__ void operator()(f32x4 (&acc)[2][2][4][2], const Unit& u, int wr, int wc, int fr, int fq) const {
        const int ch0 = (u.pm & 1) * BM + wr * 64 + fr, tok0 = u.pn * BM + wc * 32 + 8 * fq, b = tok0 >> 11, s0 = tok0 & 2047;
        f32x4 rs[2][2];
#pragma unroll
        for (int bj = 0; bj < 2; ++bj)
#pragma unroll
            for (int n = 0; n < 2; ++n) { const f32x4 q = *(const PG8_LAS f32x4*)(scl + u.par * 256 + wc * 32 + 8 * fq + bj * HALF + 4 * n);
#pragma unroll
                for (int c = 0; c < 4; ++c) rs[bj][n][c] = __builtin_amdgcn_rsqf(q[c] * (1.0f / 1024.0f) + RMS_EPS); }
        if (u.pm < 2) {
#pragma unroll
            for (int ai = 0; ai < 2; ++ai)
#pragma unroll
                for (int m = 0; m < 4; ++m) { const int ch = ch0 + ai * HALF + m * 16;
#pragma unroll
                    for (int bj = 0; bj < 2; ++bj) { const int sk = s0 + bj * HALF;
                        const unsigned o = (unsigned)((((((b * 8 + (ch >> 6)) * 32 + (sk >> 6)) * 2 + ((ch >> 5) & 1)) * 4 + ((sk >> 4) & 3)) * 64 + ((sk >> 3) & 1) * 32 + (ch & 31)) * 8);
                        *(u32x4*)(VT + o) = pack8(acc[ai][bj][m][0] * rs[bj][0], acc[ai][bj][m][1] * rs[bj][1]); } }
        } else {
            bf16_t* dst = VHT + (size_t)b * 512 * 2048 + s0;
#pragma unroll
            for (int ai = 0; ai < 2; ++ai)
#pragma unroll
                for (int m = 0; m < 4; ++m) { const int ch = ch0 + ai * HALF + m * 16;
#pragma unroll
                    for (int bj = 0; bj < 2; ++bj) *(u32x4*)(dst + (unsigned)(ch * 2048 + bj * HALF)) = pack8(acc[ai][bj][m][0] * rs[bj][0], acc[ai][bj][m][1] * rs[bj][1]); }
        }
    }
};

template <class Epi, class Sched, bool ALIGN_EPI = false, bool SP2 = false>
__device__ __forceinline__ void gemm_phase(PG8_LAS unsigned char* lds, const Gemm g, const Sched& S, const Epi& E) {
    const int tid = threadIdx.x, wid = __builtin_amdgcn_readfirstlane(tid >> 6), lane = tid & 63, wr = wid >> 2, wc = wid & 3, fr = lane & 15, fq = lane >> 4;
    const int K = g.K, nt = K / BK;
    unsigned voffA[2], voffB[2];
#pragma unroll
    for (int i = 0; i < 2; ++i) { int R, C; stage_rc(tid * 16 + i * 8192, R, C); const int Rb = (int)Epi::PERM == 2 ? ((R >> 5) * 64 + perm32(R & 31)) : Epi::PERM ? ((R & ~31) + perm32(R & 31)) : R;
        voffA[i] = (unsigned)(R * K + C) * 2u; voffB[i] = (unsigned)(Rb * K + C) * 2u; }
    const size_t kstep = (size_t)(BK * 2);
    const size_t hstep = (size_t)HALF * K * 2;
    const size_t hstepB = (int)Epi::PERM == 2 ? (size_t)32 * K * 2 : hstep;
    const size_t tstep = 2 * hstep;
    const unsigned ldsw = (unsigned)wid * 1024u;
    const int aoff = lds_byte(wr * 64 + fr, fq * 8), boff = lds_byte(wc * 32 + fr, fq * 8);
#define PG8_SA(b, h) (((b) * 2 + (h)) * HTB)
#define PG8_SB(b, h) ((4 + (b) * 2 + (h)) * HTB)
#define PG8_STAGE(bufoff, gbase, voff) do { _Pragma("unroll") for (int _i = 0; _i < 2; ++_i) \
        __builtin_amdgcn_global_load_lds((const unsigned*)((const char*)(gbase) + (voff)[_i]), (PG8_LAS unsigned*)(lds + (bufoff) + ldsw + _i * 8192), 16, 0, 0); } while (0)
#define PG8_LDA(dst, b, h) do { _Pragma("unroll") for (int m = 0; m < 4; ++m) _Pragma("unroll") for (int k = 0; k < 2; ++k) dst[m][k] = *(const PG8_LAS bf16x8*)(lds + PG8_SA(b, h) + aoff + m * 2048 + k * 1024); } while (0)
#define PG8_LDB(dst, b, h) do { _Pragma("unroll") for (int n = 0; n < 2; ++n) _Pragma("unroll") for (int k = 0; k < 2; ++k) dst[n][k] = *(const PG8_LAS bf16x8*)(lds + PG8_SB(b, h) + boff + n * 2048 + k * 1024); } while (0)
#define PG8_MMA(ai, bj, At, Bt) do { __builtin_amdgcn_s_setprio(1); _Pragma("unroll") for (int m = 0; m < 4; ++m) _Pragma("unroll") for (int n = 0; n < 2; ++n) _Pragma("unroll") for (int k = 0; k < 2; ++k) \
        acc[ai][bj][m][n] = __builtin_amdgcn_mfma_f32_16x16x32_bf16(Bt[n][k], At[m][k], acc[ai][bj][m][n], 0, 0, 0); __builtin_amdgcn_s_setprio(0); } while (0)
#define PG8_WAIT_V(n) asm volatile("s_waitcnt vmcnt(" #n ")" ::: "memory")
#define PG8_WAIT_L(n) asm volatile("s_waitcnt lgkmcnt(" #n ")" ::: "memory")
#define PG8_BAR __builtin_amdgcn_s_barrier()
#define PG8_SCHED __builtin_amdgcn_sched_barrier(0)
    Unit cur, nxt; int ui = 0;
    if (!S.next(0, cur)) return;
    cur.par = 0;
#define PG8_SCALE_DMA(u_) do { if (Epi::SCALE != 0 && wid == 0 && E.rowsq != nullptr) \
        __builtin_amdgcn_global_load_lds((const unsigned*)(E.rowsq + ((Epi::SCALE == 1 ? (u_).pm : (u_).pn) * BM + lane * 4)), (PG8_LAS unsigned*)(lds + STAGE_BYTES + (u_).par * 1024), 16, 0, 0); } while (0)
    PG8_SCALE_DMA(cur);
    f32x4 acc[2][2][4][2];
#pragma unroll
    for (int a = 0; a < 2; ++a)
#pragma unroll
        for (int b = 0; b < 2; ++b)
#pragma unroll
            for (int m = 0; m < 4; ++m)
#pragma unroll
                for (int n = 0; n < 2; ++n) acc[a][b][m][n] = (f32x4){0.f, 0.f, 0.f, 0.f};
    bf16x8 At[4][2], B0[2][2], B1[2][2];
    const char* cA = (const char*)g.A + (size_t)cur.pm * tstep; const char* cB = (const char*)g.Bt + (size_t)cur.pn * tstep;
    S.a_ready(cur);
    if constexpr (SP2) {
        PG8_STAGE(PG8_SB(0, 0), cB, voffB); PG8_STAGE(PG8_SB(0, 1), cB + hstepB, voffB); PG8_STAGE(PG8_SA(0, 0), cA, voffA); PG8_STAGE(PG8_SA(0, 1), cA + hstep, voffA);
        if (wr == 1) PG8_BAR;
        PG8_WAIT_V(2); PG8_BAR;
        PG8_STAGE(PG8_SB(1, 0), cB + kstep, voffB); PG8_STAGE(PG8_SA(1, 0), cA + kstep, voffA); PG8_STAGE(PG8_SB(1, 1), cB + hstepB + kstep, voffB);
        PG8_WAIT_V(6); PG8_BAR;
    } else {
        PG8_STAGE(PG8_SB(0, 0), cB, voffB); PG8_STAGE(PG8_SA(0, 0), cA, voffA); PG8_STAGE(PG8_SB(0, 1), cB + hstepB, voffB); PG8_STAGE(PG8_SA(0, 1), cA + hstep, voffA);
        if (wr == 1) PG8_BAR;
        PG8_WAIT_V(4); PG8_BAR;
        PG8_STAGE(PG8_SB(1, 0), cB + kstep, voffB); PG8_STAGE(PG8_SA(1, 0), cA + kstep, voffA); PG8_STAGE(PG8_SB(1, 1), cB + hstepB + kstep, voffB);
        PG8_WAIT_V(6); PG8_BAR;
    }
    for (;;) {
        const bool has_next = S.next(ui + 1, nxt); nxt.par = (ui + 1) & 1;
        const char* nA = has_next ? (const char*)g.A + (size_t)nxt.pm * tstep : cA; const char* nB = has_next ? (const char*)g.Bt + (size_t)nxt.pn * tstep : cB;
        for (int t = 0; t < nt; t += 2) {
            const bool last = (t == nt - 2);
            const char* a1 = cA + (size_t)(t + 1) * kstep;
            const char* a2 = last ? nA : cA + (size_t)(t + 2) * kstep; const char* b2 = last ? nB : cB + (size_t)(t + 2) * kstep;
            const char* a3 = a2 + kstep; const char* b3 = b2 + kstep;
            if (last && has_next) { S.a_ready(nxt); PG8_SCALE_DMA(nxt); }
            if constexpr (SP2) {
            PG8_LDB(B0, 0, 0); PG8_LDB(B1, 0, 1); PG8_SCHED; PG8_LDA(At, 0, 0); PG8_STAGE(PG8_SA(1, 1), a1 + hstep, voffA);
            PG8_WAIT_V(8); PG8_WAIT_L(0); PG8_BAR; PG8_MMA(0, 0, At, B0); PG8_MMA(0, 1, At, B1); PG8_BAR; PG8_SCHED;
            PG8_LDA(At, 0, 1); PG8_STAGE(PG8_SB(0, 0), b2, voffB); PG8_STAGE(PG8_SB(0, 1), b2 + hstepB, voffB); PG8_STAGE(PG8_SA(0, 0), a2, voffA);
            PG8_WAIT_V(8); PG8_WAIT_L(0); PG8_BAR; PG8_MMA(1, 0, At, B0); PG8_MMA(1, 1, At, B1); PG8_BAR; PG8_SCHED;
            PG8_LDB(B0, 1, 0); PG8_LDB(B1, 1, 1); PG8_SCHED; PG8_LDA(At, 1, 0); PG8_STAGE(PG8_SA(0, 1), a2 + hstep, voffA);
            PG8_WAIT_V(8); PG8_WAIT_L(0); PG8_BAR; PG8_MMA(0, 0, At, B0); PG8_MMA(0, 1, At, B1); PG8_BAR; PG8_SCHED;
            PG8_LDA(At, 1, 1); PG8_STAGE(PG8_SB(1, 0), b3, voffB); PG8_STAGE(PG8_SB(1, 1), b3 + hstepB, voffB); PG8_STAGE(PG8_SA(1, 0), a3, voffA);
            PG8_WAIT_V(8); PG8_WAIT_L(0); PG8_BAR; PG8_MMA(1, 0, At, B0); PG8_MMA(1, 1, At, B1); PG8_BAR; PG8_SCHED;
            } else {
            PG8_LDB(B0, 0, 0); PG8_SCHED; PG8_LDA(At, 0, 0); PG8_STAGE(PG8_SA(1, 1), a1 + hstep, voffA);
            PG8_WAIT_L(8); PG8_BAR; PG8_WAIT_L(0); PG8_MMA(0, 0, At, B0); PG8_BAR; PG8_SCHED;
            PG8_LDB(B1, 0, 1); PG8_STAGE(PG8_SB(0, 0), b2, voffB);
            PG8_BAR; PG8_WAIT_L(0); PG8_MMA(0, 1, At, B1); PG8_BAR;
            PG8_LDA(At, 0, 1); PG8_STAGE(PG8_SA(0, 0), a2, voffA);
            PG8_BAR; PG8_WAIT_L(0); PG8_MMA(1, 0, At, B0); PG8_BAR; PG8_SCHED;
            PG8_STAGE(PG8_SB(0, 1), b2 + hstepB, voffB);
            PG8_WAIT_V(6); PG8_BAR; PG8_MMA(1, 1, At, B1); PG8_BAR;
            PG8_LDB(B0, 1, 0); PG8_SCHED; PG8_LDA(At, 1, 0); PG8_STAGE(PG8_SA(0, 1), a2 + hstep, voffA);
            PG8_WAIT_L(8); PG8_BAR; PG8_WAIT_L(0); PG8_MMA(0, 0, At, B0); PG8_BAR; PG8_SCHED;
            PG8_LDB(B1, 1, 1); PG8_STAGE(PG8_SB(1, 0), b3, voffB);
            PG8_BAR; PG8_WAIT_L(0); PG8_MMA(0, 1, At, B1); PG8_BAR;
            PG8_LDA(At, 1, 1); PG8_STAGE(PG8_SA(1, 0), a3, voffA);
            PG8_BAR; PG8_WAIT_L(0); PG8_MMA(1, 0, At, B0); PG8_BAR; PG8_SCHED;
            PG8_STAGE(PG8_SB(1, 1), b3 + hstepB, voffB);
            PG8_WAIT_V(6); PG8_BAR; PG8_MMA(1, 1, At, B1); PG8_BAR;
            }
        }
        if constexpr (ALIGN_EPI) { if (wr == 0) PG8_BAR; }
        if constexpr (!Epi::AFTER_DRAIN) { E(acc, cur, wr, wc, fr, fq); S.done(cur); }
        if (!has_next) break;
#pragma unroll
        for (int a = 0; a < 2; ++a)
#pragma unroll
            for (int b = 0; b < 2; ++b)
#pragma unroll
                for (int m = 0; m < 4; ++m)
#pragma unroll
                    for (int n = 0; n < 2; ++n) acc[a][b][m][n] = (f32x4){0.f, 0.f, 0.f, 0.f};
        cur = nxt; cA = nA; cB = nB; ++ui;
        if constexpr (ALIGN_EPI) { if (wr == 1) PG8_BAR; }
    }
    PG8_WAIT_V(0);
    if constexpr (!ALIGN_EPI) { if (wr == 0) PG8_BAR; }
    PG8_BAR;
    if constexpr (Epi::AFTER_DRAIN) { E.fused(acc, cur, wr, wc, fr, fq, lds, wid, lane); S.done(cur); }
#undef PG8_SCALE_DMA
#undef PG8_SA
#undef PG8_SB
#undef PG8_STAGE
#undef PG8_LDA
#undef PG8_LDB
#undef PG8_MMA
#undef PG8_WAIT_V
#undef PG8_WAIT_L
#undef PG8_BAR
#undef PG8_SCHED
}
}

constexpr int NWAVES = 8;
#ifndef MK_N_LAUNCHES
#define MK_N_LAUNCHES 1
#endif
constexpr int PER_PHASE = 8;
constexpr int N_LAUNCHES = MK_N_LAUNCHES;
constexpr int BATCH = 16, SEQ = 2048, D = 1024, M = BATCH * SEQ, FF = 2816, NPROJ = 3584;
constexpr int AW = 512, HW = 512, NCHUNK = SEQ / 64;
constexpr float RMS_EPS = 1e-6f, LOG2E = 1.4426950408889634f;
#ifndef WGM_GU
#define WGM_GU 4
#endif
#ifndef WGM_DOWN
#define WGM_DOWN 4
#endif
#ifndef WGM_OUT
#define WGM_OUT 4
#endif
#ifndef WGM_IN
#define WGM_IN 4
#endif
#ifndef WGM_INT
#define WGM_INT 4
#endif

constexpr size_t MiB = 1u << 20;
constexpr size_t WS_CTL = 0, CTL_ZERO_BYTES = 1 * MiB;
constexpr size_t WS_RS1 = 256 * 1024, WS_RS2 = 384 * 1024;
constexpr size_t WS_LB = 1 * MiB, WS_DM = 2 * MiB, WS_DE = 3 * MiB;
constexpr size_t WS_WGU1 = 4 * MiB, WS_WD1 = 15 * MiB, WS_WIN = 21 * MiB, WS_WINT = 26 * MiB, WS_WOUT = 28 * MiB, WS_WGU2 = 30 * MiB, WS_WD2 = 41 * MiB;
constexpr size_t WS_XB = 48 * MiB;
constexpr size_t WS_MIX = 112 * MiB;
constexpr size_t WS_HID = 176 * MiB;
constexpr size_t WS_Q = 176 * MiB, WS_K = 208 * MiB, WS_VT = 240 * MiB, WS_QT = 272 * MiB, WS_KT = 304 * MiB, WS_VHT = 336 * MiB, WS_G = 368 * MiB, WS_END = 400 * MiB;
static_assert(WS_WGU1 + (size_t)2 * FF * D * 2 <= WS_WD1 && WS_WD1 + (size_t)D * FF * 2 <= WS_WIN && WS_WIN + (size_t)2560 * D * 2 <= WS_WINT && WS_WGU2 + (size_t)2 * FF * D * 2 <= WS_WD2 && WS_WD2 + (size_t)D * FF * 2 <= WS_XB, "weight map");
static_assert(WS_HID + (size_t)M * FF * 2 <= WS_END && WS_XB + (size_t)M * D * 2 <= WS_MIX && WS_MIX + (size_t)M * D * 2 <= WS_HID, "activation map");
constexpr int CW_TMO = 0, CW_CODE = 1;
constexpr int CW_BAR = 4096;
constexpr int CW_WQ = 16384;

constexpr int RING_OFF = 0, RING_BYTES = 131072;
constexpr int LDS_BYTES = 163840;
constexpr int LDSCTL_OFF = LDS_BYTES - 1024, MISC_OFF = LDSCTL_OFF + 320;
static_assert(MISC_OFF + 128 <= LDS_BYTES, "LDS map");

#define GAS __attribute__((address_space(1)))
#define LAS __attribute__((address_space(3)))
typedef unsigned short bf16;
typedef unsigned v4u __attribute__((ext_vector_type(4)));
typedef float f32x4 __attribute__((ext_vector_type(4)));
typedef short bf16x8 __attribute__((ext_vector_type(8)));
typedef GAS unsigned gu32;
#define RLX_AGENT __ATOMIC_RELAXED, __HIP_MEMORY_SCOPE_AGENT
#define LDS_WAIT() asm volatile("s_waitcnt lgkmcnt(0)" ::: "memory")
#define VM_WAIT() asm volatile("s_waitcnt vmcnt(0)" ::: "memory")
__device__ __forceinline__ unsigned f2bf(float f) { unsigned u = __builtin_bit_cast(unsigned, f); return (u + 0x7fffu + ((u >> 16) & 1u)) >> 16; }
__device__ __forceinline__ unsigned pk2(float lo, float hi) { return f2bf(lo) | (f2bf(hi) << 16); }
__device__ __forceinline__ float bf2f(unsigned short h) { return __builtin_bit_cast(float, (unsigned)h << 16); }
__device__ __forceinline__ float bflo(unsigned w) { return __builtin_bit_cast(float, w << 16); }
__device__ __forceinline__ float bfhi(unsigned w) { return __builtin_bit_cast(float, w & 0xffff0000u); }

#define XB_TMO      128
#define XB_XCNT(j)  (256  + 64 * (j))
#define XB_XSUB(j)  (1280 + 64 * (j))
#define XB_XGEN(j)  (2304 + 64 * (j))
#define XB_TOP      3328
#define XB_TOPGEN   3392
#define XCD_BAR_WORDS 3456
#define XB_SPIN_CAP (1u << 18)

__device__ __forceinline__ unsigned xb_ld(unsigned* p)              { return __hip_atomic_load(p, __ATOMIC_RELAXED, __HIP_MEMORY_SCOPE_AGENT); }
__device__ __forceinline__ unsigned xb_add(unsigned* p, unsigned v) { return __hip_atomic_fetch_add(p, v, __ATOMIC_RELAXED, __HIP_MEMORY_SCOPE_AGENT); }
__device__ __forceinline__ unsigned xb_xcc_id() { return (unsigned)__builtin_amdgcn_s_getreg((3 << 11) | 20) & 0xFu; }
#define XB_SPIN(cond, bar) do { unsigned _sp = 0; while (cond) { __builtin_amdgcn_s_sleep(1); \
    if ((++_sp & 255u) == 0u) { if (xb_ld(&(bar)[XB_TMO])) break; if (_sp > XB_SPIN_CAP) { atomicAdd(&(bar)[XB_TMO], 1u); break; } } } } while (0)

struct XcdBarrier {
    unsigned* bar; unsigned x;
    volatile LAS unsigned* st;
};

__device__ __forceinline__ XcdBarrier xcd_barrier_post(unsigned* bar, volatile LAS unsigned* st) {
    XcdBarrier b; b.bar = bar; b.x = xb_xcc_id(); b.st = st;
    if (threadIdx.x == 0) (void)xb_add(&bar[XB_XCNT(b.x)], 1u);
    return b;
}
__device__ __forceinline__ void xcd_barrier_complete(unsigned* bar, unsigned x, unsigned& nloc, unsigned& nx) {
    const unsigned G = gridDim.x * gridDim.y * gridDim.z;
    unsigned sum, cnt, mine, sp = 0u;
    for (;;) {
        sum = 0u; cnt = 0u; mine = 0u;
#pragma unroll
        for (unsigned j = 0; j < 16; ++j) { const unsigned c = xb_ld(&bar[XB_XCNT(j)]); sum += c; cnt += (c > 0u) ? 1u : 0u; mine = (j == x) ? c : mine; }
        if (sum == G) break;
        __builtin_amdgcn_s_sleep(1);
        if ((++sp & 255u) == 0u) { if (xb_ld(&bar[XB_TMO])) break; if (sp > XB_SPIN_CAP) { atomicAdd(&bar[XB_TMO], 1u); break; } }
    }
    nloc = mine > 0u ? mine : 1u; nx = cnt > 0u ? cnt : 1u;
}

__device__ __forceinline__ void xcd_barrier(const XcdBarrier& b) {
    asm volatile("s_waitcnt vmcnt(0)" ::: "memory");
    __syncthreads();
    if (threadIdx.x == 0) {
        unsigned* bar = b.bar;
        __builtin_amdgcn_s_waitcnt(0);
        unsigned nloc = b.st[0], nx = b.st[1];
        if (nloc == 0u) { xcd_barrier_complete(bar, b.x, nloc, nx); b.st[0] = nloc; b.st[1] = nx; }
        const unsigned old = xb_add(&bar[XB_XSUB(b.x)], 1u);
        const unsigned gen = old / nloc;
        if (old + 1u == (gen + 1u) * nloc) {
            __builtin_amdgcn_fence(__ATOMIC_RELEASE, "agent");
            asm volatile("s_waitcnt vmcnt(0)" ::: "memory");
            const unsigned og = xb_add(&bar[XB_TOP], 1u);
            const unsigned tg = og / nx;
            if (og + 1u == (tg + 1u) * nx) xb_add(&bar[XB_TOPGEN], 1u);
            else XB_SPIN(xb_ld(&bar[XB_TOPGEN]) == tg, bar);
            __builtin_amdgcn_fence(__ATOMIC_ACQUIRE, "agent");
            xb_add(&bar[XB_XGEN(b.x)], 1u);
            asm volatile("s_waitcnt vmcnt(0)" ::: "memory");
        } else {
            XB_SPIN(xb_ld(&bar[XB_XGEN(b.x)]) == gen, bar);
            __builtin_amdgcn_fence(__ATOMIC_ACQUIRE, "agent");
            asm volatile("s_waitcnt vmcnt(0)" ::: "memory");
        }
    }
    __syncthreads();
}

struct Frame {
    LAS unsigned char* lds;
    volatile LAS unsigned* MISC;
    gu32* ctl;
    int tid, lane, wave, G;
    const float* in[17]; float* out; unsigned char* ws;
};
__device__ __forceinline__ float wave_sum(float v) {
#pragma unroll
    for (int o = 1; o < 64; o <<= 1) v += __shfl_xor(v, o);
    return v;
}
__device__ __forceinline__ int srccol(int kind, int R, int& sel) {
    sel = 0;
    if (kind == 0) return R;
    const int t = R >> 8, p = R & 255, bj = p >> 7, q = p & 127, wc = q >> 5, pr = pg8::perm32(q & 31);
    if (kind == 1) { sel = bj; return 128 * t + 32 * wc + pr; }
    if (kind == 2) {
        if (t < 2) return 64 * (4 * t + wc) + 32 * bj + pr;
        if (t < 4) return 512 + 64 * (4 * (t - 2) + wc) + 32 * bj + pr;
        if (t < 8) return (bj ? 2048 : 1536) + 128 * (t - 4) + 32 * wc + pr;
        return 3072 + 256 * (t - 8) + 128 * bj + 32 * wc + pr;
    }
    return R < 512 ? 1024 + R : 2560 + (R - 512);
}
struct P0Blk { f32x4 v[8]; };
__device__ __forceinline__ void p0_load(P0Blk& t, const float* W0, const float* W1, int N, int kind, int item, int nblk, int lane) {
    const int kb = item / nblk, nb = item % nblk, k0 = 64 * kb + 8 * (lane >> 3), R = 32 * nb + 4 * (lane & 7);
    int sel; const int c = srccol(kind, R, sel);
    const float* W = (sel ? W1 : W0) + (size_t)k0 * N + c;
#pragma unroll
    for (int i = 0; i < 8; ++i) t.v[i] = *(const f32x4*)(W + (size_t)i * N);
}
__device__ __forceinline__ void p0_store(const P0Blk& t, int K, bf16* WT, const float* gain, int kind, int item, int nblk, int lane) {
    const int kb = item / nblk, nb = item % nblk, k0 = 64 * kb + 8 * (lane >> 3), R = 32 * nb + 4 * (lane & 7);
    float gk[8];
    const float ws = kind == 1 ? (((R >> 7) & 1) ? 1.0f / LOG2E : LOG2E) : 1.0f;
#pragma unroll
    for (int i = 0; i < 8; ++i) gk[i] = ws;
    if (gain) { const f32x4 g0 = *(const f32x4*)(gain + k0), g1 = *(const f32x4*)(gain + k0 + 4);
#pragma unroll
        for (int i = 0; i < 4; ++i) { gk[i] = g0[i] * ws; gk[4 + i] = g1[i] * ws; } }
#pragma unroll
    for (int j = 0; j < 4; ++j) { v4u o; o.x = pk2(t.v[0][j] * gk[0], t.v[1][j] * gk[1]); o.y = pk2(t.v[2][j] * gk[2], t.v[3][j] * gk[3]); o.z = pk2(t.v[4][j] * gk[4], t.v[5][j] * gk[5]); o.w = pk2(t.v[6][j] * gk[6], t.v[7][j] * gk[7]);
        *(GAS v4u*)(WT + (size_t)(R + j) * K + k0) = o; }
}
struct P0Job { const float* W0; const float* W1; const float* gain; bf16* WT; int K, N, kind, nblk, item; };
constexpr int P0_I_GU = (D / 64) * (2 * FF / 32), P0_I_D = (FF / 64) * (D / 32), P0_I_IN = (D / 64) * (2560 / 32), P0_I_INT = (D / 64) * (1024 / 32), P0_I_O = (D / 64) * (D / 32);
constexpr int P0_N0 = P0_I_GU + P0_I_D + P0_I_IN + P0_I_INT, P0_N1 = P0_I_GU + P0_I_D + P0_I_O;
__device__ __forceinline__ P0Job p0_job(Frame& F, int set, int it) {
    int r = it;
    if (set == 0) {
        if (r < P0_I_GU) return P0Job{F.in[2], F.in[3], nullptr, (bf16*)(F.ws + WS_WGU1), D, FF, 1, 2 * FF / 32, r}; r -= P0_I_GU;
        if (r < P0_I_D) return P0Job{F.in[4], F.in[4], nullptr, (bf16*)(F.ws + WS_WD1), FF, D, 0, D / 32, r}; r -= P0_I_D;
        if (r < P0_I_IN) return P0Job{F.in[6], F.in[6], F.in[5], (bf16*)(F.ws + WS_WIN), D, NPROJ, 2, 2560 / 32, r}; r -= P0_I_IN;
        return P0Job{F.in[6], F.in[6], F.in[5], (bf16*)(F.ws + WS_WINT), D, NPROJ, 3, 1024 / 32, r};
    }
    if (r < P0_I_GU) return P0Job{F.in[14], F.in[15], F.in[13], (bf16*)(F.ws + WS_WGU2), D, FF, 1, 2 * FF / 32, r}; r -= P0_I_GU;
    if (r < P0_I_D) return P0Job{F.in[16], F.in[16], nullptr, (bf16*)(F.ws + WS_WD2), FF, D, 0, D / 32, r}; r -= P0_I_D;
    return P0Job{F.in[12], F.in[12], nullptr, (bf16*)(F.ws + WS_WOUT), D, D, 0, D / 32, r};
}
__device__ __forceinline__ void p0_weights(Frame& F, int set, int gw, int NGW) {
    const int NIT = set == 0 ? P0_N0 : P0_N1;
    int it = gw;
    if (it < NIT) {
        P0Job j0 = p0_job(F, set, it); P0Blk t0; p0_load(t0, j0.W0, j0.W1, j0.N, j0.kind, j0.item, j0.nblk, F.lane);
        for (;;) {
            const int it1 = it + NGW; const bool more = it1 < NIT;
            P0Job j1 = j0; P0Blk t1;
            if (more) { j1 = p0_job(F, set, it1); p0_load(t1, j1.W0, j1.W1, j1.N, j1.kind, j1.item, j1.nblk, F.lane); }
            p0_store(t0, j0.K, j0.WT, j0.gain, j0.kind, j0.item, j0.nblk, F.lane);
            if (!more) break;
            it = it1; j0 = j1;
#pragma unroll
            for (int i = 0; i < 8; ++i) t0.v[i] = t1.v[i];
        }
    }
}
__device__ __forceinline__ void rms_rows4_to_bf16(const float* x, const float* g, bf16* o, int lane) {
    f32x4 v[4][4]; float s[4];
#pragma unroll
    for (int r = 0; r < 4; ++r)
#pragma unroll
        for (int j = 0; j < 4; ++j) v[r][j] = *((const GAS f32x4*)(x + (size_t)r * D) + lane + 64 * j);
#pragma unroll
    for (int r = 0; r < 4; ++r) { s[r] = 0.f;
#pragma unroll
        for (int j = 0; j < 4; ++j) s[r] += (v[r][j].x * v[r][j].x + v[r][j].y * v[r][j].y) + (v[r][j].z * v[r][j].z + v[r][j].w * v[r][j].w); }
#pragma unroll
    for (int of = 1; of < 64; of <<= 1) {
#pragma unroll
        for (int r = 0; r < 4; ++r) s[r] += __shfl_xor(s[r], of); }
    f32x4 gg[4];
#pragma unroll
    for (int j = 0; j < 4; ++j) gg[j] = *((const GAS f32x4*)g + lane + 64 * j);
#pragma unroll
    for (int r = 0; r < 4; ++r) { const float rr = __builtin_amdgcn_rsqf(s[r] * (1.f / D) + RMS_EPS);
        GAS unsigned long long* o8 = (GAS unsigned long long*)(o + (size_t)r * D) + lane;
#pragma unroll
        for (int j = 0; j < 4; ++j) o8[64 * j] = (unsigned long long)pk2(v[r][j].x * rr * gg[j].x, v[r][j].y * rr * gg[j].y) | ((unsigned long long)pk2(v[r][j].z * rr * gg[j].z, v[r][j].w * rr * gg[j].w) << 32); }
}
__device__ __forceinline__ void p0_prologue(Frame& F, unsigned long long& p0_probe) {
    const int gw = (int)blockIdx.x * NWAVES + F.wave, NGW = F.G * NWAVES;
#if defined(PROBE_PHASE) && (PROBE_PHASE == 13 || PROBE_PHASE == 14)
    const unsigned long long p0_t0 = __builtin_amdgcn_s_memrealtime();
#endif
    p0_weights(F, 0, gw, NGW);
#if defined(PROBE_PHASE) && (PROBE_PHASE == 13 || PROBE_PHASE == 14)
    const unsigned long long tp1_ = __builtin_amdgcn_s_memrealtime();
    if (PROBE_PHASE == 13) p0_probe = tp1_ - p0_t0;
#endif
    for (int m = 4 * gw; m < M; m += 4 * NGW) rms_rows4_to_bf16(F.in[0] + (size_t)m * D, F.in[1], (bf16*)(F.ws + WS_XB) + (size_t)m * D, F.lane);
#if defined(PROBE_PHASE) && (PROBE_PHASE == 13 || PROBE_PHASE == 14)
    if (PROBE_PHASE == 14) p0_probe = __builtin_amdgcn_s_memrealtime() - tp1_;
#endif
    if (blockIdx.x == 0) {
        const float l0 = F.in[10][F.tid], l1 = F.in[10][512 + F.tid], mx = fmaxf(l0, l1), e0 = __expf(l0 - mx), e1 = __expf(l1 - mx);
        ((float*)(F.ws + WS_LB))[F.tid] = e0 / (e0 + e1);
    }
}

typedef float f32x16 __attribute__((ext_vector_type(16)));
typedef float f32x2_t __attribute__((ext_vector_type(2))); typedef __bf16 bf16x2_t __attribute__((ext_vector_type(2)));
__device__ __forceinline__ unsigned cvtpk_s(float lo, float hi) { f32x2_t v = {lo, hi}; bf16x2_t b = __builtin_convertvector(v, bf16x2_t); return __builtin_bit_cast(unsigned, b); }
__device__ __forceinline__ bf16x8 pack_step(const f32x16& x, int s) { v4u p; p.x = cvtpk_s(x[8 * s], x[8 * s + 1]); p.y = cvtpk_s(x[8 * s + 2], x[8 * s + 3]); p.z = cvtpk_s(x[8 * s + 4], x[8 * s + 5]); p.w = cvtpk_s(x[8 * s + 6], x[8 * s + 7]); return __builtin_bit_cast(bf16x8, p); }
__device__ __forceinline__ float swapmax(float m) { auto rr = __builtin_amdgcn_permlane32_swap(__float_as_uint(m), __float_as_uint(m), false, false); return fmaxf(__uint_as_float(rr[0]), __uint_as_float(rr[1])); }
__device__ __forceinline__ float swapsum(float m) { auto rr = __builtin_amdgcn_permlane32_swap(__float_as_uint(m), __float_as_uint(m), false, false); return __uint_as_float(rr[0]) + __uint_as_float(rr[1]); }
__device__ __forceinline__ int pi32(int x) { return (x & 0x13) | ((x & 4) << 1) | ((x & 8) >> 1); }
#define MFMA32(a, b, c) __builtin_amdgcn_mfma_f32_32x32x16_bf16((a), (b), (c), 0, 0, 0)
constexpr int ATT_ETAB_OFF = 0;
__device__ __forceinline__ void attn_item(Frame& F, int b, int c, int h, const LAS float* etab) {
    const bf16* Q = (const bf16*)(F.ws + WS_Q); const bf16* Kp = (const bf16*)(F.ws + WS_K); const bf16* VT = (const bf16*)(F.ws + WS_VT); bf16* MIX = (bf16*)(F.ws + WS_MIX);
    const int lane = F.lane, r32 = lane & 31, hi = lane >> 5;
    const float cfar = F.in[9][h * 257 + 256] * LOG2E;
    bf16x8 qf[2][4];
#pragma unroll
    for (int qb = 0; qb < 2; ++qb)
#pragma unroll
        for (int d0 = 0; d0 < 4; ++d0) qf[qb][d0] = *(const bf16x8*)(Q + (unsigned)((((((b * 8 + h) * 32 + c) * 2 + qb) * 4 + d0) * 64 + lane) * 8));
    f32x16 o[2][2];
#pragma unroll
    for (int db = 0; db < 2; ++db)
#pragma unroll
        for (int qb = 0; qb < 2; ++qb)
#pragma unroll
            for (int r = 0; r < 16; ++r) o[db][qb][r] = 0.f;
    float mrun[2] = {-INFINITY, -INFINITY}, lrun[2] = {0.f, 0.f};
    const int kt0 = c >= 8 ? c - 8 : 0;
    const unsigned fbase = (unsigned)(((b * 8 + h) * 32 * 8 * 64 + lane) * 8);
    const LAS float* et = etab + h * 256;
    bf16x8 kf[2][4], vf[2][4];
#define AT_LOADK(kt_) do { _Pragma("unroll") for (int kb = 0; kb < 2; ++kb) _Pragma("unroll") for (int d0 = 0; d0 < 4; ++d0) kf[kb][d0] = *(const bf16x8*)(Kp + fbase + (unsigned)((((kt_) * 2 + kb) * 4 + d0) * 512)); } while (0)
#define AT_LOADV(kt_) do { _Pragma("unroll") for (int db = 0; db < 2; ++db) _Pragma("unroll") for (int ks = 0; ks < 4; ++ks) vf[db][ks] = *(const bf16x8*)(VT + fbase + (unsigned)((((kt_) * 2 + db) * 4 + ks) * 512)); } while (0)
    AT_LOADK(kt0); AT_LOADV(kt0);
    for (int kt = kt0; kt <= c; ++kt) {
        const int j = c - kt, ktn = kt < c ? kt + 1 : c;
#pragma unroll
        for (int qb = 0; qb < 2; ++qb) {
            f32x16 s[2]; bf16x8 pk[2][2];
            const float c0 = j >= 3 ? cfar : 0.f;
#pragma unroll
            for (int r = 0; r < 16; ++r) { s[0][r] = c0; s[1][r] = c0; }
#pragma unroll
            for (int d0 = 0; d0 < 4; ++d0) { s[0] = MFMA32(kf[0][d0], qf[qb][d0], s[0]); s[1] = MFMA32(kf[1][d0], qf[qb][d0], s[1]); }
            if (qb == 1) { __builtin_amdgcn_sched_barrier(0); AT_LOADK(ktn); __builtin_amdgcn_sched_barrier(0); }
            if (j < 3) {
                const int ib = 64 * j + 32 * qb + r32 - 8 * hi + 63;
#pragma unroll
                for (int kb = 0; kb < 2; ++kb)
#pragma unroll
                    for (int r = 0; r < 16; ++r) s[kb][r] += et[ib - 32 * kb - 16 * (r >> 3) - (r & 7)];
            }
            float tm = fmaxf(s[0][0], s[1][0]);
#pragma unroll
            for (int r = 1; r < 16; ++r) tm = fmaxf(tm, fmaxf(s[0][r], s[1][r]));
            tm = swapmax(tm);
            const float mn = fmaxf(mrun[qb], tm), alpha = __builtin_amdgcn_exp2f(mrun[qb] - mn); mrun[qb] = mn;
            float ls = 0.f;
#pragma unroll
            for (int kb = 0; kb < 2; ++kb)
#pragma unroll
                for (int r = 0; r < 16; ++r) { const float p = __builtin_amdgcn_exp2f(s[kb][r] - mn); s[kb][r] = p; ls += p; }
            lrun[qb] = lrun[qb] * alpha + ls;
#pragma unroll
            for (int db = 0; db < 2; ++db)
#pragma unroll
                for (int r = 0; r < 16; ++r) o[db][qb][r] *= alpha;
#pragma unroll
            for (int kb = 0; kb < 2; ++kb) { pk[kb][0] = pack_step(s[kb], 0); pk[kb][1] = pack_step(s[kb], 1); }
#pragma unroll
            for (int db = 0; db < 2; ++db)
#pragma unroll
                for (int kb = 0; kb < 2; ++kb)
#pragma unroll
                    for (int sp = 0; sp < 2; ++sp) o[db][qb] = MFMA32(vf[db][2 * kb + sp], pk[kb][sp], o[db][qb]);
        }
        __builtin_amdgcn_sched_barrier(0); AT_LOADV(ktn); __builtin_amdgcn_sched_barrier(0);
    }
#undef AT_LOADK
#undef AT_LOADV
#pragma unroll
    for (int qb = 0; qb < 2; ++qb) {
        const float inv = 1.0f / swapsum(lrun[qb]);
        bf16* orow = MIX + (unsigned)((b * SEQ + 64 * c + 32 * qb + r32) * 1024 + h * 64 + 16 * hi);
#pragma unroll
        for (int db = 0; db < 2; ++db) {
            unsigned wx[4], wy[4];
#pragma unroll
            for (int g = 0; g < 4; ++g) { wx[g] = cvtpk_s(o[db][qb][4 * g] * inv, o[db][qb][4 * g + 1] * inv); wy[g] = cvtpk_s(o[db][qb][4 * g + 2] * inv, o[db][qb][4 * g + 3] * inv); }
#pragma unroll
            for (int p = 0; p < 2; ++p) {
                auto ax = __builtin_amdgcn_permlane32_swap(wx[p], wx[p + 2], false, false); auto ay = __builtin_amdgcn_permlane32_swap(wy[p], wy[p + 2], false, false);
                *(v4u*)(orow + 32 * db + 8 * p) = (v4u){ax[0], ay[0], ax[1], ay[1]}; }
        }
    }
}
__device__ __forceinline__ void attn_phase(Frame& F) {
    LAS float* etab = (LAS float*)(F.lds + RING_OFF + ATT_ETAB_OFF);
    for (int i = F.tid; i < 8 * 256; i += NWAVES * 64) { const int h = i >> 8; int rel = (i & 255) - 63; rel = rel > 128 ? 128 : rel; etab[i] = F.in[9][h * 257 + rel + 128] * LOG2E; }
    __syncthreads();
    for (int k = 0; k < 8; ++k) {
        const int shard = ((int)blockIdx.x + k) & 7;
        gu32* head = F.ctl + CW_WQ + 64 * shard;
        for (;;) {
            unsigned n = 0; if (F.lane == 0) n = __hip_atomic_fetch_add(head, 1u, RLX_AGENT);
            n = (unsigned)__builtin_amdgcn_readfirstlane((int)n);
            if (n >= 512u) break;
            const int bh = 8 * (int)(n >> 5) + shard, c = 31 - (int)(n & 31);
            attn_item(F, bh >> 3, c, bh & 7, etab);
        }
    }
    __syncthreads();
}

__device__ __forceinline__ unsigned off_b(unsigned row, unsigned ch) { return 256u * row + 16u * (ch ^ (((row & 3) << 2) | ((row >> 2) & 3))); }
__device__ __forceinline__ unsigned tr_read_addr_b(unsigned lane, unsigned c, unsigned ks, unsigned t) {
    const unsigned h = lane >> 5, blk = (lane >> 4) & 1, q = (lane & 15) >> 2, p = lane & 3;
    return off_b(16 * ks + 8 * h + 4 * t + q, 4 * c + 2 * blk + (p >> 1)) + 8 * (p & 1);
}
typedef short v4i16_t __attribute__((ext_vector_type(4)));
__device__ __forceinline__ v4i16_t lds_tr(const LAS unsigned char* p) { return __builtin_amdgcn_ds_read_tr16_b64_v4i16((LAS v4i16_t*)p); }
__device__ __forceinline__ bf16x8 krow_frag(bf16x8 nat) {
    const v4u d = __builtin_bit_cast(v4u, nat);
    auto a = __builtin_amdgcn_permlane32_swap(d.x, d.z, false, false); auto b = __builtin_amdgcn_permlane32_swap(d.y, d.w, false, false);
    v4u r; r.x = a[0]; r.y = b[0]; r.z = a[1]; r.w = b[1]; return __builtin_bit_cast(bf16x8, r);
}
constexpr int HG_PS_OFF = 8192, HG_DD_OFF = 10240, HG_GN_OFF = 12288, HG_BUF_OFF = 16384;
constexpr int HG_QT_OFF = 16384, HG_VT_OFF = 32768, HG_BUF_BYTES = 49152;
constexpr int HG_OX_OFF = HG_BUF_OFF + 2 * HG_BUF_BYTES, HG_OX_BYTES = 64 * 264;
constexpr int HG_XS_OFF = HG_OX_OFF + 2 * HG_OX_BYTES;
static_assert(HG_XS_OFF + 3 * 2048 <= LDSCTL_OFF && HG_OX_OFF % 16 == 0 && HG_XS_OFF % 16 == 0, "HGRN LDS map");
__device__ __forceinline__ void dma16(const void* g, LAS unsigned char* l) { __builtin_amdgcn_global_load_lds((const unsigned*)g, (LAS unsigned*)l, 16, 0, 0); }
__device__ __forceinline__ void hgrn_finalize(Frame& F, const v4u (&gw)[4], int b, int hh, int c) {
    bf16* MIX = (bf16*)(F.ws + WS_MIX);
    const int ht = F.tid - 256, tok = ht >> 2, pc = ht & 3;
    const LAS float* ps = (const LAS float*)(F.lds + RING_OFF + HG_PS_OFF) + ((c & 1) * 2 + (tok >> 5)) * 128 + (tok & 31);
    const float tot = (ps[0] + ps[32]) + (ps[64] + ps[96]);
    const float rs = __builtin_amdgcn_rsqf(tot * (1.0f / 128.0f) + RMS_EPS);
    const LAS unsigned char* ox = F.lds + RING_OFF + HG_OX_OFF + (c & 1) * HG_OX_BYTES + tok * 264 + 64 * pc;
    const LAS f32x4* gn = (const LAS f32x4*)(F.lds + RING_OFF + HG_GN_OFF) + 8 * pc;
    bf16* dst = MIX + (unsigned)((b * SEQ + 64 * c + tok) * 1024 + 512 + hh * 128 + 32 * pc);
#pragma unroll
    for (int q = 0; q < 4; ++q) { unsigned ow[4]; const unsigned g4w[4] = {gw[q].x, gw[q].y, gw[q].z, gw[q].w};
#pragma unroll
        for (int i = 0; i < 2; ++i) { const pg8::u32x2 o2 = *(const LAS pg8::u32x2*)(ox + 16 * q + 8 * i); const f32x4 g4 = gn[2 * q + i];
            ow[2 * i] = cvtpk_s(bflo(o2.x) * rs * g4[0] * bflo(g4w[2 * i]), bfhi(o2.x) * rs * g4[1] * bfhi(g4w[2 * i]));
            ow[2 * i + 1] = cvtpk_s(bflo(o2.y) * rs * g4[2] * bflo(g4w[2 * i + 1]), bfhi(o2.y) * rs * g4[3] * bfhi(g4w[2 * i + 1])); }
        *(v4u*)(dst + 8 * q) = (v4u){ow[0], ow[1], ow[2], ow[3]}; }
}
__device__ __forceinline__ void hgrn_phase(Frame& F, int bh, unsigned long long& hg_wait_acc) {
    (void)hg_wait_acc;
    const unsigned char* QT = F.ws + WS_QT; const unsigned char* KT = F.ws + WS_KT; const unsigned char* VHT = F.ws + WS_VHT; const bf16* Gt = (const bf16*)(F.ws + WS_G);
    const unsigned char* DM = F.ws + WS_DM; const unsigned char* DE = F.ws + WS_DE;
    const int b = bh >> 2, hh = bh & 3, lane = F.lane, r32 = lane & 31, hi = lane >> 5, w = F.wave, tid = F.tid;
    LAS unsigned char* const bufs = F.lds + RING_OFF + HG_BUF_OFF;
    LAS float* const psw = (LAS float*)(F.lds + RING_OFF + HG_PS_OFF);
    LAS float* const ddw = (LAS float*)(F.lds + RING_OFF + HG_DD_OFF);
    if (tid < 128) ((LAS float*)(F.lds + RING_OFF + HG_GN_OFF))[tid] = F.in[11][tid];
    if (w >= 4) {
        const int hw = w - 4;
        unsigned so_k[4], so_v[4];
#pragma unroll
        for (int j = 0; j < 4; ++j) { const unsigned ii = (unsigned)(hw + 4 * j), sl = ii * 64 + lane;
            { const unsigned img = sl >> 9, s9 = sl & 511, row = s9 >> 4, ch = (s9 & 15) ^ (((row & 3) << 2) | ((row >> 2) & 3)); so_k[j] = ((32 * img + row) * 512 + hh * 128) * 2 + ch * 16; }
            { const unsigned row = sl >> 3, ch = (sl & 7) ^ (row & 7); so_v[j] = ((hh * 128 + row) * SEQ) * 2 + ch * 16; } }
        const unsigned so_d = (unsigned)((hh * 128) * 4 + (lane & 31) * 16);
        const unsigned char* const ddsrc = (lane < 32 ? DM : DE) + (size_t)(b * NCHUNK) * 2048 + so_d;
        const unsigned char* const ktb = KT + (size_t)(b * SEQ) * 1024; const unsigned char* const qtb = QT + (size_t)(b * SEQ) * 1024; const unsigned char* const vtb = VHT + (size_t)(b * 512) * SEQ * 2;
#define HG_DMA(c_) do { LAS unsigned char* nb_ = bufs + ((c_) & 1) * HG_BUF_BYTES + hw * 1024; const size_t ck_ = (size_t)(c_) * 65536, cv_ = (size_t)(c_) * 128; \
        _Pragma("unroll") for (int j_ = 0; j_ < 4; ++j_) { dma16(ktb + ck_ + so_k[j_], nb_ + j_ * 4096); dma16(qtb + ck_ + so_k[j_], nb_ + HG_QT_OFF + j_ * 4096); dma16(vtb + cv_ + so_v[j_], nb_ + HG_VT_OFF + j_ * 4096); } \
        if (hw == 0) dma16(ddsrc + (size_t)(c_) * 2048, (LAS unsigned char*)(ddw + ((c_) & 1) * 256)); } while (0)
        const unsigned src_g = (unsigned)((b * SEQ + ((tid - 256) >> 2)) * 512 + hh * 128 + 32 * (tid & 3));
        const unsigned rk_ = (unsigned)pi32(r32), sk_ = ((rk_ & 3) << 2) | ((rk_ >> 2) & 3), sq_ = (((unsigned)r32 & 3) << 2) | (((unsigned)r32 >> 2) & 3);
        const unsigned kt_base = 256u * rk_ + 16u * ((unsigned)hi ^ (sk_ & 1)), kt_e = sk_ >> 1, qt_base = (unsigned)HG_QT_OFF + 256u * (unsigned)r32 + 16u * ((unsigned)hi ^ (sq_ & 1)), qt_e = sq_ >> 1;
        HG_DMA(0);
        asm volatile("s_waitcnt vmcnt(0) lgkmcnt(0)" ::: "memory"); __builtin_amdgcn_s_barrier(); asm volatile("" ::: "memory");
        for (int c = 0; c <= NCHUNK; ++c) {
            if (c + 1 < NCHUNK) HG_DMA(c + 1);
            if (hw < 3 && c < NCHUNK) {
                const LAS unsigned char* buf = bufs + (c & 1) * HG_BUF_BYTES;
                const int sbx = hw >> 1, tbx = (hw + 1) >> 1;
                unsigned ek = kt_e, eq = qt_e; asm volatile("" : "+v"(ek), "+v"(eq));
                f32x16 X;
#pragma unroll
                for (int r = 0; r < 16; ++r) X[r] = 0.f;
#pragma unroll
                for (int ks = 0; ks < 8; ++ks) { const bf16x8 kf = *(const LAS bf16x8*)(buf + sbx * 8192 + kt_base + (((unsigned)ks ^ ek) << 5)), qf = *(const LAS bf16x8*)(buf + tbx * 8192 + qt_base + (((unsigned)ks ^ eq) << 5)); X = MFMA32(kf, qf, X); }
                if (sbx == tbx) {
                    int thr = r32 - 8 * hi; asm volatile("" : "+v"(thr));
#pragma unroll
                    for (int r = 0; r < 16; ++r) X[r] = thr >= 16 * (r >> 3) + (r & 7) ? X[r] : 0.f;
                }
                LAS unsigned char* xw = F.lds + RING_OFF + HG_XS_OFF + hw * 2048 + lane * 16;
                *(LAS bf16x8*)xw = pack_step(X, 0); *(LAS bf16x8*)(xw + 1024) = pack_step(X, 1);
            }
            if (c > 0) { const bf16* gcp = Gt + (size_t)((c - 1) * 64 * 512); v4u gc[4];
#pragma unroll
                for (int q = 0; q < 4; ++q) gc[q] = *(const v4u*)(gcp + src_g + 8 * q);
                hgrn_finalize(F, gc, b, hh, c - 1); }
            asm volatile("s_waitcnt lgkmcnt(0)" ::: "memory"); __builtin_amdgcn_s_barrier(); asm volatile("" ::: "memory");
            asm volatile("s_waitcnt vmcnt(0) lgkmcnt(0)" ::: "memory"); __builtin_amdgcn_s_barrier(); asm volatile("" ::: "memory");
        }
#undef HG_DMA
    } else {
        const int vb = w;
        f32x16 S[4];
#pragma unroll
        for (int kb = 0; kb < 4; ++kb)
#pragma unroll
            for (int r = 0; r < 16; ++r) S[kb][r] = 0.f;
        const unsigned rk_ = (unsigned)pi32(r32), sk_ = ((rk_ & 3) << 2) | ((rk_ >> 2) & 3), sq_ = (((unsigned)r32 & 3) << 2) | (((unsigned)r32 >> 2) & 3);
        const unsigned kt_base = 256u * rk_ + 16u * ((unsigned)hi ^ (sk_ & 1)), kt_e = sk_ >> 1, qt_base = (unsigned)HG_QT_OFF + 256u * (unsigned)r32 + 16u * ((unsigned)hi ^ (sq_ & 1)), qt_e = sq_ >> 1;
        unsigned rd_tr[4][2], rd_vt[4];
#pragma unroll
        for (int kb = 0; kb < 4; ++kb) { rd_tr[kb][0] = tr_read_addr_b((unsigned)lane, (unsigned)kb, 0u, 0u); rd_tr[kb][1] = tr_read_addr_b((unsigned)lane, (unsigned)kb, 0u, 1u); }
#pragma unroll
        for (int k4 = 0; k4 < 4; ++k4) rd_vt[k4] = (unsigned)(HG_VT_OFF + (32 * vb + r32) * 128 + (((2 * k4 + hi) ^ (r32 & 7)) << 4));
        const unsigned wr_ox = (unsigned)(HG_OX_OFF + r32 * 264 + (32 * vb + 4 * hi) * 2);
        asm volatile("s_waitcnt vmcnt(0) lgkmcnt(0)" ::: "memory"); __builtin_amdgcn_s_barrier(); asm volatile("" ::: "memory");
        for (int c = 0; c <= NCHUNK; ++c) {
            const LAS unsigned char* buf = bufs + (c & 1) * HG_BUF_BYTES;
            f32x16 o[2]; bf16x8 vfr[4];
            if (c < NCHUNK) {
            const LAS float* dd = ddw + (c & 1) * 256 + 4 * hi;
#pragma unroll
            for (int kb = 0; kb < 4; ++kb)
#pragma unroll
                for (int g = 0; g < 4; ++g) { const f32x4 a = *(const LAS f32x4*)(dd + 32 * kb + 8 * g);
#pragma unroll
                    for (int i = 0; i < 4; ++i) S[kb][4 * g + i] *= a[i]; }
            unsigned ek = kt_e, eq = qt_e; asm volatile("" : "+v"(ek), "+v"(eq));
#define HG_RDKT(ks_) (kt_base + (((unsigned)(ks_) ^ ek) << 5))
#define HG_RDQT(ks_) (qt_base + (((unsigned)(ks_) ^ eq) << 5))
            __builtin_amdgcn_sched_barrier(0);
#pragma unroll
            for (int k4 = 0; k4 < 4; ++k4) vfr[k4] = *(const LAS bf16x8*)(buf + rd_vt[k4]);
#pragma unroll
            for (int r = 0; r < 16; ++r) { o[0][r] = 0.f; o[1][r] = 0.f; }
#pragma unroll
            for (int kb = 0; kb < 4; ++kb)
#pragma unroll
                for (int sp = 0; sp < 2; ++sp) { const bf16x8 sf = pack_step(S[kb], sp);
                    const bf16x8 q0 = *(const LAS bf16x8*)(buf + HG_RDQT(2 * kb + sp)), q1 = *(const LAS bf16x8*)(buf + 8192 + HG_RDQT(2 * kb + sp));
                    o[0] = MFMA32(sf, krow_frag(q0), o[0]); o[1] = MFMA32(sf, krow_frag(q1), o[1]); }
            __builtin_amdgcn_sched_barrier(0);
#pragma unroll
            for (int kb = 0; kb < 4; ++kb) {
#pragma unroll
                for (int k4 = 0; k4 < 4; ++k4) {
                    const LAS unsigned char* ip = buf + (k4 >> 1) * 8192 + (k4 & 1) * 4096;
                    const v4i16_t lo = lds_tr(ip + rd_tr[kb][0]), hi4 = lds_tr(ip + rd_tr[kb][1]);
                    const bf16x8 af = __builtin_shufflevector(lo, hi4, 0, 1, 2, 3, 4, 5, 6, 7);
                    S[kb] = MFMA32(af, vfr[k4], S[kb]);
                }
#pragma unroll
                for (int g = 0; g < 4; ++g) { const f32x4 a = *(const LAS f32x4*)(dd + 128 + 32 * kb + 8 * g);
#pragma unroll
                    for (int i = 0; i < 4; ++i) S[kb][4 * g + i] *= a[i]; }
            }
            }
            asm volatile("s_waitcnt lgkmcnt(0)" ::: "memory"); __builtin_amdgcn_s_barrier(); asm volatile("" ::: "memory");
            if (c < NCHUNK) {
            { const LAS unsigned char* xr = F.lds + RING_OFF + HG_XS_OFF + lane * 16;
              o[0] = MFMA32(vfr[0], *(const LAS bf16x8*)(xr), o[0]); o[0] = MFMA32(vfr[1], *(const LAS bf16x8*)(xr + 1024), o[0]);
              o[1] = MFMA32(vfr[0], *(const LAS bf16x8*)(xr + 2048), o[1]); o[1] = MFMA32(vfr[1], *(const LAS bf16x8*)(xr + 3072), o[1]);
              o[1] = MFMA32(vfr[2], *(const LAS bf16x8*)(xr + 4096), o[1]); o[1] = MFMA32(vfr[3], *(const LAS bf16x8*)(xr + 5120), o[1]); }
#pragma unroll
            for (int tbi = 0; tbi < 2; ++tbi) { float q = 0.f;
#pragma unroll
              for (int r = 0; r < 16; ++r) q += o[tbi][r] * o[tbi][r];
              q = swapsum(q);
              if (hi == 0) psw[((c & 1) * 2 + tbi) * 128 + vb * 32 + r32] = q;
              LAS unsigned char* oxw = F.lds + RING_OFF + (c & 1) * HG_OX_BYTES + wr_ox + tbi * 32 * 264;
#pragma unroll
              for (int g = 0; g < 4; ++g) *(LAS pg8::u32x2*)(oxw + 16 * g) = (pg8::u32x2){cvtpk_s(o[tbi][4 * g], o[tbi][4 * g + 1]), cvtpk_s(o[tbi][4 * g + 2], o[tbi][4 * g + 3])}; }
            }
            asm volatile("s_waitcnt vmcnt(0) lgkmcnt(0)" ::: "memory"); __builtin_amdgcn_s_barrier(); asm volatile("" ::: "memory");
        }
#undef HG_RDKT
#undef HG_RDQT
    }
    __syncthreads();
}

struct Args { const float* in[17]; float* out; unsigned char* ws; int ph_lo, ph_hi, li, pad; };
__global__ void __launch_bounds__(NWAVES * 64, 2) mega_fwd(Args args) {
    extern __shared__ __attribute__((aligned(16))) unsigned char lds[];
    Frame F;
    F.lds = (LAS unsigned char*)lds;
    F.MISC = (volatile LAS unsigned*)(F.lds + MISC_OFF);
    F.tid = threadIdx.x; F.lane = F.tid & 63; F.wave = __builtin_amdgcn_readfirstlane(F.tid >> 6);
    F.G = gridDim.x;
#pragma unroll
    for (int i = 0; i < 17; ++i) F.in[i] = args.in[i];
    F.out = args.out; F.ws = args.ws;
    F.ctl = (gu32*)(args.ws + WS_CTL);
    for (int u = F.tid; u < (LDS_BYTES - LDSCTL_OFF) / 4; u += NWAVES * 64) ((LAS unsigned*)(F.lds + LDSCTL_OFF))[u] = 0u;
    __syncthreads();
    XcdBarrier bar; bar.bar = (unsigned*)(F.ctl + CW_BAR); bar.x = 0; bar.st = nullptr;
    if (N_LAUNCHES != PER_PHASE) bar = xcd_barrier_post((unsigned*)(F.ctl + CW_BAR), F.MISC + 8);
#define GRID_BAR(seam) do { if (N_LAUNCHES == PER_PHASE) { if (F.tid == 0) __hip_atomic_store(F.ctl + CW_TMO, 0xBADBA0u | (unsigned)(seam), RLX_AGENT); } else { xcd_barrier(bar); } } while (0)
    const int lo = args.ph_lo, hi = args.ph_hi;
#ifdef PROBE_PHASE
    unsigned long long ts_prev = __builtin_amdgcn_s_memrealtime(), ts_dt = 0ull; int ts_k = 0;
#define STAMP() do { const unsigned long long t_ = __builtin_amdgcn_s_memrealtime(); if (ts_k == PROBE_PHASE) ts_dt = t_ - ts_prev; ts_prev = t_; ++ts_k; } while (0)
#else
#define STAMP() do {} while (0)
#endif
#define IN(k) (lo <= (k) && (k) < hi)
#define BOTH(k) (IN(k) && IN((k) + 1))
    bf16* const XB = (bf16*)(F.ws + WS_XB); bf16* const HID = (bf16*)(F.ws + WS_HID); bf16* const MIXp = (bf16*)(F.ws + WS_MIX);
    float* const RS1 = (float*)(F.ws + WS_RS1); float* const RS2 = (float*)(F.ws + WS_RS2);
    const LAS float* const SCL = (const LAS float*)(F.lds + RING_OFF + RING_BYTES);

    if (IN(0)) { unsigned long long p0_probe = 0ull; p0_prologue(F, p0_probe);
#if defined(PROBE_PHASE) && (PROBE_PHASE == 13 || PROBE_PHASE == 14)
        ts_dt = p0_probe;
#endif
        if (BOTH(0)) GRID_BAR(0); STAMP(); }
    if (IN(1)) {
        pg8::Gemm g{XB, (const bf16*)(F.ws + WS_WGU1), M, 2 * FF, D}; pg8::StaticOrder S; S.init(M, 2 * FF, F.G, (int)blockIdx.x, WGM_GU);
        pg8::EpiSwiGLU E{HID, nullptr, SCL, FF};
        pg8::gemm_phase<pg8::EpiSwiGLU, pg8::StaticOrder, true, true>(F.lds + RING_OFF, g, S, E);
        if (BOTH(1)) GRID_BAR(1); STAMP();
    }
    if (IN(2)) {
        pg8::Gemm g{HID, (const bf16*)(F.ws + WS_WD1), M, D, FF}; pg8::StaticOrder S; S.init(M, D, F.G, (int)blockIdx.x, WGM_DOWN);
        pg8::EpiRes<0> E{F.in[0], nullptr, XB, RS1, 0.5f};
        pg8::gemm_phase<pg8::EpiRes<0>, pg8::StaticOrder, true, true>(F.lds + RING_OFF, g, S, E);
        if (BOTH(2)) GRID_BAR(2); STAMP();
    }
    if (IN(3)) {
        { pg8::Gemm g{XB, (const bf16*)(F.ws + WS_WIN), M, 2560, D}; pg8::StaticOrder S; S.init(M, 2560, F.G, (int)blockIdx.x, WGM_IN);
          pg8::EpiWin E{(bf16*)(F.ws + WS_Q), (bf16*)(F.ws + WS_K), (bf16*)(F.ws + WS_QT), (bf16*)(F.ws + WS_KT), (bf16*)(F.ws + WS_G), (float*)(F.ws + WS_DM), (float*)(F.ws + WS_DE), RS1, F.in[7], F.in[8], (const float*)(F.ws + WS_LB), SCL};
          pg8::gemm_phase<pg8::EpiWin, pg8::StaticOrder, true, true>(F.lds + RING_OFF, g, S, E); }
        { pg8::Gemm g{(const bf16*)(F.ws + WS_WINT), XB, 1024, M, D}; pg8::StaticOrder S; S.init(1024, M, F.G, (int)blockIdx.x, WGM_INT);
          pg8::EpiVT E{(bf16*)(F.ws + WS_VT), (bf16*)(F.ws + WS_VHT), RS1, SCL};
          pg8::gemm_phase<pg8::EpiVT, pg8::StaticOrder, true, true>(F.lds + RING_OFF, g, S, E); }
        if (BOTH(3)) GRID_BAR(3); STAMP();
    }
    if (IN(4)) {
#ifdef PROBE_PHASE
        const unsigned long long th00_ = __builtin_amdgcn_s_memrealtime();
#endif
#ifdef PROBE_PHASE
        const unsigned long long th0_ = __builtin_amdgcn_s_memrealtime();
        if (PROBE_PHASE == 9) ts_dt = th0_ - th00_;
#endif
        unsigned long long hg_wait_acc = 0ull;
        if (blockIdx.x < 64) hgrn_phase(F, (int)blockIdx.x, hg_wait_acc);
#ifdef PROBE_PHASE
        if (PROBE_PHASE == 11 || PROBE_PHASE == 12) ts_dt = hg_wait_acc;
#endif
#ifdef PROBE_PHASE
        if (PROBE_PHASE == 8) ts_dt = __builtin_amdgcn_s_memrealtime() - th0_;
#endif
#ifdef PROBE_PHASE
        const unsigned long long ta0_ = __builtin_amdgcn_s_memrealtime();
#endif
        attn_phase(F);
        if (blockIdx.x >= 64) p0_weights(F, 1, ((int)blockIdx.x - 64) * NWAVES + F.wave, (F.G - 64) * NWAVES);
#ifdef PROBE_PHASE
        if (PROBE_PHASE == 10) ts_dt = __builtin_amdgcn_s_memrealtime() - ta0_;
#endif
        if (BOTH(4)) GRID_BAR(4); STAMP();
    }
    if (IN(5)) {
        pg8::Gemm g{MIXp, (const bf16*)(F.ws + WS_WOUT), M, D, D}; pg8::StaticOrder S; S.init(M, D, F.G, (int)blockIdx.x, WGM_OUT);
        pg8::EpiRes<1> E{nullptr, nullptr, XB, RS2, 1.0f};
        pg8::gemm_phase<pg8::EpiRes<1>, pg8::StaticOrder, true, true>(F.lds + RING_OFF, g, S, E);
        if (BOTH(5)) GRID_BAR(5); STAMP();
    }
    if (IN(6)) {
        pg8::Gemm g{XB, (const bf16*)(F.ws + WS_WGU2), M, 2 * FF, D}; pg8::StaticOrder S; S.init(M, 2 * FF, F.G, (int)blockIdx.x, WGM_GU);
        pg8::EpiSwiGLU E{HID, RS2, SCL, FF};
        pg8::gemm_phase<pg8::EpiSwiGLU, pg8::StaticOrder, true, true>(F.lds + RING_OFF, g, S, E);
        if (BOTH(6)) GRID_BAR(6); STAMP();
    }
    if (IN(7)) {
        pg8::Gemm g{HID, (const bf16*)(F.ws + WS_WD2), M, D, FF}; pg8::StaticOrder S; S.init(M, D, F.G, (int)blockIdx.x, WGM_DOWN);
        pg8::EpiRes<2> E{nullptr, F.out, XB, nullptr, 0.5f};
        pg8::gemm_phase<pg8::EpiRes<2>, pg8::StaticOrder, true, true>(F.lds + RING_OFF, g, S, E);
    }
#ifdef PROBE_PHASE
    __syncthreads(); STAMP();
    if (blockIdx.x == (PROBE_PHASE == 10 ? 255 : 0) && F.tid == 0) { const unsigned long long t0_ = __builtin_amdgcn_s_memrealtime(); while (__builtin_amdgcn_s_memrealtime() - t0_ < 4ull * ts_dt) __builtin_amdgcn_s_sleep(8); }
#endif
#undef IN
#undef BOTH
}

extern "C" void kernel_launch(void* const* d_in, const int* in_sizes, int n_in, void* d_out, int out_size, void* d_ws, size_t ws_size, hipStream_t stream) {
    static int grid = 0;
    if (grid == 0) {
        if (n_in != 17 || in_sizes[0] != M * D || out_size != M * D || ws_size < WS_END) { fprintf(stderr, "kernel_launch: unexpected shapes (n_in %d, in0 %d, out %d, ws %zu); nothing launched\n", n_in, n_in > 0 ? in_sizes[0] : -1, out_size, ws_size); grid = -1; return; }
        int dev = 0, cus = 0, per_cu = 0;
        if (hipGetDevice(&dev) != hipSuccess || hipDeviceGetAttribute(&cus, hipDeviceAttributeMultiprocessorCount, dev) != hipSuccess) { grid = -1; return; }
        if (hipFuncSetAttribute((const void*)mega_fwd, hipFuncAttributeMaxDynamicSharedMemorySize, LDS_BYTES) != hipSuccess) { fprintf(stderr, "kernel_launch: hipFuncSetAttribute failed\n"); grid = -1; return; }
        if (hipOccupancyMaxActiveBlocksPerMultiprocessor(&per_cu, (const void*)mega_fwd, NWAVES * 64, LDS_BYTES) != hipSuccess || per_cu < 1) fprintf(stderr, "kernel_launch: note: occupancy query reports %d workgroups per CU\n", per_cu);
        (void)hipGetLastError();
        grid = cus;
    }
    if (grid < 0) return;
    if (hipMemsetAsync((char*)d_ws + WS_CTL, 0, CTL_ZERO_BYTES, stream) != hipSuccess) { fprintf(stderr, "kernel_launch: hipMemsetAsync failed\n"); return; }
    Args a{};
    for (int i = 0; i < 17; ++i) a.in[i] = (const float*)d_in[i];
    a.out = (float*)d_out; a.ws = (unsigned char*)d_ws;
    for (int li = 0; li < N_LAUNCHES; ++li) {
        a.ph_lo = (N_LAUNCHES == PER_PHASE) ? li : 0; a.ph_hi = (N_LAUNCHES == PER_PHASE) ? li + 1 : PER_PHASE; a.li = li;
        hipLaunchKernelGGL(mega_fwd, dim3(grid), dim3(NWAVES * 64), LDS_BYTES, stream, a);
        const hipError_t le = hipPeekAtLastError();
        if (le != hipSuccess) { fprintf(stderr, "kernel_launch: launch %d failed: %s\n", li, hipGetErrorName(le)); break; }
    }
}
```

```cpp
#include <hip/hip_runtime.h>
#include <cstdio>
#include <cstdint>
namespace pg8 {
#define PG8_LAS __attribute__((address_space(3)))
typedef unsigned short bf16_t;
typedef short bf16x8 __attribute__((ext_vector_type(8)));
typedef float f32x4 __attribute__((ext_vector_type(4)));
typedef unsigned u32x4 __attribute__((ext_vector_type(4)));
constexpr int BM = 256, BK = 64, HALF = 128, HTB = HALF * BK * 2  , STAGE_BYTES = 8 * HTB, NXCD = 8, WGM = 4;

__host__ __device__ __forceinline__ int lds_byte(int r, int c) { const int st = (r >> 4) * 2 + (c >> 5), rr = r & 15, cc = c & 31, ob = rr * 64 + cc * 2; return st * 1024 + (ob ^ (((ob >> 9) & 1) << 5)); }
__host__ __device__ __forceinline__ void stage_rc(int b, int& R, int& C) { const int st = b / 1024, sb = b % 1024, swz = sb ^ (((sb >> 9) & 1) << 5); R = (st >> 1) * 16 + swz / 64; C = (st & 1) * 32 + (swz % 64) / 2; }
__host__ __device__ __forceinline__ int perm32(int rho) { const int n = rho >> 4, i = rho & 15; return 8 * (i >> 2) + 4 * n + (i & 3); }

struct Unit { int pm, pn, par; };
struct Gemm { const bf16_t* A; const bf16_t* Bt; int M, N, K; };

struct StaticOrder {
    int nM, nN, nwg, G, c, wgm;
    __host__ __device__ void init(int M, int N, int G_, int c_, int wgm_ = WGM) { nM = M / BM; nN = N / BM; nwg = nM * nN; G = G_; c = c_; wgm = wgm_; }
    __host__ __device__ bool next(int i, Unit& u) const {
        const long L = (long)i * G + c; if (L >= nwg) return false;
        int wgid = (int)L; { const int q = nwg / NXCD, r = nwg % NXCD, xcd = wgid % NXCD, off = wgid / NXCD; wgid = (xcd < r ? xcd * (q + 1) : r * (q + 1) + (xcd - r) * q) + off; }
        const int nig = wgm * nN, gid = wgid / nig, fm = gid * wgm, gsz = (nM - fm) < wgm ? (nM - fm) : wgm;
        u.pm = fm + ((wgid % nig) % gsz); u.pn = (wgid % nig) / gsz; return true;
    }
    __device__ __forceinline__ void a_ready(const Unit&) const {}
    __device__ __forceinline__ void done(const Unit&) const {}
};


typedef unsigned u32x2 __attribute__((ext_vector_type(2)));
constexpr float RMS_EPS = 1e-6f, LOG2E = 1.4426950408889634f, QSCALE = 0.125f * 1.4426950408889634f;
__device__ __forceinline__ unsigned cvt_pk_bf16(float lo, float hi) { unsigned r; asm volatile("v_cvt_pk_bf16_f32 %0, %1, %2" : "=v"(r) : "v"(lo), "v"(hi)); return r; }
__device__ __forceinline__ float fsigmoid(float x) { return __builtin_amdgcn_rcpf(1.0f + __builtin_amdgcn_exp2f(-x * LOG2E)); }
__device__ __forceinline__ float fsilu(float x) { return x * fsigmoid(x); }
__device__ __forceinline__ f32x4 silu4(f32x4 v) { return (f32x4){fsilu(v[0]), fsilu(v[1]), fsilu(v[2]), fsilu(v[3])}; }
__device__ __forceinline__ u32x4 pack8(f32x4 a, f32x4 b) { u32x4 w; w.x = cvt_pk_bf16(a[0], a[1]); w.y = cvt_pk_bf16(a[2], a[3]); w.z = cvt_pk_bf16(b[0], b[1]); w.w = cvt_pk_bf16(b[2], b[3]); return w; }
__device__ __forceinline__ float rowscale(const float* rowsq, const PG8_LAS float* slot, int rl) { return rowsq ? __builtin_amdgcn_rsqf(slot[rl] * (1.0f / 1024.0f) + RMS_EPS) : 1.0f; }
template <int CTRL> __device__ __forceinline__ float dpp_mov0(float x) { return __builtin_bit_cast(float, __builtin_amdgcn_update_dpp(0, __builtin_bit_cast(int, x), CTRL, 0xf, 0xf, true)); }
__device__ __forceinline__ float row_scan16(float x) { x += dpp_mov0<0x111>(x); x += dpp_mov0<0x112>(x); x += dpp_mov0<0x114>(x); x += dpp_mov0<0x118>(x); return x; }

struct EpiSwiGLU {
    static constexpr bool PERM = false, AFTER_DRAIN = false; static constexpr int SCALE = 1;
    bf16_t* H; const float* rowsq; const PG8_LAS float* scl; int ldh;
    __device__ __forceinline__ void operator()(f32x4 (&acc)[2][2][4][2], const Unit& u, int wr, int wc, int fr, int fq) const {
        const int row0 = u.pm * BM + wr * 64 + fr, col0 = u.pn * HALF + wc * 32 + 8 * fq; const PG8_LAS float* slot = scl + u.par * 256 + wr * 64 + fr;
#pragma unroll
        for (int ai = 0; ai < 2; ++ai)
#pragma unroll
            for (int m = 0; m < 4; ++m) { const int row = row0 + ai * HALF + m * 16; const float r = rowscale(rowsq, slot, ai * HALF + m * 16);
                f32x4 hh[2];
#pragma unroll
                for (int n = 0; n < 2; ++n) { const f32x4 g = acc[ai][0][m][n] * r, gu = g * (acc[ai][1][m][n] * r);
#pragma unroll
                    for (int c = 0; c < 4; ++c) hh[n][c] = gu[c] * __builtin_amdgcn_rcpf(1.0f + __builtin_amdgcn_exp2f(-g[c])); }
                *(u32x4*)(H + (unsigned)(row * ldh + col0)) = pack8(hh[0], hh[1]); }
    }
};
__device__ __forceinline__ unsigned dpp_x8_hi(unsigned old, unsigned src) { return (unsigned)__builtin_amdgcn_update_dpp((int)old, (int)src, 0x128, 0xf, 0xc, false); }
__device__ __forceinline__ unsigned dpp_x8_lo(unsigned old, unsigned src) { return (unsigned)__builtin_amdgcn_update_dpp((int)old, (int)src, 0x128, 0xf, 0x3, false); }
__device__ __forceinline__ void xch8(u32x4& p, u32x4& q) { u32x4 a, b;
#pragma unroll
    for (int i = 0; i < 4; ++i) { a[i] = dpp_x8_hi(p[i], q[i]); b[i] = dpp_x8_lo(q[i], p[i]); }
    p = a; q = b; }
__device__ __forceinline__ void xch8(f32x4& p, f32x4& q) { u32x4 a = __builtin_bit_cast(u32x4, p), b = __builtin_bit_cast(u32x4, q); xch8(a, b); p = __builtin_bit_cast(f32x4, a); q = __builtin_bit_cast(f32x4, b); }
__device__ __forceinline__ f32x4 bf4lo(u32x4 w) { return (f32x4){__builtin_bit_cast(float, w.x << 16), __builtin_bit_cast(float, w.x & 0xffff0000u), __builtin_bit_cast(float, w.y << 16), __builtin_bit_cast(float, w.y & 0xffff0000u)}; }
__device__ __forceinline__ f32x4 bf4hi(u32x4 w) { return (f32x4){__builtin_bit_cast(float, w.z << 16), __builtin_bit_cast(float, w.z & 0xffff0000u), __builtin_bit_cast(float, w.w << 16), __builtin_bit_cast(float, w.w & 0xffff0000u)}; }
__device__ __forceinline__ float sq4(f32x4 t) { return (t[0] * t[0] + t[1] * t[1]) + (t[2] * t[2] + t[3] * t[3]); }
template <int MODE> struct EpiRes {
    static constexpr int PERM = 2; static constexpr bool AFTER_DRAIN = false; static constexpr int SCALE = 0;
    const float* base; float* out; bf16_t* xb; float* rowsq; float scale;
    __device__ __forceinline__ void operator()(f32x4 (&acc)[2][2][4][2], const Unit& u, int wr, int wc, int fr, int fq) const {
        const int row0 = u.pm * BM + wr * 64 + fr, rowl = u.pm * BM + wr * 64 + (fr & 7), colw = u.pn * BM + wc * 64 + 8 * fq;
        const unsigned offH = (unsigned)(rowl * 1024 + colw + 32 * (fr >> 3)), offF = (unsigned)(rowl * 1024 + colw + 4 * (fr >> 3));
#define EPR_ROWS(g, h) ((((g) >> 2) * HALF + ((g) & 3) * 16 + 8 * (h)) * 1024)
#define EPR_H(p, g, h) ((p) + EPR_ROWS(g, h))[offH]
#define EPR_F(p, g, bj, h) ((p) + (EPR_ROWS(g, h) + (bj) * 32))[offF]
        if constexpr (MODE == 0) {
            f32x4 rb[4][4];
#pragma unroll
            for (int g = 0; g < 4; ++g)
#pragma unroll
                for (int j = 0; j < 4; ++j) rb[g][j] = *(const f32x4*)&EPR_F(base, g, j >> 1, j & 1);
            __builtin_amdgcn_sched_barrier(0);
#pragma unroll
            for (int g = 0; g < 8; ++g) { const int ai = g >> 2, m = g & 3; f32x4 v[4];
#pragma unroll
                for (int j = 0; j < 4; ++j) v[j] = rb[g & 3][j];
                if (g + 4 < 8) {
#pragma unroll
                    for (int j = 0; j < 4; ++j) rb[g & 3][j] = *(const f32x4*)&EPR_F(base, g + 4, j >> 1, j & 1); }
                xch8(v[0], v[1]); xch8(v[2], v[3]);
#pragma unroll
                for (int j = 0; j < 4; ++j) v[j] = v[j] + acc[ai][j >> 1][m][j & 1] * scale;
                float ss = (sq4(v[0]) + sq4(v[1])) + (sq4(v[2]) + sq4(v[3]));
                u32x4 p0 = pack8(v[0], v[1]), p1 = pack8(v[2], v[3]); xch8(p0, p1);
                *(u32x4*)&EPR_H(xb, g, 0) = p0; *(u32x4*)&EPR_H(xb, g, 1) = p1;
                ss += __shfl_xor(ss, 16); ss += __shfl_xor(ss, 32); if (fq == 0) __hip_atomic_fetch_add(rowsq + row0 + ai * HALF + m * 16, ss, __ATOMIC_RELAXED, __HIP_MEMORY_SCOPE_AGENT);
                __builtin_amdgcn_sched_barrier(0); }
        } else {
            u32x4 rb[8][2];
#pragma unroll
            for (int g = 0; g < 8; ++g)
#pragma unroll
                for (int h = 0; h < 2; ++h) rb[g][h] = *(const u32x4*)&EPR_H(xb, g, h);
            __builtin_amdgcn_sched_barrier(0);
#pragma unroll
            for (int g = 0; g < 8; ++g) { const int ai = g >> 2, m = g & 3;
                u32x4 x0 = rb[g][0], x1 = rb[g][1]; xch8(x0, x1);
                f32x4 v[4] = {bf4lo(x0) + acc[ai][0][m][0] * scale, bf4hi(x0) + acc[ai][0][m][1] * scale, bf4lo(x1) + acc[ai][1][m][0] * scale, bf4hi(x1) + acc[ai][1][m][1] * scale};
                if (MODE == 2) { xch8(v[0], v[1]); xch8(v[2], v[3]);
#pragma unroll
                    for (int j = 0; j < 4; ++j) *(f32x4*)&EPR_F(out, g, j >> 1, j & 1) = v[j]; }
                else { float ss = (sq4(v[0]) + sq4(v[1])) + (sq4(v[2]) + sq4(v[3]));
                    u32x4 p0 = pack8(v[0], v[1]), p1 = pack8(v[2], v[3]); xch8(p0, p1);
                    *(u32x4*)&EPR_H(xb, g, 0) = p0; *(u32x4*)&EPR_H(xb, g, 1) = p1;
                    ss += __shfl_xor(ss, 16); ss += __shfl_xor(ss, 32); if (fq == 0) __hip_atomic_fetch_add(rowsq + row0 + ai * HALF + m * 16, ss, __ATOMIC_RELAXED, __HIP_MEMORY_SCOPE_AGENT); }
                __builtin_amdgcn_sched_barrier(0); }
        }
#undef EPR_ROWS
#undef EPR_H
#undef EPR_F
    }
};
struct EpiWin {
    static constexpr bool PERM = false, AFTER_DRAIN = false; static constexpr int SCALE = 1;
    bf16_t *Q, *K, *QT, *KT, *G; float *DM, *DE; const float *rowsq, *gq, *gk, *lb; const PG8_LAS float* scl;
    __device__ __forceinline__ void operator()(f32x4 (&acc)[2][2][4][2], const Unit& u, int wr, int wc, int fr, int fq) const {
        const int row0 = u.pm * BM + wr * 64 + fr, t = u.pn; const PG8_LAS float* slot = scl + u.par * 256 + wr * 64 + fr;
        if (t < 4) {
            const bool isq = t < 2; const int head = 4 * (t & 1) + wc; const float* gp = isq ? gq : gk; const float gs = isq ? QSCALE : 1.0f;
            f32x4 gv[2][2];
#pragma unroll
            for (int bj = 0; bj < 2; ++bj)
#pragma unroll
                for (int n = 0; n < 2; ++n) gv[bj][n] = *(const f32x4*)(gp + 32 * bj + 8 * fq + 4 * n) * gs;
            bf16_t* dst = (isq ? Q : K) + (head * 32 * 8) * 512 + (fq >> 1) * 512 + (fq & 1) * 256;
#pragma unroll
            for (int ai = 0; ai < 2; ++ai)
#pragma unroll
                for (int m = 0; m < 4; ++m) { const int row = row0 + ai * HALF + m * 16; const float r = rowscale(rowsq, slot, ai * HALF + m * 16); float ss = 0.f;
#pragma unroll
                    for (int bj = 0; bj < 2; ++bj)
#pragma unroll
                        for (int n = 0; n < 2; ++n) { const f32x4 v = acc[ai][bj][m][n] * r; acc[ai][bj][m][n] = v; ss += (v[0] * v[0] + v[1] * v[1]) + (v[2] * v[2] + v[3] * v[3]); }
                    ss += __shfl_xor(ss, 16); ss += __shfl_xor(ss, 32);
                    const float inv = __builtin_amdgcn_rsqf(ss * (1.0f / 64.0f) + RMS_EPS);
                    const int tk = row & 2047, t5 = tk & 31, r32 = isq ? t5 : ((t5 & 0x13) | ((t5 & 4) << 1) | ((t5 & 8) >> 1));
                    const unsigned o = (unsigned)((((row >> 11) * 8 * 32 + (tk >> 6)) * 2 + ((tk >> 5) & 1)) * 4 * 512 + r32 * 8);
#pragma unroll
                    for (int bj = 0; bj < 2; ++bj) *(u32x4*)(dst + o + (unsigned)(2 * bj * 512)) = pack8(acc[ai][bj][m][0] * inv * gv[bj][0], acc[ai][bj][m][1] * inv * gv[bj][1]); }
        } else if (t < 8) {
            const int hh = t - 4, kbase = hh * 128 + wc * 32 + 8 * fq;
            float lbv[8]; { const f32x4 l0 = *(const f32x4*)(lb + kbase), l1 = *(const f32x4*)(lb + kbase + 4);
#pragma unroll
                for (int c = 0; c < 4; ++c) { lbv[c] = l0[c]; lbv[4 + c] = l1[c]; } }
            const int lane = fq * 16 + fr;
#pragma unroll
            for (int ai = 0; ai < 2; ++ai) { u32x2 qkeep[4], kkeep[4];
#pragma unroll
                for (int n = 0; n < 2; ++n) {
                    float omf[4][4], carry[4], bmid[4];
#pragma unroll
                    for (int m = 0; m < 4; ++m) { const float r = rowscale(rowsq, slot, ai * HALF + m * 16);
#pragma unroll
                        for (int c = 0; c < 4; ++c) { const int e = 4 * n + c; const float a = acc[ai][0][m][n][c] * r, b = acc[ai][1][m][n][c] * r;
                            const float sg = fsigmoid(b), f = lbv[e] + (1.0f - lbv[e]) * sg; omf[m][c] = (1.0f - lbv[e]) * (1.0f - sg);
                            acc[ai][1][m][n][c] = __builtin_amdgcn_logf(f);
                            acc[ai][0][m][n][c] = fsilu(a); } }
#pragma unroll
                    for (int c = 0; c < 4; ++c) { carry[c] = 0.f; bmid[c] = 0.f; }
#pragma unroll
                    for (int m = 0; m < 4; ++m)
#pragma unroll
                        for (int c = 0; c < 4; ++c) { float x = row_scan16(acc[ai][1][m][n][c]) + carry[c]; acc[ai][1][m][n][c] = x;
                            carry[c] = __shfl(x, lane | 15); if (m == 1) bmid[c] = carry[c]; }
#pragma unroll
                    for (int m = 0; m < 4; ++m) { const int row = row0 + ai * HALF + m * 16; f32x4 qv, kv;
#pragma unroll
                        for (int c = 0; c < 4; ++c) { const float d = acc[ai][1][m][n][c] - bmid[c];
                            qv[c] = acc[ai][0][m][n][c] * __builtin_amdgcn_exp2f(d); kv[c] = omf[m][c] * __builtin_amdgcn_exp2f(-d); }
                        const unsigned o = (unsigned)(row * 512 + kbase);
                        u32x2 wq, wk; wq.x = cvt_pk_bf16(qv[0], qv[1]); wq.y = cvt_pk_bf16(qv[2], qv[3]); wk.x = cvt_pk_bf16(kv[0], kv[1]); wk.y = cvt_pk_bf16(kv[2], kv[3]);
                        if (n == 0) { qkeep[m] = wq; kkeep[m] = wk; }
                        else { *(u32x4*)(QT + o) = (u32x4){qkeep[m].x, qkeep[m].y, wq.x, wq.y}; *(u32x4*)(KT + o) = (u32x4){kkeep[m].x, kkeep[m].y, wk.x, wk.y}; } }
                    if (fr == 0) { const int chunk = (u.pm * BM + ai * HALF + wr * 64) >> 6; f32x4 a0, e0;
#pragma unroll
                        for (int c = 0; c < 4; ++c) { a0[c] = __builtin_amdgcn_exp2f(bmid[c]); e0[c] = __builtin_amdgcn_exp2f(carry[c] - bmid[c]); }
                        *(f32x4*)(DM + (unsigned)(chunk * 512 + kbase + 4 * n)) = a0; *(f32x4*)(DE + (unsigned)(chunk * 512 + kbase + 4 * n)) = e0; }
                    asm volatile("" ::: "memory");
                } }
        } else {
            bf16_t* dst = G + (t - 8) * 256 + wc * 32 + 8 * fq;
#pragma unroll
            for (int ai = 0; ai < 2; ++ai)
#pragma unroll
                for (int m = 0; m < 4; ++m) { const int row = row0 + ai * HALF + m * 16; const float r = rowscale(rowsq, slot, ai * HALF + m * 16);
#pragma unroll
                    for (int bj = 0; bj < 2; ++bj) *(u32x4*)(dst + (unsigned)(row * 512 + bj * HALF)) = pack8(silu4(acc[ai][bj][m][0] * r), silu4(acc[ai][bj][m][1] * r)); }
        }
    }
};
struct EpiVT {
    static constexpr bool PERM = true, AFTER_DRAIN = false; static constexpr int SCALE = 2;
    bf16_t *VT, *VHT; const float* rowsq; const PG8_LAS float* scl;
    __device__ __forceinline__ void operator()(f32x4 (&acc)[2][2][4][2], const Unit& u, int wr, int wc, int fr, int fq) const {
        const int ch0 = (u.pm & 1) * BM + wr * 64 + fr, tok0 = u.pn * BM + wc * 32 + 8 * fq, b = tok0 >> 11, s0 = tok0 & 2047;
        f32x4 rs[2][2];
#pragma unroll
        for (int bj = 0; bj < 2; ++bj)
#pragma unroll
            for (int n = 0; n < 2; ++n) { const f32x4 q = *(const PG8_LAS f32x4*)(scl + u.par * 256 + wc * 32 + 8 * fq + bj * HALF + 4 * n);
#pragma unroll
                for (int c = 0; c < 4; ++c) rs[bj][n][c] = __builtin_amdgcn_rsqf(q[c] * (1.0f / 1024.0f) + RMS_EPS); }
        if (u.pm < 2) {
#pragma unroll
            for (int ai = 0; ai < 2; ++ai)
#pragma unroll
                for (int m = 0; m < 4; ++m) { const int ch = ch0 + ai * HALF + m * 16;
#pragma unroll
                    for (int bj = 0; bj < 2; ++bj) { const int sk = s0 + bj * HALF;
                        const unsigned o = (unsigned)((((((b * 8 + (ch >> 6)) * 32 + (sk >> 6)) * 2 + ((ch >> 5) & 1)) * 4 + ((sk >> 4) & 3)) * 64 + ((sk >> 3) & 1) * 32 + (ch & 31)) * 8);
                        *(u32x4*)(VT + o) = pack8(acc[ai][bj][m][0] * rs[bj][0], acc[ai][bj][m][1] * rs[bj][1]); } }
        } else {
            bf16_t* dst = VHT + (size_t)b * 512 * 2048 + s0;
#pragma unroll
            for (int ai = 0; ai < 2; ++ai)
#pragma unroll
                for (int m = 0; m < 4; ++m) { const int ch = ch0 + ai * HALF + m * 16;
#pragma unroll
                    for (int bj = 0; bj < 2; ++bj) *(u32x4*)(dst + (unsigned)(ch * 2048 + bj * HALF)) = pack8(acc[ai][bj][m][0] * rs[bj][0], acc[ai][bj][m][1] * rs[bj][1]); }
        }
    }
};

template <class Epi, class Sched, bool ALIGN_EPI = false, bool SP2 = false>
__device__ __forceinline__ void gemm_phase(PG8_LAS unsigned char* lds, const Gemm g, const Sched& S, const Epi& E) {
    const int tid = threadIdx.x, wid = __builtin_amdgcn_readfirstlane(tid >> 6), lane = tid & 63, wr = wid >> 2, wc = wid & 3, fr = lane & 15, fq = lane >> 4;
    const int K = g.K, nt = K / BK;
    unsigned voffA[2], voffB[2];
#pragma unroll
    for (int i = 0; i < 2; ++i) { int R, C; stage_rc(tid * 16 + i * 8192, R, C); const int Rb = (int)Epi::PERM == 2 ? ((R >> 5) * 64 + perm32(R & 31)) : Epi::PERM ? ((R & ~31) + perm32(R & 31)) : R;
        voffA[i] = (unsigned)(R * K + C) * 2u; voffB[i] = (unsigned)(Rb * K + C) * 2u; }
    const size_t kstep = (size_t)(BK * 2);
    const size_t hstep = (size_t)HALF * K * 2;
    const size_t hstepB = (int)Epi::PERM == 2 ? (size_t)32 * K * 2 : hstep;
    const size_t tstep = 2 * hstep;
    const unsigned ldsw = (unsigned)wid * 1024u;
    const int aoff = lds_byte(wr * 64 + fr, fq * 8), boff = lds_byte(wc * 32 + fr, fq * 8);
#define PG8_SA(b, h) (((b) * 2 + (h)) * HTB)
#define PG8_SB(b, h) ((4 + (b) * 2 + (h)) * HTB)
#define PG8_STAGE(bufoff, gbase, voff) do { _Pragma("unroll") for (int _i = 0; _i < 2; ++_i) \
        __builtin_amdgcn_global_load_lds((const unsigned*)((const char*)(gbase) + (voff)[_i]), (PG8_LAS unsigned*)(lds + (bufoff) + ldsw + _i * 8192), 16, 0, 0); } while (0)
#define PG8_LDA(dst, b, h) do { _Pragma("unroll") for (int m = 0; m < 4; ++m) _Pragma("unroll") for (int k = 0; k < 2; ++k) dst[m][k] = *(const PG8_LAS bf16x8*)(lds + PG8_SA(b, h) + aoff + m * 2048 + k * 1024); } while (0)
#define PG8_LDB(dst, b, h) do { _Pragma("unroll") for (int n = 0; n < 2; ++n) _Pragma("unroll") for (int k = 0; k < 2; ++k) dst[n][k] = *(const PG8_LAS bf16x8*)(lds + PG8_SB(b, h) + boff + n * 2048 + k * 1024); } while (0)
#define PG8_MMA(ai, bj, At, Bt) do { __builtin_amdgcn_s_setprio(1); _Pragma("unroll") for (int m = 0; m < 4; ++m) _Pragma("unroll") for (int n = 0; n < 2; ++n) _Pragma("unroll") for (int k = 0; k < 2; ++k) \
        acc[ai][bj][m][n] = __builtin_amdgcn_mfma_f32_16x16x32_bf16(Bt[n][k], At[m][k], acc[ai][bj][m][n], 0, 0, 0); __builtin_amdgcn_s_setprio(0); } while (0)
#define PG8_WAIT_V(n) asm volatile("s_waitcnt vmcnt(" #n ")" ::: "memory")
#define PG8_WAIT_L(n) asm volatile("s_waitcnt lgkmcnt(" #n ")" ::: "memory")
#define PG8_BAR __builtin_amdgcn_s_barrier()
#define PG8_SCHED __builtin_amdgcn_sched_barrier(0)
    Unit cur, nxt; int ui = 0;
    if (!S.next(0, cur)) return;
    cur.par = 0;
#define PG8_SCALE_DMA(u_) do { if (Epi::SCALE != 0 && wid == 0 && E.rowsq != nullptr) \
        __builtin_amdgcn_global_load_lds((const unsigned*)(E.rowsq + ((Epi::SCALE == 1 ? (u_).pm : (u_).pn) * BM + lane * 4)), (PG8_LAS unsigned*)(lds + STAGE_BYTES + (u_).par * 1024), 16, 0, 0); } while (0)
    PG8_SCALE_DMA(cur);
    f32x4 acc[2][2][4][2];
#pragma unroll
    for (int a = 0; a < 2; ++a)
#pragma unroll
        for (int b = 0; b < 2; ++b)
#pragma unroll
            for (int m = 0; m < 4; ++m)
#pragma unroll
                for (int n = 0; n < 2; ++n) acc[a][b][m][n] = (f32x4){0.f, 0.f, 0.f, 0.f};
    bf16x8 At[4][2], B0[2][2], B1[2][2];
    const char* cA = (const char*)g.A + (size_t)cur.pm * tstep; const char* cB = (const char*)g.Bt + (size_t)cur.pn * tstep;
    S.a_ready(cur);
    if constexpr (SP2) {
        PG8_STAGE(PG8_SB(0, 0), cB, voffB); PG8_STAGE(PG8_SB(0, 1), cB + hstepB, voffB); PG8_STAGE(PG8_SA(0, 0), cA, voffA); PG8_STAGE(PG8_SA(0, 1), cA + hstep, voffA);
        if (wr == 1) PG8_BAR;
        PG8_WAIT_V(2); PG8_BAR;
        PG8_STAGE(PG8_SB(1, 0), cB + kstep, voffB); PG8_STAGE(PG8_SA(1, 0), cA + kstep, voffA); PG8_STAGE(PG8_SB(1, 1), cB + hstepB + kstep, voffB);
        PG8_WAIT_V(6); PG8_BAR;
    } else {
        PG8_STAGE(PG8_SB(0, 0), cB, voffB); PG8_STAGE(PG8_SA(0, 0), cA, voffA); PG8_STAGE(PG8_SB(0, 1), cB + hstepB, voffB); PG8_STAGE(PG8_SA(0, 1), cA + hstep, voffA);
        if (wr == 1) PG8_BAR;
        PG8_WAIT_V(4); PG8_BAR;
        PG8_STAGE(PG8_SB(1, 0), cB + kstep, voffB); PG8_STAGE(PG8_SA(1, 0), cA + kstep, voffA); PG8_STAGE(PG8_SB(1, 1), cB + hstepB + kstep, voffB);
        PG8_WAIT_V(6); PG8_BAR;
    }
    for (;;) {
        const bool has_next = S.next(ui + 1, nxt); nxt.par = (ui + 1) & 1;
        const char* nA = has_next ? (const char*)g.A + (size_t)nxt.pm * tstep : cA; const char* nB = has_next ? (const char*)g.Bt + (size_t)nxt.pn * tstep : cB;
        for (int t = 0; t < nt; t += 2) {
            const bool last = (t == nt - 2);
            const char* a1 = cA + (size_t)(t + 1) * kstep;
            const char* a2 = last ? nA : cA + (size_t)(t + 2) * kstep; const char* b2 = last ? nB : cB + (size_t)(t + 2) * kstep;
            const char* a3 = a2 + kstep; const char* b3 = b2 + kstep;
            if (last && has_next) { S.a_ready(nxt); PG8_SCALE_DMA(nxt); }
            if constexpr (SP2) {
            PG8_LDB(B0, 0, 0); PG8_LDB(B1, 0, 1); PG8_SCHED; PG8_LDA(At, 0, 0); PG8_STAGE(PG8_SA(1, 1), a1 + hstep, voffA);
            PG8_WAIT_V(8); PG8_WAIT_L(0); PG8_BAR; PG8_MMA(0, 0, At, B0); PG8_MMA(0, 1, At, B1); PG8_BAR; PG8_SCHED;
            PG8_LDA(At, 0, 1); PG8_STAGE(PG8_SB(0, 0), b2, voffB); PG8_STAGE(PG8_SB(0, 1), b2 + hstepB, voffB); PG8_STAGE(PG8_SA(0, 0), a2, voffA);
            PG8_WAIT_V(8); PG8_WAIT_L(0); PG8_BAR; PG8_MMA(1, 0, At, B0); PG8_MMA(1, 1, At, B1); PG8_BAR; PG8_SCHED;
            PG8_LDB(B0, 1, 0); PG8_LDB(B1, 1, 1); PG8_SCHED; PG8_LDA(At, 1, 0); PG8_STAGE(PG8_SA(0, 1), a2 + hstep, voffA);
            PG8_WAIT_V(8); PG8_WAIT_L(0); PG8_BAR; PG8_MMA(0, 0, At, B0); PG8_MMA(0, 1, At, B1); PG8_BAR; PG8_SCHED;
            PG8_LDA(At, 1, 1); PG8_STAGE(PG8_SB(1, 0), b3, voffB); PG8_STAGE(PG8_SB(1, 1), b3 + hstepB, voffB); PG8_STAGE(PG8_SA(1, 0), a3, voffA);
            PG8_WAIT_V(8); PG8_WAIT_L(0); PG8_BAR; PG8_MMA(1, 0, At, B0); PG8_MMA(1, 1, At, B1); PG8_BAR; PG8_SCHED;
            } else {
            PG8_LDB(B0, 0, 0); PG8_SCHED; PG8_LDA(At, 0, 0); PG8_STAGE(PG8_SA(1, 1), a1 + hstep, voffA);
            PG8_WAIT_L(8); PG8_BAR; PG8_WAIT_L(0); PG8_MMA(0, 0, At, B0); PG8_BAR; PG8_SCHED;
            PG8_LDB(B1, 0, 1); PG8_STAGE(PG8_SB(0, 0), b2, voffB);
            PG8_BAR; PG8_WAIT_L(0); PG8_MMA(0, 1, At, B1); PG8_BAR;
            PG8_LDA(At, 0, 1); PG8_STAGE(PG8_SA(0, 0), a2, voffA);
            PG8_BAR; PG8_WAIT_L(0); PG8_MMA(1, 0, At, B0); PG8_BAR; PG8_SCHED;
            PG8_STAGE(PG8_SB(0, 1), b2 + hstepB, voffB);
            PG8_WAIT_V(6); PG8_BAR; PG8_MMA(1, 1, At, B1); PG8_BAR;
            PG8_LDB(B0, 1, 0); PG8_SCHED; PG8_LDA(At, 1, 0); PG8_STAGE(PG8_SA(0, 1), a2 + hstep, voffA);
            PG8_WAIT_L(8); PG8_BAR; PG8_WAIT_L(0); PG8_MMA(0, 0, At, B0); PG8_BAR; PG8_SCHED;
            PG8_LDB(B1, 1, 1); PG8_STAGE(PG8_SB(1, 0), b3, voffB);
            PG8_BAR; PG8_WAIT_L(0); PG8_MMA(0, 1, At, B1); PG8_BAR;
            PG8_LDA(At, 1, 1); PG8_STAGE(PG8_SA(1, 0), a3, voffA);
            PG8_BAR; PG8_WAIT_L(0); PG8_MMA(1, 0, At, B0); PG8_BAR; PG8_SCHED;
            PG8_STAGE(PG8_SB(1, 1), b3 + hstepB, voffB);
            PG8_WAIT_V(6); PG8_BAR; PG8_MMA(1, 1, At, B1); PG8_BAR;
            }
        }
        if constexpr (ALIGN_EPI) { if (wr == 0) PG8_BAR; }
        if constexpr (!Epi::AFTER_DRAIN) { E(acc, cur, wr, wc, fr, fq); S.done(cur); }
        if (!has_next) break;
#pragma unroll
        for (int a = 0; a < 2; ++a)
#pragma unroll
            for (int b = 0; b < 2; ++b)
#pragma unroll
                for (int m = 0; m < 4; ++m)
#pragma unroll
                    for (int n = 0; n < 2; ++n) acc[a][b][m][n] = (f32x4){0.f, 0.f, 0.f, 0.f};
        cur = nxt; cA = nA; cB = nB; ++ui;
        if constexpr (ALIGN_EPI) { if (wr == 1) PG8_BAR; }
    }
    PG8_WAIT_V(0);
    if constexpr (!ALIGN_EPI) { if (wr == 0) PG8_BAR; }
    PG8_BAR;
    if constexpr (Epi::AFTER_DRAIN) { E.fused(acc, cur, wr, wc, fr, fq, lds, wid, lane); S.done(cur); }
#undef PG8_SCALE_DMA
#undef PG8_SA
#undef PG8_SB
#undef PG8_STAGE
#undef PG8_LDA
#undef PG8_LDB
#undef PG8_MMA
#undef PG8_WAIT_V
#undef PG8_WAIT_L
#undef PG8_BAR
#undef PG8_SCHED
}
}

constexpr int NWAVES = 8;
#ifndef MK_N_LAUNCHES
#define MK_N_LAUNCHES 1
#endif
constexpr int PER_PHASE = 8;
constexpr int N_LAUNCHES = MK_N_LAUNCHES;
constexpr int BATCH = 16, SEQ = 2048, D = 1024, M = BATCH * SEQ, FF = 2816, NPROJ = 3584;
constexpr int AW = 512, HW = 512, NCHUNK = SEQ / 64;
constexpr float RMS_EPS = 1e-6f, LOG2E = 1.4426950408889634f;
#ifndef WGM_GU
#define WGM_GU 4
#endif
#ifndef WGM_DOWN
#define WGM_DOWN 4
#endif
#ifndef WGM_OUT
#define WGM_OUT 4
#endif
#ifndef WGM_IN
#define WGM_IN 4
#endif
#ifndef WGM_INT
#define WGM_INT 4
#endif

constexpr size_t MiB = 1u << 20;
constexpr size_t WS_CTL = 0, CTL_ZERO_BYTES = 1 * MiB;
constexpr size_t WS_RS1 = 256 * 1024, WS_RS2 = 384 * 1024;
constexpr size_t WS_LB = 1 * MiB, WS_DM = 2 * MiB, WS_DE = 3 * MiB;
constexpr size_t WS_WGU1 = 4 * MiB, WS_WD1 = 15 * MiB, WS_WIN = 21 * MiB, WS_WINT = 26 * MiB, WS_WOUT = 28 * MiB, WS_WGU2 = 30 * MiB, WS_WD2 = 41 * MiB;
constexpr size_t WS_XB = 48 * MiB;
constexpr size_t WS_MIX = 112 * MiB;
constexpr size_t WS_HID = 176 * MiB;
constexpr size_t WS_Q = 176 * MiB, WS_K = 208 * MiB, WS_VT = 240 * MiB, WS_QT = 272 * MiB, WS_KT = 304 * MiB, WS_VHT = 336 * MiB, WS_G = 368 * MiB, WS_END = 400 * MiB;
static_assert(WS_WGU1 + (size_t)2 * FF * D * 2 <= WS_WD1 && WS_WD1 + (size_t)D * FF * 2 <= WS_WIN && WS_WIN + (size_t)2560 * D * 2 <= WS_WINT && WS_WGU2 + (size_t)2 * FF * D * 2 <= WS_WD2 && WS_WD2 + (size_t)D * FF * 2 <= WS_XB, "weight map");
static_assert(WS_HID + (size_t)M * FF * 2 <= WS_END && WS_XB + (size_t)M * D * 2 <= WS_MIX && WS_MIX + (size_t)M * D * 2 <= WS_HID, "activation map");
constexpr int CW_TMO = 0, CW_CODE = 1;
constexpr int CW_BAR = 4096;
constexpr int CW_WQ = 16384;

constexpr int RING_OFF = 0, RING_BYTES = 131072;
constexpr int LDS_BYTES = 163840;
constexpr int LDSCTL_OFF = LDS_BYTES - 1024, MISC_OFF = LDSCTL_OFF + 320;
static_assert(MISC_OFF + 128 <= LDS_BYTES, "LDS map");

#define GAS __attribute__((address_space(1)))
#define LAS __attribute__((address_space(3)))
typedef unsigned short bf16;
typedef unsigned v4u __attribute__((ext_vector_type(4)));
typedef float f32x4 __attribute__((ext_vector_type(4)));
typedef short bf16x8 __attribute__((ext_vector_type(8)));
typedef GAS unsigned gu32;
#define RLX_AGENT __ATOMIC_RELAXED, __HIP_MEMORY_SCOPE_AGENT
#define LDS_WAIT() asm volatile("s_waitcnt lgkmcnt(0)" ::: "memory")
#define VM_WAIT() asm volatile("s_waitcnt vmcnt(0)" ::: "memory")
__device__ __forceinline__ unsigned f2bf(float f) { unsigned u = __builtin_bit_cast(unsigned, f); return (u + 0x7fffu + ((u >> 16) & 1u)) >> 16; }
__device__ __forceinline__ unsigned pk2(float lo, float hi) { return f2bf(lo) | (f2bf(hi) << 16); }
__device__ __forceinline__ float bf2f(unsigned short h) { return __builtin_bit_cast(float, (unsigned)h << 16); }
__device__ __forceinline__ float bflo(unsigned w) { return __builtin_bit_cast(float, w << 16); }
__device__ __forceinline__ float bfhi(unsigned w) { return __builtin_bit_cast(float, w & 0xffff0000u); }

#define XB_TMO      128
#define XB_XCNT(j)  (256  + 64 * (j))
#define XB_XSUB(j)  (1280 + 64 * (j))
#define XB_XGEN(j)  (2304 + 64 * (j))
#define XB_TOP      3328
#define XB_TOPGEN   3392
#define XCD_BAR_WORDS 3456
#define XB_SPIN_CAP (1u << 18)

__device__ __forceinline__ unsigned xb_ld(unsigned* p)              { return __hip_atomic_load(p, __ATOMIC_RELAXED, __HIP_MEMORY_SCOPE_AGENT); }
__device__ __forceinline__ unsigned xb_add(unsigned* p, unsigned v) { return __hip_atomic_fetch_add(p, v, __ATOMIC_RELAXED, __HIP_MEMORY_SCOPE_AGENT); }
__device__ __forceinline__ unsigned xb_xcc_id() { return (unsigned)__builtin_amdgcn_s_getreg((3 << 11) | 20) & 0xFu; }
#define XB_SPIN(cond, bar) do { unsigned _sp = 0; while (cond) { __builtin_amdgcn_s_sleep(1); \
    if ((++_sp & 255u) == 0u) { if (xb_ld(&(bar)[XB_TMO])) break; if (_sp > XB_SPIN_CAP) { atomicAdd(&(bar)[XB_TMO], 1u); break; } } } } while (0)

struct XcdBarrier {
    unsigned* bar; unsigned x;
    volatile LAS unsigned* st;
};

__device__ __forceinline__ XcdBarrier xcd_barrier_post(unsigned* bar, volatile LAS unsigned* st) {
    XcdBarrier b; b.bar = bar; b.x = xb_xcc_id(); b.st = st;
    if (threadIdx.x == 0) (void)xb_add(&bar[XB_XCNT(b.x)], 1u);
    return b;
}
__device__ __forceinline__ void xcd_barrier_complete(unsigned* bar, unsigned x, unsigned& nloc, unsigned& nx) {
    const unsigned G = gridDim.x * gridDim.y * gridDim.z;
    unsigned sum, cnt, mine, sp = 0u;
    for (;;) {
        sum = 0u; cnt = 0u; mine = 0u;
#pragma unroll
        for (unsigned j = 0; j < 16; ++j) { const unsigned c = xb_ld(&bar[XB_XCNT(j)]); sum += c; cnt += (c > 0u) ? 1u : 0u; mine = (j == x) ? c : mine; }
        if (sum == G) break;
        __builtin_amdgcn_s_sleep(1);
        if ((++sp & 255u) == 0u) { if (xb_ld(&bar[XB_TMO])) break; if (sp > XB_SPIN_CAP) { atomicAdd(&bar[XB_TMO], 1u); break; } }
    }
    nloc = mine > 0u ? mine : 1u; nx = cnt > 0u ? cnt : 1u;
}

__device__ __forceinline__ void xcd_barrier(const XcdBarrier& b) {
    asm volatile("s_waitcnt vmcnt(0)" ::: "memory");
    __syncthreads();
    if (threadIdx.x == 0) {
        unsigned* bar = b.bar;
        __builtin_amdgcn_s_waitcnt(0);
        unsigned nloc = b.st[0], nx = b.st[1];
        if (nloc == 0u) { xcd_barrier_complete(bar, b.x, nloc, nx); b.st[0] = nloc; b.st[1] = nx; }
        const unsigned old = xb_add(&bar[XB_XSUB(b.x)], 1u);
        const unsigned gen = old / nloc;
        if (old + 1u == (gen + 1u) * nloc) {
            __builtin_amdgcn_fence(__ATOMIC_RELEASE, "agent");
            asm volatile("s_waitcnt vmcnt(0)" ::: "memory");
            const unsigned og = xb_add(&bar[XB_TOP], 1u);
            const unsigned tg = og / nx;
            if (og + 1u == (tg + 1u) * nx) xb_add(&bar[XB_TOPGEN], 1u);
            else XB_SPIN(xb_ld(&bar[XB_TOPGEN]) == tg, bar);
            __builtin_amdgcn_fence(__ATOMIC_ACQUIRE, "agent");
            xb_add(&bar[XB_XGEN(b.x)], 1u);
            asm volatile("s_waitcnt vmcnt(0)" ::: "memory");
        } else {
            XB_SPIN(xb_ld(&bar[XB_XGEN(b.x)]) == gen, bar);
            __builtin_amdgcn_fence(__ATOMIC_ACQUIRE, "agent");
            asm volatile("s_waitcnt vmcnt(0)" ::: "memory");
        }
    }
    __syncthreads();
}

struct Frame {
    LAS unsigned char* lds;
    volatile LAS unsigned* MISC;
    gu32* ctl;
    int tid, lane, wave, G;
    const float* in[17]; float* out; unsigned char* ws;
};
__device__ __forceinline__ float wave_sum(float v) {
#pragma unroll
    for (int o = 1; o < 64; o <<= 1) v += __shfl_xor(v, o);
    return v;
}
__device__ __forceinline__ int srccol(int kind, int R, int& sel) {
    sel = 0;
    if (kind == 0) return R;
    const int t = R >> 8, p = R & 255, bj = p >> 7, q = p & 127, wc = q >> 5, pr = pg8::perm32(q & 31);
    if (kind == 1) { sel = bj; return 128 * t + 32 * wc + pr; }
    if (kind == 2) {
        if (t < 2) return 64 * (4 * t + wc) + 32 * bj + pr;
        if (t < 4) return 512 + 64 * (4 * (t - 2) + wc) + 32 * bj + pr;
        if (t < 8) return (bj ? 2048 : 1536) + 128 * (t - 4) + 32 * wc + pr;
        return 3072 + 256 * (t - 8) + 128 * bj + 32 * wc + pr;
    }
    return R < 512 ? 1024 + R : 2560 + (R - 512);
}
struct P0Blk { f32x4 v[8]; };
__device__ __forceinline__ void p0_load(P0Blk& t, const float* W0, const float* W1, int N, int kind, int item, int nblk, int lane) {
    const int kb = item / nblk, nb = item % nblk, k0 = 64 * kb + 8 * (lane >> 3), R = 32 * nb + 4 * (lane & 7);
    int sel; const int c = srccol(kind, R, sel);
    const float* W = (sel ? W1 : W0) + (size_t)k0 * N + c;
#pragma unroll
    for (int i = 0; i < 8; ++i) t.v[i] = *(const f32x4*)(W + (size_t)i * N);
}
__device__ __forceinline__ void p0_store(const P0Blk& t, int K, bf16* WT, const float* gain, int kind, int item, int nblk, int lane) {
    const int kb = item / nblk, nb = item % nblk, k0 = 64 * kb + 8 * (lane >> 3), R = 32 * nb + 4 * (lane & 7);
    float gk[8];
    const float ws = kind == 1 ? (((R >> 7) & 1) ? 1.0f / LOG2E : LOG2E) : 1.0f;
#pragma unroll
    for (int i = 0; i < 8; ++i) gk[i] = ws;
    if (gain) { const f32x4 g0 = *(const f32x4*)(gain + k0), g1 = *(const f32x4*)(gain + k0 + 4);
#pragma unroll
        for (int i = 0; i < 4; ++i) { gk[i] = g0[i] * ws; gk[4 + i] = g1[i] * ws; } }
#pragma unroll
    for (int j = 0; j < 4; ++j) { v4u o; o.x = pk2(t.v[0][j] * gk[0], t.v[1][j] * gk[1]); o.y = pk2(t.v[2][j] * gk[2], t.v[3][j] * gk[3]); o.z = pk2(t.v[4][j] * gk[4], t.v[5][j] * gk[5]); o.w = pk2(t.v[6][j] * gk[6], t.v[7][j] * gk[7]);
        *(GAS v4u*)(WT + (size_t)(R + j) * K + k0) = o; }
}
struct P0Job { const float* W0; const float* W1; const float* gain; bf16* WT; int K, N, kind, nblk, item; };
constexpr int P0_I_GU = (D / 64) * (2 * FF / 32), P0_I_D = (FF / 64) * (D / 32), P0_I_IN = (D / 64) * (2560 / 32), P0_I_INT = (D / 64) * (1024 / 32), P0_I_O = (D / 64) * (D / 32);
constexpr int P0_N0 = P0_I_GU + P0_I_D + P0_I_IN + P0_I_INT, P0_N1 = P0_I_GU + P0_I_D + P0_I_O;
__device__ __forceinline__ P0Job p0_job(Frame& F, int set, int it) {
    int r = it;
    if (set == 0) {
        if (r < P0_I_GU) return P0Job{F.in[2], F.in[3], nullptr, (bf16*)(F.ws + WS_WGU1), D, FF, 1, 2 * FF / 32, r}; r -= P0_I_GU;
        if (r < P0_I_D) return P0Job{F.in[4], F.in[4], nullptr, (bf16*)(F.ws + WS_WD1), FF, D, 0, D / 32, r}; r -= P0_I_D;
        if (r < P0_I_IN) return P0Job{F.in[6], F.in[6], F.in[5], (bf16*)(F.ws + WS_WIN), D, NPROJ, 2, 2560 / 32, r}; r -= P0_I_IN;
        return P0Job{F.in[6], F.in[6], F.in[5], (bf16*)(F.ws + WS_WINT), D, NPROJ, 3, 1024 / 32, r};
    }
    if (r < P0_I_GU) return P0Job{F.in[14], F.in[15], F.in[13], (bf16*)(F.ws + WS_WGU2), D, FF, 1, 2 * FF / 32, r}; r -= P0_I_GU;
    if (r < P0_I_D) return P0Job{F.in[16], F.in[16], nullptr, (bf16*)(F.ws + WS_WD2), FF, D, 0, D / 32, r}; r -= P0_I_D;
    return P0Job{F.in[12], F.in[12], nullptr, (bf16*)(F.ws + WS_WOUT), D, D, 0, D / 32, r};
}
__device__ __forceinline__ void p0_weights(Frame& F, int set, int gw, int NGW) {
    const int NIT = set == 0 ? P0_N0 : P0_N1;
    int it = gw;
    if (it < NIT) {
        P0Job j0 = p0_job(F, set, it); P0Blk t0; p0_load(t0, j0.W0, j0.W1, j0.N, j0.kind, j0.item, j0.nblk, F.lane);
        for (;;) {
            const int it1 = it + NGW; const bool more = it1 < NIT;
            P0Job j1 = j0; P0Blk t1;
            if (more) { j1 = p0_job(F, set, it1); p0_load(t1, j1.W0, j1.W1, j1.N, j1.kind, j1.item, j1.nblk, F.lane); }
            p0_store(t0, j0.K, j0.WT, j0.gain, j0.kind, j0.item, j0.nblk, F.lane);
            if (!more) break;
            it = it1; j0 = j1;
#pragma unroll
            for (int i = 0; i < 8; ++i) t0.v[i] = t1.v[i];
        }
    }
}
__device__ __forceinline__ void rms_rows4_to_bf16(const float* x, const float* g, bf16* o, int lane) {
    f32x4 v[4][4]; float s[4];
#pragma unroll
    for (int r = 0; r < 4; ++r)
#pragma unroll
        for (int j = 0; j < 4; ++j) v[r][j] = *((const GAS f32x4*)(x + (size_t)r * D) + lane + 64 * j);
#pragma unroll
    for (int r = 0; r < 4; ++r) { s[r] = 0.f;
#pragma unroll
        for (int j = 0; j < 4; ++j) s[r] += (v[r][j].x * v[r][j].x + v[r][j].y * v[r][j].y) + (v[r][j].z * v[r][j].z + v[r][j].w * v[r][j].w); }
#pragma unroll
    for (int of = 1; of < 64; of <<= 1) {
#pragma unroll
        for (int r = 0; r < 4; ++r) s[r] += __shfl_xor(s[r], of); }
    f32x4 gg[4];
#pragma unroll
    for (int j = 0; j < 4; ++j) gg[j] = *((const GAS f32x4*)g + lane + 64 * j);
#pragma unroll
    for (int r = 0; r < 4; ++r) { const float rr = __builtin_amdgcn_rsqf(s[r] * (1.f / D) + RMS_EPS);
        GAS unsigned long long* o8 = (GAS unsigned long long*)(o + (size_t)r * D) + lane;
#pragma unroll
        for (int j = 0; j < 4; ++j) o8[64 * j] = (unsigned long long)pk2(v[r][j].x * rr * gg[j].x, v[r][j].y * rr * gg[j].y) | ((unsigned long long)pk2(v[r][j].z * rr * gg[j].z, v[r][j].w * rr * gg[j].w) << 32); }
}
__device__ __forceinline__ void p0_prologue(Frame& F, unsigned long long& p0_probe) {
    const int gw = (int)blockIdx.x * NWAVES + F.wave, NGW = F.G * NWAVES;
#if defined(PROBE_PHASE) && (PROBE_PHASE == 13 || PROBE_PHASE == 14)
    const unsigned long long p0_t0 = __builtin_amdgcn_s_memrealtime();
#endif
    p0_weights(F, 0, gw, NGW);
#if defined(PROBE_PHASE) && (PROBE_PHASE == 13 || PROBE_PHASE == 14)
    const unsigned long long tp1_ = __builtin_amdgcn_s_memrealtime();
    if (PROBE_PHASE == 13) p0_probe = tp1_ - p0_t0;
#endif
    for (int m = 4 * gw; m < M; m += 4 * NGW) rms_rows4_to_bf16(F.in[0] + (size_t)m * D, F.in[1], (bf16*)(F.ws + WS_XB) + (size_t)m * D, F.lane);
#if defined(PROBE_PHASE) && (PROBE_PHASE == 13 || PROBE_PHASE == 14)
    if (PROBE_PHASE == 14) p0_probe = __builtin_amdgcn_s_memrealtime() - tp1_;
#endif
    if (blockIdx.x == 0) {
        const float l0 = F.in[10][F.tid], l1 = F.in[10][512 + F.tid], mx = fmaxf(l0, l1), e0 = __expf(l0 - mx), e1 = __expf(l1 - mx);
        ((float*)(F.ws + WS_LB))[F.tid] = e0 / (e0 + e1);
    }
}

typedef float f32x16 __attribute__((ext_vector_type(16)));
typedef float f32x2_t __attribute__((ext_vector_type(2))); typedef __bf16 bf16x2_t __attribute__((ext_vector_type(2)));
__device__ __forceinline__ unsigned cvtpk_s(float lo, float hi) { f32x2_t v = {lo, hi}; bf16x2_t b = __builtin_convertvector(v, bf16x2_t); return __builtin_bit_cast(unsigned, b); }
__device__ __forceinline__ bf16x8 pack_step(const f32x16& x, int s) { v4u p; p.x = cvtpk_s(x[8 * s], x[8 * s + 1]); p.y = cvtpk_s(x[8 * s + 2], x[8 * s + 3]); p.z = cvtpk_s(x[8 * s + 4], x[8 * s + 5]); p.w = cvtpk_s(x[8 * s + 6], x[8 * s + 7]); return __builtin_bit_cast(bf16x8, p); }
__device__ __forceinline__ float swapmax(float m) { auto rr = __builtin_amdgcn_permlane32_swap(__float_as_uint(m), __float_as_uint(m), false, false); return fmaxf(__uint_as_float(rr[0]), __uint_as_float(rr[1])); }
__device__ __forceinline__ float swapsum(float m) { auto rr = __builtin_amdgcn_permlane32_swap(__float_as_uint(m), __float_as_uint(m), false, false); return __uint_as_float(rr[0]) + __uint_as_float(rr[1]); }
__device__ __forceinline__ int pi32(int x) { return (x & 0x13) | ((x & 4) << 1) | ((x & 8) >> 1); }
#define MFMA32(a, b, c) __builtin_amdgcn_mfma_f32_32x32x16_bf16((a), (b), (c), 0, 0, 0)
constexpr int ATT_ETAB_OFF = 0;
__device__ __forceinline__ void attn_item(Frame& F, int b, int c, int h, const LAS float* etab) {
    const bf16* Q = (const bf16*)(F.ws + WS_Q); const bf16* Kp = (const bf16*)(F.ws + WS_K); const bf16* VT = (const bf16*)(F.ws + WS_VT); bf16* MIX = (bf16*)(F.ws + WS_MIX);
    const int lane = F.lane, r32 = lane & 31, hi = lane >> 5;
    const float cfar = F.in[9][h * 257 + 256] * LOG2E;
    bf16x8 qf[2][4];
#pragma unroll
    for (int qb = 0; qb < 2; ++qb)
#pragma unroll
        for (int d0 = 0; d0 < 4; ++d0) qf[qb][d0] = *(const bf16x8*)(Q + (unsigned)((((((b * 8 + h) * 32 + c) * 2 + qb) * 4 + d0) * 64 + lane) * 8));
    f32x16 o[2][2];
#pragma unroll
    for (int db = 0; db < 2; ++db)
#pragma unroll
        for (int qb = 0; qb < 2; ++qb)
#pragma unroll
            for (int r = 0; r < 16; ++r) o[db][qb][r] = 0.f;
    float mrun[2] = {-INFINITY, -INFINITY}, lrun[2] = {0.f, 0.f};
    const int kt0 = c >= 8 ? c - 8 : 0;
    const unsigned fbase = (unsigned)(((b * 8 + h) * 32 * 8 * 64 + lane) * 8);
    const LAS float* et = etab + h * 256;
    bf16x8 kf[2][4], vf[2][4];
#define AT_LOADK(kt_) do { _Pragma("unroll") for (int kb = 0; kb < 2; ++kb) _Pragma("unroll") for (int d0 = 0; d0 < 4; ++d0) kf[kb][d0] = *(const bf16x8*)(Kp + fbase + (unsigned)((((kt_) * 2 + kb) * 4 + d0) * 512)); } while (0)
#define AT_LOADV(kt_) do { _Pragma("unroll") for (int db = 0; db < 2; ++db) _Pragma("unroll") for (int ks = 0; ks < 4; ++ks) vf[db][ks] = *(const bf16x8*)(VT + fbase + (unsigned)((((kt_) * 2 + db) * 4 + ks) * 512)); } while (0)
    AT_LOADK(kt0); AT_LOADV(kt0);
    for (int kt = kt0; kt <= c; ++kt) {
        const int j = c - kt, ktn = kt < c ? kt + 1 : c;
#pragma unroll
        for (int qb = 0; qb < 2; ++qb) {
            f32x16 s[2]; bf16x8 pk[2][2];
            const float c0 = j >= 3 ? cfar : 0.f;
#pragma unroll
            for (int r = 0; r < 16; ++r) { s[0][r] = c0; s[1][r] = c0; }
#pragma unroll
            for (int d0 = 0; d0 < 4; ++d0) { s[0] = MFMA32(kf[0][d0], qf[qb][d0], s[0]); s[1] = MFMA32(kf[1][d0], qf[qb][d0], s[1]); }
            if (qb == 1) { __builtin_amdgcn_sched_barrier(0); AT_LOADK(ktn); __builtin_amdgcn_sched_barrier(0); }
            if (j < 3) {
                const int ib = 64 * j + 32 * qb + r32 - 8 * hi + 63;
#pragma unroll
                for (int kb = 0; kb < 2; ++kb)
#pragma unroll
                    for (int r = 0; r < 16; ++r) s[kb][r] += et[ib - 32 * kb - 16 * (r >> 3) - (r & 7)];
            }
            float tm = fmaxf(s[0][0], s[1][0]);
#pragma unroll
            for (int r = 1; r < 16; ++r) tm = fmaxf(tm, fmaxf(s[0][r], s[1][r]));
            tm = swapmax(tm);
            const float mn = fmaxf(mrun[qb], tm), alpha = __builtin_amdgcn_exp2f(mrun[qb] - mn); mrun[qb] = mn;
            float ls = 0.f;
#pragma unroll
            for (int kb = 0; kb < 2; ++kb)
#pragma unroll
                for (int r = 0; r < 16; ++r) { const float p = __builtin_amdgcn_exp2f(s[kb][r] - mn); s[kb][r] = p; ls += p; }
            lrun[qb] = lrun[qb] * alpha + ls;
#pragma unroll
            for (int db = 0; db < 2; ++db)
#pragma unroll
                for (int r = 0; r < 16; ++r) o[db][qb][r] *= alpha;
#pragma unroll
            for (int kb = 0; kb < 2; ++kb) { pk[kb][0] = pack_step(s[kb], 0); pk[kb][1] = pack_step(s[kb], 1); }
#pragma unroll
            for (int db = 0; db < 2; ++db)
#pragma unroll
                for (int kb = 0; kb < 2; ++kb)
#pragma unroll
                    for (int sp = 0; sp < 2; ++sp) o[db][qb] = MFMA32(vf[db][2 * kb + sp], pk[kb][sp], o[db][qb]);
        }
        __builtin_amdgcn_sched_barrier(0); AT_LOADV(ktn); __builtin_amdgcn_sched_barrier(0);
    }
#undef AT_LOADK
#undef AT_LOADV
#pragma unroll
    for (int qb = 0; qb < 2; ++qb) {
        const float inv = 1.0f / swapsum(lrun[qb]);
        bf16* orow = MIX + (unsigned)((b * SEQ + 64 * c + 32 * qb + r32) * 1024 + h * 64 + 16 * hi);
#pragma unroll
        for (int db = 0; db < 2; ++db) {
            unsigned wx[4], wy[4];
#pragma unroll
            for (int g = 0; g < 4; ++g) { wx[g] = cvtpk_s(o[db][qb][4 * g] * inv, o[db][qb][4 * g + 1] * inv); wy[g] = cvtpk_s(o[db][qb][4 * g + 2] * inv, o[db][qb][4 * g + 3] * inv); }
#pragma unroll
            for (int p = 0; p < 2; ++p) {
                auto ax = __builtin_amdgcn_permlane32_swap(wx[p], wx[p + 2], false, false); auto ay = __builtin_amdgcn_permlane32_swap(wy[p], wy[p + 2], false, false);
                *(v4u*)(orow + 32 * db + 8 * p) = (v4u){ax[0], ay[0], ax[1], ay[1]}; }
        }
    }
}
__device__ __forceinline__ void attn_phase(Frame& F) {
    LAS float* etab = (LAS float*)(F.lds + RING_OFF + ATT_ETAB_OFF);
    for (int i = F.tid; i < 8 * 256; i += NWAVES * 64) { const int h = i >> 8; int rel = (i & 255) - 63; rel = rel > 128 ? 128 : rel; etab[i] = F.in[9][h * 257 + rel + 128] * LOG2E; }
    __syncthreads();
    for (int k = 0; k < 8; ++k) {
        const int shard = ((int)blockIdx.x + k) & 7;
        gu32* head = F.ctl + CW_WQ + 64 * shard;
        for (;;) {
            unsigned n = 0; if (F.lane == 0) n = __hip_atomic_fetch_add(head, 1u, RLX_AGENT);
            n = (unsigned)__builtin_amdgcn_readfirstlane((int)n);
            if (n >= 512u) break;
            const int bh = 8 * (int)(n >> 5) + shard, c = 31 - (int)(n & 31);
            attn_item(F, bh >> 3, c, bh & 7, etab);
        }
    }
    __syncthreads();
}

__device__ __forceinline__ unsigned off_b(unsigned row, unsigned ch) { return 256u * row + 16u * (ch ^ (((row & 3) << 2) | ((row >> 2) & 3))); }
__device__ __forceinline__ unsigned tr_read_addr_b(unsigned lane, unsigned c, unsigned ks, unsigned t) {
    const unsigned h = lane >> 5, blk = (lane >> 4) & 1, q = (lane & 15) >> 2, p = lane & 3;
    return off_b(16 * ks + 8 * h + 4 * t + q, 4 * c + 2 * blk + (p >> 1)) + 8 * (p & 1);
}
typedef short v4i16_t __attribute__((ext_vector_type(4)));
__device__ __forceinline__ v4i16_t lds_tr(const LAS unsigned char* p) { return __builtin_amdgcn_ds_read_tr16_b64_v4i16((LAS v4i16_t*)p); }
__device__ __forceinline__ bf16x8 krow_frag(bf16x8 nat) {
    const v4u d = __builtin_bit_cast(v4u, nat);
    auto a = __builtin_amdgcn_permlane32_swap(d.x, d.z, false, false); auto b = __builtin_amdgcn_permlane32_swap(d.y, d.w, false, false);
    v4u r; r.x = a[0]; r.y = b[0]; r.z = a[1]; r.w = b[1]; return __builtin_bit_cast(bf16x8, r);
}
constexpr int HG_PS_OFF = 8192, HG_DD_OFF = 10240, HG_GN_OFF = 12288, HG_BUF_OFF = 16384;
constexpr int HG_QT_OFF = 16384, HG_VT_OFF = 32768, HG_BUF_BYTES = 49152;
constexpr int HG_OX_OFF = HG_BUF_OFF + 2 * HG_BUF_BYTES, HG_OX_BYTES = 64 * 264;
constexpr int HG_XS_OFF = HG_OX_OFF + 2 * HG_OX_BYTES;
static_assert(HG_XS_OFF + 3 * 2048 <= LDSCTL_OFF && HG_OX_OFF % 16 == 0 && HG_XS_OFF % 16 == 0, "HGRN LDS map");
__device__ __forceinline__ void dma16(const void* g, LAS unsigned char* l) { __builtin_amdgcn_global_load_lds((const unsigned*)g, (LAS unsigned*)l, 16, 0, 0); }
__device__ __forceinline__ void hgrn_finalize(Frame& F, const v4u (&gw)[4], int b, int hh, int c) {
    bf16* MIX = (bf16*)(F.ws + WS_MIX);
    const int ht = F.tid - 256, tok = ht >> 2, pc = ht & 3;
    const LAS float* ps = (const LAS float*)(F.lds + RING_OFF + HG_PS_OFF) + ((c & 1) * 2 + (tok >> 5)) * 128 + (tok & 31);
    const float tot = (ps[0] + ps[32]) + (ps[64] + ps[96]);
    const float rs = __builtin_amdgcn_rsqf(tot * (1.0f / 128.0f) + RMS_EPS);
    const LAS unsigned char* ox = F.lds + RING_OFF + HG_OX_OFF + (c & 1) * HG_OX_BYTES + tok * 264 + 64 * pc;
    const LAS f32x4* gn = (const LAS f32x4*)(F.lds + RING_OFF + HG_GN_OFF) + 8 * pc;
    bf16* dst = MIX + (unsigned)((b * SEQ + 64 * c + tok) * 1024 + 512 + hh * 128 + 32 * pc);
#pragma unroll
    for (int q = 0; q < 4; ++q) { unsigned ow[4]; const unsigned g4w[4] = {gw[q].x, gw[q].y, gw[q].z, gw[q].w};
#pragma unroll
        for (int i = 0; i < 2; ++i) { const pg8::u32x2 o2 = *(const LAS pg8::u32x2*)(ox + 16 * q + 8 * i); const f32x4 g4 = gn[2 * q + i];
            ow[2 * i] = cvtpk_s(bflo(o2.x) * rs * g4[0] * bflo(g4w[2 * i]), bfhi(o2.x) * rs * g4[1] * bfhi(g4w[2 * i]));
            ow[2 * i + 1] = cvtpk_s(bflo(o2.y) * rs * g4[2] * bflo(g4w[2 * i + 1]), bfhi(o2.y) * rs * g4[3] * bfhi(g4w[2 * i + 1])); }
        *(v4u*)(dst + 8 * q) = (v4u){ow[0], ow[1], ow[2], ow[3]}; }
}
__device__ __forceinline__ void hgrn_phase(Frame& F, int bh, unsigned long long& hg_wait_acc) {
    (void)hg_wait_acc;
    const unsigned char* QT = F.ws + WS_QT; const unsigned char* KT = F.ws + WS_KT; const unsigned char* VHT = F.ws + WS_VHT; const bf16* Gt = (const bf16*)(F.ws + WS_G);
    const unsigned char* DM = F.ws + WS_DM; const unsigned char* DE = F.ws + WS_DE;
    const int b = bh >> 2, hh = bh & 3, lane = F.lane, r32 = lane & 31, hi = lane >> 5, w = F.wave, tid = F.tid;
    LAS unsigned char* const bufs = F.lds + RING_OFF + HG_BUF_OFF;
    LAS float* const psw = (LAS float*)(F.lds + RING_OFF + HG_PS_OFF);
    LAS float* const ddw = (LAS float*)(F.lds + RING_OFF + HG_DD_OFF);
    if (tid < 128) ((LAS float*)(F.lds + RING_OFF + HG_GN_OFF))[tid] = F.in[11][tid];
    if (w >= 4) {
        const int hw = w - 4;
        unsigned so_k[4], so_v[4];
#pragma unroll
        for (int j = 0; j < 4; ++j) { const unsigned ii = (unsigned)(hw + 4 * j), sl = ii * 64 + lane;
            { const unsigned img = sl >> 9, s9 = sl & 511, row = s9 >> 4, ch = (s9 & 15) ^ (((row & 3) << 2) | ((row >> 2) & 3)); so_k[j] = ((32 * img + row) * 512 + hh * 128) * 2 + ch * 16; }
            { const unsigned row = sl >> 3, ch = (sl & 7) ^ (row & 7); so_v[j] = ((hh * 128 + row) * SEQ) * 2 + ch * 16; } }
        const unsigned so_d = (unsigned)((hh * 128) * 4 + (lane & 31) * 16);
        const unsigned char* const ddsrc = (lane < 32 ? DM : DE) + (size_t)(b * NCHUNK) * 2048 + so_d;
        const unsigned char* const ktb = KT + (size_t)(b * SEQ) * 1024; const unsigned char* const qtb = QT + (size_t)(b * SEQ) * 1024; const unsigned char* const vtb = VHT + (size_t)(b * 512) * SEQ * 2;
#define HG_DMA(c_) do { LAS unsigned char* nb_ = bufs + ((c_) & 1) * HG_BUF_BYTES + hw * 1024; const size_t ck_ = (size_t)(c_) * 65536, cv_ = (size_t)(c_) * 128; \
        _Pragma("unroll") for (int j_ = 0; j_ < 4; ++j_) { dma16(ktb + ck_ + so_k[j_], nb_ + j_ * 4096); dma16(qtb + ck_ + so_k[j_], nb_ + HG_QT_OFF + j_ * 4096); dma16(vtb + cv_ + so_v[j_], nb_ + HG_VT_OFF + j_ * 4096); } \
        if (hw == 0) dma16(ddsrc + (size_t)(c_) * 2048, (LAS unsigned char*)(ddw + ((c_) & 1) * 256)); } while (0)
        const unsigned src_g = (unsigned)((b * SEQ + ((tid - 256) >> 2)) * 512 + hh * 128 + 32 * (tid & 3));
        const unsigned rk_ = (unsigned)pi32(r32), sk_ = ((rk_ & 3) << 2) | ((rk_ >> 2) & 3), sq_ = (((unsigned)r32 & 3) << 2) | (((unsigned)r32 >> 2) & 3);
        const unsigned kt_base = 256u * rk_ + 16u * ((unsigned)hi ^ (sk_ & 1)), kt_e = sk_ >> 1, qt_base = (unsigned)HG_QT_OFF + 256u * (unsigned)r32 + 16u * ((unsigned)hi ^ (sq_ & 1)), qt_e = sq_ >> 1;
        HG_DMA(0);
        asm volatile("s_waitcnt vmcnt(0) lgkmcnt(0)" ::: "memory"); __builtin_amdgcn_s_barrier(); asm volatile("" ::: "memory");
        for (int c = 0; c <= NCHUNK; ++c) {
            if (c + 1 < NCHUNK) HG_DMA(c + 1);
            if (hw < 3 && c < NCHUNK) {
                const LAS unsigned char* buf = bufs + (c & 1) * HG_BUF_BYTES;
                const int sbx = hw >> 1, tbx = (hw + 1) >> 1;
                unsigned ek = kt_e, eq = qt_e; asm volatile("" : "+v"(ek), "+v"(eq));
                f32x16 X;
#pragma unroll
                for (int r = 0; r < 16; ++r) X[r] = 0.f;
#pragma unroll
                for (int ks = 0; ks < 8; ++ks) { const bf16x8 kf = *(const LAS bf16x8*)(buf + sbx * 8192 + kt_base + (((unsigned)ks ^ ek) << 5)), qf = *(const LAS bf16x8*)(buf + tbx * 8192 + qt_base + (((unsigned)ks ^ eq) << 5)); X = MFMA32(kf, qf, X); }
                if (sbx == tbx) {
                    int thr = r32 - 8 * hi; asm volatile("" : "+v"(thr));
#pragma unroll
                    for (int r = 0; r < 16; ++r) X[r] = thr >= 16 * (r >> 3) + (r & 7) ? X[r] : 0.f;
                }
                LAS unsigned char* xw = F.lds + RING_OFF + HG_XS_OFF + hw * 2048 + lane * 16;
                *(LAS bf16x8*)xw = pack_step(X, 0); *(LAS bf16x8*)(xw + 1024) = pack_step(X, 1);
            }
            if (c > 0) { const bf16* gcp = Gt + (size_t)((c - 1) * 64 * 512); v4u gc[4];
#pragma unroll
                for (int q = 0; q < 4; ++q) gc[q] = *(const v4u*)(gcp + src_g + 8 * q);
                hgrn_finalize(F, gc, b, hh, c - 1); }
            asm volatile("s_waitcnt lgkmcnt(0)" ::: "memory"); __builtin_amdgcn_s_barrier(); asm volatile("" ::: "memory");
            asm volatile("s_waitcnt vmcnt(0) lgkmcnt(0)" ::: "memory"); __builtin_amdgcn_s_barrier(); asm volatile("" ::: "memory");
        }
#undef HG_DMA
    } else {
        const int vb = w;
        f32x16 S[4];
#pragma unroll
        for (int kb = 0; kb < 4; ++kb)
#pragma unroll
            for (int r = 0; r < 16; ++r) S[kb][r] = 0.f;
        const unsigned rk_ = (unsigned)pi32(r32), sk_ = ((rk_ & 3) << 2) | ((rk_ >> 2) & 3), sq_ = (((unsigned)r32 & 3) << 2) | (((unsigned)r32 >> 2) & 3);
        const unsigned kt_base = 256u * rk_ + 16u * ((unsigned)hi ^ (sk_ & 1)), kt_e = sk_ >> 1, qt_base = (unsigned)HG_QT_OFF + 256u * (unsigned)r32 + 16u * ((unsigned)hi ^ (sq_ & 1)), qt_e = sq_ >> 1;
        unsigned rd_tr[4][2], rd_vt[4];
#pragma unroll
        for (int kb = 0; kb < 4; ++kb) { rd_tr[kb][0] = tr_read_addr_b((unsigned)lane, (unsigned)kb, 0u, 0u); rd_tr[kb][1] = tr_read_addr_b((unsigned)lane, (unsigned)kb, 0u, 1u); }
#pragma unroll
        for (int k4 = 0; k4 < 4; ++k4) rd_vt[k4] = (unsigned)(HG_VT_OFF + (32 * vb + r32) * 128 + (((2 * k4 + hi) ^ (r32 & 7)) << 4));
        const unsigned wr_ox = (unsigned)(HG_OX_OFF + r32 * 264 + (32 * vb + 4 * hi) * 2);
        asm volatile("s_waitcnt vmcnt(0) lgkmcnt(0)" ::: "memory"); __builtin_amdgcn_s_barrier(); asm volatile("" ::: "memory");
        for (int c = 0; c <= NCHUNK; ++c) {
            const LAS unsigned char* buf = bufs + (c & 1) * HG_BUF_BYTES;
            f32x16 o[2]; bf16x8 vfr[4];
            if (c < NCHUNK) {
            const LAS float* dd = ddw + (c & 1) * 256 + 4 * hi;
#pragma unroll
            for (int kb = 0; kb < 4; ++kb)
#pragma unroll
                for (int g = 0; g < 4; ++g) { const f32x4 a = *(const LAS f32x4*)(dd + 32 * kb + 8 * g);
#pragma unroll
                    for (int i = 0; i < 4; ++i) S[kb][4 * g + i] *= a[i]; }
            unsigned ek = kt_e, eq = qt_e; asm volatile("" : "+v"(ek), "+v"(eq));
#define HG_RDKT(ks_) (kt_base + (((unsigned)(ks_) ^ ek) << 5))
#define HG_RDQT(ks_) (qt_base + (((unsigned)(ks_) ^ eq) << 5))
            __builtin_amdgcn_sched_barrier(0);
#pragma unroll
            for (int k4 = 0; k4 < 4; ++k4) vfr[k4] = *(const LAS bf16x8*)(buf + rd_vt[k4]);
#pragma unroll
            for (int r = 0; r < 16; ++r) { o[0][r] = 0.f; o[1][r] = 0.f; }
#pragma unroll
            for (int kb = 0; kb < 4; ++kb)
#pragma unroll
                for (int sp = 0; sp < 2; ++sp) { const bf16x8 sf = pack_step(S[kb], sp);
                    const bf16x8 q0 = *(const LAS bf16x8*)(buf + HG_RDQT(2 * kb + sp)), q1 = *(const LAS bf16x8*)(buf + 8192 + HG_RDQT(2 * kb + sp));
                    o[0] = MFMA32(sf, krow_frag(q0), o[0]); o[1] = MFMA32(sf, krow_frag(q1), o[1]); }
            __builtin_amdgcn_sched_barrier(0);
#pragma unroll
            for (int kb = 0; kb < 4; ++kb) {
#pragma unroll
                for (int k4 = 0; k4 < 4; ++k4) {
                    const LAS unsigned char* ip = buf + (k4 >> 1) * 8192 + (k4 & 1) * 4096;
                    const v4i16_t lo = lds_tr(ip + rd_tr[kb][0]), hi4 = lds_tr(ip + rd_tr[kb][1]);
                    const bf16x8 af = __builtin_shufflevector(lo, hi4, 0, 1, 2, 3, 4, 5, 6, 7);
                    S[kb] = MFMA32(af, vfr[k4], S[kb]);
                }
#pragma unroll
                for (int g = 0; g < 4; ++g) { const f32x4 a = *(const LAS f32x4*)(dd + 128 + 32 * kb + 8 * g);
#pragma unroll
                    for (int i = 0; i < 4; ++i) S[kb][4 * g + i] *= a[i]; }
            }
            }
            asm volatile("s_waitcnt lgkmcnt(0)" ::: "memory"); __builtin_amdgcn_s_barrier(); asm volatile("" ::: "memory");
            if (c < NCHUNK) {
            { const LAS unsigned char* xr = F.lds + RING_OFF + HG_XS_OFF + lane * 16;
              o[0] = MFMA32(vfr[0], *(const LAS bf16x8*)(xr), o[0]); o[0] = MFMA32(vfr[1], *(const LAS bf16x8*)(xr + 1024), o[0]);
              o[1] = MFMA32(vfr[0], *(const LAS bf16x8*)(xr + 2048), o[1]); o[1] = MFMA32(vfr[1], *(const LAS bf16x8*)(xr + 3072), o[1]);
              o[1] = MFMA32(vfr[2], *(const LAS bf16x8*)(xr + 4096), o[1]); o[1] = MFMA32(vfr[3], *(const LAS bf16x8*)(xr + 5120), o[1]); }
#pragma unroll
            for (int tbi = 0; tbi < 2; ++tbi) { float q = 0.f;
#pragma unroll
              for (int r = 0; r < 16; ++r) q += o[tbi][r] * o[tbi][r];
              q = swapsum(q);
              if (hi == 0) psw[((c & 1) * 2 + tbi) * 128 + vb * 32 + r32] = q;
              LAS unsigned char* oxw = F.lds + RING_OFF + (c & 1) * HG_OX_BYTES + wr_ox + tbi * 32 * 264;
#pragma unroll
              for (int g = 0; g < 4; ++g) *(LAS pg8::u32x2*)(oxw + 16 * g) = (pg8::u32x2){cvtpk_s(o[tbi][4 * g], o[tbi][4 * g + 1]), cvtpk_s(o[tbi][4 * g + 2], o[tbi][4 * g + 3])}; }
            }
            asm volatile("s_waitcnt vmcnt(0) lgkmcnt(0)" ::: "memory"); __builtin_amdgcn_s_barrier(); asm volatile("" ::: "memory");
        }
#undef HG_RDKT
#undef HG_RDQT
    }
    __syncthreads();
}

struct Args { const float* in[17]; float* out; unsigned char* ws; int ph_lo, ph_hi, li, pad; };
__global__ void __launch_bounds__(NWAVES * 64, 2) mega_fwd(Args args) {
    extern __shared__ __attribute__((aligned(16))) unsigned char lds[];
    Frame F;
    F.lds = (LAS unsigned char*)lds;
    F.MISC = (volatile LAS unsigned*)(F.lds + MISC_OFF);
    F.tid = threadIdx.x; F.lane = F.tid & 63; F.wave = __builtin_amdgcn_readfirstlane(F.tid >> 6);
    F.G = gridDim.x;
#pragma unroll
    for (int i = 0; i < 17; ++i) F.in[i] = args.in[i];
    F.out = args.out; F.ws = args.ws;
    F.ctl = (gu32*)(args.ws + WS_CTL);
    for (int u = F.tid; u < (LDS_BYTES - LDSCTL_OFF) / 4; u += NWAVES * 64) ((LAS unsigned*)(F.lds + LDSCTL_OFF))[u] = 0u;
    __syncthreads();
    XcdBarrier bar; bar.bar = (unsigned*)(F.ctl + CW_BAR); bar.x = 0; bar.st = nullptr;
    if (N_LAUNCHES != PER_PHASE) bar = xcd_barrier_post((unsigned*)(F.ctl + CW_BAR), F.MISC + 8);
#define GRID_BAR(seam) do { if (N_LAUNCHES == PER_PHASE) { if (F.tid == 0) __hip_atomic_store(F.ctl + CW_TMO, 0xBADBA0u | (unsigned)(seam), RLX_AGENT); } else { xcd_barrier(bar); } } while (0)
    const int lo = args.ph_lo, hi = args.ph_hi;
#ifdef PROBE_PHASE
    unsigned long long ts_prev = __builtin_amdgcn_s_memrealtime(), ts_dt = 0ull; int ts_k = 0;
#define STAMP() do { const unsigned long long t_ = __builtin_amdgcn_s_memrealtime(); if (ts_k == PROBE_PHASE) ts_dt = t_ - ts_prev; ts_prev = t_; ++ts_k; } while (0)
#else
#define STAMP() do {} while (0)
#endif
#define IN(k) (lo <= (k) && (k) < hi)
#define BOTH(k) (IN(k) && IN((k) + 1))
    bf16* const XB = (bf16*)(F.ws + WS_XB); bf16* const HID = (bf16*)(F.ws + WS_HID); bf16* const MIXp = (bf16*)(F.ws + WS_MIX);
    float* const RS1 = (float*)(F.ws + WS_RS1); float* const RS2 = (float*)(F.ws + WS_RS2);
    const LAS float* const SCL = (const LAS float*)(F.lds + RING_OFF + RING_BYTES);

    if (IN(0)) { unsigned long long p0_probe = 0ull; p0_prologue(F, p0_probe);
#if defined(PROBE_PHASE) && (PROBE_PHASE == 13 || PROBE_PHASE == 14)
        ts_dt = p0_probe;
#endif
        if (BOTH(0)) GRID_BAR(0); STAMP(); }
    if (IN(1)) {
        pg8::Gemm g{XB, (const bf16*)(F.ws + WS_WGU1), M, 2 * FF, D}; pg8::StaticOrder S; S.init(M, 2 * FF, F.G, (int)blockIdx.x, WGM_GU);
        pg8::EpiSwiGLU E{HID, nullptr, SCL, FF};
        pg8::gemm_phase<pg8::EpiSwiGLU, pg8::StaticOrder, true, true>(F.lds + RING_OFF, g, S, E);
        if (BOTH(1)) GRID_BAR(1); STAMP();
    }
    if (IN(2)) {
        pg8::Gemm g{HID, (const bf16*)(F.ws + WS_WD1), M, D, FF}; pg8::StaticOrder S; S.init(M, D, F.G, (int)blockIdx.x, WGM_DOWN);
        pg8::EpiRes<0> E{F.in[0], nullptr, XB, RS1, 0.5f};
        pg8::gemm_phase<pg8::EpiRes<0>, pg8::StaticOrder, true, true>(F.lds + RING_OFF, g, S, E);
        if (BOTH(2)) GRID_BAR(2); STAMP();
    }
    if (IN(3)) {
        { pg8::Gemm g{XB, (const bf16*)(F.ws + WS_WIN), M, 2560, D}; pg8::StaticOrder S; S.init(M, 2560, F.G, (int)blockIdx.x, WGM_IN);
          pg8::EpiWin E{(bf16*)(F.ws + WS_Q), (bf16*)(F.ws + WS_K), (bf16*)(F.ws + WS_QT), (bf16*)(F.ws + WS_KT), (bf16*)(F.ws + WS_G), (float*)(F.ws + WS_DM), (float*)(F.ws + WS_DE), RS1, F.in[7], F.in[8], (const float*)(F.ws + WS_LB), SCL};
          pg8::gemm_phase<pg8::EpiWin, pg8::StaticOrder, true, true>(F.lds + RING_OFF, g, S, E); }
        { pg8::Gemm g{(const bf16*)(F.ws + WS_WINT), XB, 1024, M, D}; pg8::StaticOrder S; S.init(1024, M, F.G, (int)blockIdx.x, WGM_INT);
          pg8::EpiVT E{(bf16*)(F.ws + WS_VT), (bf16*)(F.ws + WS_VHT), RS1, SCL};
          pg8::gemm_phase<pg8::EpiVT, pg8::StaticOrder, true, true>(F.lds + RING_OFF, g, S, E); }
        if (BOTH(3)) GRID_BAR(3); STAMP();
    }
    if (IN(4)) {
#ifdef PROBE_PHASE
        const unsigned long long th00_ = __builtin_amdgcn_s_memrealtime();
#endif
#ifdef PROBE_PHASE
        const unsigned long long th0_ = __builtin_amdgcn_s_memrealtime();
        if (PROBE_PHASE == 9) ts_dt = th0_ - th00_;
#endif
        unsigned long long hg_wait_acc = 0ull;
        if (blockIdx.x < 64) hgrn_phase(F, (int)blockIdx.x, hg_wait_acc);
#ifdef PROBE_PHASE
        if (PROBE_PHASE == 11 || PROBE_PHASE == 12) ts_dt = hg_wait_acc;
#endif
#ifdef PROBE_PHASE
        if (PROBE_PHASE == 8) ts_dt = __builtin_amdgcn_s_memrealtime() - th0_;
#endif
#ifdef PROBE_PHASE
        const unsigned long long ta0_ = __builtin_amdgcn_s_memrealtime();
#endif
        attn_phase(F);
        if (blockIdx.x >= 64) p0_weights(F, 1, ((int)blockIdx.x - 64) * NWAVES + F.wave, (F.G - 64) * NWAVES);
#ifdef PROBE_PHASE
        if (PROBE_PHASE == 10) ts_dt = __builtin_amdgcn_s_memrealtime() - ta0_;
#endif
        if (BOTH(4)) GRID_BAR(4); STAMP();
    }
    if (IN(5)) {
        pg8::Gemm g{MIXp, (const bf16*)(F.ws + WS_WOUT), M, D, D}; pg8::StaticOrder S; S.init(M, D, F.G, (int)blockIdx.x, WGM_OUT);
        pg8::EpiRes<1> E{nullptr, nullptr, XB, RS2, 1.0f};
        pg8::gemm_phase<pg8::EpiRes<1>, pg8::StaticOrder, true, true>(F.lds + RING_OFF, g, S, E);
        if (BOTH(5)) GRID_BAR(5); STAMP();
    }
    if (IN(6)) {
        pg8::Gemm g{XB, (const bf16*)(F.ws + WS_WGU2), M, 2 * FF, D}; pg8::StaticOrder S; S.init(M, 2 * FF, F.G, (int)blockIdx.x, WGM_GU);
        pg8::EpiSwiGLU E{HID, RS2, SCL, FF};
        pg8::gemm_phase<pg8::EpiSwiGLU, pg8::StaticOrder, true, true>(F.lds + RING_OFF, g, S, E);
        if (BOTH(6)) GRID_BAR(6); STAMP();
    }
    if (IN(7)) {
        pg8::Gemm g{HID, (const bf16*)(F.ws + WS_WD2), M, D, FF}; pg8::StaticOrder S; S.init(M, D, F.G, (int)blockIdx.x, WGM_DOWN);
        pg8::EpiRes<2> E{nullptr, F.out, XB, nullptr, 0.5f};
        pg8::gemm_phase<pg8::EpiRes<2>, pg8::StaticOrder, true, true>(F.lds + RING_OFF, g, S, E);
    }
#ifdef PROBE_PHASE
    __syncthreads(); STAMP();
    if (blockIdx.x == (PROBE_PHASE == 10 ? 255 : 0) && F.tid == 0) { const unsigned long long t0_ = __builtin_amdgcn_s_memrealtime(); while (__builtin_amdgcn_s_memrealtime() - t0_ < 4ull * ts_dt) __builtin_amdgcn_s_sleep(8); }
#endif
#undef IN
#undef BOTH
}

extern "C" void kernel_launch(void* const* d_in, const int* in_sizes, int n_in, void* d_out, int out_size, void* d_ws, size_t ws_size, hipStream_t stream) {
    static int grid = 0;
    if (grid == 0) {
        if (n_in != 17 || in_sizes[0] != M * D || out_size != M * D || ws_size < WS_END) { fprintf(stderr, "kernel_launch: unexpected shapes (n_in %d, in0 %d, out %d, ws %zu); nothing launched\n", n_in, n_in > 0 ? in_sizes[0] : -1, out_size, ws_size); grid = -1; return; }
        int dev = 0, cus = 0, per_cu = 0;
        if (hipGetDevice(&dev) != hipSuccess || hipDeviceGetAttribute(&cus, hipDeviceAttributeMultiprocessorCount, dev) != hipSuccess) { grid = -1; return; }
        if (hipFuncSetAttribute((const void*)mega_fwd, hipFuncAttributeMaxDynamicSharedMemorySize, LDS_BYTES) != hipSuccess) { fprintf(stderr, "kernel_launch: hipFuncSetAttribute failed\n"); grid = -1; return; }
        if (hipOccupancyMaxActiveBlocksPerMultiprocessor(&per_cu, (const void*)mega_fwd, NWAVES * 64, LDS_BYTES) != hipSuccess || per_cu < 1) fprintf(stderr, "kernel_launch: note: occupancy query reports %d workgroups per CU\n", per_cu);
        (void)hipGetLastError();
        grid = cus;
    }
    if (grid < 0) return;
    if (hipMemsetAsync((char*)d_ws + WS_CTL, 0, CTL_ZERO_BYTES, stream) != hipSuccess) { fprintf(stderr, "kernel_launch: hipMemsetAsync failed\n"); return; }
    Args a{};
    for (int i = 0; i < 17; ++i) a.in[i] = (const float*)d_in[i];
    a.out = (float*)d_out; a.ws = (unsigned char*)d_ws;
    for (int li = 0; li < N_LAUNCHES; ++li) {
        a.ph_lo = (N_LAUNCHES == PER_PHASE) ? li : 0; a.ph_hi = (N_LAUNCHES == PER_PHASE) ? li + 1 : PER_PHASE; a.li = li;
        hipLaunchKernelGGL(mega_fwd, dim3(grid), dim3(NWAVES * 64), LDS_BYTES, stream, a);
        const hipError_t le = hipPeekAtLastError();
        if (le != hipSuccess) { fprintf(stderr, "kernel_launch: launch %d failed: %s\n", li, hipGetErrorName(le)); break; }
    }
}
```

```cpp
#include <hip/hip_runtime.h>
#include <cstdio>
#include <cstdint>
namespace pg8 {
#define PG8_LAS __attribute__((address_space(3)))
typedef unsigned short bf16_t;
typedef short bf16x8 __attribute__((ext_vector_type(8)));
typedef float f32x4 __attribute__((ext_vector_type(4)));
typedef unsigned u32x4 __attribute__((ext_vector_type(4)));
constexpr int BM = 256, BK = 64, HALF = 128, HTB = HALF * BK * 2  , STAGE_BYTES = 8 * HTB, NXCD = 8, WGM = 4;

__host__ __device__ __forceinline__ int lds_byte(int r, int c) { const int st = (r >> 4) * 2 + (c >> 5), rr = r & 15, cc = c & 31, ob = rr * 64 + cc * 2; return st * 1024 + (ob ^ (((ob >> 9) & 1) << 5)); }
__host__ __device__ __forceinline__ void stage_rc(int b, int& R, int& C) { const int st = b / 1024, sb = b % 1024, swz = sb ^ (((sb >> 9) & 1) << 5); R = (st >> 1) * 16 + swz / 64; C = (st & 1) * 32 + (swz % 64) / 2; }
__host__ __device__ __forceinline__ int perm32(int rho) { const int n = rho >> 4, i = rho & 15; return 8 * (i >> 2) + 4 * n + (i & 3); }

struct Unit { int pm, pn, par; };
struct Gemm { const bf16_t* A; const bf16_t* Bt; int M, N, K; };

struct StaticOrder {
    int nM, nN, nwg, G, c, wgm, rev;
    __host__ __device__ void init(int M, int N, int G_, int c_, int wgm_ = WGM, int rev_ = 0) { nM = M / BM; nN = N / BM; nwg = nM * nN; G = G_; c = c_; wgm = wgm_; rev = rev_; }
    __host__ __device__ bool next(int i, Unit& u) const {
        const long L = (long)i * G + c; if (L >= nwg) return false;
        int wgid = (int)L; { const int q = nwg / NXCD, r = nwg % NXCD, xcd = wgid % NXCD, cnt = q + (xcd < r ? 1 : 0); int off = wgid / NXCD; if (rev) off = cnt - 1 - off; wgid = (xcd < r ? xcd * (q + 1) : r * (q + 1) + (xcd - r) * q) + off; }
        const int nig = wgm * nN, gid = wgid / nig, fm = gid * wgm, gsz = (nM - fm) < wgm ? (nM - fm) : wgm;
        u.pm = fm + ((wgid % nig) % gsz); u.pn = (wgid % nig) / gsz; return true;
    }
    __device__ __forceinline__ void a_ready(const Unit&) const {}
    __device__ __forceinline__ void done(const Unit&) const {}
};


#ifndef ZC_SWIGLU
#define ZC_SWIGLU true
#endif
#ifndef ZC_RES
#define ZC_RES true
#endif
#ifndef ZC_WIN
#define ZC_WIN false
#endif
#ifndef ZC_VT
#define ZC_VT true
#endif
typedef unsigned u32x2 __attribute__((ext_vector_type(2)));
typedef float f32x2 __attribute__((ext_vector_type(2)));
constexpr float RMS_EPS = 1e-6f, LOG2E = 1.4426950408889634f, QSCALE = 0.125f * 1.4426950408889634f;
__device__ __forceinline__ unsigned cvt_pk_bf16(float lo, float hi) { unsigned r; asm volatile("v_cvt_pk_bf16_f32 %0, %1, %2" : "=v"(r) : "v"(lo), "v"(hi)); return r; }
__device__ __forceinline__ float fsigmoid(float x) { return __builtin_amdgcn_rcpf(1.0f + __builtin_amdgcn_exp2f(-x * LOG2E)); }
__device__ __forceinline__ float fsilu(float x) { return x * fsigmoid(x); }
__device__ __forceinline__ f32x4 silu4(f32x4 v) { return (f32x4){fsilu(v[0]), fsilu(v[1]), fsilu(v[2]), fsilu(v[3])}; }
__device__ __forceinline__ u32x4 pack8(f32x4 a, f32x4 b) { u32x4 w; w.x = cvt_pk_bf16(a[0], a[1]); w.y = cvt_pk_bf16(a[2], a[3]); w.z = cvt_pk_bf16(b[0], b[1]); w.w = cvt_pk_bf16(b[2], b[3]); return w; }
__device__ __forceinline__ float rowscale(const float* rowsq, const PG8_LAS float* slot, int rl) { return rowsq ? __builtin_amdgcn_rsqf(slot[rl] * (1.0f / 1024.0f) + RMS_EPS) : 1.0f; }
template <int CTRL> __device__ __forceinline__ float dpp_mov0(float x) { return __builtin_bit_cast(float, __builtin_amdgcn_update_dpp(0, __builtin_bit_cast(int, x), CTRL, 0xf, 0xf, true)); }
__device__ __forceinline__ float row_scan16(float x) { x += dpp_mov0<0x111>(x); x += dpp_mov0<0x112>(x); x += dpp_mov0<0x114>(x); x += dpp_mov0<0x118>(x); return x; }

struct EpiSwiGLU {
    static constexpr bool PERM = false, AFTER_DRAIN = false, ZEROC = ZC_SWIGLU; static constexpr int SCALE = 1;
    bf16_t* H; const float* rowsq; const PG8_LAS float* scl; int ldh;
    __device__ __forceinline__ void operator()(f32x4 (&acc)[2][2][4][2], const Unit& u, int wr, int wc, int fr, int fq) const {
        const int row0 = u.pm * BM + wr * 64 + fr, col0 = u.pn * HALF + wc * 32 + 8 * fq; const PG8_LAS float* slot = scl + u.par * 256 + wr * 64 + fr;
#pragma unroll
        for (int ai = 0; ai < 2; ++ai)
#pragma unroll
            for (int m = 0; m < 4; ++m) { const int row = row0 + ai * HALF + m * 16; const float r = rowscale(rowsq, slot, ai * HALF + m * 16);
                f32x4 hh[2]; const f32x2 r2 = (f32x2){r, r}, one2 = (f32x2){1.0f, 1.0f};
#pragma unroll
                for (int n = 0; n < 2; ++n)
#pragma unroll
                    for (int p = 0; p < 2; ++p) { const f32x2 a = (f32x2){acc[ai][0][m][n][2 * p], acc[ai][0][m][n][2 * p + 1]}, b = (f32x2){acc[ai][1][m][n][2 * p], acc[ai][1][m][n][2 * p + 1]};
                        const f32x2 g = rowsq ? a * r2 : a, gu = g * (rowsq ? b * r2 : b);
                        const f32x2 den = one2 + (f32x2){__builtin_amdgcn_exp2f(-g[0]), __builtin_amdgcn_exp2f(-g[1])};
                        const f32x2 h = gu * (f32x2){__builtin_amdgcn_rcpf(den[0]), __builtin_amdgcn_rcpf(den[1])};
                        hh[n][2 * p] = h[0]; hh[n][2 * p + 1] = h[1]; }
                *(u32x4*)(H + (unsigned)(row * ldh + col0)) = pack8(hh[0], hh[1]); }
    }
};
__device__ __forceinline__ unsigned dpp_x8_hi(unsigned old, unsigned src) { return (unsigned)__builtin_amdgcn_update_dpp((int)old, (int)src, 0x128, 0xf, 0xc, false); }
__device__ __forceinline__ unsigned dpp_x8_lo(unsigned old, unsigned src) { return (unsigned)__builtin_amdgcn_update_dpp((int)old, (int)src, 0x128, 0xf, 0x3, false); }
__device__ __forceinline__ void xch8(u32x4& p, u32x4& q) { u32x4 a, b;
#pragma unroll
    for (int i = 0; i < 4; ++i) { a[i] = dpp_x8_hi(p[i], q[i]); b[i] = dpp_x8_lo(q[i], p[i]); }
    p = a; q = b; }
__device__ __forceinline__ void xch8(f32x4& p, f32x4& q) { u32x4 a = __builtin_bit_cast(u32x4, p), b = __builtin_bit_cast(u32x4, q); xch8(a, b); p = __builtin_bit_cast(f32x4, a); q = __builtin_bit_cast(f32x4, b); }
__device__ __forceinline__ f32x4 bf4lo(u32x4 w) { return (f32x4){__builtin_bit_cast(float, w.x << 16), __builtin_bit_cast(float, w.x & 0xffff0000u), __builtin_bit_cast(float, w.y << 16), __builtin_bit_cast(float, w.y & 0xffff0000u)}; }
__device__ __forceinline__ f32x4 bf4hi(u32x4 w) { return (f32x4){__builtin_bit_cast(float, w.z << 16), __builtin_bit_cast(float, w.z & 0xffff0000u), __builtin_bit_cast(float, w.w << 16), __builtin_bit_cast(float, w.w & 0xffff0000u)}; }
__device__ __forceinline__ float sq4(f32x4 t) { return (t[0] * t[0] + t[1] * t[1]) + (t[2] * t[2] + t[3] * t[3]); }
template <int MODE> struct EpiRes {
    static constexpr int PERM = 2; static constexpr bool AFTER_DRAIN = false, ZEROC = ZC_RES; static constexpr int SCALE = 0;
    const float* base; float* out; bf16_t* xb; float* rowsq; float scale;
    __device__ __forceinline__ void operator()(f32x4 (&acc)[2][2][4][2], const Unit& u, int wr, int wc, int fr, int fq) const {
        const int row0 = u.pm * BM + wr * 64 + fr, rowl = u.pm * BM + wr * 64 + (fr & 7), colw = u.pn * BM + wc * 64 + 8 * fq;
        const unsigned offH = (unsigned)(rowl * 1024 + colw + 32 * (fr >> 3)), offF = (unsigned)(rowl * 1024 + colw + 4 * (fr >> 3));
#define EPR_ROWS(g, h) ((((g) >> 2) * HALF + ((g) & 3) * 16 + 8 * (h)) * 1024)
#define EPR_H(p, g, h) ((p) + EPR_ROWS(g, h))[offH]
#define EPR_F(p, g, bj, h) ((p) + (EPR_ROWS(g, h) + (bj) * 32))[offF]
        if constexpr (MODE == 0) {
            f32x4 rb[4][4];
#pragma unroll
            for (int g = 0; g < 4; ++g)
#pragma unroll
                for (int j = 0; j < 4; ++j) rb[g][j] = *(const f32x4*)&EPR_F(base, g, j >> 1, j & 1);
            __builtin_amdgcn_sched_barrier(0);
#pragma unroll
            for (int g = 0; g < 8; ++g) { const int ai = g >> 2, m = g & 3; f32x4 v[4];
#pragma unroll
                for (int j = 0; j < 4; ++j) v[j] = rb[g & 3][j];
                if (g + 4 < 8) {
#pragma unroll
                    for (int j = 0; j < 4; ++j) rb[g & 3][j] = *(const f32x4*)&EPR_F(base, g + 4, j >> 1, j & 1); }
                xch8(v[0], v[1]); xch8(v[2], v[3]);
#pragma unroll
                for (int j = 0; j < 4; ++j) v[j] = v[j] + acc[ai][j >> 1][m][j & 1] * scale;
                float ss = (sq4(v[0]) + sq4(v[1])) + (sq4(v[2]) + sq4(v[3]));
                u32x4 p0 = pack8(v[0], v[1]), p1 = pack8(v[2], v[3]); xch8(p0, p1);
                *(u32x4*)&EPR_H(xb, g, 0) = p0; *(u32x4*)&EPR_H(xb, g, 1) = p1;
                ss += __shfl_xor(ss, 16); ss += __shfl_xor(ss, 32); if (fq == 0) __hip_atomic_fetch_add(rowsq + row0 + ai * HALF + m * 16, ss, __ATOMIC_RELAXED, __HIP_MEMORY_SCOPE_AGENT);
                __builtin_amdgcn_sched_barrier(0); }
        } else {
            u32x4 rb[8][2];
#pragma unroll
            for (int g = 0; g < 8; ++g)
#pragma unroll
                for (int h = 0; h < 2; ++h) rb[g][h] = *(const u32x4*)&EPR_H(xb, g, h);
            __builtin_amdgcn_sched_barrier(0);
#pragma unroll
            for (int g = 0; g < 8; ++g) { const int ai = g >> 2, m = g & 3;
                u32x4 x0 = rb[g][0], x1 = rb[g][1]; xch8(x0, x1);
                f32x4 v[4] = {bf4lo(x0) + acc[ai][0][m][0] * scale, bf4hi(x0) + acc[ai][0][m][1] * scale, bf4lo(x1) + acc[ai][1][m][0] * scale, bf4hi(x1) + acc[ai][1][m][1] * scale};
                if (MODE == 2) { xch8(v[0], v[1]); xch8(v[2], v[3]);
#pragma unroll
                    for (int j = 0; j < 4; ++j) *(f32x4*)&EPR_F(out, g, j >> 1, j & 1) = v[j]; }
                else { float ss = (sq4(v[0]) + sq4(v[1])) + (sq4(v[2]) + sq4(v[3]));
                    u32x4 p0 = pack8(v[0], v[1]), p1 = pack8(v[2], v[3]); xch8(p0, p1);
                    *(u32x4*)&EPR_H(xb, g, 0) = p0; *(u32x4*)&EPR_H(xb, g, 1) = p1;
                    ss += __shfl_xor(ss, 16); ss += __shfl_xor(ss, 32); if (fq == 0) __hip_atomic_fetch_add(rowsq + row0 + ai * HALF + m * 16, ss, __ATOMIC_RELAXED, __HIP_MEMORY_SCOPE_AGENT); }
                __builtin_amdgcn_sched_barrier(0); }
        }
#undef EPR_ROWS
#undef EPR_H
#undef EPR_F
    }
};
struct EpiWin {
    static constexpr bool PERM = false, AFTER_DRAIN = false, ZEROC = ZC_WIN; static constexpr int SCALE = 1;
    bf16_t *Q, *K, *QT, *KT, *G; float *DM, *DE; const float *rowsq, *gq, *gk, *lb; const PG8_LAS float* scl;
    __device__ __forceinline__ void operator()(f32x4 (&acc)[2][2][4][2], const Unit& u, int wr, int wc, int fr, int fq) const {
        const int row0 = u.pm * BM + wr * 64 + fr, t = u.pn; const PG8_LAS float* slot = scl + u.par * 256 + wr * 64 + fr;
        if (t < 4) {
            const bool isq = t < 2; const int head = 4 * (t & 1) + wc; const float* gp = isq ? gq : gk; const float gs = isq ? QSCALE : 1.0f;
            f32x4 gv[2][2];
#pragma unroll
            for (int bj = 0; bj < 2; ++bj)
#pragma unroll
                for (int n = 0; n < 2; ++n) gv[bj][n] = *(const f32x4*)(gp + 32 * bj + 8 * fq + 4 * n) * gs;
            bf16_t* dst = (isq ? Q : K) + (head * 32 * 8) * 512 + (fq >> 1) * 512 + (fq & 1) * 256;
#pragma unroll
            for (int ai = 0; ai < 2; ++ai)
#pragma unroll
                for (int m = 0; m < 4; ++m) { const int row = row0 + ai * HALF + m * 16; const float r = rowscale(rowsq, slot, ai * HALF + m * 16); float ss = 0.f;
#pragma unroll
                    for (int bj = 0; bj < 2; ++bj)
#pragma unroll
                        for (int n = 0; n < 2; ++n) { const f32x4 v = acc[ai][bj][m][n] * r; acc[ai][bj][m][n] = v; ss += (v[0] * v[0] + v[1] * v[1]) + (v[2] * v[2] + v[3] * v[3]); }
                    ss += __shfl_xor(ss, 16); ss += __shfl_xor(ss, 32);
                    const float inv = __builtin_amdgcn_rsqf(ss * (1.0f / 64.0f) + RMS_EPS);
                    const int tk = row & 2047, t5 = tk & 31, r32 = isq ? t5 : ((t5 & 0x13) | ((t5 & 4) << 1) | ((t5 & 8) >> 1));
                    const unsigned o = (unsigned)((((row >> 11) * 8 * 32 + (tk >> 6)) * 2 + ((tk >> 5) & 1)) * 4 * 512 + r32 * 8);
#pragma unroll
                    for (int bj = 0; bj < 2; ++bj) *(u32x4*)(dst + o + (unsigned)(2 * bj * 512)) = pack8(acc[ai][bj][m][0] * inv * gv[bj][0], acc[ai][bj][m][1] * inv * gv[bj][1]); }
        } else if (t < 8) {
            const int hh = t - 4, kbase = hh * 128 + wc * 32 + 8 * fq;
            float lbv[8]; { const f32x4 l0 = *(const f32x4*)(lb + kbase), l1 = *(const f32x4*)(lb + kbase + 4);
#pragma unroll
                for (int c = 0; c < 4; ++c) { lbv[c] = l0[c]; lbv[4 + c] = l1[c]; } }
            const int lane = fq * 16 + fr;
#pragma unroll
            for (int ai = 0; ai < 2; ++ai) { u32x2 qkeep[4], kkeep[4];
#pragma unroll
                for (int n = 0; n < 2; ++n) {
                    float omf[4][4], carry[4], bmid[4];
#pragma unroll
                    for (int m = 0; m < 4; ++m) { const float r = rowscale(rowsq, slot, ai * HALF + m * 16);
#pragma unroll
                        for (int c = 0; c < 4; ++c) { const int e = 4 * n + c; const float a = acc[ai][0][m][n][c] * r, b = acc[ai][1][m][n][c] * r;
                            const float sg = fsigmoid(b), f = lbv[e] + (1.0f - lbv[e]) * sg; omf[m][c] = (1.0f - lbv[e]) * (1.0f - sg);
                            acc[ai][1][m][n][c] = __builtin_amdgcn_logf(f);
                            acc[ai][0][m][n][c] = fsilu(a); } }
#pragma unroll
                    for (int c = 0; c < 4; ++c) { carry[c] = 0.f; bmid[c] = 0.f; }
#pragma unroll
                    for (int m = 0; m < 4; ++m)
#pragma unroll
                        for (int c = 0; c < 4; ++c) { float x = row_scan16(acc[ai][1][m][n][c]) + carry[c]; acc[ai][1][m][n][c] = x;
                            carry[c] = __shfl(x, lane | 15); if (m == 1) bmid[c] = carry[c]; }
#pragma unroll
                    for (int m = 0; m < 4; ++m) { const int row = row0 + ai * HALF + m * 16; f32x4 qv, kv;
#pragma unroll
                        for (int c = 0; c < 4; ++c) { const float d = acc[ai][1][m][n][c] - bmid[c];
                            qv[c] = acc[ai][0][m][n][c] * __builtin_amdgcn_exp2f(d); kv[c] = omf[m][c] * __builtin_amdgcn_exp2f(-d); }
                        const unsigned o = (unsigned)(row * 512 + kbase);
                        u32x2 wq, wk; wq.x = cvt_pk_bf16(qv[0], qv[1]); wq.y = cvt_pk_bf16(qv[2], qv[3]); wk.x = cvt_pk_bf16(kv[0], kv[1]); wk.y = cvt_pk_bf16(kv[2], kv[3]);
                        if (n == 0) { qkeep[m] = wq; kkeep[m] = wk; }
                        else { *(u32x4*)(QT + o) = (u32x4){qkeep[m].x, qkeep[m].y, wq.x, wq.y}; *(u32x4*)(KT + o) = (u32x4){kkeep[m].x, kkeep[m].y, wk.x, wk.y}; } }
                    if (fr == 0) { const int chunk = (u.pm * BM + ai * HALF + wr * 64) >> 6; f32x4 a0, e0;
#pragma unroll
                        for (int c = 0; c < 4; ++c) { a0[c] = __builtin_amdgcn_exp2f(bmid[c]); e0[c] = __builtin_amdgcn_exp2f(carry[c] - bmid[c]); }
                        *(f32x4*)(DM + (unsigned)(chunk * 512 + kbase + 4 * n)) = a0; *(f32x4*)(DE + (unsigned)(chunk * 512 + kbase + 4 * n)) = e0; }
                    asm volatile("" ::: "memory");
                } }
        } else {
            bf16_t* dst = G + (t - 8) * 256 + wc * 32 + 8 * fq;
#pragma unroll
            for (int ai = 0; ai < 2; ++ai)
#pragma unroll
                for (int m = 0; m < 4; ++m) { const int row = row0 + ai * HALF + m * 16; const float r = rowscale(rowsq, slot, ai * HALF + m * 16);
#pragma unroll
                    for (int bj = 0; bj < 2; ++bj) *(u32x4*)(dst + (unsigned)(row * 512 + bj * HALF)) = pack8(silu4(acc[ai][bj][m][0] * r), silu4(acc[ai][bj][m][1] * r)); }
        }
    }
};
struct EpiVT {
    static constexpr bool PERM = true, AFTER_DRAIN = false, ZEROC = ZC_VT; static constexpr int SCALE = 2;
    bf16_t *VT, *VHT; const float* rowsq; const PG8_LAS float* scl;
    __device__ __forceinline__ void operator()(f32x4 (&acc)[2][2][4][2], const Unit& u, int wr, int wc, int fr, int fq) const {
        const int ch0 = (u.pm & 1) * BM + wr * 64 + fr, tok0 = u.pn * BM + wc * 32 + 8 * fq, b = tok0 >> 11, s0 = tok0 & 2047;
        f32x4 rs[2][2];
#pragma unroll
        for (int bj = 0; bj < 2; ++bj)
#pragma unroll
            for (int n = 0; n < 2; ++n) { const f32x4 q = *(const PG8_LAS f32x4*)(scl + u.par * 256 + wc * 32 + 8 * fq + bj * HALF + 4 * n);
#pragma unroll
                for (int c = 0; c < 4; ++c) rs[bj][n][c] = __builtin_amdgcn_rsqf(q[c] * (1.0f / 1024.0f) + RMS_EPS); }
        if (u.pm < 2) {
#pragma unroll
            for (int ai = 0; ai < 2; ++ai)
#pragma unroll
                for (int m = 0; m < 4; ++m) { const int ch = ch0 + ai * HALF + m * 16;
#pragma unroll
                    for (int bj = 0; bj < 2; ++bj) { const int sk = s0 + bj * HALF;
                        const unsigned o = (unsigned)((((((b * 8 + (ch >> 6)) * 32 + (sk >> 6)) * 2 + ((ch >> 5) & 1)) * 4 + ((sk >> 4) & 3)) * 64 + ((sk >> 3) & 1) * 32 + (ch & 31)) * 8);
                        *(u32x4*)(VT + o) = pack8(acc[ai][bj][m][0] * rs[bj][0], acc[ai][bj][m][1] * rs[bj][1]); } }
        } else {
            bf16_t* dst = VHT + (size_t)b * 512 * 2048 + s0;
#pragma unroll
            for (int ai = 0; ai < 2; ++ai)
#pragma unroll
                for (int m = 0; m < 4; ++m) { const int ch = ch0 + ai * HALF + m * 16;
#pragma unroll
                    for (int bj = 0; bj < 2; ++bj) *(u32x4*)(dst + (unsigned)(ch * 2048 + bj * HALF)) = pack8(acc[ai][bj][m][0] * rs[bj][0], acc[ai][bj][m][1] * rs[bj][1]); }
        }
    }
};

template <class Epi, class Sched, bool ALIGN_EPI = false, bool SP2 = false>
__device__ __forceinline__ void gemm_phase(PG8_LAS unsigned char* lds, const Gemm g, const Sched& S, const Epi& E) {
    const int tid = threadIdx.x, wid = __builtin_amdgcn_readfirstlane(tid >> 6), lane = tid & 63, wr = wid >> 2, wc = wid & 3, fr = lane & 15, fq = lane >> 4;
    const int K = g.K, nt = K / BK;
    unsigned voffA[2], voffB[2];
#pragma unroll
    for (int i = 0; i < 2; ++i) { int R, C; stage_rc(tid * 16 + i * 8192, R, C); const int Rb = (int)Epi::PERM == 2 ? ((R >> 5) * 64 + perm32(R & 31)) : Epi::PERM ? ((R & ~31) + perm32(R & 31)) : R;
        voffA[i] = (unsigned)(R * K + C) * 2u; voffB[i] = (unsigned)(Rb * K + C) * 2u; }
    const size_t kstep = (size_t)(BK * 2);
    const size_t hstep = (size_t)HALF * K * 2;
    const size_t hstepB = (int)Epi::PERM == 2 ? (size_t)32 * K * 2 : hstep;
    const size_t tstep = 2 * hstep;
    const unsigned ldsw = (unsigned)wid * 1024u;
    const int aoff = lds_byte(wr * 64 + fr, fq * 8), boff = lds_byte(wc * 32 + fr, fq * 8);
#define PG8_SA(b, h) (((b) * 2 + (h)) * HTB)
#define PG8_SB(b, h) ((4 + (b) * 2 + (h)) * HTB)
#define PG8_STAGE(bufoff, gbase, voff) do { _Pragma("unroll") for (int _i = 0; _i < 2; ++_i) \
        __builtin_amdgcn_global_load_lds((const unsigned*)((const char*)(gbase) + (voff)[_i]), (PG8_LAS unsigned*)(lds + (bufoff) + ldsw + _i * 8192), 16, 0, 0); } while (0)
#define PG8_LDA(dst, b, h) do { _Pragma("unroll") for (int m = 0; m < 4; ++m) _Pragma("unroll") for (int k = 0; k < 2; ++k) dst[m][k] = *(const PG8_LAS bf16x8*)(lds + PG8_SA(b, h) + aoff + m * 2048 + k * 1024); } while (0)
#define PG8_LDB(dst, b, h) do { _Pragma("unroll") for (int n = 0; n < 2; ++n) _Pragma("unroll") for (int k = 0; k < 2; ++k) dst[n][k] = *(const PG8_LAS bf16x8*)(lds + PG8_SB(b, h) + boff + n * 2048 + k * 1024); } while (0)
#define PG8_MMA(ai, bj, At, Bt) do { __builtin_amdgcn_s_setprio(1); _Pragma("unroll") for (int m = 0; m < 4; ++m) _Pragma("unroll") for (int n = 0; n < 2; ++n) _Pragma("unroll") for (int k = 0; k < 2; ++k) \
        acc[ai][bj][m][n] = __builtin_amdgcn_mfma_f32_16x16x32_bf16(Bt[n][k], At[m][k], acc[ai][bj][m][n], 0, 0, 0); __builtin_amdgcn_s_setprio(0); } while (0)
#define PG8_MMA_Z(ai, bj, At, Bt) do { __builtin_amdgcn_s_setprio(1); _Pragma("unroll") for (int m = 0; m < 4; ++m) _Pragma("unroll") for (int n = 0; n < 2; ++n) \
        asm volatile("v_mfma_f32_16x16x32_bf16 %0, %1, %2, 0" : "+v"(acc[ai][bj][m][n]) : "v"(Bt[n][0]), "v"(At[m][0])); \
        _Pragma("unroll") for (int m = 0; m < 4; ++m) _Pragma("unroll") for (int n = 0; n < 2; ++n) \
        acc[ai][bj][m][n] = __builtin_amdgcn_mfma_f32_16x16x32_bf16(Bt[n][1], At[m][1], acc[ai][bj][m][n], 0, 0, 0); __builtin_amdgcn_s_setprio(0); } while (0)
#define PG8_MMA0(ai, At) do { if (ZC && t == 0) { PG8_MMA_Z(ai, 0, At, B0); PG8_MMA_Z(ai, 1, At, B1); } else { PG8_MMA(ai, 0, At, B0); PG8_MMA(ai, 1, At, B1); } } while (0)
#define PG8_WAIT_V(n) asm volatile("s_waitcnt vmcnt(" #n ")" ::: "memory")
#define PG8_WAIT_L(n) asm volatile("s_waitcnt lgkmcnt(" #n ")" ::: "memory")
#define PG8_BAR __builtin_amdgcn_s_barrier()
#define PG8_SCHED __builtin_amdgcn_sched_barrier(0)
    Unit cur, nxt; int ui = 0;
    if (!S.next(0, cur)) return;
    cur.par = 0;
#define PG8_SCALE_DMA(u_) do { if (Epi::SCALE != 0 && wid == 0 && E.rowsq != nullptr) \
        __builtin_amdgcn_global_load_lds((const unsigned*)(E.rowsq + ((Epi::SCALE == 1 ? (u_).pm : (u_).pn) * BM + lane * 4)), (PG8_LAS unsigned*)(lds + STAGE_BYTES + (u_).par * 1024), 16, 0, 0); } while (0)
    PG8_SCALE_DMA(cur);
    constexpr bool ZC = SP2 && Epi::ZEROC;
    f32x4 acc[2][2][4][2];
#pragma unroll
    for (int a = 0; a < 2; ++a)
#pragma unroll
        for (int b = 0; b < 2; ++b)
#pragma unroll
            for (int m = 0; m < 4; ++m)
#pragma unroll
                for (int n = 0; n < 2; ++n) acc[a][b][m][n] = (f32x4){0.f, 0.f, 0.f, 0.f};
    bf16x8 At[4][2], B0[2][2], B1[2][2];
    const char* cA = (const char*)g.A + (size_t)cur.pm * tstep; const char* cB = (const char*)g.Bt + (size_t)cur.pn * tstep;
    S.a_ready(cur);
    if constexpr (SP2) {
        PG8_STAGE(PG8_SB(0, 0), cB, voffB); PG8_STAGE(PG8_SB(0, 1), cB + hstepB, voffB); PG8_STAGE(PG8_SA(0, 0), cA, voffA); PG8_STAGE(PG8_SA(0, 1), cA + hstep, voffA);
        if (wr == 1) PG8_BAR;
        PG8_WAIT_V(2); PG8_BAR;
        PG8_STAGE(PG8_SB(1, 0), cB + kstep, voffB); PG8_STAGE(PG8_SA(1, 0), cA + kstep, voffA); PG8_STAGE(PG8_SB(1, 1), cB + hstepB + kstep, voffB);
        PG8_WAIT_V(6); PG8_BAR;
    } else {
        PG8_STAGE(PG8_SB(0, 0), cB, voffB); PG8_STAGE(PG8_SA(0, 0), cA, voffA); PG8_STAGE(PG8_SB(0, 1), cB + hstepB, voffB); PG8_STAGE(PG8_SA(0, 1), cA + hstep, voffA);
        if (wr == 1) PG8_BAR;
        PG8_WAIT_V(4); PG8_BAR;
        PG8_STAGE(PG8_SB(1, 0), cB + kstep, voffB); PG8_STAGE(PG8_SA(1, 0), cA + kstep, voffA); PG8_STAGE(PG8_SB(1, 1), cB + hstepB + kstep, voffB);
        PG8_WAIT_V(6); PG8_BAR;
    }
    for (;;) {
        const bool has_next = S.next(ui + 1, nxt); nxt.par = (ui + 1) & 1;
        const char* nA = has_next ? (const char*)g.A + (size_t)nxt.pm * tstep : cA; const char* nB = has_next ? (const char*)g.Bt + (size_t)nxt.pn * tstep : cB;
        for (int t = 0; t < nt; t += 2) {
            const bool last = (t == nt - 2);
            const char* a1 = cA + (size_t)(t + 1) * kstep;
            const char* a2 = last ? nA : cA + (size_t)(t + 2) * kstep; const char* b2 = last ? nB : cB + (size_t)(t + 2) * kstep;
            const char* a3 = a2 + kstep; const char* b3 = b2 + kstep;
            if (last && has_next) { S.a_ready(nxt); PG8_SCALE_DMA(nxt); }
            if constexpr (SP2) {
            PG8_LDB(B0, 0, 0); PG8_LDB(B1, 0, 1); PG8_SCHED; PG8_LDA(At, 0, 0); PG8_STAGE(PG8_SA(1, 1), a1 + hstep, voffA);
            PG8_WAIT_V(8); PG8_WAIT_L(0); PG8_BAR; PG8_MMA0(0, At); PG8_BAR; PG8_SCHED;
            PG8_LDA(At, 0, 1); PG8_STAGE(PG8_SB(0, 0), b2, voffB); PG8_STAGE(PG8_SB(0, 1), b2 + hstepB, voffB); PG8_STAGE(PG8_SA(0, 0), a2, voffA);
            PG8_WAIT_V(8); PG8_WAIT_L(0); PG8_BAR; PG8_MMA0(1, At); PG8_BAR; PG8_SCHED;
            PG8_LDB(B0, 1, 0); PG8_LDB(B1, 1, 1); PG8_SCHED; PG8_LDA(At, 1, 0); PG8_STAGE(PG8_SA(0, 1), a2 + hstep, voffA);
            PG8_WAIT_V(8); PG8_WAIT_L(0); PG8_BAR; PG8_MMA(0, 0, At, B0); PG8_MMA(0, 1, At, B1); PG8_BAR; PG8_SCHED;
            PG8_LDA(At, 1, 1); PG8_STAGE(PG8_SB(1, 0), b3, voffB); PG8_STAGE(PG8_SB(1, 1), b3 + hstepB, voffB); PG8_STAGE(PG8_SA(1, 0), a3, voffA);
            PG8_WAIT_V(8); PG8_WAIT_L(0); PG8_BAR; PG8_MMA(1, 0, At, B0); PG8_MMA(1, 1, At, B1); PG8_BAR; PG8_SCHED;
            } else {
            PG8_LDB(B0, 0, 0); PG8_SCHED; PG8_LDA(At, 0, 0); PG8_STAGE(PG8_SA(1, 1), a1 + hstep, voffA);
            PG8_WAIT_L(8); PG8_BAR; PG8_WAIT_L(0); PG8_MMA(0, 0, At, B0); PG8_BAR; PG8_SCHED;
            PG8_LDB(B1, 0, 1); PG8_STAGE(PG8_SB(0, 0), b2, voffB);
            PG8_BAR; PG8_WAIT_L(0); PG8_MMA(0, 1, At, B1); PG8_BAR;
            PG8_LDA(At, 0, 1); PG8_STAGE(PG8_SA(0, 0), a2, voffA);
            PG8_BAR; PG8_WAIT_L(0); PG8_MMA(1, 0, At, B0); PG8_BAR; PG8_SCHED;
            PG8_STAGE(PG8_SB(0, 1), b2 + hstepB, voffB);
            PG8_WAIT_V(6); PG8_BAR; PG8_MMA(1, 1, At, B1); PG8_BAR;
            PG8_LDB(B0, 1, 0); PG8_SCHED; PG8_LDA(At, 1, 0); PG8_STAGE(PG8_SA(0, 1), a2 + hstep, voffA);
            PG8_WAIT_L(8); PG8_BAR; PG8_WAIT_L(0); PG8_MMA(0, 0, At, B0); PG8_BAR; PG8_SCHED;
            PG8_LDB(B1, 1, 1); PG8_STAGE(PG8_SB(1, 0), b3, voffB);
            PG8_BAR; PG8_WAIT_L(0); PG8_MMA(0, 1, At, B1); PG8_BAR;
            PG8_LDA(At, 1, 1); PG8_STAGE(PG8_SA(1, 0), a3, voffA);
            PG8_BAR; PG8_WAIT_L(0); PG8_MMA(1, 0, At, B0); PG8_BAR; PG8_SCHED;
            PG8_STAGE(PG8_SB(1, 1), b3 + hstepB, voffB);
            PG8_WAIT_V(6); PG8_BAR; PG8_MMA(1, 1, At, B1); PG8_BAR;
            }
        }
        if constexpr (ALIGN_EPI) { if (wr == 0) PG8_BAR; }
        if constexpr (!Epi::AFTER_DRAIN) { E(acc, cur, wr, wc, fr, fq); S.done(cur); }
        if (!has_next) break;
        if constexpr (!ZC) {
#pragma unroll
        for (int a = 0; a < 2; ++a)
#pragma unroll
            for (int b = 0; b < 2; ++b)
#pragma unroll
                for (int m = 0; m < 4; ++m)
#pragma unroll
                    for (int n = 0; n < 2; ++n) acc[a][b][m][n] = (f32x4){0.f, 0.f, 0.f, 0.f};
        }
        cur = nxt; cA = nA; cB = nB; ++ui;
        if constexpr (ALIGN_EPI) { if (wr == 1) PG8_BAR; }
    }
    PG8_WAIT_V(0);
    if constexpr (!ALIGN_EPI) { if (wr == 0) PG8_BAR; }
    PG8_BAR;
    if constexpr (Epi::AFTER_DRAIN) { E.fused(acc, cur, wr, wc, fr, fq, lds, wid, lane); S.done(cur); }
#undef PG8_SCALE_DMA
#undef PG8_SA
#undef PG8_SB
#undef PG8_STAGE
#undef PG8_LDA
#undef PG8_LDB
#undef PG8_MMA
#undef PG8_MMA_Z
#undef PG8_MMA0
#undef PG8_WAIT_V
#undef PG8_WAIT_L
#undef PG8_BAR
#undef PG8_SCHED
}
}

constexpr int NWAVES = 8;
#ifndef MK_N_LAUNCHES
#define MK_N_LAUNCHES 1
#endif
constexpr int PER_PHASE = 8;
constexpr int N_LAUNCHES = MK_N_LAUNCHES;
constexpr int BATCH = 16, SEQ = 2048, D = 1024, M = BATCH * SEQ, FF = 2816, NPROJ = 3584;
constexpr int AW = 512, HW = 512, NCHUNK = SEQ / 64;
constexpr float RMS_EPS = 1e-6f, LOG2E = 1.4426950408889634f;
#ifndef WGM_GU
#define WGM_GU 4
#endif
#ifndef WGM_DOWN
#define WGM_DOWN 4
#endif
#ifndef WGM_OUT
#define WGM_OUT 4
#endif
#ifndef WGM_IN
#define WGM_IN 4
#endif
#ifndef WGM_INT
#define WGM_INT 4
#endif
#ifndef REV_DOWN
#define REV_DOWN 1
#endif

constexpr size_t MiB = 1u << 20;
constexpr size_t WS_CTL = 0, CTL_ZERO_BYTES = 512 * 1024;
constexpr size_t WS_RS1 = 256 * 1024, WS_RS2 = 384 * 1024;
constexpr size_t WS_LB = 1 * MiB, WS_DM = 2 * MiB, WS_DE = 3 * MiB;
constexpr size_t WS_WGU1 = 4 * MiB, WS_WD1 = 15 * MiB, WS_WIN = 21 * MiB, WS_WINT = 26 * MiB, WS_WOUT = 28 * MiB, WS_WGU2 = 30 * MiB, WS_WD2 = 41 * MiB;
constexpr size_t WS_XB = 48 * MiB;
constexpr size_t WS_MIX = 112 * MiB;
constexpr size_t WS_HID = 176 * MiB;
constexpr size_t WS_Q = 176 * MiB, WS_K = 208 * MiB, WS_VT = 240 * MiB, WS_QT = 272 * MiB, WS_KT = 304 * MiB, WS_VHT = 336 * MiB, WS_G = 368 * MiB, WS_END = 400 * MiB;
static_assert(WS_WGU1 + (size_t)2 * FF * D * 2 <= WS_WD1 && WS_WD1 + (size_t)D * FF * 2 <= WS_WIN && WS_WIN + (size_t)2560 * D * 2 <= WS_WINT && WS_WGU2 + (size_t)2 * FF * D * 2 <= WS_WD2 && WS_WD2 + (size_t)D * FF * 2 <= WS_XB, "weight map");
static_assert(WS_HID + (size_t)M * FF * 2 <= WS_END && WS_XB + (size_t)M * D * 2 <= WS_MIX && WS_MIX + (size_t)M * D * 2 <= WS_HID, "activation map");
constexpr int CW_TMO = 0, CW_CODE = 1;
constexpr int CW_BAR = 4096;
constexpr int CW_WQ = 16384;

constexpr int RING_OFF = 0, RING_BYTES = 131072;
constexpr int LDS_BYTES = 163840;
constexpr int LDSCTL_OFF = LDS_BYTES - 1024, MISC_OFF = LDSCTL_OFF + 320;
static_assert(MISC_OFF + 128 <= LDS_BYTES, "LDS map");

#define GAS __attribute__((address_space(1)))
#define LAS __attribute__((address_space(3)))
typedef unsigned short bf16;
typedef unsigned v4u __attribute__((ext_vector_type(4)));
typedef float f32x4 __attribute__((ext_vector_type(4)));
typedef short bf16x8 __attribute__((ext_vector_type(8)));
typedef GAS unsigned gu32;
#define RLX_AGENT __ATOMIC_RELAXED, __HIP_MEMORY_SCOPE_AGENT
#define LDS_WAIT() asm volatile("s_waitcnt lgkmcnt(0)" ::: "memory")
#define VM_WAIT() asm volatile("s_waitcnt vmcnt(0)" ::: "memory")
__device__ __forceinline__ unsigned f2bf(float f) { unsigned u = __builtin_bit_cast(unsigned, f); return (u + 0x7fffu + ((u >> 16) & 1u)) >> 16; }
__device__ __forceinline__ unsigned pk2(float lo, float hi) { return f2bf(lo) | (f2bf(hi) << 16); }
__device__ __forceinline__ float bf2f(unsigned short h) { return __builtin_bit_cast(float, (unsigned)h << 16); }
__device__ __forceinline__ float bflo(unsigned w) { return __builtin_bit_cast(float, w << 16); }
__device__ __forceinline__ float bfhi(unsigned w) { return __builtin_bit_cast(float, w & 0xffff0000u); }

#define XB_TMO      128
#define XB_XCNT(j)  (256  + 64 * (j))
#define XB_XSUB(j)  (1280 + 64 * (j))
#define XB_XGEN(j)  (2304 + 64 * (j))
#define XB_TOP      3328
#define XB_TOPGEN   3392
#define XCD_BAR_WORDS 3456
#define XB_SPIN_CAP (1u << 18)

__device__ __forceinline__ unsigned xb_ld(unsigned* p)              { return __hip_atomic_load(p, __ATOMIC_RELAXED, __HIP_MEMORY_SCOPE_AGENT); }
__device__ __forceinline__ unsigned xb_add(unsigned* p, unsigned v) { return __hip_atomic_fetch_add(p, v, __ATOMIC_RELAXED, __HIP_MEMORY_SCOPE_AGENT); }
__device__ __forceinline__ unsigned xb_xcc_id() { return (unsigned)__builtin_amdgcn_s_getreg((3 << 11) | 20) & 0xFu; }
#define XB_SPIN(cond, bar) do { unsigned _sp = 0; while (cond) { __builtin_amdgcn_s_sleep(1); \
    if ((++_sp & 255u) == 0u) { if (xb_ld(&(bar)[XB_TMO])) break; if (_sp > XB_SPIN_CAP) { atomicAdd(&(bar)[XB_TMO], 1u); break; } } } } while (0)

struct XcdBarrier {
    unsigned* bar; unsigned x;
    volatile LAS unsigned* st;
};

__device__ __forceinline__ XcdBarrier xcd_barrier_post(unsigned* bar, volatile LAS unsigned* st) {
    XcdBarrier b; b.bar = bar; b.x = xb_xcc_id(); b.st = st;
    if (threadIdx.x == 0) (void)xb_add(&bar[XB_XCNT(b.x)], 1u);
    return b;
}
__device__ __forceinline__ void xcd_barrier_complete(unsigned* bar, unsigned x, unsigned& nloc, unsigned& nx) {
    const unsigned G = gridDim.x * gridDim.y * gridDim.z;
    unsigned sum, cnt, mine, sp = 0u;
    for (;;) {
        sum = 0u; cnt = 0u; mine = 0u;
#pragma unroll
        for (unsigned j = 0; j < 16; ++j) { const unsigned c = xb_ld(&bar[XB_XCNT(j)]); sum += c; cnt += (c > 0u) ? 1u : 0u; mine = (j == x) ? c : mine; }
        if (sum == G) break;
        __builtin_amdgcn_s_sleep(1);
        if ((++sp & 255u) == 0u) { if (xb_ld(&bar[XB_TMO])) break; if (sp > XB_SPIN_CAP) { atomicAdd(&bar[XB_TMO], 1u); break; } }
    }
    nloc = mine > 0u ? mine : 1u; nx = cnt > 0u ? cnt : 1u;
}

__device__ __forceinline__ void xcd_barrier(const XcdBarrier& b) {
    asm volatile("s_waitcnt vmcnt(0)" ::: "memory");
    __syncthreads();
    if (threadIdx.x == 0) {
        unsigned* bar = b.bar;
        __builtin_amdgcn_s_waitcnt(0);
        unsigned nloc = b.st[0], nx = b.st[1];
        if (nloc == 0u) { xcd_barrier_complete(bar, b.x, nloc, nx); b.st[0] = nloc; b.st[1] = nx; }
        const unsigned old = xb_add(&bar[XB_XSUB(b.x)], 1u);
        const unsigned gen = old / nloc;
        if (old + 1u == (gen + 1u) * nloc) {
            __builtin_amdgcn_fence(__ATOMIC_RELEASE, "agent");
            asm volatile("s_waitcnt vmcnt(0)" ::: "memory");
            const unsigned og = xb_add(&bar[XB_TOP], 1u);
            const unsigned tg = og / nx;
            if (og + 1u == (tg + 1u) * nx) xb_add(&bar[XB_TOPGEN], 1u);
            else XB_SPIN(xb_ld(&bar[XB_TOPGEN]) == tg, bar);
            __builtin_amdgcn_fence(__ATOMIC_ACQUIRE, "agent");
            xb_add(&bar[XB_XGEN(b.x)], 1u);
            asm volatile("s_waitcnt vmcnt(0)" ::: "memory");
        } else {
            XB_SPIN(xb_ld(&bar[XB_XGEN(b.x)]) == gen, bar);
            __builtin_amdgcn_fence(__ATOMIC_ACQUIRE, "agent");
            asm volatile("s_waitcnt vmcnt(0)" ::: "memory");
        }
    }
    __syncthreads();
}

struct Frame {
    LAS unsigned char* lds;
    volatile LAS unsigned* MISC;
    gu32* ctl;
    int tid, lane, wave, G;
    const float* in[17]; float* out; unsigned char* ws;
};
__device__ __forceinline__ float wave_sum(float v) {
#pragma unroll
    for (int o = 1; o < 64; o <<= 1) v += __shfl_xor(v, o);
    return v;
}
__device__ __forceinline__ int srccol(int kind, int R, int& sel) {
    sel = 0;
    if (kind == 0) return R;
    const int t = R >> 8, p = R & 255, bj = p >> 7, q = p & 127, wc = q >> 5, pr = pg8::perm32(q & 31);
    if (kind == 1) { sel = bj; return 128 * t + 32 * wc + pr; }
    if (kind == 2) {
        if (t < 2) return 64 * (4 * t + wc) + 32 * bj + pr;
        if (t < 4) return 512 + 64 * (4 * (t - 2) + wc) + 32 * bj + pr;
        if (t < 8) return (bj ? 2048 : 1536) + 128 * (t - 4) + 32 * wc + pr;
        return 3072 + 256 * (t - 8) + 128 * bj + 32 * wc + pr;
    }
    return R < 512 ? 1024 + R : 2560 + (R - 512);
}
struct P0Blk { f32x4 v[8]; };
__device__ __forceinline__ void p0_load(P0Blk& t, const float* W0, const float* W1, int N, int kind, int item, int nblk, int lane) {
    const int kb = item / nblk, nb = item % nblk, k0 = 64 * kb + 8 * (lane >> 3), R = 32 * nb + 4 * (lane & 7);
    int sel; const int c = srccol(kind, R, sel);
    const float* W = (sel ? W1 : W0) + (size_t)k0 * N + c;
#pragma unroll
    for (int i = 0; i < 8; ++i) t.v[i] = *(const f32x4*)(W + (size_t)i * N);
}
__device__ __forceinline__ void p0_store(const P0Blk& t, int K, bf16* WT, const float* gain, int kind, int item, int nblk, int lane) {
    const int kb = item / nblk, nb = item % nblk, k0 = 64 * kb + 8 * (lane >> 3), R = 32 * nb + 4 * (lane & 7);
    float gk[8];
    const float ws = kind == 1 ? (((R >> 7) & 1) ? 1.0f / LOG2E : LOG2E) : 1.0f;
#pragma unroll
    for (int i = 0; i < 8; ++i) gk[i] = ws;
    if (gain) { const f32x4 g0 = *(const f32x4*)(gain + k0), g1 = *(const f32x4*)(gain + k0 + 4);
#pragma unroll
        for (int i = 0; i < 4; ++i) { gk[i] = g0[i] * ws; gk[4 + i] = g1[i] * ws; } }
#pragma unroll
    for (int j = 0; j < 4; ++j) { v4u o; o.x = pk2(t.v[0][j] * gk[0], t.v[1][j] * gk[1]); o.y = pk2(t.v[2][j] * gk[2], t.v[3][j] * gk[3]); o.z = pk2(t.v[4][j] * gk[4], t.v[5][j] * gk[5]); o.w = pk2(t.v[6][j] * gk[6], t.v[7][j] * gk[7]);
        *(GAS v4u*)(WT + (size_t)(R + j) * K + k0) = o; }
}
struct P0Job { const float* W0; const float* W1; const float* gain; bf16* WT; int K, N, kind, nblk, item; };
constexpr int P0_I_GU = (D / 64) * (2 * FF / 32), P0_I_D = (FF / 64) * (D / 32), P0_I_IN = (D / 64) * (2560 / 32), P0_I_INT = (D / 64) * (1024 / 32), P0_I_O = (D / 64) * (D / 32);
constexpr int P0_N0 = P0_I_GU + P0_I_D + P0_I_IN + P0_I_INT, P0_N1 = P0_I_GU + P0_I_D + P0_I_O;
__device__ __forceinline__ P0Job p0_job(Frame& F, int set, int it) {
    int r = it;
    if (set == 0) {
        if (r < P0_I_GU) return P0Job{F.in[2], F.in[3], nullptr, (bf16*)(F.ws + WS_WGU1), D, FF, 1, 2 * FF / 32, r}; r -= P0_I_GU;
        if (r < P0_I_D) return P0Job{F.in[4], F.in[4], nullptr, (bf16*)(F.ws + WS_WD1), FF, D, 0, D / 32, r}; r -= P0_I_D;
        if (r < P0_I_IN) return P0Job{F.in[6], F.in[6], F.in[5], (bf16*)(F.ws + WS_WIN), D, NPROJ, 2, 2560 / 32, r}; r -= P0_I_IN;
        return P0Job{F.in[6], F.in[6], F.in[5], (bf16*)(F.ws + WS_WINT), D, NPROJ, 3, 1024 / 32, r};
    }
    if (r < P0_I_GU) return P0Job{F.in[14], F.in[15], F.in[13], (bf16*)(F.ws + WS_WGU2), D, FF, 1, 2 * FF / 32, r}; r -= P0_I_GU;
    if (r < P0_I_D) return P0Job{F.in[16], F.in[16], nullptr, (bf16*)(F.ws + WS_WD2), FF, D, 0, D / 32, r}; r -= P0_I_D;
    return P0Job{F.in[12], F.in[12], nullptr, (bf16*)(F.ws + WS_WOUT), D, D, 0, D / 32, r};
}
__device__ __forceinline__ void p0_weights(Frame& F, int set, int gw, int NGW, int hi = 0x7fffffff) {
    const int NIT0 = set == 0 ? P0_N0 : P0_N1, NIT = NIT0 < hi ? NIT0 : hi;
    int it = gw;
    if (it < NIT) {
        P0Job j0 = p0_job(F, set, it); P0Blk t0; p0_load(t0, j0.W0, j0.W1, j0.N, j0.kind, j0.item, j0.nblk, F.lane);
        for (;;) {
            const int it1 = it + NGW; const bool more = it1 < NIT;
            P0Job j1 = j0; P0Blk t1;
            if (more) { j1 = p0_job(F, set, it1); p0_load(t1, j1.W0, j1.W1, j1.N, j1.kind, j1.item, j1.nblk, F.lane); }
            p0_store(t0, j0.K, j0.WT, j0.gain, j0.kind, j0.item, j0.nblk, F.lane);
            if (!more) break;
            it = it1; j0 = j1;
#pragma unroll
            for (int i = 0; i < 8; ++i) t0.v[i] = t1.v[i];
        }
    }
}
__device__ __forceinline__ void rms_rows4_to_bf16(const float* x, const float* g, bf16* o, int lane) {
    f32x4 v[4][4]; float s[4];
#pragma unroll
    for (int r = 0; r < 4; ++r)
#pragma unroll
        for (int j = 0; j < 4; ++j) v[r][j] = *((const GAS f32x4*)(x + (size_t)r * D) + lane + 64 * j);
#pragma unroll
    for (int r = 0; r < 4; ++r) { s[r] = 0.f;
#pragma unroll
        for (int j = 0; j < 4; ++j) s[r] += (v[r][j].x * v[r][j].x + v[r][j].y * v[r][j].y) + (v[r][j].z * v[r][j].z + v[r][j].w * v[r][j].w); }
#pragma unroll
    for (int of = 1; of < 64; of <<= 1) {
#pragma unroll
        for (int r = 0; r < 4; ++r) s[r] += __shfl_xor(s[r], of); }
    f32x4 gg[4];
#pragma unroll
    for (int j = 0; j < 4; ++j) gg[j] = *((const GAS f32x4*)g + lane + 64 * j);
#pragma unroll
    for (int r = 0; r < 4; ++r) { const float rr = __builtin_amdgcn_rsqf(s[r] * (1.f / D) + RMS_EPS);
        GAS unsigned long long* o8 = (GAS unsigned long long*)(o + (size_t)r * D) + lane;
#pragma unroll
        for (int j = 0; j < 4; ++j) o8[64 * j] = (unsigned long long)pk2(v[r][j].x * rr * gg[j].x, v[r][j].y * rr * gg[j].y) | ((unsigned long long)pk2(v[r][j].z * rr * gg[j].z, v[r][j].w * rr * gg[j].w) << 32); }
}
#ifndef P0_STATIC_ROWS
#define P0_TICKET 1
#endif
#ifndef P4_STATIC_WEIGHTS
#define P4_DEAL_WEIGHTS 1
#endif
#ifndef P0_STAT_SWEEPS
#define P0_STAT_SWEEPS 0
#endif
__device__ __forceinline__ void p0_prologue(Frame& F, unsigned long long& p0_probe) {
    const int gw = (int)blockIdx.x * NWAVES + F.wave, NGW = F.G * NWAVES;
#if defined(PROBE_PHASE) && (PROBE_PHASE == 13 || PROBE_PHASE == 14)
    const unsigned long long p0_t0 = __builtin_amdgcn_s_memrealtime();
#endif
#ifdef P0_TICKET
    if (F.tid == 0) F.MISC[18] = __hip_atomic_fetch_add(F.ctl + 13, 1u, RLX_AGENT);
#endif
    p0_weights(F, 0, gw, NGW);
#if defined(PROBE_PHASE) && (PROBE_PHASE == 13 || PROBE_PHASE == 14)
    const unsigned long long tp1_ = __builtin_amdgcn_s_memrealtime();
    if (PROBE_PHASE == 13) p0_probe = tp1_ - p0_t0;
#endif
#ifdef P0_TICKET
    { const int NRG = M / 4, NSTAT = P0_STAT_SWEEPS * NGW < NRG ? P0_STAT_SWEEPS * NGW : NRG, NITEM = (NRG - NSTAT) / NWAVES;
      for (int rg = gw; rg < NSTAT; rg += NGW) rms_rows4_to_bf16(F.in[0] + (size_t)rg * 4 * D, F.in[1], (bf16*)(F.ws + WS_XB) + (size_t)rg * 4 * D, F.lane);
      __syncthreads();
      for (int k = 0;; ++k) {
          const unsigned it = F.MISC[18 + (k & 1)];
          if (it >= (unsigned)NITEM) break;
          if (F.tid == 0) F.MISC[18 + ((k + 1) & 1)] = __hip_atomic_fetch_add(F.ctl + 13, 1u, RLX_AGENT);
          const int rg = NSTAT + (int)it * NWAVES + F.wave;
          rms_rows4_to_bf16(F.in[0] + (size_t)rg * 4 * D, F.in[1], (bf16*)(F.ws + WS_XB) + (size_t)rg * 4 * D, F.lane);
          __syncthreads(); } }
#else
    for (int m = 4 * gw; m < M; m += 4 * NGW) rms_rows4_to_bf16(F.in[0] + (size_t)m * D, F.in[1], (bf16*)(F.ws + WS_XB) + (size_t)m * D, F.lane);
#endif
#if defined(PROBE_PHASE) && (PROBE_PHASE == 13 || PROBE_PHASE == 14)
    if (PROBE_PHASE == 14) p0_probe = __builtin_amdgcn_s_memrealtime() - tp1_;
#endif
    if (blockIdx.x == 0) {
        const float l0 = F.in[10][F.tid], l1 = F.in[10][512 + F.tid], mx = fmaxf(l0, l1), e0 = __expf(l0 - mx), e1 = __expf(l1 - mx);
        ((float*)(F.ws + WS_LB))[F.tid] = e0 / (e0 + e1);
    }
}

typedef float f32x16 __attribute__((ext_vector_type(16)));
typedef float f32x2_t __attribute__((ext_vector_type(2))); typedef __bf16 bf16x2_t __attribute__((ext_vector_type(2)));
__device__ __forceinline__ unsigned cvtpk_s(float lo, float hi) { f32x2_t v = {lo, hi}; bf16x2_t b = __builtin_convertvector(v, bf16x2_t); return __builtin_bit_cast(unsigned, b); }
__device__ __forceinline__ bf16x8 pack_step(const f32x16& x, int s) { v4u p; p.x = cvtpk_s(x[8 * s], x[8 * s + 1]); p.y = cvtpk_s(x[8 * s + 2], x[8 * s + 3]); p.z = cvtpk_s(x[8 * s + 4], x[8 * s + 5]); p.w = cvtpk_s(x[8 * s + 6], x[8 * s + 7]); return __builtin_bit_cast(bf16x8, p); }
__device__ __forceinline__ float swapmax(float m) { auto rr = __builtin_amdgcn_permlane32_swap(__float_as_uint(m), __float_as_uint(m), false, false); return fmaxf(__uint_as_float(rr[0]), __uint_as_float(rr[1])); }
__device__ __forceinline__ float swapsum(float m) { auto rr = __builtin_amdgcn_permlane32_swap(__float_as_uint(m), __float_as_uint(m), false, false); return __uint_as_float(rr[0]) + __uint_as_float(rr[1]); }
__device__ __forceinline__ int pi32(int x) { return (x & 0x13) | ((x & 4) << 1) | ((x & 8) >> 1); }
#define MFMA32(a, b, c) __builtin_amdgcn_mfma_f32_32x32x16_bf16((a), (b), (c), 0, 0, 0)
constexpr int ATT_ETAB_OFF = 0;
__device__ __forceinline__ void attn_item(Frame& F, int b, int c, int h, const LAS float* etab) {
    const bf16* Q = (const bf16*)(F.ws + WS_Q); const bf16* Kp = (const bf16*)(F.ws + WS_K); const bf16* VT = (const bf16*)(F.ws + WS_VT); bf16* MIX = (bf16*)(F.ws + WS_MIX);
    const int lane = F.lane, r32 = lane & 31, hi = lane >> 5;
    const float cfar = F.in[9][h * 257 + 256] * LOG2E;
    bf16x8 qf[2][4];
#pragma unroll
    for (int qb = 0; qb < 2; ++qb)
#pragma unroll
        for (int d0 = 0; d0 < 4; ++d0) qf[qb][d0] = *(const bf16x8*)(Q + (unsigned)((((((b * 8 + h) * 32 + c) * 2 + qb) * 4 + d0) * 64 + lane) * 8));
    f32x16 o[2][2];
#pragma unroll
    for (int db = 0; db < 2; ++db)
#pragma unroll
        for (int qb = 0; qb < 2; ++qb)
#pragma unroll
            for (int r = 0; r < 16; ++r) o[db][qb][r] = 0.f;
    float mrun[2] = {-INFINITY, -INFINITY}, lrun[2] = {0.f, 0.f};
    const int kt0 = c >= 8 ? c - 8 : 0;
    const unsigned fbase = (unsigned)(((b * 8 + h) * 32 * 8 * 64 + lane) * 8);
    const LAS float* et = etab + h * 256;
    bf16x8 kf[2][4], vf[2][4];
#define AT_LOADK(kt_) do { _Pragma("unroll") for (int kb = 0; kb < 2; ++kb) _Pragma("unroll") for (int d0 = 0; d0 < 4; ++d0) kf[kb][d0] = *(const bf16x8*)(Kp + fbase + (unsigned)((((kt_) * 2 + kb) * 4 + d0) * 512)); } while (0)
#define AT_LOADV(kt_) do { _Pragma("unroll") for (int db = 0; db < 2; ++db) _Pragma("unroll") for (int ks = 0; ks < 4; ++ks) vf[db][ks] = *(const bf16x8*)(VT + fbase + (unsigned)((((kt_) * 2 + db) * 4 + ks) * 512)); } while (0)
    AT_LOADK(kt0); AT_LOADV(kt0);
    for (int kt = kt0; kt <= c; ++kt) {
        const int j = c - kt, ktn = kt < c ? kt + 1 : c;
#pragma unroll
        for (int qb = 0; qb < 2; ++qb) {
            f32x16 s[2]; bf16x8 pk[2][2];
            const float c0 = j >= 3 ? cfar : 0.f;
#pragma unroll
            for (int r = 0; r < 16; ++r) { s[0][r] = c0; s[1][r] = c0; }
#pragma unroll
            for (int d0 = 0; d0 < 4; ++d0) { s[0] = MFMA32(kf[0][d0], qf[qb][d0], s[0]); s[1] = MFMA32(kf[1][d0], qf[qb][d0], s[1]); }
            if (qb == 1) { __builtin_amdgcn_sched_barrier(0); AT_LOADK(ktn); __builtin_amdgcn_sched_barrier(0); }
            if (j < 3) {
                const int ib = 64 * j + 32 * qb + r32 - 8 * hi + 63;
#pragma unroll
                for (int kb = 0; kb < 2; ++kb)
#pragma unroll
                    for (int r = 0; r < 16; ++r) s[kb][r] += et[ib - 32 * kb - 16 * (r >> 3) - (r & 7)];
            }
            float tm = fmaxf(s[0][0], s[1][0]);
#pragma unroll
            for (int r = 1; r < 16; ++r) tm = fmaxf(tm, fmaxf(s[0][r], s[1][r]));
            tm = swapmax(tm);
            const float mn = fmaxf(mrun[qb], tm), alpha = __builtin_amdgcn_exp2f(mrun[qb] - mn); mrun[qb] = mn;
            float ls = 0.f;
#pragma unroll
            for (int kb = 0; kb < 2; ++kb)
#pragma unroll
                for (int r = 0; r < 16; ++r) { const float p = __builtin_amdgcn_exp2f(s[kb][r] - mn); s[kb][r] = p; ls += p; }
            lrun[qb] = lrun[qb] * alpha + ls;
#pragma unroll
            for (int db = 0; db < 2; ++db)
#pragma unroll
                for (int r = 0; r < 16; ++r) o[db][qb][r] *= alpha;
#pragma unroll
            for (int kb = 0; kb < 2; ++kb) { pk[kb][0] = pack_step(s[kb], 0); pk[kb][1] = pack_step(s[kb], 1); }
#pragma unroll
            for (int db = 0; db < 2; ++db)
#pragma unroll
                for (int kb = 0; kb < 2; ++kb)
#pragma unroll
                    for (int sp = 0; sp < 2; ++sp) o[db][qb] = MFMA32(vf[db][2 * kb + sp], pk[kb][sp], o[db][qb]);
        }
        __builtin_amdgcn_sched_barrier(0); AT_LOADV(ktn); __builtin_amdgcn_sched_barrier(0);
    }
#undef AT_LOADK
#undef AT_LOADV
#pragma unroll
    for (int qb = 0; qb < 2; ++qb) {
        const float inv = 1.0f / swapsum(lrun[qb]);
        bf16* orow = MIX + (unsigned)((b * SEQ + 64 * c + 32 * qb + r32) * 1024 + h * 64 + 16 * hi);
#pragma unroll
        for (int db = 0; db < 2; ++db) {
            unsigned wx[4], wy[4];
#pragma unroll
            for (int g = 0; g < 4; ++g) { wx[g] = cvtpk_s(o[db][qb][4 * g] * inv, o[db][qb][4 * g + 1] * inv); wy[g] = cvtpk_s(o[db][qb][4 * g + 2] * inv, o[db][qb][4 * g + 3] * inv); }
#pragma unroll
            for (int p = 0; p < 2; ++p) {
                auto ax = __builtin_amdgcn_permlane32_swap(wx[p], wx[p + 2], false, false); auto ay = __builtin_amdgcn_permlane32_swap(wy[p], wy[p + 2], false, false);
                *(v4u*)(orow + 32 * db + 8 * p) = (v4u){ax[0], ay[0], ax[1], ay[1]}; }
        }
    }
}
__device__ __forceinline__ void attn_phase(Frame& F) {
    LAS float* etab = (LAS float*)(F.lds + RING_OFF + ATT_ETAB_OFF);
    for (int i = F.tid; i < 8 * 256; i += NWAVES * 64) { const int h = i >> 8; int rel = (i & 255) - 63; rel = rel > 128 ? 128 : rel; etab[i] = F.in[9][h * 257 + rel + 128] * LOG2E; }
    __syncthreads();
    for (int k = 0; k < 8; ++k) {
        const int shard = ((int)blockIdx.x + k) & 7;
        gu32* head = F.ctl + CW_WQ + 64 * shard;
        for (;;) {
            unsigned n = 0; if (F.lane == 0) n = __hip_atomic_fetch_add(head, 1u, RLX_AGENT);
            n = (unsigned)__builtin_amdgcn_readfirstlane((int)n);
            if (n >= 512u) break;
            const int bh = 8 * (int)(n >> 5) + shard, c = 31 - (int)(n & 31);
            attn_item(F, bh >> 3, c, bh & 7, etab);
        }
    }
    __syncthreads();
}

__device__ __forceinline__ unsigned off_b(unsigned row, unsigned ch) { return 256u * row + 16u * (ch ^ (((row & 3) << 2) | ((row >> 2) & 3))); }
__device__ __forceinline__ unsigned tr_read_addr_b(unsigned lane, unsigned c, unsigned ks, unsigned t) {
    const unsigned h = lane >> 5, blk = (lane >> 4) & 1, q = (lane & 15) >> 2, p = lane & 3;
    return off_b(16 * ks + 8 * h + 4 * t + q, 4 * c + 2 * blk + (p >> 1)) + 8 * (p & 1);
}
typedef short v4i16_t __attribute__((ext_vector_type(4)));
__device__ __forceinline__ v4i16_t lds_tr(const LAS unsigned char* p) { return __builtin_amdgcn_ds_read_tr16_b64_v4i16((LAS v4i16_t*)p); }
__device__ __forceinline__ bf16x8 krow_frag(bf16x8 nat) {
    const v4u d = __builtin_bit_cast(v4u, nat);
    auto a = __builtin_amdgcn_permlane32_swap(d.x, d.z, false, false); auto b = __builtin_amdgcn_permlane32_swap(d.y, d.w, false, false);
    v4u r; r.x = a[0]; r.y = b[0]; r.z = a[1]; r.w = b[1]; return __builtin_bit_cast(bf16x8, r);
}
constexpr int HG_PS_OFF = 8192, HG_DD_OFF = 10240, HG_GN_OFF = 12288, HG_BUF_OFF = 16384;
#ifndef HG_DMA_LATE
#define HG_DMA_EARLY 1
#endif
#ifndef HG_DMA_WAIT_FIRST
#define HG_DMA_ISSUE_FIRST 1
#endif
#ifndef HG_FIN_SPLIT
#define HG_FIN_SPLIT 4
#endif
#if !defined(HG_DMA_EARLY) && !defined(HG_FIN_BEFORE_MID)
#define HG_FIN_AFTER_MID 1
#endif
constexpr int HG_QT_OFF = 16384, HG_VT_OFF = 32768, HG_BUF_BYTES = 49152;
constexpr int HG_OX_OFF = HG_BUF_OFF + 2 * HG_BUF_BYTES, HG_OX_BYTES = 64 * 264;
constexpr int HG_XS_OFF = HG_OX_OFF + 2 * HG_OX_BYTES;
static_assert(HG_XS_OFF + 3 * 2048 <= LDSCTL_OFF && HG_OX_OFF % 16 == 0 && HG_XS_OFF % 16 == 0, "HGRN LDS map");
__device__ __forceinline__ void dma16(const void* g, LAS unsigned char* l) { __builtin_amdgcn_global_load_lds((const unsigned*)g, (LAS unsigned*)l, 16, 0, 0); }
template <int Q0, int Q1> __device__ __forceinline__ void hgrn_finalize(Frame& F, const v4u (&gw)[4], int b, int hh, int c) {
    bf16* MIX = (bf16*)(F.ws + WS_MIX);
    const int ht = F.tid - 256, tok = ht >> 2, pc = ht & 3;
    const LAS float* ps = (const LAS float*)(F.lds + RING_OFF + HG_PS_OFF) + ((c & 1) * 2 + (tok >> 5)) * 128 + (tok & 31);
    const float tot = (ps[0] + ps[32]) + (ps[64] + ps[96]);
    const float rs = __builtin_amdgcn_rsqf(tot * (1.0f / 128.0f) + RMS_EPS);
    const LAS unsigned char* ox = F.lds + RING_OFF + HG_OX_OFF + (c & 1) * HG_OX_BYTES + tok * 264 + 64 * pc;
    const LAS f32x4* gn = (const LAS f32x4*)(F.lds + RING_OFF + HG_GN_OFF) + 8 * pc;
    bf16* dst = MIX + (unsigned)((b * SEQ + 64 * c + tok) * 1024 + 512 + hh * 128 + 32 * pc);
#pragma unroll
    for (int q = Q0; q < Q1; ++q) { unsigned ow[4]; const unsigned g4w[4] = {gw[q].x, gw[q].y, gw[q].z, gw[q].w};
#pragma unroll
        for (int i = 0; i < 2; ++i) { const pg8::u32x2 o2 = *(const LAS pg8::u32x2*)(ox + 16 * q + 8 * i); const f32x4 g4 = gn[2 * q + i];
            ow[2 * i] = cvtpk_s(bflo(o2.x) * rs * g4[0] * bflo(g4w[2 * i]), bfhi(o2.x) * rs * g4[1] * bfhi(g4w[2 * i]));
            ow[2 * i + 1] = cvtpk_s(bflo(o2.y) * rs * g4[2] * bflo(g4w[2 * i + 1]), bfhi(o2.y) * rs * g4[3] * bfhi(g4w[2 * i + 1])); }
        *(v4u*)(dst + 8 * q) = (v4u){ow[0], ow[1], ow[2], ow[3]}; }
}
__device__ __forceinline__ void hgrn_phase(Frame& F, int bh, unsigned long long& hg_wait_acc) {
    const unsigned char* QT = F.ws + WS_QT; const unsigned char* KT = F.ws + WS_KT; const unsigned char* VHT = F.ws + WS_VHT; const bf16* Gt = (const bf16*)(F.ws + WS_G);
    const unsigned char* DM = F.ws + WS_DM; const unsigned char* DE = F.ws + WS_DE;
    const int b = bh >> 2, hh = bh & 3, lane = F.lane, r32 = lane & 31, hi = lane >> 5, w = F.wave, tid = F.tid;
    LAS unsigned char* const bufs = F.lds + RING_OFF + HG_BUF_OFF;
    LAS float* const psw = (LAS float*)(F.lds + RING_OFF + HG_PS_OFF);
    LAS float* const ddw = (LAS float*)(F.lds + RING_OFF + HG_DD_OFF);
    if (tid < 128) ((LAS float*)(F.lds + RING_OFF + HG_GN_OFF))[tid] = F.in[11][tid];
    if (w >= 4) {
        const int hw = w - 4;
        unsigned so_k[4], so_v[4];
#pragma unroll
        for (int j = 0; j < 4; ++j) { const unsigned ii = (unsigned)(hw + 4 * j), sl = ii * 64 + lane;
            { const unsigned img = sl >> 9, s9 = sl & 511, row = s9 >> 4, ch = (s9 & 15) ^ (((row & 3) << 2) | ((row >> 2) & 3)); so_k[j] = ((32 * img + row) * 512 + hh * 128) * 2 + ch * 16; }
            { const unsigned row = sl >> 3, ch = (sl & 7) ^ (row & 7); so_v[j] = ((hh * 128 + row) * SEQ) * 2 + ch * 16; } }
        const unsigned so_d = (unsigned)((hh * 128) * 4 + (lane & 31) * 16);
        const unsigned char* const ddsrc = (lane < 32 ? DM : DE) + (size_t)(b * NCHUNK) * 2048 + so_d;
        const unsigned char* const ktb = KT + (size_t)(b * SEQ) * 1024; const unsigned char* const qtb = QT + (size_t)(b * SEQ) * 1024; const unsigned char* const vtb = VHT + (size_t)(b * 512) * SEQ * 2;
#define HG_DMA(c_) do { LAS unsigned char* nb_ = bufs + ((c_) & 1) * HG_BUF_BYTES + hw * 1024; const size_t ck_ = (size_t)(c_) * 65536, cv_ = (size_t)(c_) * 128; \
        _Pragma("unroll") for (int j_ = 0; j_ < 4; ++j_) { dma16(ktb + ck_ + so_k[j_], nb_ + j_ * 4096); dma16(qtb + ck_ + so_k[j_], nb_ + HG_QT_OFF + j_ * 4096); dma16(vtb + cv_ + so_v[j_], nb_ + HG_VT_OFF + j_ * 4096); } \
        if (hw == 0) dma16(ddsrc + (size_t)(c_) * 2048, (LAS unsigned char*)(ddw + ((c_) & 1) * 256)); } while (0)
        const unsigned src_g = (unsigned)((b * SEQ + ((tid - 256) >> 2)) * 512 + hh * 128 + 32 * (tid & 3));
        const unsigned rk_ = (unsigned)pi32(r32), sk_ = ((rk_ & 3) << 2) | ((rk_ >> 2) & 3), sq_ = (((unsigned)r32 & 3) << 2) | (((unsigned)r32 >> 2) & 3);
        const unsigned kt_base = 256u * rk_ + 16u * ((unsigned)hi ^ (sk_ & 1)), kt_e = sk_ >> 1, qt_base = (unsigned)HG_QT_OFF + 256u * (unsigned)r32 + 16u * ((unsigned)hi ^ (sq_ & 1)), qt_e = sq_ >> 1;
#ifdef HG_DMA_EARLY
        HG_DMA(0); HG_DMA(1);
#else
        HG_DMA(0);
#endif
        v4u gcur[4] = {(v4u){0u, 0u, 0u, 0u}, (v4u){0u, 0u, 0u, 0u}, (v4u){0u, 0u, 0u, 0u}, (v4u){0u, 0u, 0u, 0u}};
        asm volatile("s_waitcnt vmcnt(0) lgkmcnt(0)" ::: "memory"); __builtin_amdgcn_s_barrier(); asm volatile("" ::: "memory");
        for (int c = 0; c <= NCHUNK; ++c) {
#if defined(PROBE_PHASE) && PROBE_PHASE >= 30 && PROBE_PHASE <= 33
            const unsigned long long hq0_ = __builtin_amdgcn_s_memrealtime();
#endif
#ifndef HG_DMA_EARLY
            if (c + 1 < NCHUNK) HG_DMA(c + 1);
#endif
            v4u gnxt[4]; { const bf16* gcp = Gt + (size_t)((c < NCHUNK ? c : NCHUNK - 1) * 64 * 512);
#pragma unroll
                for (int q = 0; q < 4; ++q) gnxt[q] = *(const v4u*)(gcp + src_g + 8 * q); }
#if defined(PROBE_PHASE) && PROBE_PHASE >= 30 && PROBE_PHASE <= 33
            const unsigned long long hq1_ = __builtin_amdgcn_s_memrealtime();
#endif
            if (hw < 3 && c < NCHUNK) {
                const LAS unsigned char* buf = bufs + (c & 1) * HG_BUF_BYTES;
                const int sbx = hw >> 1, tbx = (hw + 1) >> 1;
                unsigned ek = kt_e, eq = qt_e; asm volatile("" : "+v"(ek), "+v"(eq));
                f32x16 X;
#pragma unroll
                for (int r = 0; r < 16; ++r) X[r] = 0.f;
#pragma unroll
                for (int ks = 0; ks < 8; ++ks) { const bf16x8 kf = *(const LAS bf16x8*)(buf + sbx * 8192 + kt_base + (((unsigned)ks ^ ek) << 5)), qf = *(const LAS bf16x8*)(buf + tbx * 8192 + qt_base + (((unsigned)ks ^ eq) << 5)); X = MFMA32(kf, qf, X); }
                if (sbx == tbx) {
                    int thr = r32 - 8 * hi; asm volatile("" : "+v"(thr));
#pragma unroll
                    for (int r = 0; r < 16; ++r) X[r] = thr >= 16 * (r >> 3) + (r & 7) ? X[r] : 0.f;
                }
                LAS unsigned char* xw = F.lds + RING_OFF + HG_XS_OFF + hw * 2048 + lane * 16;
                *(LAS bf16x8*)xw = pack_step(X, 0); *(LAS bf16x8*)(xw + 1024) = pack_step(X, 1);
            }
#if defined(PROBE_PHASE) && PROBE_PHASE >= 30 && PROBE_PHASE <= 33
            asm volatile("s_waitcnt lgkmcnt(0)" ::: "memory"); const unsigned long long hq2_ = __builtin_amdgcn_s_memrealtime();
#endif
#ifndef HG_FIN_AFTER_MID
            if (c > 0) hgrn_finalize<0, HG_FIN_SPLIT>(F, gcur, b, hh, c - 1);
#endif
#if defined(PROBE_PHASE) && PROBE_PHASE >= 30 && PROBE_PHASE <= 33
            { asm volatile("s_waitcnt lgkmcnt(0)" ::: "memory"); const unsigned long long hq3_ = __builtin_amdgcn_s_memrealtime();
              hg_wait_acc += PROBE_PHASE == 30 ? hq1_ - hq0_ : PROBE_PHASE == 31 ? hq2_ - hq1_ : PROBE_PHASE == 32 ? hq3_ - hq2_ : hq3_ - hq0_; }
#endif
            asm volatile("s_waitcnt lgkmcnt(0)" ::: "memory"); __builtin_amdgcn_s_barrier(); asm volatile("" ::: "memory");
#ifdef HG_FIN_AFTER_MID
            if (c > 0) hgrn_finalize<0, 4>(F, gcur, b, hh, c - 1);
#endif
#ifdef HG_DMA_EARLY
#ifdef HG_DMA_ISSUE_FIRST
            if (c + 2 < NCHUNK) { HG_DMA(c + 2); if (hw == 0) asm volatile("s_waitcnt vmcnt(13)" ::: "memory"); else asm volatile("s_waitcnt vmcnt(12)" ::: "memory"); }
            else asm volatile("s_waitcnt vmcnt(0)" ::: "memory");
#else
            asm volatile("s_waitcnt vmcnt(0)" ::: "memory");
            if (c + 2 < NCHUNK) HG_DMA(c + 2);
#endif
            if (HG_FIN_SPLIT < 4 && c > 0) hgrn_finalize<HG_FIN_SPLIT, 4>(F, gcur, b, hh, c - 1);
            asm volatile("s_waitcnt lgkmcnt(0)" ::: "memory"); __builtin_amdgcn_s_barrier(); asm volatile("" ::: "memory");
#else
            asm volatile("s_waitcnt vmcnt(0) lgkmcnt(0)" ::: "memory"); __builtin_amdgcn_s_barrier(); asm volatile("" ::: "memory");
#endif
#pragma unroll
            for (int q = 0; q < 4; ++q) gcur[q] = gnxt[q];
        }
#undef HG_DMA
    } else {
        const int vb = w;
        f32x16 S[4];
#pragma unroll
        for (int kb = 0; kb < 4; ++kb)
#pragma unroll
            for (int r = 0; r < 16; ++r) S[kb][r] = 0.f;
        const unsigned rk_ = (unsigned)pi32(r32), sk_ = ((rk_ & 3) << 2) | ((rk_ >> 2) & 3), sq_ = (((unsigned)r32 & 3) << 2) | (((unsigned)r32 >> 2) & 3);
        const unsigned kt_base = 256u * rk_ + 16u * ((unsigned)hi ^ (sk_ & 1)), kt_e = sk_ >> 1, qt_base = (unsigned)HG_QT_OFF + 256u * (unsigned)r32 + 16u * ((unsigned)hi ^ (sq_ & 1)), qt_e = sq_ >> 1;
        unsigned rd_tr[4][2], rd_vt[4];
#pragma unroll
        for (int kb = 0; kb < 4; ++kb) { rd_tr[kb][0] = tr_read_addr_b((unsigned)lane, (unsigned)kb, 0u, 0u); rd_tr[kb][1] = tr_read_addr_b((unsigned)lane, (unsigned)kb, 0u, 1u); }
#pragma unroll
        for (int k4 = 0; k4 < 4; ++k4) rd_vt[k4] = (unsigned)(HG_VT_OFF + (32 * vb + r32) * 128 + (((2 * k4 + hi) ^ (r32 & 7)) << 4));
        const unsigned wr_ox = (unsigned)(HG_OX_OFF + r32 * 264 + (32 * vb + 4 * hi) * 2);
        asm volatile("s_waitcnt vmcnt(0) lgkmcnt(0)" ::: "memory"); __builtin_amdgcn_s_barrier(); asm volatile("" ::: "memory");
        for (int c = 0; c <= NCHUNK; ++c) {
            const LAS unsigned char* buf = bufs + (c & 1) * HG_BUF_BYTES;
            f32x16 o[2]; bf16x8 vfr[4];
            if (c < NCHUNK) {
            const LAS float* dd = ddw + (c & 1) * 256 + 4 * hi;
#pragma unroll
            for (int kb = 0; kb < 4; ++kb)
#pragma unroll
                for (int g = 0; g < 4; ++g) { const f32x4 a = *(const LAS f32x4*)(dd + 32 * kb + 8 * g);
#pragma unroll
                    for (int i = 0; i < 4; ++i) S[kb][4 * g + i] *= a[i]; }
            unsigned ek = kt_e, eq = qt_e; asm volatile("" : "+v"(ek), "+v"(eq));
#define HG_RDKT(ks_) (kt_base + (((unsigned)(ks_) ^ ek) << 5))
#define HG_RDQT(ks_) (qt_base + (((unsigned)(ks_) ^ eq) << 5))
            __builtin_amdgcn_sched_barrier(0);
#pragma unroll
            for (int k4 = 0; k4 < 4; ++k4) vfr[k4] = *(const LAS bf16x8*)(buf + rd_vt[k4]);
#pragma unroll
            for (int r = 0; r < 16; ++r) { o[0][r] = 0.f; o[1][r] = 0.f; }
#pragma unroll
            for (int kb = 0; kb < 4; ++kb)
#pragma unroll
                for (int sp = 0; sp < 2; ++sp) { const bf16x8 sf = pack_step(S[kb], sp);
                    const bf16x8 q0 = *(const LAS bf16x8*)(buf + HG_RDQT(2 * kb + sp)), q1 = *(const LAS bf16x8*)(buf + 8192 + HG_RDQT(2 * kb + sp));
                    o[0] = MFMA32(sf, krow_frag(q0), o[0]); o[1] = MFMA32(sf, krow_frag(q1), o[1]); }
            __builtin_amdgcn_sched_barrier(0);
#pragma unroll
            for (int kb = 0; kb < 4; ++kb) {
#pragma unroll
                for (int k4 = 0; k4 < 4; ++k4) {
                    const LAS unsigned char* ip = buf + (k4 >> 1) * 8192 + (k4 & 1) * 4096;
                    const v4i16_t lo = lds_tr(ip + rd_tr[kb][0]), hi4 = lds_tr(ip + rd_tr[kb][1]);
                    const bf16x8 af = __builtin_shufflevector(lo, hi4, 0, 1, 2, 3, 4, 5, 6, 7);
                    S[kb] = MFMA32(af, vfr[k4], S[kb]);
                }
#pragma unroll
                for (int g = 0; g < 4; ++g) { const f32x4 a = *(const LAS f32x4*)(dd + 128 + 32 * kb + 8 * g);
#pragma unroll
                    for (int i = 0; i < 4; ++i) S[kb][4 * g + i] *= a[i]; }
            }
            }
#if defined(PROBE_PHASE) && (PROBE_PHASE == 18)
            asm volatile("s_waitcnt lgkmcnt(0)" ::: "memory"); const unsigned long long tb_ = __builtin_amdgcn_s_memrealtime();
#endif
            asm volatile("s_waitcnt lgkmcnt(0)" ::: "memory"); __builtin_amdgcn_s_barrier(); asm volatile("" ::: "memory");
#if defined(PROBE_PHASE) && (PROBE_PHASE == 18)
            hg_wait_acc += __builtin_amdgcn_s_memrealtime() - tb_;
#endif
            if (c < NCHUNK) {
            { const LAS unsigned char* xr = F.lds + RING_OFF + HG_XS_OFF + lane * 16;
              o[0] = MFMA32(vfr[0], *(const LAS bf16x8*)(xr), o[0]); o[0] = MFMA32(vfr[1], *(const LAS bf16x8*)(xr + 1024), o[0]);
              o[1] = MFMA32(vfr[0], *(const LAS bf16x8*)(xr + 2048), o[1]); o[1] = MFMA32(vfr[1], *(const LAS bf16x8*)(xr + 3072), o[1]);
              o[1] = MFMA32(vfr[2], *(const LAS bf16x8*)(xr + 4096), o[1]); o[1] = MFMA32(vfr[3], *(const LAS bf16x8*)(xr + 5120), o[1]); }
#pragma unroll
            for (int tbi = 0; tbi < 2; ++tbi) { float q = 0.f;
#pragma unroll
              for (int r = 0; r < 16; ++r) q += o[tbi][r] * o[tbi][r];
              q = swapsum(q);
              if (hi == 0) psw[((c & 1) * 2 + tbi) * 128 + vb * 32 + r32] = q;
              LAS unsigned char* oxw = F.lds + RING_OFF + (c & 1) * HG_OX_BYTES + wr_ox + tbi * 32 * 264;
#pragma unroll
              for (int g = 0; g < 4; ++g) *(LAS pg8::u32x2*)(oxw + 16 * g) = (pg8::u32x2){cvtpk_s(o[tbi][4 * g], o[tbi][4 * g + 1]), cvtpk_s(o[tbi][4 * g + 2], o[tbi][4 * g + 3])}; }
            }
#if defined(PROBE_PHASE) && (PROBE_PHASE == 19)
            asm volatile("s_waitcnt vmcnt(0) lgkmcnt(0)" ::: "memory"); const unsigned long long te_ = __builtin_amdgcn_s_memrealtime();
#endif
            asm volatile("s_waitcnt vmcnt(0) lgkmcnt(0)" ::: "memory"); __builtin_amdgcn_s_barrier(); asm volatile("" ::: "memory");
#if defined(PROBE_PHASE) && (PROBE_PHASE == 19)
            hg_wait_acc += __builtin_amdgcn_s_memrealtime() - te_;
#endif
        }
#undef HG_RDKT
#undef HG_RDQT
    }
    __syncthreads();
}

struct Args { const float* in[17]; float* out; unsigned char* ws; int ph_lo, ph_hi, li, pad; };
__global__ void __launch_bounds__(NWAVES * 64, 2) mega_fwd(Args args) {
    extern __shared__ __attribute__((aligned(16))) unsigned char lds[];
    Frame F;
    F.lds = (LAS unsigned char*)lds;
    F.MISC = (volatile LAS unsigned*)(F.lds + MISC_OFF);
    F.tid = threadIdx.x; F.lane = F.tid & 63; F.wave = __builtin_amdgcn_readfirstlane(F.tid >> 6);
    F.G = gridDim.x;
#pragma unroll
    for (int i = 0; i < 17; ++i) F.in[i] = args.in[i];
    F.out = args.out; F.ws = args.ws;
    F.ctl = (gu32*)(args.ws + WS_CTL);
    for (int u = F.tid; u < (LDS_BYTES - LDSCTL_OFF) / 4; u += NWAVES * 64) ((LAS unsigned*)(F.lds + LDSCTL_OFF))[u] = 0u;
    __syncthreads();
    XcdBarrier bar; bar.bar = (unsigned*)(F.ctl + CW_BAR); bar.x = 0; bar.st = nullptr;
    if (N_LAUNCHES != PER_PHASE) bar = xcd_barrier_post((unsigned*)(F.ctl + CW_BAR), F.MISC + 8);
#define GRID_BAR(seam) do { if (N_LAUNCHES == PER_PHASE) { if (F.tid == 0) __hip_atomic_store(F.ctl + CW_TMO, 0xBADBA0u | (unsigned)(seam), RLX_AGENT); } else { xcd_barrier(bar); } } while (0)
    const int lo = args.ph_lo, hi = args.ph_hi;
#ifdef PROBE_PHASE
    unsigned long long ts_prev = __builtin_amdgcn_s_memrealtime(), ts_dt = 0ull; int ts_k = 0;
#define STAMP() do { const unsigned long long t_ = __builtin_amdgcn_s_memrealtime(); if (ts_k == PROBE_PHASE) ts_dt = t_ - ts_prev; ts_prev = t_; ++ts_k; } while (0)
#else
#define STAMP() do {} while (0)
#endif
#define IN(k) (lo <= (k) && (k) < hi)
#define BOTH(k) (IN(k) && IN((k) + 1))
    bf16* const XB = (bf16*)(F.ws + WS_XB); bf16* const HID = (bf16*)(F.ws + WS_HID); bf16* const MIXp = (bf16*)(F.ws + WS_MIX);
    float* const RS1 = (float*)(F.ws + WS_RS1); float* const RS2 = (float*)(F.ws + WS_RS2);
    const LAS float* const SCL = (const LAS float*)(F.lds + RING_OFF + RING_BYTES);

    if (IN(0)) { unsigned long long p0_probe = 0ull; p0_prologue(F, p0_probe);
#if defined(PROBE_PHASE) && (PROBE_PHASE == 13 || PROBE_PHASE == 14)
        ts_dt = p0_probe;
#endif
        if (BOTH(0)) GRID_BAR(0); STAMP(); }
    if (IN(1)) {
        pg8::Gemm g{XB, (const bf16*)(F.ws + WS_WGU1), M, 2 * FF, D}; pg8::StaticOrder S; S.init(M, 2 * FF, F.G, (int)blockIdx.x, WGM_GU);
        pg8::EpiSwiGLU E{HID, nullptr, SCL, FF};
        pg8::gemm_phase<pg8::EpiSwiGLU, pg8::StaticOrder, true, true>(F.lds + RING_OFF, g, S, E);
        if (BOTH(1)) GRID_BAR(1); STAMP();
    }
    if (IN(2)) {
        pg8::Gemm g{HID, (const bf16*)(F.ws + WS_WD1), M, D, FF}; pg8::StaticOrder S; S.init(M, D, F.G, (int)blockIdx.x, WGM_DOWN, REV_DOWN);
        pg8::EpiRes<0> E{F.in[0], nullptr, XB, RS1, 0.5f};
        pg8::gemm_phase<pg8::EpiRes<0>, pg8::StaticOrder, true, true>(F.lds + RING_OFF, g, S, E);
        if (BOTH(2)) GRID_BAR(2); STAMP();
    }
    if (IN(3)) {
        { pg8::Gemm g{XB, (const bf16*)(F.ws + WS_WIN), M, 2560, D}; pg8::StaticOrder S; S.init(M, 2560, F.G, (int)blockIdx.x, WGM_IN);
          pg8::EpiWin E{(bf16*)(F.ws + WS_Q), (bf16*)(F.ws + WS_K), (bf16*)(F.ws + WS_QT), (bf16*)(F.ws + WS_KT), (bf16*)(F.ws + WS_G), (float*)(F.ws + WS_DM), (float*)(F.ws + WS_DE), RS1, F.in[7], F.in[8], (const float*)(F.ws + WS_LB), SCL};
          pg8::gemm_phase<pg8::EpiWin, pg8::StaticOrder, true, true>(F.lds + RING_OFF, g, S, E); }
        { pg8::Gemm g{(const bf16*)(F.ws + WS_WINT), XB, 1024, M, D}; pg8::StaticOrder S; S.init(1024, M, F.G, (int)blockIdx.x, WGM_INT);
          pg8::EpiVT E{(bf16*)(F.ws + WS_VT), (bf16*)(F.ws + WS_VHT), RS1, SCL};
          pg8::gemm_phase<pg8::EpiVT, pg8::StaticOrder, true, true>(F.lds + RING_OFF, g, S, E); }
        if (BOTH(3)) GRID_BAR(3); STAMP();
    }
    if (IN(4)) {
#ifdef PROBE_PHASE
        const unsigned long long th00_ = __builtin_amdgcn_s_memrealtime();
#endif
#ifdef PROBE_PHASE
        const unsigned long long th0_ = __builtin_amdgcn_s_memrealtime();
        if (PROBE_PHASE == 9) ts_dt = th0_ - th00_;
#endif
        unsigned long long hg_wait_acc = 0ull;
        if (blockIdx.x < 64) hgrn_phase(F, (int)blockIdx.x, hg_wait_acc);
#ifdef PROBE_PHASE
        if (PROBE_PHASE >= 30 && PROBE_PHASE <= 33 && blockIdx.x < 64 && F.tid == 256) __hip_atomic_fetch_max(F.ctl + 8, (unsigned)hg_wait_acc, RLX_AGENT);
        if ((PROBE_PHASE == 18 || PROBE_PHASE == 19) && blockIdx.x < 64 && F.tid == 0) __hip_atomic_fetch_max(F.ctl + 8, (unsigned)hg_wait_acc, RLX_AGENT);
#endif
#ifdef PROBE_PHASE
        if (PROBE_PHASE == 8) ts_dt = __builtin_amdgcn_s_memrealtime() - th0_;
#endif
#ifdef PROBE_PHASE
        if (PROBE_PHASE == 15 && blockIdx.x < 64 && F.tid == 0) __hip_atomic_fetch_max(F.ctl + 8, (unsigned)(__builtin_amdgcn_s_memrealtime() - th0_), RLX_AGENT);
#endif
#ifdef PROBE_PHASE
        const unsigned long long ta0_ = __builtin_amdgcn_s_memrealtime();
#endif
        if (blockIdx.x >= 64) attn_phase(F);
#ifdef P4_DEAL_WEIGHTS
        if (blockIdx.x >= 64) {
            if (F.tid == 0) F.MISC[20] = __hip_atomic_fetch_add(F.ctl + 14, 1u, RLX_AGENT);
            __syncthreads();
            for (int k = 0;; ++k) {
                const unsigned tk = F.MISC[20 + (k & 1)];
                if ((int)tk * 2 * NWAVES >= P0_N1) break;
                if (F.tid == 0) F.MISC[20 + ((k + 1) & 1)] = __hip_atomic_fetch_add(F.ctl + 14, 1u, RLX_AGENT);
                p0_weights(F, 1, (int)tk * 2 * NWAVES + F.wave, NWAVES, ((int)tk + 1) * 2 * NWAVES);
                __syncthreads(); } }
#else
        if (blockIdx.x >= 64) p0_weights(F, 1, ((int)blockIdx.x - 64) * NWAVES + F.wave, (F.G - 64) * NWAVES);
#endif
#ifdef PROBE_PHASE
        if (PROBE_PHASE == 10) ts_dt = __builtin_amdgcn_s_memrealtime() - ta0_;
#endif
#ifdef PROBE_PHASE
        if (PROBE_PHASE == 16 && blockIdx.x >= 64 && F.tid == 0) __hip_atomic_fetch_max(F.ctl + 8, (unsigned)(__builtin_amdgcn_s_memrealtime() - th0_), RLX_AGENT);
        if (PROBE_PHASE == 17 && blockIdx.x < 64 && F.tid == 0) __hip_atomic_fetch_max(F.ctl + 8, (unsigned)(__builtin_amdgcn_s_memrealtime() - th0_), RLX_AGENT);
#endif
        if (BOTH(4)) GRID_BAR(4); STAMP();
    }
    if (IN(5)) {
        pg8::Gemm g{MIXp, (const bf16*)(F.ws + WS_WOUT), M, D, D}; pg8::StaticOrder S; S.init(M, D, F.G, (int)blockIdx.x, WGM_OUT);
        pg8::EpiRes<1> E{nullptr, nullptr, XB, RS2, 1.0f};
        pg8::gemm_phase<pg8::EpiRes<1>, pg8::StaticOrder, true, true>(F.lds + RING_OFF, g, S, E);
        if (BOTH(5)) GRID_BAR(5); STAMP();
    }
    if (IN(6)) {
        pg8::Gemm g{XB, (const bf16*)(F.ws + WS_WGU2), M, 2 * FF, D}; pg8::StaticOrder S; S.init(M, 2 * FF, F.G, (int)blockIdx.x, WGM_GU);
        pg8::EpiSwiGLU E{HID, RS2, SCL, FF};
        pg8::gemm_phase<pg8::EpiSwiGLU, pg8::StaticOrder, true, true>(F.lds + RING_OFF, g, S, E);
        if (BOTH(6)) GRID_BAR(6); STAMP();
    }
    if (IN(7)) {
        pg8::Gemm g{HID, (const bf16*)(F.ws + WS_WD2), M, D, FF}; pg8::StaticOrder S; S.init(M, D, F.G, (int)blockIdx.x, WGM_DOWN, REV_DOWN);
        pg8::EpiRes<2> E{nullptr, F.out, XB, nullptr, 0.5f};
        pg8::gemm_phase<pg8::EpiRes<2>, pg8::StaticOrder, true, true>(F.lds + RING_OFF, g, S, E);
    }
#ifdef PROBE_PHASE
    __syncthreads(); STAMP();
    if ((PROBE_PHASE >= 15 && PROBE_PHASE <= 19) || (PROBE_PHASE >= 30 && PROBE_PHASE <= 33)) ts_dt = __hip_atomic_load(F.ctl + 8, RLX_AGENT);
    if (blockIdx.x == (PROBE_PHASE == 10 ? 255 : 0) && F.tid == 0) { const unsigned long long t0_ = __builtin_amdgcn_s_memrealtime(); while (__builtin_amdgcn_s_memrealtime() - t0_ < 4ull * ts_dt) __builtin_amdgcn_s_sleep(8); }
#endif
#undef IN
#undef BOTH
}

extern "C" void kernel_launch(void* const* d_in, const int* in_sizes, int n_in, void* d_out, int out_size, void* d_ws, size_t ws_size, hipStream_t stream) {
    static int grid = 0;
    if (grid == 0) {
        if (n_in != 17 || in_sizes[0] != M * D || out_size != M * D || ws_size < WS_END) { fprintf(stderr, "kernel_launch: unexpected shapes (n_in %d, in0 %d, out %d, ws %zu); nothing launched\n", n_in, n_in > 0 ? in_sizes[0] : -1, out_size, ws_size); grid = -1; return; }
        int dev = 0, cus = 0, per_cu = 0;
        if (hipGetDevice(&dev) != hipSuccess || hipDeviceGetAttribute(&cus, hipDeviceAttributeMultiprocessorCount, dev) != hipSuccess) { grid = -1; return; }
        if (hipFuncSetAttribute((const void*)mega_fwd, hipFuncAttributeMaxDynamicSharedMemorySize, LDS_BYTES) != hipSuccess) { fprintf(stderr, "kernel_launch: hipFuncSetAttribute failed\n"); grid = -1; return; }
        if (hipOccupancyMaxActiveBlocksPerMultiprocessor(&per_cu, (const void*)mega_fwd, NWAVES * 64, LDS_BYTES) != hipSuccess || per_cu < 1) fprintf(stderr, "kernel_launch: note: occupancy query reports %d workgroups per CU\n", per_cu);
        (void)hipGetLastError();
        grid = cus;
    }
    if (grid < 0) return;
    if (hipMemsetAsync((char*)d_ws + WS_CTL, 0, CTL_ZERO_BYTES, stream) != hipSuccess) { fprintf(stderr, "kernel_launch: hipMemsetAsync failed\n"); return; }
    Args a{};
    for (int i = 0; i < 17; ++i) a.in[i] = (const float*)d_in[i];
    a.out = (float*)d_out; a.ws = (unsigned char*)d_ws;
    for (int li = 0; li < N_LAUNCHES; ++li) {
        a.ph_lo = (N_LAUNCHES == PER_PHASE) ? li : 0; a.ph_hi = (N_LAUNCHES == PER_PHASE) ? li + 1 : PER_PHASE; a.li = li;
        hipLaunchKernelGGL(mega_fwd, dim3(grid), dim3(NWAVES * 64), LDS_BYTES, stream, a);
        const hipError_t le = hipPeekAtLastError();
        if (le != hipSuccess) { fprintf(stderr, "kernel_launch: launch %d failed: %s\n", li, hipGetErrorName(le)); break; }
    }
}
```
